# Optimizing an MI355X kernel written in HIP

```python
import math
import jax, jax.numpy as jnp
from jax import lax
import numpy as np

D_MODEL = 1024
BATCH = 2
SEQ = 8192
DEPTH = 1

DN_HEADS = 8
DN_DK = 128
DN_DV = 128
DN_CONV = 4
DN_CHUNK = 64
MLA_HEADS = 8
MLA_DH = 128
MLA_DV = 128
Q_LORA = 256
KV_LORA = 256
IDX_HEADS = 8
IDX_DIM = 64
IDX_TOPK_MAX = 256
Q_BLOCK = 128
PEER_KEYS = 128
PEER_EXPERTS = PEER_KEYS * PEER_KEYS
PEER_HEADS = 8
PEER_DQ = 256
PEER_TOPK = 16
PEER_BLOCK = 128
EPS = 1e-6
IN_SPLITS = (DN_HEADS * DN_DK, DN_HEADS * DN_DK, DN_HEADS * DN_DV, DN_HEADS * DN_DV, DN_HEADS, DN_HEADS, Q_LORA, KV_LORA, IDX_DIM, IDX_HEADS, D_MODEL, D_MODEL)
IN_COLS = sum(IN_SPLITS)

kernel_name = 'hybrid_deltanet_dsa_peer_block'


def rmsnorm(x, w):
    xf = x.astype(jnp.float32)
    y = xf * lax.rsqrt(jnp.mean(xf * xf, axis=-1, keepdims=True) + EPS)
    return (y * w.astype(jnp.float32)).astype(x.dtype)


def l2norm(x):
    xf = x.astype(jnp.float32)
    return xf * lax.rsqrt(jnp.sum(xf * xf, axis=-1, keepdims=True) + EPS)


def causal_conv(x, w):
    K = w.shape[0]
    L = x.shape[1]
    xp = jnp.pad(x, ((0, 0), (K - 1, 0), (0, 0)))
    return sum(xp[:, i:i + L] * w[i] for i in range(K))


def to_blocks(a, blk):
    B, L = a.shape[:2]
    a = a.reshape((B, L // blk, blk) + a.shape[2:])
    return jnp.moveaxis(a, 1, 0)


def from_blocks(a):
    a = jnp.moveaxis(a, 0, 1)
    return a.reshape((a.shape[0], a.shape[1] * a.shape[2]) + a.shape[3:])


def gated_delta_rule(q, k, v, g, beta):
    B, L, H, dk = q.shape
    dv = v.shape[-1]
    C = DN_CHUNK
    n = L // C
    f32 = jnp.float32

    def chunk(a):
        a = jnp.moveaxis(a.astype(f32), 2, 1)
        return a.reshape((B, H, n, C) + a.shape[3:])

    q, k, v, g, beta = map(chunk, (q, k, v, g, beta))
    q = q * (dk ** -0.5)
    g = jnp.cumsum(g, axis=-1)
    tril = jnp.tril(jnp.ones((C, C), bool))
    strict = jnp.tril(jnp.ones((C, C), bool), -1)
    decay = jnp.exp(jnp.where(tril, g[..., :, None] - g[..., None, :], -jnp.inf))
    kb = k * beta[..., None]
    A = jnp.where(strict, jnp.einsum('bhncd,bhnsd->bhncs', kb, k) * decay, 0.0)
    eye = jnp.eye(C, dtype=f32)
    rhs = jnp.concatenate([v * beta[..., None], kb * jnp.exp(g)[..., None]], axis=-1)
    sol = lax.linalg.triangular_solve(A + eye, rhs, left_side=True, lower=True)
    u, w = sol[..., :dv], sol[..., dv:]
    attn = jnp.where(tril, jnp.einsum('bhncd,bhnsd->bhncs', q, k) * decay, 0.0)
    q_dec = q * jnp.exp(g)[..., None]
    k_dec = k * jnp.exp(g[..., -1:] - g)[..., None]
    g_last = jnp.exp(g[..., -1])

    def step(S, xs):
        qd, kd, u_c, w_c, a_c, gl = xs
        v_new = u_c - jnp.einsum('bhcd,bhde->bhce', w_c, S)
        o = jnp.einsum('bhcd,bhde->bhce', qd, S) + jnp.einsum('bhcs,bhse->bhce', a_c, v_new)
        S = S * gl[..., None, None] + jnp.einsum('bhcd,bhce->bhde', kd, v_new)
        return S, o

    xs = tuple(jnp.moveaxis(a, 2, 0) for a in (q_dec, k_dec, u, w, attn, g_last))
    S0 = jnp.zeros((B, H, dk, dv), f32)
    _, o = lax.scan(step, S0, xs)
    o = jnp.moveaxis(o, 0, 2).reshape(B, H, L, dv)
    return jnp.moveaxis(o, 1, 2)


def dsa_branch(q_lat, c_kv, k_idx, w_idx, q_norm_w, kv_norm_w, idx_k_norm_w, w_uq, w_iq, w_uk, w_uv):
    B, L, _ = q_lat.shape
    f32 = jnp.float32
    topk = min(IDX_TOPK_MAX, L // 4)
    q_lat = rmsnorm(q_lat, q_norm_w)
    c_kv = rmsnorm(c_kv, kv_norm_w)
    k_idx = rmsnorm(k_idx, idx_k_norm_w).astype(f32)
    q = (q_lat @ w_uq).reshape(B, L, MLA_HEADS, MLA_DH)
    q_idx = (q_lat @ w_iq).reshape(B, L, IDX_HEADS, IDX_DIM).astype(f32)
    w_idx = w_idx.astype(f32) * (IDX_HEADS ** -0.5 * IDX_DIM ** -0.5)
    q_abs = jnp.einsum('blhd,chd->blhc', q, w_uk) * (MLA_DH ** -0.5)
    key_pos = jnp.arange(L)

    def block(xs):
        qa, qi, wi, t0 = xs
        tq = t0 + jnp.arange(Q_BLOCK)
        s = jax.nn.relu(jnp.einsum('bqhd,bkd->bqhk', qi, k_idx))
        score = jnp.einsum('bqhk,bqh->bqk', s, wi)
        score = jnp.where(key_pos[None, None, :] <= tq[None, :, None], score, -jnp.inf)
        _, idx = lax.top_k(score, topk)
        valid = idx <= tq[None, :, None]
        kv = jax.vmap(lambda ckv, i: ckv[i])(c_kv, idx)
        logits = jnp.einsum('bqhc,bqkc->bqhk', qa, kv).astype(f32)
        logits = jnp.where(valid[:, :, None, :], logits, -jnp.inf)
        p = jax.nn.softmax(logits, axis=-1).astype(kv.dtype)
        return jnp.einsum('bqhk,bqkc->bqhc', p, kv)

    nb = L // Q_BLOCK
    xs = (to_blocks(q_abs, Q_BLOCK), to_blocks(q_idx, Q_BLOCK), to_blocks(w_idx, Q_BLOCK),
          jnp.arange(nb, dtype=jnp.int32) * Q_BLOCK)
    o_lat = from_blocks(lax.map(block, xs))
    o = jnp.einsum('blhc,chd->blhd', o_lat, w_uv)
    return o.reshape(B, L, MLA_HEADS * MLA_DV)


def mixer(h, w_in, dn_conv_w, dn_a_log, dn_dt_bias, dn_onorm_w, q_norm_w, kv_norm_w, idx_k_norm_w,
          w_uq, w_iq, w_uk, w_uv, w_a_out, w_b_out, w_o):
    B, L, _ = h.shape
    f32 = jnp.float32
    offs = np.cumsum(IN_SPLITS)[:-1].tolist()
    q, k, v, z, b, a, q_lat, c_kv, k_idx, w_idx, g_a, g_b = jnp.split(h @ w_in, offs, axis=-1)
    qkv = jax.nn.silu(causal_conv(jnp.concatenate([q, k, v], axis=-1), dn_conv_w))
    q, k, v = jnp.split(qkv, [DN_HEADS * DN_DK, 2 * DN_HEADS * DN_DK], axis=-1)
    q = l2norm(q.reshape(B, L, DN_HEADS, DN_DK))
    k = l2norm(k.reshape(B, L, DN_HEADS, DN_DK))
    v = v.reshape(B, L, DN_HEADS, DN_DV)
    beta = jax.nn.sigmoid(b.astype(f32))
    g = -jnp.exp(dn_a_log.astype(f32)) * jax.nn.softplus(a.astype(f32) + dn_dt_bias.astype(f32))
    o = gated_delta_rule(q, k, v, g, beta).astype(h.dtype)
    o = rmsnorm(o, dn_onorm_w) * jax.nn.silu(z.reshape(B, L, DN_HEADS, DN_DV))
    y_a = o.reshape(B, L, DN_HEADS * DN_DV) @ w_a_out
    y_b = dsa_branch(q_lat, c_kv, k_idx, w_idx, q_norm_w, kv_norm_w, idx_k_norm_w, w_uq, w_iq, w_uk, w_uv) @ w_b_out
    m = jax.nn.sigmoid(g_a) * y_a + jax.nn.sigmoid(g_b) * y_b
    return m @ w_o


def peer(h, w_q, sub_keys, u_emb, v_emb):
    B, L, _ = h.shape
    f32 = jnp.float32
    q = (h @ w_q).reshape(B, L, PEER_HEADS, 2, PEER_DQ // 2)
    s = jnp.einsum('blhpd,hpnd->blhpn', q, sub_keys).astype(f32)
    sv, si = lax.top_k(s, PEER_TOPK)
    cand = sv[..., 0, :, None] + sv[..., 1, None, :]
    cand_idx = si[..., 0, :, None] * PEER_KEYS + si[..., 1, None, :]
    top_v, top_j = lax.top_k(cand.reshape(B, L, PEER_HEADS, PEER_TOPK * PEER_TOPK), PEER_TOPK)
    experts = jnp.take_along_axis(cand_idx.reshape(B, L, PEER_HEADS, PEER_TOPK * PEER_TOPK), top_j, axis=-1)
    gates = jax.nn.softmax(top_v, axis=-1).astype(h.dtype)
    E = PEER_HEADS * PEER_TOPK
    experts = experts.reshape(B, L, E)
    gates = gates.reshape(B, L, E)

    def block(xs):
        hb, eb, gb = xs
        act = jax.nn.gelu(jnp.einsum('bted,btd->bte', u_emb[eb], hb), approximate=False) * gb
        return jnp.einsum('bte,bted->btd', act, v_emb[eb])

    xs = (to_blocks(h, PEER_BLOCK), to_blocks(experts, PEER_BLOCK), to_blocks(gates, PEER_BLOCK))
    return from_blocks(lax.map(block, xs))


def setup_inputs(seed: int = 0) -> dict:
    key = jax.random.key(seed)
    ks = iter(jax.random.split(key, 40))

    def nrm(shape, scale):
        return jax.random.normal(next(ks), shape, jnp.float32) * scale

    def gain(shape):
        return 1.0 + nrm(shape, 0.02)

    Dp = DEPTH
    D = D_MODEL
    x = nrm((BATCH, SEQ, D), 1.0)
    c = nrm((BATCH, D), 1.0)
    w_ada = nrm((Dp, D, 6 * D), D ** -0.5)
    b_ada = nrm((Dp, 6 * D), 0.02)
    norm1_w = gain((Dp, D))
    w_in = nrm((Dp, D, IN_COLS), D ** -0.5)
    dn_conv_w = nrm((Dp, DN_CONV, DN_HEADS * (2 * DN_DK + DN_DV)), DN_CONV ** -0.5)
    dn_a_log = jnp.log(jax.random.uniform(next(ks), (Dp, DN_HEADS), jnp.float32, 1.0, 16.0))
    dt = jnp.exp(jax.random.uniform(next(ks), (Dp, DN_HEADS), jnp.float32, math.log(1e-3), math.log(1e-1)))
    dn_dt_bias = dt + jnp.log(-jnp.expm1(-dt))
    dn_onorm_w = gain((Dp, DN_DV))
    q_norm_w = gain((Dp, Q_LORA))
    kv_norm_w = gain((Dp, KV_LORA))
    idx_k_norm_w = gain((Dp, IDX_DIM))
    w_uq = nrm((Dp, Q_LORA, MLA_HEADS * MLA_DH), Q_LORA ** -0.5)
    w_iq = nrm((Dp, Q_LORA, IDX_HEADS * IDX_DIM), Q_LORA ** -0.5)
    w_uk = nrm((Dp, KV_LORA, MLA_HEADS, MLA_DH), KV_LORA ** -0.5)
    w_uv = nrm((Dp, KV_LORA, MLA_HEADS, MLA_DV), KV_LORA ** -0.5)
    w_a_out = nrm((Dp, DN_HEADS * DN_DV, D), (DN_HEADS * DN_DV) ** -0.5)
    w_b_out = nrm((Dp, MLA_HEADS * MLA_DV, D), (MLA_HEADS * MLA_DV) ** -0.5)
    w_o = nrm((Dp, D, D), D ** -0.5)
    norm2_w = gain((Dp, D))
    peer_w_q = nrm((Dp, D, PEER_HEADS * PEER_DQ), D ** -0.5)
    peer_sub_keys = nrm((Dp, PEER_HEADS, 2, PEER_KEYS, PEER_DQ // 2), (PEER_DQ // 2) ** -0.5)
    peer_u = nrm((Dp, PEER_EXPERTS, D), D ** -0.5)
    peer_v = nrm((Dp, PEER_EXPERTS, D), 0.2)
    final_norm_w = gain((D,))
    return {'x': x, 'c': c, 'w_ada': w_ada, 'b_ada': b_ada, 'norm1_w': norm1_w, 'w_in': w_in,
            'dn_conv_w': dn_conv_w, 'dn_a_log': dn_a_log, 'dn_dt_bias': dn_dt_bias, 'dn_onorm_w': dn_onorm_w,
            'q_norm_w': q_norm_w, 'kv_norm_w': kv_norm_w, 'idx_k_norm_w': idx_k_norm_w,
            'w_uq': w_uq, 'w_iq': w_iq, 'w_uk': w_uk, 'w_uv': w_uv,
            'w_a_out': w_a_out, 'w_b_out': w_b_out, 'w_o': w_o, 'norm2_w': norm2_w,
            'peer_w_q': peer_w_q, 'peer_sub_keys': peer_sub_keys, 'peer_u': peer_u, 'peer_v': peer_v,
            'final_norm_w': final_norm_w}


def reference(x, c, w_ada, b_ada, norm1_w, w_in, dn_conv_w, dn_a_log, dn_dt_bias, dn_onorm_w,
              q_norm_w, kv_norm_w, idx_k_norm_w, w_uq, w_iq, w_uk, w_uv, w_a_out, w_b_out, w_o,
              norm2_w, peer_w_q, peer_sub_keys, peer_u, peer_v, final_norm_w):
    B = x.shape[0]
    for l in range(DEPTH):
        mod = (jax.nn.silu(c) @ w_ada[l] + b_ada[l]).reshape(B, 6, D_MODEL)
        sh1, sc1, gt1, sh2, sc2, gt2 = [mod[:, i, None, :] for i in range(6)]
        h = rmsnorm(x, norm1_w[l]) * (1.0 + sc1) + sh1
        x = x + gt1 * mixer(h, w_in[l], dn_conv_w[l], dn_a_log[l], dn_dt_bias[l], dn_onorm_w[l],
                            q_norm_w[l], kv_norm_w[l], idx_k_norm_w[l], w_uq[l], w_iq[l], w_uk[l], w_uv[l],
                            w_a_out[l], w_b_out[l], w_o[l])
        h = rmsnorm(x, norm2_w[l]) * (1.0 + sc2) + sh2
        x = x + gt2 * peer(h, peer_w_q[l], peer_sub_keys[l], peer_u[l], peer_v[l])
    return rmsnorm(x, final_norm_w)
```

```cpp
#include <hip/hip_runtime.h>
#include <cstdio>
#include <cstdint>
#define HD __host__ __device__ __forceinline__
#ifndef HD
#define HD
#endif

typedef unsigned short bf16_t;
HD float bf2f(bf16_t v) { unsigned u = ((unsigned)v) << 16; float f; __builtin_memcpy(&f, &u, 4); return f; }
HD bf16_t f2bf(float f) { unsigned u; __builtin_memcpy(&u, &f, 4); u = (u + 0x7fffu + ((u >> 16) & 1u)) >> 16; return (bf16_t)u; }
HD float siluf(float x) { return x / (1.f + expf(-x)); }
HD float sigmf(float x) { return 1.f / (1.f + expf(-x)); }
HD float softplusf(float x) { return x > 20.f ? x : log1pf(expf(x)); }
HD float geluf(float x) { return 0.5f * x * (1.f + erff(x * 0.70710678118654752f)); }

struct CfgFull {
    static constexpr int D = 1024, B = 2, L = 8192;
    static constexpr int DNH = 8, DK = 128, DV = 128, CONV = 4, CH = 64;
    static constexpr int MH = 8, MDH = 128, MDV = 128, QL = 256, KVL = 256;
    static constexpr int IH = 8, ID = 64, TOPK_MAX = 256;
    static constexpr int PK = 128, PH = 8, PDQ = 256, PTK = 16;
};
struct CfgSmall {
    static constexpr int D = 64, B = 2, L = 512;
    static constexpr int DNH = 2, DK = 16, DV = 16, CONV = 4, CH = 64;
    static constexpr int MH = 2, MDH = 16, MDV = 16, QL = 32, KVL = 32;
    static constexpr int IH = 4, ID = 16, TOPK_MAX = 64;
    static constexpr int PK = 16, PH = 2, PDQ = 32, PTK = 4;
};
template <class C> struct Dims {
    static constexpr int T = C::B * C::L, HK = C::DNH * C::DK, HV = C::DNH * C::DV, QKVC = 2 * HK + HV;
    static constexpr int NCH = C::L / C::CH, NCHUNKS = C::B * C::DNH * NCH;
    static constexpr int TOPK = (C::TOPK_MAX < C::L / 4) ? C::TOPK_MAX : C::L / 4;
    static constexpr int PE = C::PK * C::PK, SLOTS = C::PH * C::PTK, PD2 = C::PDQ / 2;
    static constexpr int OFF_Q = 0, OFF_K = HK, OFF_V = 2 * HK, OFF_Z = 2 * HK + HV, OFF_B = OFF_Z + HV, OFF_A = OFF_B + C::DNH,
                         OFF_QL = OFF_A + C::DNH, OFF_CKV = OFF_QL + C::QL, OFF_KI = OFF_CKV + C::KVL, OFF_WI = OFF_KI + C::ID,
                         OFF_GA = OFF_WI + C::IH, OFF_GB = OFF_GA + C::D, IN_COLS = OFF_GB + C::D;
    static constexpr float EPS = 1e-6f;
};

struct NP {
    const float *x, *c, *w_ada, *b_ada, *norm1_w, *w_in, *dn_conv_w, *dn_a_log, *dn_dt_bias, *dn_onorm_w, *q_norm_w, *kv_norm_w, *idx_k_norm_w,
        *w_uq, *w_iq, *w_uk, *w_uv, *w_a_out, *w_b_out, *w_o, *norm2_w, *peer_w_q, *peer_sub_keys, *peer_u, *peer_v, *final_norm_w;
    float* out;
    float* MOD; bf16_t* H1; bf16_t* QKVP; bf16_t* QKVN; bf16_t* Z; bf16_t* GA; bf16_t* GB;
    float *BETA, *G, *GC, *GL, *QLATR, *CKVR, *KIDXR, *WIDX; bf16_t *QLATN, *CKVN, *KIDXN;
    float* AMAT; bf16_t* ATT; bf16_t* W; bf16_t* O; bf16_t* OG;
    float *QF, *QIDX; bf16_t* QABS; int* IDX; bf16_t* OLAT; bf16_t* OATT; bf16_t* M; float* X1; bf16_t* H2;
    float* PQ; int* EXPI; float* GATE; float* ACT;
    float* SCRP;
};
#define SCR(w) P.SCRP[(size_t)(w) * NT + tid]

template <class C> struct WsMap {
    typedef Dims<C> Dm;
    static constexpr size_t al(size_t x) { return (x + 255) & ~(size_t)255; }
    static constexpr size_t mx(size_t a, size_t b) { return a > b ? a : b; }
    static constexpr size_t SZ_QKV = al((size_t)Dm::T * Dm::QKVC * 2);
    static constexpr size_t S1a = al(mx((size_t)Dm::T * C::MH * C::KVL * 2, (size_t)Dm::T * C::D * 4));
    static constexpr size_t S1b = al(mx(mx((size_t)Dm::T * Dm::TOPK * 4, (size_t)Dm::T * C::MH * C::MDV * 2), (size_t)Dm::T * C::D * 2));
    static constexpr size_t RAW = al((size_t)Dm::T * C::QL * 4) + al((size_t)Dm::T * C::KVL * 4) + al((size_t)Dm::T * C::ID * 4);
    static constexpr size_t SZ_A1 = mx(mx(SZ_QKV, RAW), S1a + S1b);
    static constexpr size_t SZ_AAW = al((size_t)Dm::NCHUNKS * C::CH * C::CH * 4) + al((size_t)Dm::NCHUNKS * C::CH * C::CH * 2) + al((size_t)Dm::NCHUNKS * C::CH * C::DK * 2);
    static constexpr size_t SZ_QQ = al((size_t)Dm::T * C::MH * C::MDH * 4) + al((size_t)Dm::T * C::IH * C::ID * 4);
    static constexpr size_t SZ_ZGG = al((size_t)Dm::T * Dm::HV * 2) + 2 * al((size_t)Dm::T * C::D * 2);
    static constexpr size_t SZ_A0 = mx(mx(SZ_QKV, SZ_AAW), mx(SZ_QQ, SZ_ZGG));
    static constexpr size_t A1 = 1 << 20, A0 = A1 + SZ_A1, A2 = A0 + SZ_A0;
    static constexpr size_t o_MOD = 4096, o_BETA = A2, o_G = o_BETA + al((size_t)Dm::T * C::DNH * 4), o_GC = o_G + al((size_t)Dm::T * C::DNH * 4),
        o_GL = o_GC + al((size_t)Dm::T * C::DNH * 4), o_WIDX = o_GL + al((size_t)Dm::NCHUNKS * 4), o_QLATN = o_WIDX + al((size_t)Dm::T * C::IH * 4),
        o_CKVN = o_QLATN + al((size_t)Dm::T * C::QL * 2), o_KIDXN = o_CKVN + al((size_t)Dm::T * C::KVL * 2), A3 = o_KIDXN + al((size_t)Dm::T * C::ID * 2);
    static constexpr size_t SCR_BYTES = 16u << 20;
    static constexpr size_t o_PQ = A0;
    static constexpr size_t END = mx(A3 + SCR_BYTES, o_PQ + al((size_t)Dm::T * C::PH * C::PDQ * 4));
    static_assert(o_MOD + (size_t)C::B * 6 * C::D * 4 <= A1, "MOD in the first MiB");
    static constexpr size_t o_QLATR = A1, o_CKVR = o_QLATR + al((size_t)Dm::T * C::QL * 4), o_KIDXR = o_CKVR + al((size_t)Dm::T * C::KVL * 4);
    static constexpr size_t o_AMAT = A0, o_ATT = o_AMAT + al((size_t)Dm::NCHUNKS * C::CH * C::CH * 4), o_W = o_ATT + al((size_t)Dm::NCHUNKS * C::CH * C::CH * 2);
    static constexpr size_t o_QF = A0, o_QIDX = o_QF + al((size_t)Dm::T * C::MH * C::MDH * 4);
    static constexpr size_t o_QABS = A1, o_IDX = A1 + S1a;
    static constexpr size_t o_Z = A0, o_GA = o_Z + al((size_t)Dm::T * Dm::HV * 2), o_GB = o_GA + al((size_t)Dm::T * C::D * 2);
    static constexpr size_t o_OATT = o_IDX, o_X1 = A1, o_H2 = o_IDX;
    static constexpr size_t d_H1 = 0, d_O = al((size_t)Dm::T * C::D * 2), d_OG = 0, d_M = d_O;
    static constexpr size_t d_EXPI = 0, d_GATE = al((size_t)Dm::T * Dm::SLOTS * 4), d_ACT = 2 * d_GATE, d_SCR = (size_t)Dm::T * C::D * 2;
    static_assert(d_O + (size_t)Dm::T * Dm::HV * 2 <= (size_t)Dm::T * C::D * 4 && d_ACT + (size_t)Dm::T * Dm::SLOTS * 4 <= d_SCR, "d_out scratch");
};

template <class C> inline void np_setup(NP& P, void* const* d_in, void* d_out, void* d_ws) {
    typedef WsMap<C> W;
    const float** f = (const float**)&P.x;
    for (int i = 0; i < 26; ++i) f[i] = (const float*)d_in[i];
    char* ws = (char*)d_ws; char* dob = (char*)d_out;
    P.out = (float*)d_out;
    P.MOD = (float*)(ws + W::o_MOD); P.H1 = (bf16_t*)(dob + W::d_H1); P.QKVP = (bf16_t*)(ws + W::A0); P.QKVN = (bf16_t*)(ws + W::A1);
    P.Z = (bf16_t*)(ws + W::o_Z); P.GA = (bf16_t*)(ws + W::o_GA); P.GB = (bf16_t*)(ws + W::o_GB);
    P.BETA = (float*)(ws + W::o_BETA); P.G = (float*)(ws + W::o_G); P.GC = (float*)(ws + W::o_GC); P.GL = (float*)(ws + W::o_GL);
    P.QLATR = (float*)(ws + W::o_QLATR); P.CKVR = (float*)(ws + W::o_CKVR); P.KIDXR = (float*)(ws + W::o_KIDXR); P.WIDX = (float*)(ws + W::o_WIDX);
    P.QLATN = (bf16_t*)(ws + W::o_QLATN); P.CKVN = (bf16_t*)(ws + W::o_CKVN); P.KIDXN = (bf16_t*)(ws + W::o_KIDXN);
    P.AMAT = (float*)(ws + W::o_AMAT); P.ATT = (bf16_t*)(ws + W::o_ATT); P.W = (bf16_t*)(ws + W::o_W); P.O = (bf16_t*)(dob + W::d_O); P.OG = (bf16_t*)(dob + W::d_OG);
    P.QF = (float*)(ws + W::o_QF); P.QIDX = (float*)(ws + W::o_QIDX); P.QABS = (bf16_t*)(ws + W::o_QABS); P.IDX = (int*)(ws + W::o_IDX); P.OLAT = P.QABS;
    P.OATT = (bf16_t*)(ws + W::o_OATT); P.M = (bf16_t*)(dob + W::d_M); P.X1 = (float*)(ws + W::o_X1); P.H2 = (bf16_t*)(ws + W::o_H2);
    P.PQ = (float*)(ws + W::o_PQ); P.EXPI = (int*)(dob + W::d_EXPI); P.GATE = (float*)(dob + W::d_GATE); P.ACT = (float*)(dob + W::d_ACT);
    P.SCRP = (float*)(ws + W::A3);
}

enum { ST_MOD = 0, ST_H1, ST_INPROJ_A, ST_DSANORM, ST_CONV, ST_GC, ST_AMAT, ST_SOLVE, ST_SCALE, ST_SCAN, ST_Q, ST_QABS, ST_INDEX, ST_ATTN,
       ST_INPROJ_B, ST_OGATE, ST_OATT, ST_MERGE, ST_WO, ST_H2, ST_PEERQ, ST_ROUTE, ST_PACT, ST_POUT, ST_FINAL, ST_COUNT };

template <class C> HD void n_mod(const NP& P, int item) {
    const int D = C::D; const int b = item / (6 * D), j = item % (6 * D);
    float acc = P.b_ada[j];
    for (int i = 0; i < D; ++i) acc += siluf(P.c[b * D + i]) * P.w_ada[(size_t)i * 6 * D + j];
    P.MOD[item] = acc;
}
template <class C> HD void n_h1(const NP& P, int t) {
    const int D = C::D; const int b = t / C::L; const float* xr = P.x + (size_t)t * D;
    float ss = 0.f; for (int i = 0; i < D; ++i) ss += xr[i] * xr[i];
    const float rstd = 1.f / sqrtf(ss / D + Dims<C>::EPS);
    const float* sh = P.MOD + (size_t)b * 6 * D; const float* sc = sh + D;
    for (int i = 0; i < D; ++i) P.H1[(size_t)t * D + i] = f2bf(xr[i] * rstd * P.norm1_w[i] * (1.f + sc[i]) + sh[i]);
}
template <class C> HD void inproj_store(const NP& P, int t, int n, float v) {
    typedef Dims<C> Dm;
    if (n < Dm::OFF_Z) P.QKVP[(size_t)t * Dm::QKVC + n] = f2bf(v);
    else if (n < Dm::OFF_B) P.Z[(size_t)t * Dm::HV + (n - Dm::OFF_Z)] = f2bf(v);
    else if (n < Dm::OFF_A) P.BETA[(size_t)t * C::DNH + (n - Dm::OFF_B)] = sigmf(v);
    else if (n < Dm::OFF_QL) { const int h = n - Dm::OFF_A; P.G[(size_t)t * C::DNH + h] = -expf(P.dn_a_log[h]) * softplusf(v + P.dn_dt_bias[h]); }
    else if (n < Dm::OFF_CKV) P.QLATR[(size_t)t * C::QL + (n - Dm::OFF_QL)] = v;
    else if (n < Dm::OFF_KI) P.CKVR[(size_t)t * C::KVL + (n - Dm::OFF_CKV)] = v;
    else if (n < Dm::OFF_WI) P.KIDXR[(size_t)t * C::ID + (n - Dm::OFF_KI)] = v;
    else if (n < Dm::OFF_GA) P.WIDX[(size_t)t * C::IH + (n - Dm::OFF_WI)] = v * (1.f / sqrtf((float)C::IH) / sqrtf((float)C::ID));
    else if (n < Dm::OFF_GB) P.GA[(size_t)t * C::D + (n - Dm::OFF_GA)] = f2bf(v);
    else P.GB[(size_t)t * C::D + (n - Dm::OFF_GB)] = f2bf(v);
}
template <class C> HD void n_inproj(const NP& P, int item, int c0, int c1) {
    typedef Dims<C> Dm; const int ng = (c1 - c0) / 4; const int t = item / ng, n = c0 + 4 * (item % ng);
    float a0 = 0, a1 = 0, a2 = 0, a3 = 0; const bf16_t* hr = P.H1 + (size_t)t * C::D;
    for (int k = 0; k < C::D; ++k) { const float h = bf2f(hr[k]); const float* w = P.w_in + (size_t)k * Dm::IN_COLS + n; a0 += h * w[0]; a1 += h * w[1]; a2 += h * w[2]; a3 += h * w[3]; }
    inproj_store<C>(P, t, n, a0); inproj_store<C>(P, t, n + 1, a1); inproj_store<C>(P, t, n + 2, a2); inproj_store<C>(P, t, n + 3, a3);
}
template <class C> HD void n_dsanorm(const NP& P, int t) {
    typedef Dims<C> Dm;
    { const float* r = P.QLATR + (size_t)t * C::QL; float ss = 0; for (int i = 0; i < C::QL; ++i) ss += r[i] * r[i]; const float rs = 1.f / sqrtf(ss / C::QL + Dm::EPS);
      for (int i = 0; i < C::QL; ++i) P.QLATN[(size_t)t * C::QL + i] = f2bf(r[i] * rs * P.q_norm_w[i]); }
    { const float* r = P.CKVR + (size_t)t * C::KVL; float ss = 0; for (int i = 0; i < C::KVL; ++i) ss += r[i] * r[i]; const float rs = 1.f / sqrtf(ss / C::KVL + Dm::EPS);
      for (int i = 0; i < C::KVL; ++i) P.CKVN[(size_t)t * C::KVL + i] = f2bf(r[i] * rs * P.kv_norm_w[i]); }
    { const float* r = P.KIDXR + (size_t)t * C::ID; float ss = 0; for (int i = 0; i < C::ID; ++i) ss += r[i] * r[i]; const float rs = 1.f / sqrtf(ss / C::ID + Dm::EPS);
      for (int i = 0; i < C::ID; ++i) P.KIDXN[(size_t)t * C::ID + i] = f2bf(r[i] * rs * P.idx_k_norm_w[i]); }
}
template <class C> HD float conv_at(const NP& P, int t, int ch) {
    typedef Dims<C> Dm; const int l = t % C::L; float acc = 0.f;
    for (int i = 0; i < C::CONV; ++i) { const int ll = l - (C::CONV - 1) + i; if (ll >= 0) acc += bf2f(P.QKVP[(size_t)(t - (C::CONV - 1) + i) * Dm::QKVC + ch]) * P.dn_conv_w[(size_t)i * Dm::QKVC + ch]; }
    return siluf(acc);
}
template <class C> HD void n_conv(const NP& P, int item) {
    typedef Dims<C> Dm; const int which = item % 3, h = (item / 3) % C::DNH, t = item / (3 * C::DNH);
    const int dim = (which == 2) ? C::DV : C::DK; const int ch0 = (which == 0 ? 0 : which == 1 ? Dm::HK : 2 * Dm::HK) + h * dim;
    float rs = 1.f;
    if (which < 2) { float ss = 0.f; for (int d = 0; d < dim; ++d) { const float v = conv_at<C>(P, t, ch0 + d); ss += v * v; } rs = 1.f / sqrtf(ss + Dm::EPS); }
    for (int d = 0; d < dim; ++d) P.QKVN[(size_t)t * Dm::QKVC + ch0 + d] = f2bf(conv_at<C>(P, t, ch0 + d) * rs);
}
template <class C> HD void n_gc(const NP& P, int item) {
    typedef Dims<C> Dm; const int n = item % Dm::NCH, h = (item / Dm::NCH) % C::DNH, b = item / (Dm::NCH * C::DNH);
    float s = 0.f; for (int i = 0; i < C::CH; ++i) { const size_t t = (size_t)b * C::L + n * C::CH + i; s += P.G[t * C::DNH + h]; P.GC[t * C::DNH + h] = s; }
    P.GL[item] = expf(s);
}
template <class C> HD void n_amat(const NP& P, int item) {
    typedef Dims<C> Dm; const int j = item % C::CH, i = (item / C::CH) % C::CH, cid = item / (C::CH * C::CH);
    const int n = cid % Dm::NCH, h = (cid / Dm::NCH) % C::DNH, b = cid / (Dm::NCH * C::DNH);
    const size_t ti = (size_t)b * C::L + n * C::CH + i, tj = (size_t)b * C::L + n * C::CH + j;
    float a = 0.f, at = 0.f;
    if (j <= i) {
        const bf16_t* ki = P.QKVN + ti * Dm::QKVC + Dm::HK + h * C::DK; const bf16_t* kj = P.QKVN + tj * Dm::QKVC + Dm::HK + h * C::DK; const bf16_t* qi = P.QKVN + ti * Dm::QKVC + h * C::DK;
        float kk = 0.f, qk = 0.f; for (int d = 0; d < C::DK; ++d) { const float kjd = bf2f(kj[d]); kk += bf2f(ki[d]) * kjd; qk += bf2f(qi[d]) * kjd; }
        const float dec = expf(P.GC[ti * C::DNH + h] - P.GC[tj * C::DNH + h]);
        if (j < i) a = P.BETA[ti * C::DNH + h] * kk * dec;
        at = qk * (1.f / sqrtf((float)C::DK)) * dec;
    }
    P.AMAT[(size_t)cid * C::CH * C::CH + i * C::CH + j] = a;
    P.ATT[(size_t)cid * C::CH * C::CH + i * C::CH + j] = f2bf(at);
}
template <class C> HD void n_solve(const NP& P, int item, int tid, int NT) {
    typedef Dims<C> Dm; const int NC = C::DV + C::DK; const int col = item % NC, cid = item / NC;
    const int n = cid % Dm::NCH, h = (cid / Dm::NCH) % C::DNH, b = cid / (Dm::NCH * C::DNH);
    const float* A = P.AMAT + (size_t)cid * C::CH * C::CH;
    for (int i = 0; i < C::CH; ++i) {
        const size_t t = (size_t)b * C::L + n * C::CH + i; const float beta = P.BETA[t * C::DNH + h];
        float r;
        if (col < C::DV) r = bf2f(P.QKVN[t * Dm::QKVC + 2 * Dm::HK + h * C::DV + col]) * beta;
        else r = bf2f(P.QKVN[t * Dm::QKVC + Dm::HK + h * C::DK + (col - C::DV)]) * beta * expf(P.GC[t * C::DNH + h]);
        for (int j = 0; j < i; ++j) r -= A[i * C::CH + j] * SCR(j);
        SCR(i) = r;
    }
    for (int i = 0; i < C::CH; ++i) {
        const size_t t = (size_t)b * C::L + n * C::CH + i;
        if (col < C::DV) P.QKVN[t * Dm::QKVC + 2 * Dm::HK + h * C::DV + col] = f2bf(SCR(i));
        else P.W[((size_t)cid * C::CH + i) * C::DK + (col - C::DV)] = f2bf(SCR(i));
    }
}
template <class C> HD void n_scale(const NP& P, int item) {
    typedef Dims<C> Dm; const int h = item % C::DNH; const size_t t = item / C::DNH; const int l = (int)(t % C::L), b = (int)(t / C::L), n = l / C::CH;
    const float gc = P.GC[t * C::DNH + h]; const size_t tl = (size_t)b * C::L + n * C::CH + C::CH - 1; const float gl = P.GC[tl * C::DNH + h];
    const float fq = expf(gc) * (1.f / sqrtf((float)C::DK)), fk = expf(gl - gc);
    bf16_t* q = P.QKVN + t * Dm::QKVC + h * C::DK; bf16_t* k = P.QKVN + t * Dm::QKVC + Dm::HK + h * C::DK;
    for (int d = 0; d < C::DK; ++d) { q[d] = f2bf(bf2f(q[d]) * fq); k[d] = f2bf(bf2f(k[d]) * fk); }
}
template <class C> HD void n_scan(const NP& P, int item, int tid, int NT) {
    typedef Dims<C> Dm; const int e = item % C::DV, h = (item / C::DV) % C::DNH, b = item / (C::DV * C::DNH);
    for (int d = 0; d < C::DK; ++d) SCR(d) = 0.f;
    for (int n = 0; n < Dm::NCH; ++n) {
        const int cid = (b * C::DNH + h) * Dm::NCH + n; const size_t t0 = (size_t)b * C::L + n * C::CH;
        const bf16_t* Wc = P.W + (size_t)cid * C::CH * C::DK; const bf16_t* At = P.ATT + (size_t)cid * C::CH * C::CH;
        for (int r = 0; r < C::CH; ++r) { float acc = bf2f(P.QKVN[(t0 + r) * Dm::QKVC + 2 * Dm::HK + h * C::DV + e]);
            for (int d = 0; d < C::DK; ++d) acc -= bf2f(Wc[r * C::DK + d]) * SCR(d);
            SCR(C::DK + r) = acc; }
        for (int r = 0; r < C::CH; ++r) { float o = 0.f; const bf16_t* qd = P.QKVN + (t0 + r) * Dm::QKVC + h * C::DK;
            for (int d = 0; d < C::DK; ++d) o += bf2f(qd[d]) * SCR(d);
            for (int s = 0; s <= r; ++s) o += bf2f(At[r * C::CH + s]) * SCR(C::DK + s);
            P.O[(t0 + r) * Dm::HV + h * C::DV + e] = f2bf(o); }
        const float gl = P.GL[cid];
        for (int d = 0; d < C::DK; ++d) { float acc = SCR(d) * gl;
            for (int r = 0; r < C::CH; ++r) acc += bf2f(P.QKVN[(t0 + r) * Dm::QKVC + Dm::HK + h * C::DK + d]) * SCR(C::DK + r);
            SCR(d) = acc; }
    }
}
template <class C> HD void n_ogate(const NP& P, int item) {
    typedef Dims<C> Dm; const int h = item % C::DNH; const size_t t = item / C::DNH; const bf16_t* o = P.O + t * Dm::HV + h * C::DV;
    float ss = 0.f; for (int d = 0; d < C::DV; ++d) { const float v = bf2f(o[d]); ss += v * v; } const float rs = 1.f / sqrtf(ss / C::DV + Dm::EPS);
    for (int d = 0; d < C::DV; ++d) P.OG[t * Dm::HV + h * C::DV + d] = f2bf(bf2f(o[d]) * rs * P.dn_onorm_w[d] * siluf(bf2f(P.Z[t * Dm::HV + h * C::DV + d])));
}
template <class C> HD void n_q(const NP& P, int item) {
    const int NJ = C::MH * C::MDH + C::IH * C::ID; const int j = item % NJ; const size_t t = item / NJ; const bf16_t* ql = P.QLATN + t * C::QL;
    float acc = 0.f;
    if (j < C::MH * C::MDH) { for (int k = 0; k < C::QL; ++k) acc += bf2f(ql[k]) * P.w_uq[(size_t)k * C::MH * C::MDH + j]; P.QF[t * C::MH * C::MDH + j] = acc; }
    else { const int jj = j - C::MH * C::MDH; for (int k = 0; k < C::QL; ++k) acc += bf2f(ql[k]) * P.w_iq[(size_t)k * C::IH * C::ID + jj]; P.QIDX[t * C::IH * C::ID + jj] = acc; }
}
template <class C> HD void n_qabs(const NP& P, int item) {
    const int c = item % C::KVL, h = (item / C::KVL) % C::MH; const size_t t = item / (C::KVL * C::MH);
    float acc = 0.f; for (int d = 0; d < C::MDH; ++d) acc += P.QF[t * C::MH * C::MDH + h * C::MDH + d] * P.w_uk[((size_t)c * C::MH + h) * C::MDH + d];
    P.QABS[(t * C::MH + h) * C::KVL + c] = f2bf(acc * (1.f / sqrtf((float)C::MDH)));
}
template <class C> HD void n_index(const NP& P, int t, int tid, int NT) {
    typedef Dims<C> Dm; const int K = Dm::TOPK; const int l = t % C::L, b = t / C::L; int cnt = 0;
    const float* qi = P.QIDX + (size_t)t * C::IH * C::ID; const float* wi = P.WIDX + (size_t)t * C::IH;
#define HV_(i) SCR(i)
#define HI_(i) SCR(K + (i))
#define WORSE(v1, i1, v2, i2) ((v1) < (v2) || ((v1) == (v2) && (i1) > (i2)))
    for (int s = 0; s <= l; ++s) {
        const bf16_t* kr = P.KIDXN + ((size_t)b * C::L + s) * C::ID; float sc = 0.f;
        for (int h = 0; h < C::IH; ++h) { float dot = 0.f; for (int d = 0; d < C::ID; ++d) dot += qi[h * C::ID + d] * bf2f(kr[d]); sc += wi[h] * (dot > 0.f ? dot : 0.f); }
        const float fs = (float)s;
        if (cnt < K) {
            int i = cnt++; HV_(i) = sc; HI_(i) = fs;
            while (i > 0) { const int p = (i - 1) >> 1; const float pv = HV_(p), pi = HI_(p), cv = HV_(i), ci = HI_(i);
                if (WORSE(cv, ci, pv, pi)) { HV_(p) = cv; HI_(p) = ci; HV_(i) = pv; HI_(i) = pi; i = p; } else break; }
        } else if (HV_(0) < sc) {
            int i = 0; HV_(0) = sc; HI_(0) = fs;
            for (;;) { const int a = 2 * i + 1, c2 = a + 1; int w = i; float wv = HV_(i), wx = HI_(i);
                if (a < K) { const float av = HV_(a), ai = HI_(a); if (WORSE(av, ai, wv, wx)) { w = a; wv = av; wx = ai; } }
                if (c2 < K) { const float bv = HV_(c2), bi = HI_(c2); if (WORSE(bv, bi, wv, wx)) { w = c2; wv = bv; wx = bi; } }
                if (w == i) break; const float tv = HV_(i), ti = HI_(i); HV_(i) = wv; HI_(i) = wx; HV_(w) = tv; HI_(w) = ti; i = w; }
        }
    }
    for (int k = 0; k < K; ++k) P.IDX[(size_t)t * K + k] = (k < cnt) ? (int)HI_(k) : -1;
#undef HV_
#undef HI_
#undef WORSE
}
template <class C> HD void n_attn(const NP& P, int item, int tid, int NT) {
    typedef Dims<C> Dm; const int K = Dm::TOPK; const int h = item % C::MH; const size_t t = item / C::MH; const int b = (int)(t / C::L);
    const int* idx = P.IDX + t * K; bf16_t* qa = P.QABS + (t * C::MH + h) * C::KVL;
    int nv = 0; float m = -3.0e38f;
    for (int k = 0; k < K; ++k) { const int s = idx[k]; if (s < 0) break; ++nv;
        const bf16_t* kv = P.CKVN + ((size_t)b * C::L + s) * C::KVL; float lg = 0.f; for (int c = 0; c < C::KVL; ++c) lg += bf2f(qa[c]) * bf2f(kv[c]);
        SCR(k) = lg; m = lg > m ? lg : m; }
    float sum = 0.f; for (int k = 0; k < nv; ++k) { const float p = expf(SCR(k) - m); SCR(k) = p; sum += p; }
    const float inv = 1.f / sum;
    for (int c = 0; c < C::KVL; ++c) { float acc = 0.f; for (int k = 0; k < nv; ++k) acc += SCR(k) * bf2f(P.CKVN[((size_t)b * C::L + idx[k]) * C::KVL + c]);
        SCR(K + c) = acc * inv; }
    for (int c = 0; c < C::KVL; ++c) qa[c] = f2bf(SCR(K + c));
}
template <class C> HD void n_oatt(const NP& P, int item) {
    const int d = item % C::MDV, h = (item / C::MDV) % C::MH; const size_t t = item / (C::MDV * C::MH);
    float acc = 0.f; for (int c = 0; c < C::KVL; ++c) acc += bf2f(P.OLAT[(t * C::MH + h) * C::KVL + c]) * P.w_uv[((size_t)c * C::MH + h) * C::MDV + d];
    P.OATT[t * C::MH * C::MDV + h * C::MDV + d] = f2bf(acc);
}
template <class C> HD void n_merge(const NP& P, int item) {
    typedef Dims<C> Dm; const int n = item % C::D; const size_t t = item / C::D;
    float ya = 0.f, yb = 0.f;
    for (int k = 0; k < Dm::HV; ++k) ya += bf2f(P.OG[t * Dm::HV + k]) * P.w_a_out[(size_t)k * C::D + n];
    for (int k = 0; k < C::MH * C::MDV; ++k) yb += bf2f(P.OATT[t * C::MH * C::MDV + k]) * P.w_b_out[(size_t)k * C::D + n];
    P.M[t * C::D + n] = f2bf(sigmf(bf2f(P.GA[t * C::D + n])) * ya + sigmf(bf2f(P.GB[t * C::D + n])) * yb);
}
template <class C> HD void n_wo(const NP& P, int item) {
    const int n = item % C::D; const size_t t = item / C::D; const int b = (int)(t / C::L);
    float acc = 0.f; for (int k = 0; k < C::D; ++k) acc += bf2f(P.M[t * C::D + k]) * P.w_o[(size_t)k * C::D + n];
    P.X1[t * C::D + n] = P.x[t * C::D + n] + P.MOD[(size_t)b * 6 * C::D + 2 * C::D + n] * acc;
}
template <class C> HD void n_h2(const NP& P, int t) {
    const int D = C::D; const int b = t / C::L; const float* xr = P.X1 + (size_t)t * D;
    float ss = 0.f; for (int i = 0; i < D; ++i) ss += xr[i] * xr[i];
    const float rstd = 1.f / sqrtf(ss / D + Dims<C>::EPS);
    const float* sh = P.MOD + (size_t)b * 6 * D + 3 * D; const float* sc = sh + D;
    for (int i = 0; i < D; ++i) P.H2[(size_t)t * D + i] = f2bf(xr[i] * rstd * P.norm2_w[i] * (1.f + sc[i]) + sh[i]);
}
template <class C> HD void n_peerq(const NP& P, int item) {
    const int NJ = C::PH * C::PDQ; const int j = item % NJ; const size_t t = item / NJ;
    float acc = 0.f; for (int k = 0; k < C::D; ++k) acc += bf2f(P.H2[t * C::D + k]) * P.peer_w_q[(size_t)k * NJ + j];
    P.PQ[t * NJ + j] = acc;
}
template <class C> HD void n_route(const NP& P, int item, int tid, int NT) {
    typedef Dims<C> Dm; const int PK = C::PK, TK = C::PTK; const int h = item % C::PH; const size_t t = item / C::PH;
    const int oS = 0, oSV = 2 * PK, oSI = oSV + 2 * TK, oC = oSI + 2 * TK;
    for (int p = 0; p < 2; ++p) for (int n = 0; n < PK; ++n) {
        const float* q = P.PQ + t * C::PH * C::PDQ + (h * 2 + p) * Dm::PD2; const float* key = P.peer_sub_keys + (((size_t)h * 2 + p) * PK + n) * Dm::PD2;
        float acc = 0.f; for (int d = 0; d < Dm::PD2; ++d) acc += q[d] * key[d]; SCR(oS + p * PK + n) = acc; }
    for (int p = 0; p < 2; ++p) for (int k = 0; k < TK; ++k) { int bi = 0; float bv = -3.0e38f;
        for (int n = 0; n < PK; ++n) { const float v = SCR(oS + p * PK + n); if (v > bv) { bv = v; bi = n; } }
        SCR(oSV + p * TK + k) = bv; SCR(oSI + p * TK + k) = (float)bi; SCR(oS + p * PK + bi) = -3.0e38f; }
    for (int i = 0; i < TK; ++i) for (int j = 0; j < TK; ++j) SCR(oC + i * TK + j) = SCR(oSV + i) + SCR(oSV + TK + j);
    float tv[C::PTK]; int te[C::PTK]; float mx = -3.0e38f;
#pragma unroll
    for (int k = 0; k < TK; ++k) { int bi = 0; float bv = -3.0e38f;
        for (int n = 0; n < TK * TK; ++n) { const float v = SCR(oC + n); if (v > bv) { bv = v; bi = n; } }
        SCR(oC + bi) = -3.0e38f; tv[k] = bv; te[k] = (int)SCR(oSI + bi / TK) * PK + (int)SCR(oSI + TK + bi % TK); mx = bv > mx ? bv : mx; }
    float sum = 0.f;
#pragma unroll
    for (int k = 0; k < TK; ++k) { tv[k] = expf(tv[k] - mx); sum += tv[k]; }
#pragma unroll
    for (int k = 0; k < TK; ++k) { P.EXPI[t * Dm::SLOTS + h * TK + k] = te[k]; P.GATE[t * Dm::SLOTS + h * TK + k] = tv[k] / sum; }
}
template <class C> HD void n_pact(const NP& P, int item) {
    typedef Dims<C> Dm; const int sl = item % Dm::SLOTS; const size_t t = item / Dm::SLOTS; const int e = P.EXPI[t * Dm::SLOTS + sl];
    const float* u = P.peer_u + (size_t)e * C::D; float acc = 0.f; for (int d = 0; d < C::D; ++d) acc += u[d] * bf2f(P.H2[t * C::D + d]);
    P.ACT[t * Dm::SLOTS + sl] = geluf(acc) * P.GATE[t * Dm::SLOTS + sl];
}
template <class C> HD void n_pout(const NP& P, int item) {
    typedef Dims<C> Dm; const int d = item % C::D; const size_t t = item / C::D; const int b = (int)(t / C::L);
    float acc = 0.f; for (int s = 0; s < Dm::SLOTS; ++s) acc += P.ACT[t * Dm::SLOTS + s] * P.peer_v[(size_t)P.EXPI[t * Dm::SLOTS + s] * C::D + d];
    P.X1[t * C::D + d] += P.MOD[(size_t)b * 6 * C::D + 5 * C::D + d] * acc;
}
template <class C> HD void n_final(const NP& P, int t) {
    const int D = C::D; const float* xr = P.X1 + (size_t)t * D; float ss = 0.f; for (int i = 0; i < D; ++i) ss += xr[i] * xr[i];
    const float rstd = 1.f / sqrtf(ss / D + Dims<C>::EPS);
    for (int i = 0; i < D; ++i) P.out[(size_t)t * D + i] = xr[i] * rstd * P.final_norm_w[i];
}

template <class C> HD long stage_items(int st) {
    typedef Dims<C> Dm; const long T = Dm::T;
    switch (st) {
        case ST_MOD: return (long)C::B * 6 * C::D; case ST_H1: return T;
        case ST_INPROJ_A: return T * ((Dm::OFF_GA - 0) / 4) - T * (Dm::HV / 4);
        case ST_DSANORM: return T; case ST_CONV: return T * C::DNH * 3; case ST_GC: return Dm::NCHUNKS; case ST_AMAT: return (long)Dm::NCHUNKS * C::CH * C::CH;
        case ST_SOLVE: return (long)Dm::NCHUNKS * (C::DV + C::DK); case ST_SCALE: return T * C::DNH; case ST_SCAN: return (long)C::B * C::DNH * C::DV;
        case ST_Q: return T * (C::MH * C::MDH + C::IH * C::ID); case ST_QABS: return T * C::MH * C::KVL; case ST_INDEX: return T; case ST_ATTN: return T * C::MH;
        case ST_INPROJ_B: return T * ((Dm::HV + 2 * C::D) / 4); case ST_OGATE: return T * C::DNH; case ST_OATT: return T * C::MH * C::MDV; case ST_MERGE: return T * C::D;
        case ST_WO: return T * C::D; case ST_H2: return T; case ST_PEERQ: return T * C::PH * C::PDQ; case ST_ROUTE: return T * C::PH; case ST_PACT: return T * Dm::SLOTS;
        case ST_POUT: return T * C::D; case ST_FINAL: return T;
    }
    return 0;
}
template <class C> HD int stage_scr_words(int st) {
    typedef Dims<C> Dm;
    switch (st) { case ST_SOLVE: return C::CH; case ST_SCAN: return C::DK + C::CH; case ST_INDEX: return 2 * Dm::TOPK; case ST_ATTN: return Dm::TOPK + C::KVL;
        case ST_ROUTE: return 2 * C::PK + 4 * C::PTK + C::PTK * C::PTK; }
    return 0;
}
template <class C> HD void run_item(const NP& P, int st, long item, int tid, int NT) {
    typedef Dims<C> Dm;
    switch (st) {
        case ST_MOD: n_mod<C>(P, (int)item); break; case ST_H1: n_h1<C>(P, (int)item); break;
        case ST_INPROJ_A: { const int ngA = Dm::OFF_Z / 4, ngB = (Dm::OFF_GA - Dm::OFF_B) / 4, ng = ngA + ngB; const int t = (int)(item / ng), g = (int)(item % ng);
            if (g < ngA) n_inproj<C>(P, t * ngA + g, 0, Dm::OFF_Z); else n_inproj<C>(P, t * ngB + (g - ngA), Dm::OFF_B, Dm::OFF_GA); } break;
        case ST_DSANORM: n_dsanorm<C>(P, (int)item); break; case ST_CONV: n_conv<C>(P, (int)item); break; case ST_GC: n_gc<C>(P, (int)item); break;
        case ST_AMAT: n_amat<C>(P, (int)item); break; case ST_SOLVE: n_solve<C>(P, (int)item, tid, NT); break; case ST_SCALE: n_scale<C>(P, (int)item); break;
        case ST_SCAN: n_scan<C>(P, (int)item, tid, NT); break; case ST_Q: n_q<C>(P, (int)item); break; case ST_QABS: n_qabs<C>(P, (int)item); break;
        case ST_INDEX: n_index<C>(P, (int)item, tid, NT); break; case ST_ATTN: n_attn<C>(P, (int)item, tid, NT); break;
        case ST_INPROJ_B: { const int ngA = Dm::HV / 4, ngB = 2 * C::D / 4, ng = ngA + ngB; const int t = (int)(item / ng), g = (int)(item % ng);
            if (g < ngA) n_inproj<C>(P, t * ngA + g, Dm::OFF_Z, Dm::OFF_B); else n_inproj<C>(P, t * ngB + (g - ngA), Dm::OFF_GA, Dm::IN_COLS); } break;
        case ST_OGATE: n_ogate<C>(P, (int)item); break; case ST_OATT: n_oatt<C>(P, (int)item); break; case ST_MERGE: n_merge<C>(P, (int)item); break;
        case ST_WO: n_wo<C>(P, (int)item); break; case ST_H2: n_h2<C>(P, (int)item); break; case ST_PEERQ: n_peerq<C>(P, (int)item); break;
        case ST_ROUTE: n_route<C>(P, (int)item, tid, NT); break; case ST_PACT: n_pact<C>(P, (int)item); break; case ST_POUT: n_pout<C>(P, (int)item); break;
        case ST_FINAL: n_final<C>(P, (int)item); break;
    }
}
template <class C> __global__ void __launch_bounds__(256) k_stage(NP P, int st, long nitems) {
    const int tid = blockIdx.x * 256 + threadIdx.x, NT = gridDim.x * 256;
    for (long it = tid; it < nitems; it += NT) run_item<C>(P, st, it, tid, NT);
}
extern "C" void kernel_launch(void* const* d_in, const int* in_sizes, int n_in, void* d_out, int out_size, void* d_ws, size_t ws_size, hipStream_t stream) {
    typedef CfgFull C; typedef WsMap<C> W;
    if (n_in != 26 || ws_size < W::END) { fprintf(stderr, "kernel_launch: need 26 inputs and %zu bytes of workspace, got %d / %zu\n", (size_t)W::END, n_in, ws_size); return; }
    NP P; np_setup<C>(P, d_in, d_out, d_ws);
    float* scr_main = P.SCRP; float* scr_alt = (float*)((char*)d_out + W::d_SCR);
    for (int st = 0; st < ST_COUNT; ++st) {
        P.SCRP = (st == ST_ROUTE) ? scr_alt : scr_main;
        const long n = stage_items<C>(st); const int words = stage_scr_words<C>(st);
        long nt = 65536 * 4; if (words) { nt = (long)(W::SCR_BYTES / (4 * (size_t)words)); nt &= ~255L; }
        long blocks = (n + 255) / 256; if (blocks * 256 > nt) blocks = nt / 256; if (blocks < 1) blocks = 1;
        hipLaunchKernelGGL(k_stage<C>, dim3((unsigned)blocks), dim3(256), 0, stream, P, st, n);
    }
}
```

```cpp
#include <hip/hip_runtime.h>
#include <cstdio>
#include <cstdint>
#define HD __host__ __device__ __forceinline__
#ifndef HD
#define HD
#endif

typedef unsigned short bf16_t;
HD float bf2f(bf16_t v) { unsigned u = ((unsigned)v) << 16; float f; __builtin_memcpy(&f, &u, 4); return f; }
HD bf16_t f2bf(float f) { unsigned u; __builtin_memcpy(&u, &f, 4); u = (u + 0x7fffu + ((u >> 16) & 1u)) >> 16; return (bf16_t)u; }
HD float siluf(float x) { return x / (1.f + expf(-x)); }
HD float sigmf(float x) { return 1.f / (1.f + expf(-x)); }
HD float softplusf(float x) { return x > 20.f ? x : log1pf(expf(x)); }
HD float geluf(float x) { return 0.5f * x * (1.f + erff(x * 0.70710678118654752f)); }

struct CfgFull {
    static constexpr int D = 1024, B = 2, L = 8192;
    static constexpr int DNH = 8, DK = 128, DV = 128, CONV = 4, CH = 64;
    static constexpr int MH = 8, MDH = 128, MDV = 128, QL = 256, KVL = 256;
    static constexpr int IH = 8, ID = 64, TOPK_MAX = 256;
    static constexpr int PK = 128, PH = 8, PDQ = 256, PTK = 16;
};
struct CfgSmall {
    static constexpr int D = 64, B = 2, L = 512;
    static constexpr int DNH = 2, DK = 16, DV = 16, CONV = 4, CH = 64;
    static constexpr int MH = 2, MDH = 16, MDV = 16, QL = 32, KVL = 32;
    static constexpr int IH = 4, ID = 16, TOPK_MAX = 64;
    static constexpr int PK = 16, PH = 2, PDQ = 32, PTK = 4;
};
template <class C> struct Dims {
    static constexpr int T = C::B * C::L, HK = C::DNH * C::DK, HV = C::DNH * C::DV, QKVC = 2 * HK + HV;
    static constexpr int NCH = C::L / C::CH, NCHUNKS = C::B * C::DNH * NCH;
    static constexpr int TOPK = (C::TOPK_MAX < C::L / 4) ? C::TOPK_MAX : C::L / 4;
    static constexpr int PE = C::PK * C::PK, SLOTS = C::PH * C::PTK, PD2 = C::PDQ / 2;
    static constexpr int OFF_Q = 0, OFF_K = HK, OFF_V = 2 * HK, OFF_Z = 2 * HK + HV, OFF_B = OFF_Z + HV, OFF_A = OFF_B + C::DNH,
                         OFF_QL = OFF_A + C::DNH, OFF_CKV = OFF_QL + C::QL, OFF_KI = OFF_CKV + C::KVL, OFF_WI = OFF_KI + C::ID,
                         OFF_GA = OFF_WI + C::IH, OFF_GB = OFF_GA + C::D, IN_COLS = OFF_GB + C::D;
    static constexpr float EPS = 1e-6f;
};

struct NP {
    const float *x, *c, *w_ada, *b_ada, *norm1_w, *w_in, *dn_conv_w, *dn_a_log, *dn_dt_bias, *dn_onorm_w, *q_norm_w, *kv_norm_w, *idx_k_norm_w,
        *w_uq, *w_iq, *w_uk, *w_uv, *w_a_out, *w_b_out, *w_o, *norm2_w, *peer_w_q, *peer_sub_keys, *peer_u, *peer_v, *final_norm_w;
    float* out;
    float* MOD; bf16_t* H1; bf16_t* QKVP; bf16_t* QKVN; bf16_t* Z; bf16_t* GA; bf16_t* GB;
    float *BETA, *G, *GC, *GL, *QLATR, *CKVR, *KIDXR, *WIDX; bf16_t *QLATN, *CKVN, *KIDXN;
    float* AMAT; bf16_t* ATT; bf16_t* W; bf16_t* O; bf16_t* OG;
    float *QF, *QIDX; bf16_t* QABS; int* IDX; bf16_t* OLAT; bf16_t* OATT; bf16_t* M; float* X1; bf16_t* H2;
    float* PQ; int* EXPI; float* GATE; float* ACT;
    float* SCRP;
};
#define SCR(w) P.SCRP[(size_t)(w) * NT + tid]

template <class C> struct WsMap {
    typedef Dims<C> Dm;
    static constexpr size_t al(size_t x) { return (x + 255) & ~(size_t)255; }
    static constexpr size_t mx(size_t a, size_t b) { return a > b ? a : b; }
    static constexpr size_t SZ_QKV = al((size_t)Dm::T * Dm::QKVC * 2);
    static constexpr size_t S1a = al(mx((size_t)Dm::T * C::MH * C::KVL * 2, (size_t)Dm::T * C::D * 4));
    static constexpr size_t S1b = al(mx(mx((size_t)Dm::T * Dm::TOPK * 4, (size_t)Dm::T * C::MH * C::MDV * 2), (size_t)Dm::T * C::D * 2));
    static constexpr size_t RAW = al((size_t)Dm::T * C::QL * 4) + al((size_t)Dm::T * C::KVL * 4) + al((size_t)Dm::T * C::ID * 4);
    static constexpr size_t SZ_A1 = mx(mx(SZ_QKV, RAW), S1a + S1b);
    static constexpr size_t SZ_AAW = al((size_t)Dm::NCHUNKS * C::CH * C::CH * 4) + al((size_t)Dm::NCHUNKS * C::CH * C::CH * 2) + al((size_t)Dm::NCHUNKS * C::CH * C::DK * 2);
    static constexpr size_t SZ_QQ = al((size_t)Dm::T * C::MH * C::MDH * 4) + al((size_t)Dm::T * C::IH * C::ID * 4);
    static constexpr size_t SZ_ZGG = al((size_t)Dm::T * Dm::HV * 2) + 2 * al((size_t)Dm::T * C::D * 2);
    static constexpr size_t SZ_A0 = mx(mx(SZ_QKV, SZ_AAW), mx(SZ_QQ, SZ_ZGG));
    static constexpr size_t A1 = 1 << 20, A0 = A1 + SZ_A1, A2 = A0 + SZ_A0;
    static constexpr size_t o_MOD = 65536, o_BETA = A2, o_G = o_BETA + al((size_t)Dm::T * C::DNH * 4), o_GC = o_G + al((size_t)Dm::T * C::DNH * 4),
        o_GL = o_GC + al((size_t)Dm::T * C::DNH * 4), o_WIDX = o_GL + al((size_t)Dm::NCHUNKS * 4), o_QLATN = o_WIDX + al((size_t)Dm::T * C::IH * 4),
        o_CKVN = o_QLATN + al((size_t)Dm::T * C::QL * 2), o_KIDXN = o_CKVN + al((size_t)Dm::T * C::KVL * 2), A3 = o_KIDXN + al((size_t)Dm::T * C::ID * 2);
    static constexpr size_t SCR_BYTES = 16u << 20;
    static constexpr size_t o_PQ = A0;
    static constexpr size_t END = mx(A3 + SCR_BYTES, o_PQ + al((size_t)Dm::T * C::PH * C::PDQ * 4));
    static_assert(o_MOD + (size_t)C::B * 6 * C::D * 4 <= A1, "MOD in the first MiB");
    static constexpr size_t o_QLATR = A1, o_CKVR = o_QLATR + al((size_t)Dm::T * C::QL * 4), o_KIDXR = o_CKVR + al((size_t)Dm::T * C::KVL * 4);
    static constexpr size_t o_AMAT = A0, o_ATT = o_AMAT + al((size_t)Dm::NCHUNKS * C::CH * C::CH * 4), o_W = o_ATT + al((size_t)Dm::NCHUNKS * C::CH * C::CH * 2);
    static constexpr size_t o_QF = A0, o_QIDX = o_QF + al((size_t)Dm::T * C::MH * C::MDH * 4);
    static constexpr size_t o_QABS = A1, o_IDX = A1 + S1a;
    static constexpr size_t o_Z = A0, o_GA = o_Z + al((size_t)Dm::T * Dm::HV * 2), o_GB = o_GA + al((size_t)Dm::T * C::D * 2);
    static constexpr size_t o_OATT = o_IDX, o_X1 = A1, o_H2 = o_IDX;
    static constexpr size_t d_H1 = 0, d_O = al((size_t)Dm::T * C::D * 2), d_OG = 0, d_M = d_O;
    static constexpr size_t d_EXPI = 0, d_GATE = al((size_t)Dm::T * Dm::SLOTS * 4), d_ACT = 2 * d_GATE, d_SCR = (size_t)Dm::T * C::D * 2;
    static_assert(d_O + (size_t)Dm::T * Dm::HV * 2 <= (size_t)Dm::T * C::D * 4 && d_ACT + (size_t)Dm::T * Dm::SLOTS * 4 <= d_SCR, "d_out scratch");
};

template <class C> inline void np_setup(NP& P, void* const* d_in, void* d_out, void* d_ws) {
    typedef WsMap<C> W;
    const float** f = (const float**)&P.x;
    for (int i = 0; i < 26; ++i) f[i] = (const float*)d_in[i];
    char* ws = (char*)d_ws; char* dob = (char*)d_out;
    P.out = (float*)d_out;
    P.MOD = (float*)(ws + W::o_MOD); P.H1 = (bf16_t*)(dob + W::d_H1); P.QKVP = (bf16_t*)(ws + W::A0); P.QKVN = (bf16_t*)(ws + W::A1);
    P.Z = (bf16_t*)(ws + W::o_Z); P.GA = (bf16_t*)(ws + W::o_GA); P.GB = (bf16_t*)(ws + W::o_GB);
    P.BETA = (float*)(ws + W::o_BETA); P.G = (float*)(ws + W::o_G); P.GC = (float*)(ws + W::o_GC); P.GL = (float*)(ws + W::o_GL);
    P.QLATR = (float*)(ws + W::o_QLATR); P.CKVR = (float*)(ws + W::o_CKVR); P.KIDXR = (float*)(ws + W::o_KIDXR); P.WIDX = (float*)(ws + W::o_WIDX);
    P.QLATN = (bf16_t*)(ws + W::o_QLATN); P.CKVN = (bf16_t*)(ws + W::o_CKVN); P.KIDXN = (bf16_t*)(ws + W::o_KIDXN);
    P.AMAT = (float*)(ws + W::o_AMAT); P.ATT = (bf16_t*)(ws + W::o_ATT); P.W = (bf16_t*)(ws + W::o_W); P.O = (bf16_t*)(dob + W::d_O); P.OG = (bf16_t*)(dob + W::d_OG);
    P.QF = (float*)(ws + W::o_QF); P.QIDX = (float*)(ws + W::o_QIDX); P.QABS = (bf16_t*)(ws + W::o_QABS); P.IDX = (int*)(ws + W::o_IDX); P.OLAT = P.QABS;
    P.OATT = (bf16_t*)(ws + W::o_OATT); P.M = (bf16_t*)(dob + W::d_M); P.X1 = (float*)(ws + W::o_X1); P.H2 = (bf16_t*)(ws + W::o_H2);
    P.PQ = (float*)(ws + W::o_PQ); P.EXPI = (int*)(dob + W::d_EXPI); P.GATE = (float*)(dob + W::d_GATE); P.ACT = (float*)(dob + W::d_ACT);
    P.SCRP = (float*)(ws + W::A3);
}

enum { ST_MOD = 0, ST_H1, ST_INPROJ_A, ST_DSANORM, ST_CONV, ST_GC, ST_AMAT, ST_SOLVE, ST_SCALE, ST_SCAN, ST_Q, ST_QABS, ST_INDEX, ST_ATTN,
       ST_INPROJ_B, ST_OGATE, ST_OATT, ST_MERGE, ST_WO, ST_H2, ST_PEERQ, ST_ROUTE, ST_PACT, ST_POUT, ST_FINAL, ST_COUNT };

template <class C> HD void n_mod(const NP& P, int item) {
    const int D = C::D; const int b = item / (6 * D), j = item % (6 * D);
    float acc = P.b_ada[j];
    for (int i = 0; i < D; ++i) acc += siluf(P.c[b * D + i]) * P.w_ada[(size_t)i * 6 * D + j];
    P.MOD[item] = acc;
}
template <class C> HD void n_h1(const NP& P, int t) {
    const int D = C::D; const int b = t / C::L; const float* xr = P.x + (size_t)t * D;
    float ss = 0.f; for (int i = 0; i < D; ++i) ss += xr[i] * xr[i];
    const float rstd = 1.f / sqrtf(ss / D + Dims<C>::EPS);
    const float* sh = P.MOD + (size_t)b * 6 * D; const float* sc = sh + D;
    for (int i = 0; i < D; ++i) P.H1[(size_t)t * D + i] = f2bf(xr[i] * rstd * P.norm1_w[i] * (1.f + sc[i]) + sh[i]);
}
template <class C> HD void inproj_store(const NP& P, int t, int n, float v) {
    typedef Dims<C> Dm;
    if (n < Dm::OFF_Z) P.QKVP[(size_t)t * Dm::QKVC + n] = f2bf(v);
    else if (n < Dm::OFF_B) P.Z[(size_t)t * Dm::HV + (n - Dm::OFF_Z)] = f2bf(v);
    else if (n < Dm::OFF_A) P.BETA[(size_t)t * C::DNH + (n - Dm::OFF_B)] = sigmf(v);
    else if (n < Dm::OFF_QL) { const int h = n - Dm::OFF_A; P.G[(size_t)t * C::DNH + h] = -expf(P.dn_a_log[h]) * softplusf(v + P.dn_dt_bias[h]); }
    else if (n < Dm::OFF_CKV) P.QLATR[(size_t)t * C::QL + (n - Dm::OFF_QL)] = v;
    else if (n < Dm::OFF_KI) P.CKVR[(size_t)t * C::KVL + (n - Dm::OFF_CKV)] = v;
    else if (n < Dm::OFF_WI) P.KIDXR[(size_t)t * C::ID + (n - Dm::OFF_KI)] = v;
    else if (n < Dm::OFF_GA) P.WIDX[(size_t)t * C::IH + (n - Dm::OFF_WI)] = v * (1.f / sqrtf((float)C::IH) / sqrtf((float)C::ID));
    else if (n < Dm::OFF_GB) P.GA[(size_t)t * C::D + (n - Dm::OFF_GA)] = f2bf(v);
    else P.GB[(size_t)t * C::D + (n - Dm::OFF_GB)] = f2bf(v);
}
template <class C> HD void n_inproj(const NP& P, int item, int c0, int c1) {
    typedef Dims<C> Dm; const int ng = (c1 - c0) / 4; const int t = item / ng, n = c0 + 4 * (item % ng);
    float a0 = 0, a1 = 0, a2 = 0, a3 = 0; const bf16_t* hr = P.H1 + (size_t)t * C::D;
    for (int k = 0; k < C::D; ++k) { const float h = bf2f(hr[k]); const float* w = P.w_in + (size_t)k * Dm::IN_COLS + n; a0 += h * w[0]; a1 += h * w[1]; a2 += h * w[2]; a3 += h * w[3]; }
    inproj_store<C>(P, t, n, a0); inproj_store<C>(P, t, n + 1, a1); inproj_store<C>(P, t, n + 2, a2); inproj_store<C>(P, t, n + 3, a3);
}
template <class C> HD void n_dsanorm(const NP& P, int t) {
    typedef Dims<C> Dm;
    { const float* r = P.QLATR + (size_t)t * C::QL; float ss = 0; for (int i = 0; i < C::QL; ++i) ss += r[i] * r[i]; const float rs = 1.f / sqrtf(ss / C::QL + Dm::EPS);
      for (int i = 0; i < C::QL; ++i) P.QLATN[(size_t)t * C::QL + i] = f2bf(r[i] * rs * P.q_norm_w[i]); }
    { const float* r = P.CKVR + (size_t)t * C::KVL; float ss = 0; for (int i = 0; i < C::KVL; ++i) ss += r[i] * r[i]; const float rs = 1.f / sqrtf(ss / C::KVL + Dm::EPS);
      for (int i = 0; i < C::KVL; ++i) P.CKVN[(size_t)t * C::KVL + i] = f2bf(r[i] * rs * P.kv_norm_w[i]); }
    { const float* r = P.KIDXR + (size_t)t * C::ID; float ss = 0; for (int i = 0; i < C::ID; ++i) ss += r[i] * r[i]; const float rs = 1.f / sqrtf(ss / C::ID + Dm::EPS);
      for (int i = 0; i < C::ID; ++i) P.KIDXN[(size_t)t * C::ID + i] = f2bf(r[i] * rs * P.idx_k_norm_w[i]); }
}
template <class C> HD float conv_at(const NP& P, int t, int ch) {
    typedef Dims<C> Dm; const int l = t % C::L; float acc = 0.f;
    for (int i = 0; i < C::CONV; ++i) { const int ll = l - (C::CONV - 1) + i; if (ll >= 0) acc += bf2f(P.QKVP[(size_t)(t - (C::CONV - 1) + i) * Dm::QKVC + ch]) * P.dn_conv_w[(size_t)i * Dm::QKVC + ch]; }
    return siluf(acc);
}
template <class C> HD void n_conv(const NP& P, int item) {
    typedef Dims<C> Dm; const int which = item % 3, h = (item / 3) % C::DNH, t = item / (3 * C::DNH);
    const int dim = (which == 2) ? C::DV : C::DK; const int ch0 = (which == 0 ? 0 : which == 1 ? Dm::HK : 2 * Dm::HK) + h * dim;
    float rs = 1.f;
    if (which < 2) { float ss = 0.f; for (int d = 0; d < dim; ++d) { const float v = conv_at<C>(P, t, ch0 + d); ss += v * v; } rs = 1.f / sqrtf(ss + Dm::EPS); }
    for (int d = 0; d < dim; ++d) P.QKVN[(size_t)t * Dm::QKVC + ch0 + d] = f2bf(conv_at<C>(P, t, ch0 + d) * rs);
}
template <class C> HD void n_gc(const NP& P, int item) {
    typedef Dims<C> Dm; const int n = item % Dm::NCH, h = (item / Dm::NCH) % C::DNH, b = item / (Dm::NCH * C::DNH);
    float s = 0.f; for (int i = 0; i < C::CH; ++i) { const size_t t = (size_t)b * C::L + n * C::CH + i; s += P.G[t * C::DNH + h]; P.GC[t * C::DNH + h] = s; }
    P.GL[item] = expf(s);
}
template <class C> HD void n_amat(const NP& P, int item) {
    typedef Dims<C> Dm; const int j = item % C::CH, i = (item / C::CH) % C::CH, cid = item / (C::CH * C::CH);
    const int n = cid % Dm::NCH, h = (cid / Dm::NCH) % C::DNH, b = cid / (Dm::NCH * C::DNH);
    const size_t ti = (size_t)b * C::L + n * C::CH + i, tj = (size_t)b * C::L + n * C::CH + j;
    float a = 0.f, at = 0.f;
    if (j <= i) {
        const bf16_t* ki = P.QKVN + ti * Dm::QKVC + Dm::HK + h * C::DK; const bf16_t* kj = P.QKVN + tj * Dm::QKVC + Dm::HK + h * C::DK; const bf16_t* qi = P.QKVN + ti * Dm::QKVC + h * C::DK;
        float kk = 0.f, qk = 0.f; for (int d = 0; d < C::DK; ++d) { const float kjd = bf2f(kj[d]); kk += bf2f(ki[d]) * kjd; qk += bf2f(qi[d]) * kjd; }
        const float dec = expf(P.GC[ti * C::DNH + h] - P.GC[tj * C::DNH + h]);
        if (j < i) a = P.BETA[ti * C::DNH + h] * kk * dec;
        at = qk * (1.f / sqrtf((float)C::DK)) * dec;
    }
    P.AMAT[(size_t)cid * C::CH * C::CH + i * C::CH + j] = a;
    P.ATT[(size_t)cid * C::CH * C::CH + i * C::CH + j] = f2bf(at);
}
template <class C> HD void n_solve(const NP& P, int item, int tid, int NT) {
    typedef Dims<C> Dm; const int NC = C::DV + C::DK; const int col = item % NC, cid = item / NC;
    const int n = cid % Dm::NCH, h = (cid / Dm::NCH) % C::DNH, b = cid / (Dm::NCH * C::DNH);
    const float* A = P.AMAT + (size_t)cid * C::CH * C::CH;
    for (int i = 0; i < C::CH; ++i) {
        const size_t t = (size_t)b * C::L + n * C::CH + i; const float beta = P.BETA[t * C::DNH + h];
        float r;
        if (col < C::DV) r = bf2f(P.QKVN[t * Dm::QKVC + 2 * Dm::HK + h * C::DV + col]) * beta;
        else r = bf2f(P.QKVN[t * Dm::QKVC + Dm::HK + h * C::DK + (col - C::DV)]) * beta * expf(P.GC[t * C::DNH + h]);
        for (int j = 0; j < i; ++j) r -= A[i * C::CH + j] * SCR(j);
        SCR(i) = r;
    }
    for (int i = 0; i < C::CH; ++i) {
        const size_t t = (size_t)b * C::L + n * C::CH + i;
        if (col < C::DV) P.QKVN[t * Dm::QKVC + 2 * Dm::HK + h * C::DV + col] = f2bf(SCR(i));
        else P.W[((size_t)cid * C::CH + i) * C::DK + (col - C::DV)] = f2bf(SCR(i));
    }
}
template <class C> HD void n_scale(const NP& P, int item) {
    typedef Dims<C> Dm; const int h = item % C::DNH; const size_t t = item / C::DNH; const int l = (int)(t % C::L), b = (int)(t / C::L), n = l / C::CH;
    const float gc = P.GC[t * C::DNH + h]; const size_t tl = (size_t)b * C::L + n * C::CH + C::CH - 1; const float gl = P.GC[tl * C::DNH + h];
    const float fq = expf(gc) * (1.f / sqrtf((float)C::DK)), fk = expf(gl - gc);
    bf16_t* q = P.QKVN + t * Dm::QKVC + h * C::DK; bf16_t* k = P.QKVN + t * Dm::QKVC + Dm::HK + h * C::DK;
    for (int d = 0; d < C::DK; ++d) { q[d] = f2bf(bf2f(q[d]) * fq); k[d] = f2bf(bf2f(k[d]) * fk); }
}
template <class C> HD void n_scan(const NP& P, int item, int tid, int NT) {
    typedef Dims<C> Dm; const int e = item % C::DV, h = (item / C::DV) % C::DNH, b = item / (C::DV * C::DNH);
    for (int d = 0; d < C::DK; ++d) SCR(d) = 0.f;
    for (int n = 0; n < Dm::NCH; ++n) {
        const int cid = (b * C::DNH + h) * Dm::NCH + n; const size_t t0 = (size_t)b * C::L + n * C::CH;
        const bf16_t* Wc = P.W + (size_t)cid * C::CH * C::DK; const bf16_t* At = P.ATT + (size_t)cid * C::CH * C::CH;
        for (int r = 0; r < C::CH; ++r) { float acc = bf2f(P.QKVN[(t0 + r) * Dm::QKVC + 2 * Dm::HK + h * C::DV + e]);
            for (int d = 0; d < C::DK; ++d) acc -= bf2f(Wc[r * C::DK + d]) * SCR(d);
            SCR(C::DK + r) = acc; }
        for (int r = 0; r < C::CH; ++r) { float o = 0.f; const bf16_t* qd = P.QKVN + (t0 + r) * Dm::QKVC + h * C::DK;
            for (int d = 0; d < C::DK; ++d) o += bf2f(qd[d]) * SCR(d);
            for (int s = 0; s <= r; ++s) o += bf2f(At[r * C::CH + s]) * SCR(C::DK + s);
            P.O[(t0 + r) * Dm::HV + h * C::DV + e] = f2bf(o); }
        const float gl = P.GL[cid];
        for (int d = 0; d < C::DK; ++d) { float acc = SCR(d) * gl;
            for (int r = 0; r < C::CH; ++r) acc += bf2f(P.QKVN[(t0 + r) * Dm::QKVC + Dm::HK + h * C::DK + d]) * SCR(C::DK + r);
            SCR(d) = acc; }
    }
}
template <class C> HD void n_ogate(const NP& P, int item) {
    typedef Dims<C> Dm; const int h = item % C::DNH; const size_t t = item / C::DNH; const bf16_t* o = P.O + t * Dm::HV + h * C::DV;
    float ss = 0.f; for (int d = 0; d < C::DV; ++d) { const float v = bf2f(o[d]); ss += v * v; } const float rs = 1.f / sqrtf(ss / C::DV + Dm::EPS);
    for (int d = 0; d < C::DV; ++d) P.OG[t * Dm::HV + h * C::DV + d] = f2bf(bf2f(o[d]) * rs * P.dn_onorm_w[d] * siluf(bf2f(P.Z[t * Dm::HV + h * C::DV + d])));
}
template <class C> HD void n_q(const NP& P, int item) {
    const int NJ = C::MH * C::MDH + C::IH * C::ID; const int j = item % NJ; const size_t t = item / NJ; const bf16_t* ql = P.QLATN + t * C::QL;
    float acc = 0.f;
    if (j < C::MH * C::MDH) { for (int k = 0; k < C::QL; ++k) acc += bf2f(ql[k]) * P.w_uq[(size_t)k * C::MH * C::MDH + j]; P.QF[t * C::MH * C::MDH + j] = acc; }
    else { const int jj = j - C::MH * C::MDH; for (int k = 0; k < C::QL; ++k) acc += bf2f(ql[k]) * P.w_iq[(size_t)k * C::IH * C::ID + jj]; P.QIDX[t * C::IH * C::ID + jj] = acc; }
}
template <class C> HD void n_qabs(const NP& P, int item) {
    const int c = item % C::KVL, h = (item / C::KVL) % C::MH; const size_t t = item / (C::KVL * C::MH);
    float acc = 0.f; for (int d = 0; d < C::MDH; ++d) acc += P.QF[t * C::MH * C::MDH + h * C::MDH + d] * P.w_uk[((size_t)c * C::MH + h) * C::MDH + d];
    P.QABS[(t * C::MH + h) * C::KVL + c] = f2bf(acc * (1.f / sqrtf((float)C::MDH)));
}
template <class C> HD void n_index(const NP& P, int t, int tid, int NT) {
    typedef Dims<C> Dm; const int K = Dm::TOPK; const int l = t % C::L, b = t / C::L; int cnt = 0;
    const float* qi = P.QIDX + (size_t)t * C::IH * C::ID; const float* wi = P.WIDX + (size_t)t * C::IH;
#define HV_(i) SCR(i)
#define HI_(i) SCR(K + (i))
#define WORSE(v1, i1, v2, i2) ((v1) < (v2) || ((v1) == (v2) && (i1) > (i2)))
    for (int s = 0; s <= l; ++s) {
        const bf16_t* kr = P.KIDXN + ((size_t)b * C::L + s) * C::ID; float sc = 0.f;
        for (int h = 0; h < C::IH; ++h) { float dot = 0.f; for (int d = 0; d < C::ID; ++d) dot += qi[h * C::ID + d] * bf2f(kr[d]); sc += wi[h] * (dot > 0.f ? dot : 0.f); }
        const float fs = (float)s;
        if (cnt < K) {
            int i = cnt++; HV_(i) = sc; HI_(i) = fs;
            while (i > 0) { const int p = (i - 1) >> 1; const float pv = HV_(p), pi = HI_(p), cv = HV_(i), ci = HI_(i);
                if (WORSE(cv, ci, pv, pi)) { HV_(p) = cv; HI_(p) = ci; HV_(i) = pv; HI_(i) = pi; i = p; } else break; }
        } else if (HV_(0) < sc) {
            int i = 0; HV_(0) = sc; HI_(0) = fs;
            for (;;) { const int a = 2 * i + 1, c2 = a + 1; int w = i; float wv = HV_(i), wx = HI_(i);
                if (a < K) { const float av = HV_(a), ai = HI_(a); if (WORSE(av, ai, wv, wx)) { w = a; wv = av; wx = ai; } }
                if (c2 < K) { const float bv = HV_(c2), bi = HI_(c2); if (WORSE(bv, bi, wv, wx)) { w = c2; wv = bv; wx = bi; } }
                if (w == i) break; const float tv = HV_(i), ti = HI_(i); HV_(i) = wv; HI_(i) = wx; HV_(w) = tv; HI_(w) = ti; i = w; }
        }
    }
    for (int k = 0; k < K; ++k) P.IDX[(size_t)t * K + k] = (k < cnt) ? (int)HI_(k) : -1;
#undef HV_
#undef HI_
#undef WORSE
}
template <class C> HD void n_attn(const NP& P, int item, int tid, int NT) {
    typedef Dims<C> Dm; const int K = Dm::TOPK; const int h = item % C::MH; const size_t t = item / C::MH; const int b = (int)(t / C::L);
    const int* idx = P.IDX + t * K; bf16_t* qa = P.QABS + (t * C::MH + h) * C::KVL;
    int nv = 0; float m = -3.0e38f;
    for (int k = 0; k < K; ++k) { const int s = idx[k]; if (s < 0) break; ++nv;
        const bf16_t* kv = P.CKVN + ((size_t)b * C::L + s) * C::KVL; float lg = 0.f; for (int c = 0; c < C::KVL; ++c) lg += bf2f(qa[c]) * bf2f(kv[c]);
        SCR(k) = lg; m = lg > m ? lg : m; }
    float sum = 0.f; for (int k = 0; k < nv; ++k) { const float p = expf(SCR(k) - m); SCR(k) = p; sum += p; }
    const float inv = 1.f / sum;
    for (int c = 0; c < C::KVL; ++c) { float acc = 0.f; for (int k = 0; k < nv; ++k) acc += SCR(k) * bf2f(P.CKVN[((size_t)b * C::L + idx[k]) * C::KVL + c]);
        SCR(K + c) = acc * inv; }
    for (int c = 0; c < C::KVL; ++c) qa[c] = f2bf(SCR(K + c));
}
template <class C> HD void n_oatt(const NP& P, int item) {
    const int d = item % C::MDV, h = (item / C::MDV) % C::MH; const size_t t = item / (C::MDV * C::MH);
    float acc = 0.f; for (int c = 0; c < C::KVL; ++c) acc += bf2f(P.OLAT[(t * C::MH + h) * C::KVL + c]) * P.w_uv[((size_t)c * C::MH + h) * C::MDV + d];
    P.OATT[t * C::MH * C::MDV + h * C::MDV + d] = f2bf(acc);
}
template <class C> HD void n_merge(const NP& P, int item) {
    typedef Dims<C> Dm; const int n = item % C::D; const size_t t = item / C::D;
    float ya = 0.f, yb = 0.f;
    for (int k = 0; k < Dm::HV; ++k) ya += bf2f(P.OG[t * Dm::HV + k]) * P.w_a_out[(size_t)k * C::D + n];
    for (int k = 0; k < C::MH * C::MDV; ++k) yb += bf2f(P.OATT[t * C::MH * C::MDV + k]) * P.w_b_out[(size_t)k * C::D + n];
    P.M[t * C::D + n] = f2bf(sigmf(bf2f(P.GA[t * C::D + n])) * ya + sigmf(bf2f(P.GB[t * C::D + n])) * yb);
}
template <class C> HD void n_wo(const NP& P, int item) {
    const int n = item % C::D; const size_t t = item / C::D; const int b = (int)(t / C::L);
    float acc = 0.f; for (int k = 0; k < C::D; ++k) acc += bf2f(P.M[t * C::D + k]) * P.w_o[(size_t)k * C::D + n];
    P.X1[t * C::D + n] = P.x[t * C::D + n] + P.MOD[(size_t)b * 6 * C::D + 2 * C::D + n] * acc;
}
template <class C> HD void n_h2(const NP& P, int t) {
    const int D = C::D; const int b = t / C::L; const float* xr = P.X1 + (size_t)t * D;
    float ss = 0.f; for (int i = 0; i < D; ++i) ss += xr[i] * xr[i];
    const float rstd = 1.f / sqrtf(ss / D + Dims<C>::EPS);
    const float* sh = P.MOD + (size_t)b * 6 * D + 3 * D; const float* sc = sh + D;
    for (int i = 0; i < D; ++i) P.H2[(size_t)t * D + i] = f2bf(xr[i] * rstd * P.norm2_w[i] * (1.f + sc[i]) + sh[i]);
}
template <class C> HD void n_peerq(const NP& P, int item) {
    const int NJ = C::PH * C::PDQ; const int j = item % NJ; const size_t t = item / NJ;
    float acc = 0.f; for (int k = 0; k < C::D; ++k) acc += bf2f(P.H2[t * C::D + k]) * P.peer_w_q[(size_t)k * NJ + j];
    P.PQ[t * NJ + j] = acc;
}
template <class C> HD void n_route(const NP& P, int item, int tid, int NT) {
    typedef Dims<C> Dm; const int PK = C::PK, TK = C::PTK; const int h = item % C::PH; const size_t t = item / C::PH;
    const int oS = 0, oSV = 2 * PK, oSI = oSV + 2 * TK, oC = oSI + 2 * TK;
    for (int p = 0; p < 2; ++p) for (int n = 0; n < PK; ++n) {
        const float* q = P.PQ + t * C::PH * C::PDQ + (h * 2 + p) * Dm::PD2; const float* key = P.peer_sub_keys + (((size_t)h * 2 + p) * PK + n) * Dm::PD2;
        float acc = 0.f; for (int d = 0; d < Dm::PD2; ++d) acc += q[d] * key[d]; SCR(oS + p * PK + n) = acc; }
    for (int p = 0; p < 2; ++p) for (int k = 0; k < TK; ++k) { int bi = 0; float bv = -3.0e38f;
        for (int n = 0; n < PK; ++n) { const float v = SCR(oS + p * PK + n); if (v > bv) { bv = v; bi = n; } }
        SCR(oSV + p * TK + k) = bv; SCR(oSI + p * TK + k) = (float)bi; SCR(oS + p * PK + bi) = -3.0e38f; }
    for (int i = 0; i < TK; ++i) for (int j = 0; j < TK; ++j) SCR(oC + i * TK + j) = SCR(oSV + i) + SCR(oSV + TK + j);
    float tv[C::PTK]; int te[C::PTK]; float mx = -3.0e38f;
#pragma unroll
    for (int k = 0; k < TK; ++k) { int bi = 0; float bv = -3.0e38f;
        for (int n = 0; n < TK * TK; ++n) { const float v = SCR(oC + n); if (v > bv) { bv = v; bi = n; } }
        SCR(oC + bi) = -3.0e38f; tv[k] = bv; te[k] = (int)SCR(oSI + bi / TK) * PK + (int)SCR(oSI + TK + bi % TK); mx = bv > mx ? bv : mx; }
    float sum = 0.f;
#pragma unroll
    for (int k = 0; k < TK; ++k) { tv[k] = expf(tv[k] - mx); sum += tv[k]; }
#pragma unroll
    for (int k = 0; k < TK; ++k) { P.EXPI[t * Dm::SLOTS + h * TK + k] = te[k]; P.GATE[t * Dm::SLOTS + h * TK + k] = tv[k] / sum; }
}
template <class C> HD void n_pact(const NP& P, int item) {
    typedef Dims<C> Dm; const int sl = item % Dm::SLOTS; const size_t t = item / Dm::SLOTS; const int e = P.EXPI[t * Dm::SLOTS + sl];
    const float* u = P.peer_u + (size_t)e * C::D; float acc = 0.f; for (int d = 0; d < C::D; ++d) acc += u[d] * bf2f(P.H2[t * C::D + d]);
    P.ACT[t * Dm::SLOTS + sl] = geluf(acc) * P.GATE[t * Dm::SLOTS + sl];
}
template <class C> HD void n_pout(const NP& P, int item) {
    typedef Dims<C> Dm; const int d = item % C::D; const size_t t = item / C::D; const int b = (int)(t / C::L);
    float acc = 0.f; for (int s = 0; s < Dm::SLOTS; ++s) acc += P.ACT[t * Dm::SLOTS + s] * P.peer_v[(size_t)P.EXPI[t * Dm::SLOTS + s] * C::D + d];
    P.X1[t * C::D + d] += P.MOD[(size_t)b * 6 * C::D + 5 * C::D + d] * acc;
}
template <class C> HD void n_final(const NP& P, int t) {
    const int D = C::D; const float* xr = P.X1 + (size_t)t * D; float ss = 0.f; for (int i = 0; i < D; ++i) ss += xr[i] * xr[i];
    const float rstd = 1.f / sqrtf(ss / D + Dims<C>::EPS);
    for (int i = 0; i < D; ++i) P.out[(size_t)t * D + i] = xr[i] * rstd * P.final_norm_w[i];
}

template <class C> HD long stage_items(int st) {
    typedef Dims<C> Dm; const long T = Dm::T;
    switch (st) {
        case ST_MOD: return (long)C::B * 6 * C::D; case ST_H1: return T;
        case ST_INPROJ_A: return T * ((Dm::OFF_GA - 0) / 4) - T * (Dm::HV / 4);
        case ST_DSANORM: return T; case ST_CONV: return T * C::DNH * 3; case ST_GC: return Dm::NCHUNKS; case ST_AMAT: return (long)Dm::NCHUNKS * C::CH * C::CH;
        case ST_SOLVE: return (long)Dm::NCHUNKS * (C::DV + C::DK); case ST_SCALE: return T * C::DNH; case ST_SCAN: return (long)C::B * C::DNH * C::DV;
        case ST_Q: return T * (C::MH * C::MDH + C::IH * C::ID); case ST_QABS: return T * C::MH * C::KVL; case ST_INDEX: return T; case ST_ATTN: return T * C::MH;
        case ST_INPROJ_B: return T * ((Dm::HV + 2 * C::D) / 4); case ST_OGATE: return T * C::DNH; case ST_OATT: return T * C::MH * C::MDV; case ST_MERGE: return T * C::D;
        case ST_WO: return T * C::D; case ST_H2: return T; case ST_PEERQ: return T * C::PH * C::PDQ; case ST_ROUTE: return T * C::PH; case ST_PACT: return T * Dm::SLOTS;
        case ST_POUT: return T * C::D; case ST_FINAL: return T;
    }
    return 0;
}
template <class C> HD int stage_scr_words(int st) {
    typedef Dims<C> Dm;
    switch (st) { case ST_SOLVE: return C::CH; case ST_SCAN: return C::DK + C::CH; case ST_INDEX: return 2 * Dm::TOPK; case ST_ATTN: return Dm::TOPK + C::KVL;
        case ST_ROUTE: return 2 * C::PK + 4 * C::PTK + C::PTK * C::PTK; }
    return 0;
}
template <class C> HD void run_item(const NP& P, int st, long item, int tid, int NT) {
    typedef Dims<C> Dm;
    switch (st) {
        case ST_MOD: n_mod<C>(P, (int)item); break; case ST_H1: n_h1<C>(P, (int)item); break;
        case ST_INPROJ_A: { const int ngA = Dm::OFF_Z / 4, ngB = (Dm::OFF_GA - Dm::OFF_B) / 4, ng = ngA + ngB; const int t = (int)(item / ng), g = (int)(item % ng);
            if (g < ngA) n_inproj<C>(P, t * ngA + g, 0, Dm::OFF_Z); else n_inproj<C>(P, t * ngB + (g - ngA), Dm::OFF_B, Dm::OFF_GA); } break;
        case ST_DSANORM: n_dsanorm<C>(P, (int)item); break; case ST_CONV: n_conv<C>(P, (int)item); break; case ST_GC: n_gc<C>(P, (int)item); break;
        case ST_AMAT: n_amat<C>(P, (int)item); break; case ST_SOLVE: n_solve<C>(P, (int)item, tid, NT); break; case ST_SCALE: n_scale<C>(P, (int)item); break;
        case ST_SCAN: n_scan<C>(P, (int)item, tid, NT); break; case ST_Q: n_q<C>(P, (int)item); break; case ST_QABS: n_qabs<C>(P, (int)item); break;
        case ST_INDEX: n_index<C>(P, (int)item, tid, NT); break; case ST_ATTN: n_attn<C>(P, (int)item, tid, NT); break;
        case ST_INPROJ_B: { const int ngA = Dm::HV / 4, ngB = 2 * C::D / 4, ng = ngA + ngB; const int t = (int)(item / ng), g = (int)(item % ng);
            if (g < ngA) n_inproj<C>(P, t * ngA + g, Dm::OFF_Z, Dm::OFF_B); else n_inproj<C>(P, t * ngB + (g - ngA), Dm::OFF_GA, Dm::IN_COLS); } break;
        case ST_OGATE: n_ogate<C>(P, (int)item); break; case ST_OATT: n_oatt<C>(P, (int)item); break; case ST_MERGE: n_merge<C>(P, (int)item); break;
        case ST_WO: n_wo<C>(P, (int)item); break; case ST_H2: n_h2<C>(P, (int)item); break; case ST_PEERQ: n_peerq<C>(P, (int)item); break;
        case ST_ROUTE: n_route<C>(P, (int)item, tid, NT); break; case ST_PACT: n_pact<C>(P, (int)item); break; case ST_POUT: n_pout<C>(P, (int)item); break;
        case ST_FINAL: n_final<C>(P, (int)item); break;
    }
}
#define GAS __attribute__((address_space(1)))
#define LAS __attribute__((address_space(3)))
#define XB_TMO      128
#define XB_XCNT(j)  (256  + 64 * (j))
#define XB_XSUB(j)  (1280 + 64 * (j))
#define XB_XGEN(j)  (2304 + 64 * (j))
#define XB_TOP      3328
#define XB_TOPGEN   3392
#define XCD_BAR_WORDS 3456
#ifndef XB_SPIN_CAP
#define XB_SPIN_CAP (1u << 26)
#endif
__device__ __forceinline__ unsigned xb_ld(unsigned* p)              { return __hip_atomic_load(p, __ATOMIC_RELAXED, __HIP_MEMORY_SCOPE_AGENT); }
__device__ __forceinline__ unsigned xb_add(unsigned* p, unsigned v) { return __hip_atomic_fetch_add(p, v, __ATOMIC_RELAXED, __HIP_MEMORY_SCOPE_AGENT); }
__device__ __forceinline__ unsigned xb_xcc_id() { return (unsigned)__builtin_amdgcn_s_getreg((3 << 11) | 20) & 0xFu; }
#define XB_SPIN(cond, bar) do { unsigned _sp = 0; while (cond) { __builtin_amdgcn_s_sleep(1); \
    if ((++_sp & 255u) == 0u) { if (xb_ld(&(bar)[XB_TMO])) break; if (_sp > XB_SPIN_CAP) { atomicAdd(&(bar)[XB_TMO], 1u); break; } } } } while (0)
struct XcdBarrier { unsigned* bar; unsigned x; volatile LAS unsigned* st; };
__device__ __forceinline__ XcdBarrier xcd_barrier_post(unsigned* bar, volatile LAS unsigned* st) {
    XcdBarrier b; b.bar = bar; b.x = xb_xcc_id(); b.st = st;
    if (threadIdx.x == 0) (void)xb_add(&bar[XB_XCNT(b.x)], 1u);
    return b;
}
__device__ __forceinline__ void xcd_barrier_complete(unsigned* bar, unsigned x, unsigned& nloc, unsigned& nx) {
    const unsigned G = gridDim.x * gridDim.y * gridDim.z;
    unsigned sum, cnt, mine, sp = 0u;
    for (;;) {
        sum = 0u; cnt = 0u; mine = 0u;
#pragma unroll
        for (unsigned j = 0; j < 16; ++j) { const unsigned c = xb_ld(&bar[XB_XCNT(j)]); sum += c; cnt += (c > 0u) ? 1u : 0u; mine = (j == x) ? c : mine; }
        if (sum == G) break;
        __builtin_amdgcn_s_sleep(1);
        if ((++sp & 255u) == 0u) { if (xb_ld(&bar[XB_TMO])) break; if (sp > XB_SPIN_CAP) { atomicAdd(&bar[XB_TMO], 1u); break; } }
    }
    nloc = mine > 0u ? mine : 1u; nx = cnt > 0u ? cnt : 1u;
}
__device__ __forceinline__ void xcd_barrier(const XcdBarrier& b) {
    asm volatile("s_waitcnt vmcnt(0)" ::: "memory");
    __syncthreads();
    if (threadIdx.x == 0) {
        unsigned* bar = b.bar;
        __builtin_amdgcn_s_waitcnt(0);
        unsigned nloc = b.st[0], nx = b.st[1];
        if (nloc == 0u) { xcd_barrier_complete(bar, b.x, nloc, nx); b.st[0] = nloc; b.st[1] = nx; }
        const unsigned old = xb_add(&bar[XB_XSUB(b.x)], 1u);
        const unsigned gen = old / nloc;
        if (old + 1u == (gen + 1u) * nloc) {
            __builtin_amdgcn_fence(__ATOMIC_RELEASE, "agent");
            asm volatile("s_waitcnt vmcnt(0)" ::: "memory");
            const unsigned og = xb_add(&bar[XB_TOP], 1u);
            const unsigned tg = og / nx;
            if (og + 1u == (tg + 1u) * nx) xb_add(&bar[XB_TOPGEN], 1u);
            else XB_SPIN(xb_ld(&bar[XB_TOPGEN]) == tg, bar);
            __builtin_amdgcn_fence(__ATOMIC_ACQUIRE, "agent");
            xb_add(&bar[XB_XGEN(b.x)], 1u);
            asm volatile("s_waitcnt vmcnt(0)" ::: "memory");
        } else {
            XB_SPIN(xb_ld(&bar[XB_XGEN(b.x)]) == gen, bar);
            __builtin_amdgcn_fence(__ATOMIC_ACQUIRE, "agent");
            asm volatile("s_waitcnt vmcnt(0)" ::: "memory");
        }
    }
    __syncthreads();
}
constexpr int NTHR = 512;
constexpr int LDS_BYTES = 147456;
constexpr size_t CTL_ZERO_BYTES = 32768;
struct MArgs { NP P; float* scr_main; float* scr_alt; unsigned* ctl; };
__global__ void __launch_bounds__(NTHR, 2) mega(MArgs a) {
    typedef CfgFull C; typedef WsMap<C> W;
    extern __shared__ __attribute__((aligned(16))) unsigned char lds[];
    volatile LAS unsigned* MISC = (volatile LAS unsigned*)((LAS unsigned char*)lds + LDS_BYTES - 256);
    if (threadIdx.x < 64) MISC[threadIdx.x] = 0u;
    __syncthreads();
    XcdBarrier bar = xcd_barrier_post(a.ctl, MISC + 8);
    NP P = a.P;
    const int G = gridDim.x, NTall = G * NTHR;
    const int tid = ((threadIdx.x >> 6) * G + blockIdx.x) * 64 + (threadIdx.x & 63);
    for (int st = 0; st < ST_COUNT; ++st) {
        P.SCRP = (st == ST_ROUTE) ? a.scr_alt : a.scr_main;
        const long n = stage_items<C>(st); const int words = stage_scr_words<C>(st);
        int nt = NTall; if (words) { const long cap = (long)(W::SCR_BYTES / (4 * (size_t)words)); if (cap < nt) nt = (int)cap; }
        if (tid < nt) for (long it = tid; it < n; it += nt) run_item<C>(P, st, it, tid, nt);
        if (st + 1 < ST_COUNT) xcd_barrier(bar);
    }
}
extern "C" void kernel_launch(void* const* d_in, const int* in_sizes, int n_in, void* d_out, int out_size, void* d_ws, size_t ws_size, hipStream_t stream) {
    typedef CfgFull C; typedef WsMap<C> W;
    static int grid = 0;
    if (grid == 0) {
        if (n_in != 26 || ws_size < W::END) { fprintf(stderr, "kernel_launch: need 26 inputs and %zu bytes of workspace, got %d / %zu\n", (size_t)W::END, n_in, ws_size); grid = -1; return; }
        int dev = 0, cus = 0, per_cu = 0;
        if (hipGetDevice(&dev) != hipSuccess || hipDeviceGetAttribute(&cus, hipDeviceAttributeMultiprocessorCount, dev) != hipSuccess) { grid = -1; return; }
        if (hipFuncSetAttribute((const void*)mega, hipFuncAttributeMaxDynamicSharedMemorySize, LDS_BYTES) != hipSuccess) { fprintf(stderr, "kernel_launch: hipFuncSetAttribute failed\n"); grid = -1; return; }
        if (hipOccupancyMaxActiveBlocksPerMultiprocessor(&per_cu, (const void*)mega, NTHR, LDS_BYTES) != hipSuccess || per_cu < 1) { fprintf(stderr, "kernel_launch: occupancy query says %d\n", per_cu); }
        (void)hipGetLastError();
        grid = cus;
    }
    if (grid < 0) return;
    hipMemsetAsync(d_ws, 0, CTL_ZERO_BYTES, stream);
    MArgs a{}; np_setup<C>(a.P, d_in, d_out, d_ws);
    a.scr_main = a.P.SCRP; a.scr_alt = (float*)((char*)d_out + W::d_SCR); a.ctl = (unsigned*)d_ws;
    hipLaunchKernelGGL(mega, dim3(grid), dim3(NTHR), LDS_BYTES, stream, a);
}
```

```cpp
#include <hip/hip_runtime.h>
#include <cstdio>
#include <cstdint>
#define HD __host__ __device__ __forceinline__
#ifndef HD
#define HD
#endif

typedef unsigned short bf16_t;
HD float bf2f(bf16_t v) { unsigned u = ((unsigned)v) << 16; float f; __builtin_memcpy(&f, &u, 4); return f; }
HD bf16_t f2bf(float f) { unsigned u; __builtin_memcpy(&u, &f, 4); u = (u + 0x7fffu + ((u >> 16) & 1u)) >> 16; return (bf16_t)u; }
HD float siluf(float x) { return x / (1.f + expf(-x)); }
HD float sigmf(float x) { return 1.f / (1.f + expf(-x)); }
HD float softplusf(float x) { return x > 20.f ? x : log1pf(expf(x)); }
HD float geluf(float x) { return 0.5f * x * (1.f + erff(x * 0.70710678118654752f)); }

struct CfgFull {
    static constexpr int D = 1024, B = 2, L = 8192;
    static constexpr int DNH = 8, DK = 128, DV = 128, CONV = 4, CH = 64;
    static constexpr int MH = 8, MDH = 128, MDV = 128, QL = 256, KVL = 256;
    static constexpr int IH = 8, ID = 64, TOPK_MAX = 256;
    static constexpr int PK = 128, PH = 8, PDQ = 256, PTK = 16;
};
struct CfgSmall {
    static constexpr int D = 64, B = 2, L = 512;
    static constexpr int DNH = 2, DK = 16, DV = 16, CONV = 4, CH = 64;
    static constexpr int MH = 2, MDH = 16, MDV = 16, QL = 32, KVL = 32;
    static constexpr int IH = 4, ID = 16, TOPK_MAX = 64;
    static constexpr int PK = 16, PH = 2, PDQ = 32, PTK = 4;
};
template <class C> struct Dims {
    static constexpr int T = C::B * C::L, HK = C::DNH * C::DK, HV = C::DNH * C::DV, QKVC = 2 * HK + HV;
    static constexpr int NCH = C::L / C::CH, NCHUNKS = C::B * C::DNH * NCH;
    static constexpr int TOPK = (C::TOPK_MAX < C::L / 4) ? C::TOPK_MAX : C::L / 4;
    static constexpr int PE = C::PK * C::PK, SLOTS = C::PH * C::PTK, PD2 = C::PDQ / 2;
    static constexpr int OFF_Q = 0, OFF_K = HK, OFF_V = 2 * HK, OFF_Z = 2 * HK + HV, OFF_B = OFF_Z + HV, OFF_A = OFF_B + C::DNH,
                         OFF_QL = OFF_A + C::DNH, OFF_CKV = OFF_QL + C::QL, OFF_KI = OFF_CKV + C::KVL, OFF_WI = OFF_KI + C::ID,
                         OFF_GA = OFF_WI + C::IH, OFF_GB = OFF_GA + C::D, IN_COLS = OFF_GB + C::D;
    static constexpr float EPS = 1e-6f;
};

struct NP {
    const float *x, *c, *w_ada, *b_ada, *norm1_w, *w_in, *dn_conv_w, *dn_a_log, *dn_dt_bias, *dn_onorm_w, *q_norm_w, *kv_norm_w, *idx_k_norm_w,
        *w_uq, *w_iq, *w_uk, *w_uv, *w_a_out, *w_b_out, *w_o, *norm2_w, *peer_w_q, *peer_sub_keys, *peer_u, *peer_v, *final_norm_w;
    float* out;
    float* MOD; bf16_t* H1; bf16_t* QKVP; bf16_t* QKVN; bf16_t* Z; bf16_t* GA; bf16_t* GB;
    float *BETA, *G, *GC, *GL, *QLATR, *CKVR, *KIDXR, *WIDX; bf16_t *QLATN, *CKVN, *KIDXN;
    float* AMAT; bf16_t* ATT; bf16_t* W; bf16_t* O; bf16_t* OG;
    float *QF, *QIDX; bf16_t* QABS; int* IDX; bf16_t* OLAT; bf16_t* OATT; bf16_t* M; float* X1; bf16_t* H2;
    float* PQ; int* EXPI; float* GATE; float* ACT; float* S; float* RAW;
    float* SCRP;
};
#define SCR(w) P.SCRP[(size_t)(w) * NT + tid]

template <class C> struct WsMap {
    typedef Dims<C> Dm;
    static constexpr size_t al(size_t x) { return (x + 255) & ~(size_t)255; }
    static constexpr size_t mx(size_t a, size_t b) { return a > b ? a : b; }
    static constexpr size_t SZ_QKV = al((size_t)Dm::T * Dm::QKVC * 2);
    static constexpr size_t S1a = al(mx((size_t)Dm::T * C::MH * C::KVL * 2, (size_t)Dm::T * C::D * 4));
    static constexpr size_t S1b = al(mx(mx((size_t)Dm::T * Dm::TOPK * 4, (size_t)Dm::T * C::MH * C::MDV * 2), (size_t)Dm::T * C::D * 2));
    static constexpr size_t RAW = al((size_t)Dm::T * C::QL * 4) + al((size_t)Dm::T * C::KVL * 4) + al((size_t)Dm::T * C::ID * 4);
    static constexpr size_t SZ_A1 = mx(mx(SZ_QKV, RAW), S1a + S1b);
    static constexpr size_t SZ_AAW = al((size_t)Dm::NCHUNKS * C::CH * C::CH * 4) + al((size_t)Dm::NCHUNKS * C::CH * C::CH * 2) + al((size_t)Dm::NCHUNKS * C::CH * C::DK * 2);
    static constexpr size_t SZ_QQ = al((size_t)Dm::T * C::MH * C::MDH * 4) + al((size_t)Dm::T * C::IH * C::ID * 4);
    static constexpr size_t SZ_ZGG = al((size_t)Dm::T * Dm::HV * 2) + 2 * al((size_t)Dm::T * C::D * 2);
    static constexpr size_t SZ_A0 = mx(mx(SZ_QKV, SZ_AAW), mx(SZ_QQ, SZ_ZGG));
    static constexpr size_t A1 = 1 << 20, A0 = A1 + SZ_A1, A2 = A0 + SZ_A0;
    static constexpr size_t o_MOD = 65536, o_BETA = A2, o_G = o_BETA + al((size_t)Dm::T * C::DNH * 4), o_GC = o_G + al((size_t)Dm::T * C::DNH * 4),
        o_GL = o_GC + al((size_t)Dm::T * C::DNH * 4), o_WIDX = o_GL + al((size_t)Dm::NCHUNKS * 4), o_QLATN = o_WIDX + al((size_t)Dm::T * C::IH * 4),
        o_CKVN = o_QLATN + al((size_t)Dm::T * C::QL * 2), o_KIDXN = o_CKVN + al((size_t)Dm::T * C::KVL * 2), A3 = o_KIDXN + al((size_t)Dm::T * C::ID * 2);
    static constexpr size_t SCR_BYTES = 16u << 20;
    static constexpr size_t o_PQ = A0;
    static constexpr size_t END = mx(A3 + SCR_BYTES, o_PQ + al((size_t)Dm::T * C::PH * C::PDQ * 4));
    static_assert(o_MOD + (size_t)C::B * 6 * C::D * 4 <= A1, "MOD in the first MiB");
    static constexpr size_t o_QLATR = A1, o_CKVR = o_QLATR + al((size_t)Dm::T * C::QL * 4), o_KIDXR = o_CKVR + al((size_t)Dm::T * C::KVL * 4);
    static constexpr size_t o_AMAT = A0, o_ATT = o_AMAT + al((size_t)Dm::NCHUNKS * C::CH * C::CH * 4), o_W = o_ATT + al((size_t)Dm::NCHUNKS * C::CH * C::CH * 2);
    static constexpr size_t o_QF = A0, o_QIDX = o_QF + al((size_t)Dm::T * C::MH * C::MDH * 4);
    static constexpr size_t o_QABS = A1, o_IDX = A1 + S1a;
    static constexpr size_t o_Z = A0, o_GA = o_Z + al((size_t)Dm::T * Dm::HV * 2), o_GB = o_GA + al((size_t)Dm::T * C::D * 2);
    static constexpr size_t o_OATT = o_IDX, o_X1 = A1, o_H2 = o_IDX;
    static constexpr size_t d_H1 = 0, d_O = al((size_t)Dm::T * C::D * 2), d_OG = 0, d_M = d_O;
    static constexpr size_t d_EXPI = 0, d_GATE = al((size_t)Dm::T * Dm::SLOTS * 4), d_ACT = 2 * d_GATE, d_SCR = (size_t)Dm::T * C::D * 2;
    static_assert(d_O + (size_t)Dm::T * Dm::HV * 2 <= (size_t)Dm::T * C::D * 4 && d_ACT + (size_t)Dm::T * Dm::SLOTS * 4 <= d_SCR, "d_out scratch");
};

template <class C> inline void np_setup(NP& P, void* const* d_in, void* d_out, void* d_ws) {
    typedef WsMap<C> W;
    const float** f = (const float**)&P.x;
    for (int i = 0; i < 26; ++i) f[i] = (const float*)d_in[i];
    char* ws = (char*)d_ws; char* dob = (char*)d_out;
    P.out = (float*)d_out;
    P.MOD = (float*)(ws + W::o_MOD); P.H1 = (bf16_t*)(dob + W::d_H1); P.QKVP = (bf16_t*)(ws + W::A0); P.QKVN = (bf16_t*)(ws + W::A1);
    P.Z = (bf16_t*)(ws + W::o_Z); P.GA = (bf16_t*)(ws + W::o_GA); P.GB = (bf16_t*)(ws + W::o_GB);
    P.BETA = (float*)(ws + W::o_BETA); P.G = (float*)(ws + W::o_G); P.GC = (float*)(ws + W::o_GC); P.GL = (float*)(ws + W::o_GL);
    P.QLATR = (float*)(ws + W::o_QLATR); P.CKVR = (float*)(ws + W::o_CKVR); P.KIDXR = (float*)(ws + W::o_KIDXR); P.WIDX = (float*)(ws + W::o_WIDX);
    P.QLATN = (bf16_t*)(ws + W::o_QLATN); P.CKVN = (bf16_t*)(ws + W::o_CKVN); P.KIDXN = (bf16_t*)(ws + W::o_KIDXN);
    P.AMAT = (float*)(ws + W::o_AMAT); P.ATT = (bf16_t*)(ws + W::o_ATT); P.W = (bf16_t*)(ws + W::o_W); P.O = (bf16_t*)(dob + W::d_O); P.OG = (bf16_t*)(dob + W::d_OG);
    P.QF = (float*)(ws + W::o_QF); P.QIDX = (float*)(ws + W::o_QIDX); P.QABS = (bf16_t*)(ws + W::o_QABS); P.IDX = (int*)(ws + W::o_IDX); P.OLAT = P.QABS;
    P.OATT = (bf16_t*)(ws + W::o_OATT); P.M = (bf16_t*)(dob + W::d_M); P.X1 = (float*)(ws + W::o_X1); P.H2 = (bf16_t*)(ws + W::o_H2);
    P.PQ = (float*)(ws + W::o_PQ); P.EXPI = (int*)(dob + W::d_EXPI); P.GATE = (float*)(dob + W::d_GATE); P.ACT = (float*)(dob + W::d_ACT);
    P.SCRP = (float*)(ws + W::A3); P.S = nullptr; P.RAW = (float*)(ws + W::A1);
}

enum { ST_MOD = 0, ST_H1, ST_INPROJ_A, ST_DSANORM, ST_CONV, ST_GC, ST_AMAT, ST_SOLVE, ST_SCALE, ST_SCAN, ST_Q, ST_QABS, ST_INDEX, ST_ATTN,
       ST_INPROJ_B, ST_QIDX, ST_SMALL, ST_OGATE, ST_OATT, ST_MERGE, ST_WO, ST_H2, ST_PEERQ, ST_ROUTE, ST_PACT, ST_POUT, ST_FINAL, ST_COUNT };

template <class C> HD void n_mod(const NP& P, int item) {
    const int D = C::D; const int b = item / (6 * D), j = item % (6 * D);
    float acc = P.b_ada[j];
    for (int i = 0; i < D; ++i) acc += siluf(P.c[b * D + i]) * P.w_ada[(size_t)i * 6 * D + j];
    P.MOD[item] = acc;
}
template <class C> HD void n_h1(const NP& P, int t) {
    const int D = C::D; const int b = t / C::L; const float* xr = P.x + (size_t)t * D;
    float ss = 0.f; for (int i = 0; i < D; ++i) ss += xr[i] * xr[i];
    const float rstd = 1.f / sqrtf(ss / D + Dims<C>::EPS);
    const float* sh = P.MOD + (size_t)b * 6 * D; const float* sc = sh + D;
    for (int i = 0; i < D; ++i) P.H1[(size_t)t * D + i] = f2bf(xr[i] * rstd * P.norm1_w[i] * (1.f + sc[i]) + sh[i]);
}
template <class C> HD void inproj_store(const NP& P, int t, int n, float v) {
    typedef Dims<C> Dm;
    if (n < Dm::OFF_Z) P.QKVP[(size_t)t * Dm::QKVC + n] = f2bf(v);
    else if (n < Dm::OFF_B) P.Z[(size_t)t * Dm::HV + (n - Dm::OFF_Z)] = f2bf(v);
    else if (n < Dm::OFF_A) P.BETA[(size_t)t * C::DNH + (n - Dm::OFF_B)] = sigmf(v);
    else if (n < Dm::OFF_QL) { const int h = n - Dm::OFF_A; P.G[(size_t)t * C::DNH + h] = -expf(P.dn_a_log[h]) * softplusf(v + P.dn_dt_bias[h]); }
    else if (n < Dm::OFF_CKV) P.QLATR[(size_t)t * C::QL + (n - Dm::OFF_QL)] = v;
    else if (n < Dm::OFF_KI) P.CKVR[(size_t)t * C::KVL + (n - Dm::OFF_CKV)] = v;
    else if (n < Dm::OFF_WI) P.KIDXR[(size_t)t * C::ID + (n - Dm::OFF_KI)] = v;
    else if (n < Dm::OFF_GA) P.WIDX[(size_t)t * C::IH + (n - Dm::OFF_WI)] = v * (1.f / sqrtf((float)C::IH) / sqrtf((float)C::ID));
    else if (n < Dm::OFF_GB) P.GA[(size_t)t * C::D + (n - Dm::OFF_GA)] = f2bf(v);
    else P.GB[(size_t)t * C::D + (n - Dm::OFF_GB)] = f2bf(v);
}
template <class C> HD void n_inproj(const NP& P, int item, int c0, int c1) {
    typedef Dims<C> Dm; const int ng = (c1 - c0) / 4; const int t = item / ng, n = c0 + 4 * (item % ng);
    float a0 = 0, a1 = 0, a2 = 0, a3 = 0; const bf16_t* hr = P.H1 + (size_t)t * C::D;
    for (int k = 0; k < C::D; ++k) { const float h = bf2f(hr[k]); const float* w = P.w_in + (size_t)k * Dm::IN_COLS + n; a0 += h * w[0]; a1 += h * w[1]; a2 += h * w[2]; a3 += h * w[3]; }
    inproj_store<C>(P, t, n, a0); inproj_store<C>(P, t, n + 1, a1); inproj_store<C>(P, t, n + 2, a2); inproj_store<C>(P, t, n + 3, a3);
}
template <class C> HD void n_dsanorm(const NP& P, int t) {
    typedef Dims<C> Dm;
    { const float* r = P.QLATR + (size_t)t * C::QL; float ss = 0; for (int i = 0; i < C::QL; ++i) ss += r[i] * r[i]; const float rs = 1.f / sqrtf(ss / C::QL + Dm::EPS);
      for (int i = 0; i < C::QL; ++i) P.QLATN[(size_t)t * C::QL + i] = f2bf(r[i] * rs * P.q_norm_w[i]); }
    { const float* r = P.CKVR + (size_t)t * C::KVL; float ss = 0; for (int i = 0; i < C::KVL; ++i) ss += r[i] * r[i]; const float rs = 1.f / sqrtf(ss / C::KVL + Dm::EPS);
      for (int i = 0; i < C::KVL; ++i) P.CKVN[(size_t)t * C::KVL + i] = f2bf(r[i] * rs * P.kv_norm_w[i]); }
    { const float* r = P.KIDXR + (size_t)t * C::ID; float ss = 0; for (int i = 0; i < C::ID; ++i) ss += r[i] * r[i]; const float rs = 1.f / sqrtf(ss / C::ID + Dm::EPS);
      for (int i = 0; i < C::ID; ++i) P.KIDXN[(size_t)t * C::ID + i] = f2bf(r[i] * rs * P.idx_k_norm_w[i]); }
}

template <class C> HD void n_small(const NP& P, int t) {
    typedef Dims<C> Dm; const float* r = P.RAW + (size_t)t * 768;
    { float ss = 0; for (int i = 0; i < C::QL; ++i) ss += r[i] * r[i]; const float rs = 1.f / sqrtf(ss / C::QL + Dm::EPS);
      for (int i = 0; i < C::QL; ++i) P.QLATN[(size_t)t * C::QL + i] = f2bf(r[i] * rs * P.q_norm_w[i]); }
    { const float* q = r + 256; float ss = 0; for (int i = 0; i < C::KVL; ++i) ss += q[i] * q[i]; const float rs = 1.f / sqrtf(ss / C::KVL + Dm::EPS);
      for (int i = 0; i < C::KVL; ++i) P.CKVN[(size_t)t * C::KVL + i] = f2bf(q[i] * rs * P.kv_norm_w[i]); }
    { const float* q = r + 512; float ss = 0; for (int i = 0; i < C::ID; ++i) ss += q[i] * q[i]; const float rs = 1.f / sqrtf(ss / C::ID + Dm::EPS);
      for (int i = 0; i < C::ID; ++i) P.KIDXN[(size_t)t * C::ID + i] = f2bf(q[i] * rs * P.idx_k_norm_w[i]); }
    for (int h = 0; h < C::DNH; ++h) { P.BETA[(size_t)t * C::DNH + h] = sigmf(r[576 + h]); P.G[(size_t)t * C::DNH + h] = -expf(P.dn_a_log[h]) * softplusf(r[584 + h] + P.dn_dt_bias[h]); }
    for (int h = 0; h < C::IH; ++h) P.WIDX[(size_t)t * C::IH + h] = r[592 + h] * (1.f / sqrtf((float)C::IH) / sqrtf((float)C::ID));
}
template <class C> HD float conv_at(const NP& P, int t, int ch) {
    typedef Dims<C> Dm; const int l = t % C::L; float acc = 0.f;
    for (int i = 0; i < C::CONV; ++i) { const int ll = l - (C::CONV - 1) + i; if (ll >= 0) acc += bf2f(P.QKVP[(size_t)(t - (C::CONV - 1) + i) * Dm::QKVC + ch]) * P.dn_conv_w[(size_t)i * Dm::QKVC + ch]; }
    return siluf(acc);
}
template <class C> HD void n_conv(const NP& P, int item) {
    typedef Dims<C> Dm; const int which = item % 3, h = (item / 3) % C::DNH, t = item / (3 * C::DNH);
    const int dim = (which == 2) ? C::DV : C::DK; const int ch0 = (which == 0 ? 0 : which == 1 ? Dm::HK : 2 * Dm::HK) + h * dim;
    float rs = 1.f;
    if (which < 2) { float ss = 0.f; for (int d = 0; d < dim; ++d) { const float v = conv_at<C>(P, t, ch0 + d); ss += v * v; } rs = 1.f / sqrtf(ss + Dm::EPS); }
    for (int d = 0; d < dim; ++d) P.QKVN[(size_t)t * Dm::QKVC + ch0 + d] = f2bf(conv_at<C>(P, t, ch0 + d) * rs);
}
template <class C> HD void n_gc(const NP& P, int item) {
    typedef Dims<C> Dm; const int n = item % Dm::NCH, h = (item / Dm::NCH) % C::DNH, b = item / (Dm::NCH * C::DNH);
    float s = 0.f; for (int i = 0; i < C::CH; ++i) { const size_t t = (size_t)b * C::L + n * C::CH + i; s += P.G[t * C::DNH + h]; P.GC[t * C::DNH + h] = s; }
    P.GL[item] = expf(s);
}
template <class C> HD void n_amat(const NP& P, int item) {
    typedef Dims<C> Dm; const int j = item % C::CH, i = (item / C::CH) % C::CH, cid = item / (C::CH * C::CH);
    const int n = cid % Dm::NCH, h = (cid / Dm::NCH) % C::DNH, b = cid / (Dm::NCH * C::DNH);
    const size_t ti = (size_t)b * C::L + n * C::CH + i, tj = (size_t)b * C::L + n * C::CH + j;
    float a = 0.f, at = 0.f;
    if (j <= i) {
        const bf16_t* ki = P.QKVN + ti * Dm::QKVC + Dm::HK + h * C::DK; const bf16_t* kj = P.QKVN + tj * Dm::QKVC + Dm::HK + h * C::DK; const bf16_t* qi = P.QKVN + ti * Dm::QKVC + h * C::DK;
        float kk = 0.f, qk = 0.f; for (int d = 0; d < C::DK; ++d) { const float kjd = bf2f(kj[d]); kk += bf2f(ki[d]) * kjd; qk += bf2f(qi[d]) * kjd; }
        const float dec = expf(P.GC[ti * C::DNH + h] - P.GC[tj * C::DNH + h]);
        if (j < i) a = P.BETA[ti * C::DNH + h] * kk * dec;
        at = qk * (1.f / sqrtf((float)C::DK)) * dec;
    }
    P.AMAT[(size_t)cid * C::CH * C::CH + i * C::CH + j] = a;
    P.ATT[(size_t)cid * C::CH * C::CH + i * C::CH + j] = f2bf(at);
}
template <class C> HD void n_solve(const NP& P, int item, int tid, int NT) {
    typedef Dims<C> Dm; const int NC = C::DV + C::DK; const int col = item % NC, cid = item / NC;
    const int n = cid % Dm::NCH, h = (cid / Dm::NCH) % C::DNH, b = cid / (Dm::NCH * C::DNH);
    const float* A = P.AMAT + (size_t)cid * C::CH * C::CH;
    for (int i = 0; i < C::CH; ++i) {
        const size_t t = (size_t)b * C::L + n * C::CH + i; const float beta = P.BETA[t * C::DNH + h];
        float r;
        if (col < C::DV) r = bf2f(P.QKVN[t * Dm::QKVC + 2 * Dm::HK + h * C::DV + col]) * beta;
        else r = bf2f(P.QKVN[t * Dm::QKVC + Dm::HK + h * C::DK + (col - C::DV)]) * beta * expf(P.GC[t * C::DNH + h]);
        for (int j = 0; j < i; ++j) r -= A[i * C::CH + j] * SCR(j);
        SCR(i) = r;
    }
    for (int i = 0; i < C::CH; ++i) {
        const size_t t = (size_t)b * C::L + n * C::CH + i;
        if (col < C::DV) P.QKVN[t * Dm::QKVC + 2 * Dm::HK + h * C::DV + col] = f2bf(SCR(i));
        else P.W[((size_t)cid * C::CH + i) * C::DK + (col - C::DV)] = f2bf(SCR(i));
    }
}
template <class C> HD void n_scale(const NP& P, int item) {
    typedef Dims<C> Dm; const int h = item % C::DNH; const size_t t = item / C::DNH; const int l = (int)(t % C::L), b = (int)(t / C::L), n = l / C::CH;
    const float gc = P.GC[t * C::DNH + h]; const size_t tl = (size_t)b * C::L + n * C::CH + C::CH - 1; const float gl = P.GC[tl * C::DNH + h];
    const float fq = expf(gc) * (1.f / sqrtf((float)C::DK)), fk = expf(gl - gc);
    bf16_t* q = P.QKVN + t * Dm::QKVC + h * C::DK; bf16_t* k = P.QKVN + t * Dm::QKVC + Dm::HK + h * C::DK;
    for (int d = 0; d < C::DK; ++d) { q[d] = f2bf(bf2f(q[d]) * fq); k[d] = f2bf(bf2f(k[d]) * fk); }
}
template <class C> HD void n_scan(const NP& P, int item, int tid, int NT) {
    typedef Dims<C> Dm; const int e = item % C::DV, h = (item / C::DV) % C::DNH, b = item / (C::DV * C::DNH);
    for (int d = 0; d < C::DK; ++d) SCR(d) = 0.f;
    for (int n = 0; n < Dm::NCH; ++n) {
        const int cid = (b * C::DNH + h) * Dm::NCH + n; const size_t t0 = (size_t)b * C::L + n * C::CH;
        const bf16_t* Wc = P.W + (size_t)cid * C::CH * C::DK; const bf16_t* At = P.ATT + (size_t)cid * C::CH * C::CH;
        for (int r = 0; r < C::CH; ++r) { float acc = bf2f(P.QKVN[(t0 + r) * Dm::QKVC + 2 * Dm::HK + h * C::DV + e]);
            for (int d = 0; d < C::DK; ++d) acc -= bf2f(Wc[r * C::DK + d]) * SCR(d);
            SCR(C::DK + r) = acc; }
        for (int r = 0; r < C::CH; ++r) { float o = 0.f; const bf16_t* qd = P.QKVN + (t0 + r) * Dm::QKVC + h * C::DK;
            for (int d = 0; d < C::DK; ++d) o += bf2f(qd[d]) * SCR(d);
            for (int s = 0; s <= r; ++s) o += bf2f(At[r * C::CH + s]) * SCR(C::DK + s);
            P.O[(t0 + r) * Dm::HV + h * C::DV + e] = f2bf(o); }
        const float gl = P.GL[cid];
        for (int d = 0; d < C::DK; ++d) { float acc = SCR(d) * gl;
            for (int r = 0; r < C::CH; ++r) acc += bf2f(P.QKVN[(t0 + r) * Dm::QKVC + Dm::HK + h * C::DK + d]) * SCR(C::DK + r);
            SCR(d) = acc; }
    }
}
template <class C> HD void n_ogate(const NP& P, int item) {
    typedef Dims<C> Dm; const int h = item % C::DNH; const size_t t = item / C::DNH; const bf16_t* o = P.O + t * Dm::HV + h * C::DV;
    float ss = 0.f; for (int d = 0; d < C::DV; ++d) { const float v = bf2f(o[d]); ss += v * v; } const float rs = 1.f / sqrtf(ss / C::DV + Dm::EPS);
    for (int d = 0; d < C::DV; ++d) P.OG[t * Dm::HV + h * C::DV + d] = f2bf(bf2f(o[d]) * rs * P.dn_onorm_w[d] * siluf(bf2f(P.Z[t * Dm::HV + h * C::DV + d])));
}
template <class C> HD void n_q(const NP& P, int item) {
    const int NJ = C::MH * C::MDH + C::IH * C::ID; const int j = item % NJ; const size_t t = item / NJ; const bf16_t* ql = P.QLATN + t * C::QL;
    float acc = 0.f;
    if (j < C::MH * C::MDH) { for (int k = 0; k < C::QL; ++k) acc += bf2f(ql[k]) * P.w_uq[(size_t)k * C::MH * C::MDH + j]; P.QF[t * C::MH * C::MDH + j] = acc; }
    else { const int jj = j - C::MH * C::MDH; for (int k = 0; k < C::QL; ++k) acc += bf2f(ql[k]) * P.w_iq[(size_t)k * C::IH * C::ID + jj]; P.QIDX[t * C::IH * C::ID + jj] = acc; }
}
template <class C> HD void n_qabs(const NP& P, int item) {
    const int c = item % C::KVL, h = (item / C::KVL) % C::MH; const size_t t = item / (C::KVL * C::MH);
    float acc = 0.f; for (int d = 0; d < C::MDH; ++d) acc += P.QF[t * C::MH * C::MDH + h * C::MDH + d] * P.w_uk[((size_t)c * C::MH + h) * C::MDH + d];
    P.QABS[(t * C::MH + h) * C::KVL + c] = f2bf(acc * (1.f / sqrtf((float)C::MDH)));
}
template <class C> HD void n_index(const NP& P, int t, int tid, int NT) {
    typedef Dims<C> Dm; const int K = Dm::TOPK; const int l = t % C::L, b = t / C::L; int cnt = 0;
    const float* qi = P.QIDX + (size_t)t * C::IH * C::ID; const float* wi = P.WIDX + (size_t)t * C::IH;
#define HV_(i) SCR(i)
#define HI_(i) SCR(K + (i))
#define WORSE(v1, i1, v2, i2) ((v1) < (v2) || ((v1) == (v2) && (i1) > (i2)))
    for (int s = 0; s <= l; ++s) {
        const bf16_t* kr = P.KIDXN + ((size_t)b * C::L + s) * C::ID; float sc = 0.f;
        for (int h = 0; h < C::IH; ++h) { float dot = 0.f; for (int d = 0; d < C::ID; ++d) dot += qi[h * C::ID + d] * bf2f(kr[d]); sc += wi[h] * (dot > 0.f ? dot : 0.f); }
        const float fs = (float)s;
        if (cnt < K) {
            int i = cnt++; HV_(i) = sc; HI_(i) = fs;
            while (i > 0) { const int p = (i - 1) >> 1; const float pv = HV_(p), pi = HI_(p), cv = HV_(i), ci = HI_(i);
                if (WORSE(cv, ci, pv, pi)) { HV_(p) = cv; HI_(p) = ci; HV_(i) = pv; HI_(i) = pi; i = p; } else break; }
        } else if (HV_(0) < sc) {
            int i = 0; HV_(0) = sc; HI_(0) = fs;
            for (;;) { const int a = 2 * i + 1, c2 = a + 1; int w = i; float wv = HV_(i), wx = HI_(i);
                if (a < K) { const float av = HV_(a), ai = HI_(a); if (WORSE(av, ai, wv, wx)) { w = a; wv = av; wx = ai; } }
                if (c2 < K) { const float bv = HV_(c2), bi = HI_(c2); if (WORSE(bv, bi, wv, wx)) { w = c2; wv = bv; wx = bi; } }
                if (w == i) break; const float tv = HV_(i), ti = HI_(i); HV_(i) = wv; HI_(i) = wx; HV_(w) = tv; HI_(w) = ti; i = w; }
        }
    }
    for (int k = 0; k < K; ++k) P.IDX[(size_t)t * K + k] = (k < cnt) ? (int)HI_(k) : -1;
#undef HV_
#undef HI_
#undef WORSE
}
template <class C> HD void n_attn(const NP& P, int item, int tid, int NT) {
    typedef Dims<C> Dm; const int K = Dm::TOPK; const int h = item % C::MH; const size_t t = item / C::MH; const int b = (int)(t / C::L);
    const int* idx = P.IDX + t * K; bf16_t* qa = P.QABS + (t * C::MH + h) * C::KVL;
    int nv = 0; float m = -3.0e38f;
    for (int k = 0; k < K; ++k) { const int s = idx[k]; if (s < 0) break; ++nv;
        const bf16_t* kv = P.CKVN + ((size_t)b * C::L + s) * C::KVL; float lg = 0.f; for (int c = 0; c < C::KVL; ++c) lg += bf2f(qa[c]) * bf2f(kv[c]);
        SCR(k) = lg; m = lg > m ? lg : m; }
    float sum = 0.f; for (int k = 0; k < nv; ++k) { const float p = expf(SCR(k) - m); SCR(k) = p; sum += p; }
    const float inv = 1.f / sum;
    for (int c = 0; c < C::KVL; ++c) { float acc = 0.f; for (int k = 0; k < nv; ++k) acc += SCR(k) * bf2f(P.CKVN[((size_t)b * C::L + idx[k]) * C::KVL + c]);
        SCR(K + c) = acc * inv; }
    for (int c = 0; c < C::KVL; ++c) qa[c] = f2bf(SCR(K + c));
}
template <class C> HD void n_oatt(const NP& P, int item) {
    const int d = item % C::MDV, h = (item / C::MDV) % C::MH; const size_t t = item / (C::MDV * C::MH);
    float acc = 0.f; for (int c = 0; c < C::KVL; ++c) acc += bf2f(P.OLAT[(t * C::MH + h) * C::KVL + c]) * P.w_uv[((size_t)c * C::MH + h) * C::MDV + d];
    P.OATT[t * C::MH * C::MDV + h * C::MDV + d] = f2bf(acc);
}
template <class C> HD void n_merge(const NP& P, int item) {
    typedef Dims<C> Dm; const int n = item % C::D; const size_t t = item / C::D;
    float ya = 0.f, yb = 0.f;
    for (int k = 0; k < Dm::HV; ++k) ya += bf2f(P.OG[t * Dm::HV + k]) * P.w_a_out[(size_t)k * C::D + n];
    for (int k = 0; k < C::MH * C::MDV; ++k) yb += bf2f(P.OATT[t * C::MH * C::MDV + k]) * P.w_b_out[(size_t)k * C::D + n];
    P.M[t * C::D + n] = f2bf(sigmf(bf2f(P.GA[t * C::D + n])) * ya + sigmf(bf2f(P.GB[t * C::D + n])) * yb);
}
template <class C> HD void n_wo(const NP& P, int item) {
    const int n = item % C::D; const size_t t = item / C::D; const int b = (int)(t / C::L);
    float acc = 0.f; for (int k = 0; k < C::D; ++k) acc += bf2f(P.M[t * C::D + k]) * P.w_o[(size_t)k * C::D + n];
    P.X1[t * C::D + n] = P.x[t * C::D + n] + P.MOD[(size_t)b * 6 * C::D + 2 * C::D + n] * acc;
}
template <class C> HD void n_h2(const NP& P, int t) {
    const int D = C::D; const int b = t / C::L; const float* xr = P.X1 + (size_t)t * D;
    float ss = 0.f; for (int i = 0; i < D; ++i) ss += xr[i] * xr[i];
    const float rstd = 1.f / sqrtf(ss / D + Dims<C>::EPS);
    const float* sh = P.MOD + (size_t)b * 6 * D + 3 * D; const float* sc = sh + D;
    for (int i = 0; i < D; ++i) P.H2[(size_t)t * D + i] = f2bf(xr[i] * rstd * P.norm2_w[i] * (1.f + sc[i]) + sh[i]);
}
template <class C> HD void n_peerq(const NP& P, int item) {
    const int NJ = C::PH * C::PDQ; const int j = item % NJ; const size_t t = item / NJ;
    float acc = 0.f; for (int k = 0; k < C::D; ++k) acc += bf2f(P.H2[t * C::D + k]) * P.peer_w_q[(size_t)k * NJ + j];
    P.PQ[t * NJ + j] = acc;
}
template <class C> HD void n_route(const NP& P, int item, int tid, int NT) {
    typedef Dims<C> Dm; const int PK = C::PK, TK = C::PTK; const int h = item % C::PH; const size_t t = item / C::PH;
    const int oS = 0, oSV = 2 * PK, oSI = oSV + 2 * TK, oC = oSI + 2 * TK;
    for (int p = 0; p < 2; ++p) for (int n = 0; n < PK; ++n) {
        float acc = 0.f;
        if (P.S) acc = P.S[t * (size_t)(C::PH * 2 * PK) + (h * 2 + p) * PK + n];
        else { const float* q = P.PQ + t * C::PH * C::PDQ + (h * 2 + p) * Dm::PD2; const float* key = P.peer_sub_keys + (((size_t)h * 2 + p) * PK + n) * Dm::PD2;
            for (int d = 0; d < Dm::PD2; ++d) acc += q[d] * key[d]; }
        SCR(oS + p * PK + n) = acc; }
    for (int p = 0; p < 2; ++p) for (int k = 0; k < TK; ++k) { int bi = 0; float bv = -3.0e38f;
        for (int n = 0; n < PK; ++n) { const float v = SCR(oS + p * PK + n); if (v > bv) { bv = v; bi = n; } }
        SCR(oSV + p * TK + k) = bv; SCR(oSI + p * TK + k) = (float)bi; SCR(oS + p * PK + bi) = -3.0e38f; }
    for (int i = 0; i < TK; ++i) for (int j = 0; j < TK; ++j) SCR(oC + i * TK + j) = SCR(oSV + i) + SCR(oSV + TK + j);
    float tv[C::PTK]; int te[C::PTK]; float mx = -3.0e38f;
#pragma unroll
    for (int k = 0; k < TK; ++k) { int bi = 0; float bv = -3.0e38f;
        for (int n = 0; n < TK * TK; ++n) { const float v = SCR(oC + n); if (v > bv) { bv = v; bi = n; } }
        SCR(oC + bi) = -3.0e38f; tv[k] = bv; te[k] = (int)SCR(oSI + bi / TK) * PK + (int)SCR(oSI + TK + bi % TK); mx = bv > mx ? bv : mx; }
    float sum = 0.f;
#pragma unroll
    for (int k = 0; k < TK; ++k) { tv[k] = expf(tv[k] - mx); sum += tv[k]; }
#pragma unroll
    for (int k = 0; k < TK; ++k) { P.EXPI[t * Dm::SLOTS + h * TK + k] = te[k]; P.GATE[t * Dm::SLOTS + h * TK + k] = tv[k] / sum; }
}
template <class C> HD void n_pact(const NP& P, int item) {
    typedef Dims<C> Dm; const int sl = item % Dm::SLOTS; const size_t t = item / Dm::SLOTS; const int e = P.EXPI[t * Dm::SLOTS + sl];
    const float* u = P.peer_u + (size_t)e * C::D; float acc = 0.f; for (int d = 0; d < C::D; ++d) acc += u[d] * bf2f(P.H2[t * C::D + d]);
    P.ACT[t * Dm::SLOTS + sl] = geluf(acc) * P.GATE[t * Dm::SLOTS + sl];
}
template <class C> HD void n_pout(const NP& P, int item) {
    typedef Dims<C> Dm; const int d = item % C::D; const size_t t = item / C::D; const int b = (int)(t / C::L);
    float acc = 0.f; for (int s = 0; s < Dm::SLOTS; ++s) acc += P.ACT[t * Dm::SLOTS + s] * P.peer_v[(size_t)P.EXPI[t * Dm::SLOTS + s] * C::D + d];
    P.X1[t * C::D + d] += P.MOD[(size_t)b * 6 * C::D + 5 * C::D + d] * acc;
}
template <class C> HD void n_final(const NP& P, int t) {
    const int D = C::D; const float* xr = P.X1 + (size_t)t * D; float ss = 0.f; for (int i = 0; i < D; ++i) ss += xr[i] * xr[i];
    const float rstd = 1.f / sqrtf(ss / D + Dims<C>::EPS);
    for (int i = 0; i < D; ++i) P.out[(size_t)t * D + i] = xr[i] * rstd * P.final_norm_w[i];
}

template <class C> HD long stage_items(int st) {
    typedef Dims<C> Dm; const long T = Dm::T;
    switch (st) {
        case ST_MOD: return (long)C::B * 6 * C::D; case ST_H1: return T;
        case ST_INPROJ_A: return T * ((Dm::OFF_GA - 0) / 4) - T * (Dm::HV / 4);
        case ST_DSANORM: return T; case ST_CONV: return T * C::DNH * 3; case ST_GC: return Dm::NCHUNKS; case ST_AMAT: return (long)Dm::NCHUNKS * C::CH * C::CH;
        case ST_SOLVE: return (long)Dm::NCHUNKS * (C::DV + C::DK); case ST_SCALE: return T * C::DNH; case ST_SCAN: return (long)C::B * C::DNH * C::DV;
        case ST_Q: return T * (C::MH * C::MDH + C::IH * C::ID); case ST_QIDX: return T * (C::IH * C::ID); case ST_SMALL: return T; case ST_QABS: return T * C::MH * C::KVL; case ST_INDEX: return T; case ST_ATTN: return T * C::MH;
        case ST_INPROJ_B: return T * ((Dm::HV + 2 * C::D) / 4); case ST_OGATE: return T * C::DNH; case ST_OATT: return T * C::MH * C::MDV; case ST_MERGE: return T * C::D;
        case ST_WO: return T * C::D; case ST_H2: return T; case ST_PEERQ: return T * C::PH * C::PDQ; case ST_ROUTE: return T * C::PH; case ST_PACT: return T * Dm::SLOTS;
        case ST_POUT: return T * C::D; case ST_FINAL: return T;
    }
    return 0;
}
template <class C> HD int stage_scr_words(int st) {
    typedef Dims<C> Dm;
    switch (st) { case ST_SOLVE: return C::CH; case ST_SCAN: return C::DK + C::CH; case ST_INDEX: return 2 * Dm::TOPK; case ST_ATTN: return Dm::TOPK + C::KVL;
        case ST_ROUTE: return 2 * C::PK + 4 * C::PTK + C::PTK * C::PTK; }
    return 0;
}
template <class C> HD void run_item(const NP& P, int st, long item, int tid, int NT) {
    typedef Dims<C> Dm;
    switch (st) {
        case ST_MOD: n_mod<C>(P, (int)item); break; case ST_H1: n_h1<C>(P, (int)item); break;
        case ST_INPROJ_A: { const int ngA = Dm::OFF_Z / 4, ngB = (Dm::OFF_GA - Dm::OFF_B) / 4, ng = ngA + ngB; const int t = (int)(item / ng), g = (int)(item % ng);
            if (g < ngA) n_inproj<C>(P, t * ngA + g, 0, Dm::OFF_Z); else n_inproj<C>(P, t * ngB + (g - ngA), Dm::OFF_B, Dm::OFF_GA); } break;
        case ST_DSANORM: n_dsanorm<C>(P, (int)item); break; case ST_CONV: n_conv<C>(P, (int)item); break; case ST_GC: n_gc<C>(P, (int)item); break;
        case ST_AMAT: n_amat<C>(P, (int)item); break; case ST_SOLVE: n_solve<C>(P, (int)item, tid, NT); break; case ST_SCALE: n_scale<C>(P, (int)item); break;
        case ST_SCAN: n_scan<C>(P, (int)item, tid, NT); break; case ST_Q: n_q<C>(P, (int)item); break; case ST_QIDX: { const int NI = C::IH * C::ID, NJ = C::MH * C::MDH + NI; n_q<C>(P, (int)((item / NI) * NJ + C::MH * C::MDH + item % NI)); } break; case ST_QABS: n_qabs<C>(P, (int)item); break; case ST_SMALL: n_small<C>(P, (int)item); break;
        case ST_INDEX: n_index<C>(P, (int)item, tid, NT); break; case ST_ATTN: n_attn<C>(P, (int)item, tid, NT); break;
        case ST_INPROJ_B: { const int ngA = Dm::HV / 4, ngB = 2 * C::D / 4, ng = ngA + ngB; const int t = (int)(item / ng), g = (int)(item % ng);
            if (g < ngA) n_inproj<C>(P, t * ngA + g, Dm::OFF_Z, Dm::OFF_B); else n_inproj<C>(P, t * ngB + (g - ngA), Dm::OFF_GA, Dm::IN_COLS); } break;
        case ST_OGATE: n_ogate<C>(P, (int)item); break; case ST_OATT: n_oatt<C>(P, (int)item); break; case ST_MERGE: n_merge<C>(P, (int)item); break;
        case ST_WO: n_wo<C>(P, (int)item); break; case ST_H2: n_h2<C>(P, (int)item); break; case ST_PEERQ: n_peerq<C>(P, (int)item); break;
        case ST_ROUTE: n_route<C>(P, (int)item, tid, NT); break; case ST_PACT: n_pact<C>(P, (int)item); break; case ST_POUT: n_pout<C>(P, (int)item); break;
        case ST_FINAL: n_final<C>(P, (int)item); break;
    }
}
#define GAS __attribute__((address_space(1)))
#define LAS __attribute__((address_space(3)))
#define XB_TMO      128
#define XB_XCNT(j)  (256  + 64 * (j))
#define XB_XSUB(j)  (1280 + 64 * (j))
#define XB_XGEN(j)  (2304 + 64 * (j))
#define XB_TOP      3328
#define XB_TOPGEN   3392
#define XCD_BAR_WORDS 3456
#ifndef XB_SPIN_CAP
#define XB_SPIN_CAP (1u << 26)
#endif
__device__ __forceinline__ unsigned xb_ld(unsigned* p)              { return __hip_atomic_load(p, __ATOMIC_RELAXED, __HIP_MEMORY_SCOPE_AGENT); }
__device__ __forceinline__ unsigned xb_add(unsigned* p, unsigned v) { return __hip_atomic_fetch_add(p, v, __ATOMIC_RELAXED, __HIP_MEMORY_SCOPE_AGENT); }
__device__ __forceinline__ unsigned xb_xcc_id() { return (unsigned)__builtin_amdgcn_s_getreg((3 << 11) | 20) & 0xFu; }
#define XB_SPIN(cond, bar) do { unsigned _sp = 0; while (cond) { __builtin_amdgcn_s_sleep(1); \
    if ((++_sp & 255u) == 0u) { if (xb_ld(&(bar)[XB_TMO])) break; if (_sp > XB_SPIN_CAP) { atomicAdd(&(bar)[XB_TMO], 1u); break; } } } } while (0)
struct XcdBarrier { unsigned* bar; unsigned x; volatile LAS unsigned* st; };
__device__ __forceinline__ XcdBarrier xcd_barrier_post(unsigned* bar, volatile LAS unsigned* st) {
    XcdBarrier b; b.bar = bar; b.x = xb_xcc_id(); b.st = st;
    if (threadIdx.x == 0) (void)xb_add(&bar[XB_XCNT(b.x)], 1u);
    return b;
}
__device__ __forceinline__ void xcd_barrier_complete(unsigned* bar, unsigned x, unsigned& nloc, unsigned& nx) {
    const unsigned G = gridDim.x * gridDim.y * gridDim.z;
    unsigned sum, cnt, mine, sp = 0u;
    for (;;) {
        sum = 0u; cnt = 0u; mine = 0u;
#pragma unroll
        for (unsigned j = 0; j < 16; ++j) { const unsigned c = xb_ld(&bar[XB_XCNT(j)]); sum += c; cnt += (c > 0u) ? 1u : 0u; mine = (j == x) ? c : mine; }
        if (sum == G) break;
        __builtin_amdgcn_s_sleep(1);
        if ((++sp & 255u) == 0u) { if (xb_ld(&bar[XB_TMO])) break; if (sp > XB_SPIN_CAP) { atomicAdd(&bar[XB_TMO], 1u); break; } }
    }
    nloc = mine > 0u ? mine : 1u; nx = cnt > 0u ? cnt : 1u;
}
__device__ __forceinline__ void xcd_barrier(const XcdBarrier& b) {
    asm volatile("s_waitcnt vmcnt(0)" ::: "memory");
    __syncthreads();
    if (threadIdx.x == 0) {
        unsigned* bar = b.bar;
        __builtin_amdgcn_s_waitcnt(0);
        unsigned nloc = b.st[0], nx = b.st[1];
        if (nloc == 0u) { xcd_barrier_complete(bar, b.x, nloc, nx); b.st[0] = nloc; b.st[1] = nx; }
        const unsigned old = xb_add(&bar[XB_XSUB(b.x)], 1u);
        const unsigned gen = old / nloc;
        if (old + 1u == (gen + 1u) * nloc) {
            __builtin_amdgcn_fence(__ATOMIC_RELEASE, "agent");
            asm volatile("s_waitcnt vmcnt(0)" ::: "memory");
            const unsigned og = xb_add(&bar[XB_TOP], 1u);
            const unsigned tg = og / nx;
            if (og + 1u == (tg + 1u) * nx) xb_add(&bar[XB_TOPGEN], 1u);
            else XB_SPIN(xb_ld(&bar[XB_TOPGEN]) == tg, bar);
            __builtin_amdgcn_fence(__ATOMIC_ACQUIRE, "agent");
            xb_add(&bar[XB_XGEN(b.x)], 1u);
            asm volatile("s_waitcnt vmcnt(0)" ::: "memory");
        } else {
            XB_SPIN(xb_ld(&bar[XB_XGEN(b.x)]) == gen, bar);
            __builtin_amdgcn_fence(__ATOMIC_ACQUIRE, "agent");
            asm volatile("s_waitcnt vmcnt(0)" ::: "memory");
        }
    }
    __syncthreads();
}
namespace pg8 {
#define PG8_LAS __attribute__((address_space(3)))
typedef unsigned short bf16_t;
typedef short bf16x8 __attribute__((ext_vector_type(8)));
typedef float f32x4 __attribute__((ext_vector_type(4)));
typedef unsigned u32x4 __attribute__((ext_vector_type(4)));
constexpr int BM = 256, BK = 64, HALF = 128, HTB = HALF * BK * 2  , STAGE_BYTES = 8 * HTB, NXCD = 8, WGM = 8;

__host__ __device__ __forceinline__ int lds_byte(int r, int c) { const int st = (r >> 4) * 2 + (c >> 5), rr = r & 15, cc = c & 31, ob = rr * 64 + cc * 2; return st * 1024 + (ob ^ (((ob >> 9) & 1) << 5)); }
__host__ __device__ __forceinline__ void stage_rc(int b, int& R, int& C) { const int st = b / 1024, sb = b % 1024, swz = sb ^ (((sb >> 9) & 1) << 5); R = (st >> 1) * 16 + swz / 64; C = (st & 1) * 32 + (swz % 64) / 2; }
__host__ __device__ __forceinline__ int perm32(int rho) { const int n = rho >> 4, i = rho & 15; return 8 * (i >> 2) + 4 * n + (i & 3); }
__device__ __forceinline__ unsigned cvt_pk_bf16(float lo, float hi) { unsigned r; asm volatile("v_cvt_pk_bf16_f32 %0, %1, %2" : "=v"(r) : "v"(lo), "v"(hi)); return r; }
struct Unit { int pm, pn; const char* a; const char* b; };
struct Gemm { int lda, ldb, K; };
template <class Epi, class Sched, bool ALIGN_EPI = false, bool SP2 = false>
__device__ __forceinline__ void gemm_phase(PG8_LAS unsigned char* lds, const Gemm g, const Sched& S, const Epi& E) {
    int tid = threadIdx.x; asm volatile("" : "+v"(tid));
    const int wid = __builtin_amdgcn_readfirstlane(tid >> 6), lane = tid & 63, wr = wid >> 2, wc = wid & 3, fr = lane & 15, fq = lane >> 4;
    const int K = g.K, nt = K / BK;
    unsigned voffA[2], voffB[2];
#pragma unroll
    for (int i = 0; i < 2; ++i) { int R, C; stage_rc(tid * 16 + i * 8192, R, C); const int Rb = Epi::PERM ? ((R & ~31) + perm32(R & 31)) : R;
        voffA[i] = (unsigned)(R * g.lda + C) * 2u; voffB[i] = (unsigned)(Rb * g.ldb + C) * 2u; }
    const size_t kstep = (size_t)(BK * 2);
    const size_t hstepA = (size_t)HALF * g.lda * 2, hstepB = (size_t)HALF * g.ldb * 2;
    const unsigned ldsw = (unsigned)wid * 1024u;
    const int aoff = lds_byte(wr * 64 + fr, fq * 8), boff = lds_byte(wc * 32 + fr, fq * 8);
#define PG8_SA(b, h) (((b) * 2 + (h)) * HTB)
#define PG8_SB(b, h) ((4 + (b) * 2 + (h)) * HTB)
#define PG8_STAGE(bufoff, gbase, voff) do { _Pragma("unroll") for (int _i = 0; _i < 2; ++_i) \
        __builtin_amdgcn_global_load_lds((const unsigned*)((const char*)(gbase) + (voff)[_i]), (PG8_LAS unsigned*)(lds + (bufoff) + ldsw + _i * 8192), 16, 0, 0); } while (0)
#define PG8_LDA(dst, b, h) do { _Pragma("unroll") for (int m = 0; m < 4; ++m) _Pragma("unroll") for (int k = 0; k < 2; ++k) dst[m][k] = *(const PG8_LAS bf16x8*)(lds + PG8_SA(b, h) + aoff + m * 2048 + k * 1024); } while (0)
#define PG8_LDB(dst, b, h) do { _Pragma("unroll") for (int n = 0; n < 2; ++n) _Pragma("unroll") for (int k = 0; k < 2; ++k) dst[n][k] = *(const PG8_LAS bf16x8*)(lds + PG8_SB(b, h) + boff + n * 2048 + k * 1024); } while (0)
#define PG8_MMA(ai, bj, At, Bt) do { __builtin_amdgcn_s_setprio(1); _Pragma("unroll") for (int m = 0; m < 4; ++m) _Pragma("unroll") for (int n = 0; n < 2; ++n) _Pragma("unroll") for (int k = 0; k < 2; ++k) \
        acc[ai][bj][m][n] = __builtin_amdgcn_mfma_f32_16x16x32_bf16(Bt[n][k], At[m][k], acc[ai][bj][m][n], 0, 0, 0); __builtin_amdgcn_s_setprio(0); } while (0)
#define PG8_WAIT_V(n) asm volatile("s_waitcnt vmcnt(" #n ")" ::: "memory")
#define PG8_WAIT_L(n) asm volatile("s_waitcnt lgkmcnt(" #n ")" ::: "memory")
#define PG8_BAR __builtin_amdgcn_s_barrier()
#define PG8_SCHED __builtin_amdgcn_sched_barrier(0)
    Unit cur, nxt; int ui = 0;
    if (!S.next(0, cur)) return;
    f32x4 acc[2][2][4][2];
#pragma unroll
    for (int a = 0; a < 2; ++a)
#pragma unroll
        for (int b = 0; b < 2; ++b)
#pragma unroll
            for (int m = 0; m < 4; ++m)
#pragma unroll
                for (int n = 0; n < 2; ++n) acc[a][b][m][n] = (f32x4){0.f, 0.f, 0.f, 0.f};
    bf16x8 At[4][2], B0[2][2], B1[2][2];
    const char* cA = cur.a; const char* cB = cur.b;
    S.a_ready(cur);
    if constexpr (SP2) {
        PG8_STAGE(PG8_SB(0, 0), cB, voffB); PG8_STAGE(PG8_SB(0, 1), cB + hstepB, voffB); PG8_STAGE(PG8_SA(0, 0), cA, voffA); PG8_STAGE(PG8_SA(0, 1), cA + hstepA, voffA);
        if (wr == 1) PG8_BAR;
        PG8_WAIT_V(2); PG8_BAR;
        PG8_STAGE(PG8_SB(1, 0), cB + kstep, voffB); PG8_STAGE(PG8_SA(1, 0), cA + kstep, voffA); PG8_STAGE(PG8_SB(1, 1), cB + hstepB + kstep, voffB);
        PG8_WAIT_V(6); PG8_BAR;
    } else {
        PG8_STAGE(PG8_SB(0, 0), cB, voffB); PG8_STAGE(PG8_SA(0, 0), cA, voffA); PG8_STAGE(PG8_SB(0, 1), cB + hstepB, voffB); PG8_STAGE(PG8_SA(0, 1), cA + hstepA, voffA);
        if (wr == 1) PG8_BAR;
        PG8_WAIT_V(4); PG8_BAR;
        PG8_STAGE(PG8_SB(1, 0), cB + kstep, voffB); PG8_STAGE(PG8_SA(1, 0), cA + kstep, voffA); PG8_STAGE(PG8_SB(1, 1), cB + hstepB + kstep, voffB);
        PG8_WAIT_V(6); PG8_BAR;
    }
    for (;;) {
        const bool has_next = S.next(ui + 1, nxt);
        const char* nA = has_next ? nxt.a : cA; const char* nB = has_next ? nxt.b : cB;
        for (int t = 0; t < nt; t += 2) {
            const bool last = (t == nt - 2);
            const char* a1 = cA + (size_t)(t + 1) * kstep;
            const char* a2 = last ? nA : cA + (size_t)(t + 2) * kstep; const char* b2 = last ? nB : cB + (size_t)(t + 2) * kstep;
            const char* a3 = a2 + kstep; const char* b3 = b2 + kstep;
            if (last && has_next) S.a_ready(nxt);
            if constexpr (SP2) {
            PG8_LDB(B0, 0, 0); PG8_LDB(B1, 0, 1); PG8_SCHED; PG8_LDA(At, 0, 0); PG8_STAGE(PG8_SA(1, 1), a1 + hstepA, voffA);
            PG8_WAIT_V(8); PG8_WAIT_L(0); PG8_BAR; PG8_MMA(0, 0, At, B0); PG8_MMA(0, 1, At, B1); PG8_BAR; PG8_SCHED;
            PG8_LDA(At, 0, 1); PG8_STAGE(PG8_SB(0, 0), b2, voffB); PG8_STAGE(PG8_SB(0, 1), b2 + hstepB, voffB); PG8_STAGE(PG8_SA(0, 0), a2, voffA);
            PG8_WAIT_V(8); PG8_WAIT_L(0); PG8_BAR; PG8_MMA(1, 0, At, B0); PG8_MMA(1, 1, At, B1); PG8_BAR; PG8_SCHED;
            PG8_LDB(B0, 1, 0); PG8_LDB(B1, 1, 1); PG8_SCHED; PG8_LDA(At, 1, 0); PG8_STAGE(PG8_SA(0, 1), a2 + hstepA, voffA);
            PG8_WAIT_V(8); PG8_WAIT_L(0); PG8_BAR; PG8_MMA(0, 0, At, B0); PG8_MMA(0, 1, At, B1); PG8_BAR; PG8_SCHED;
            PG8_LDA(At, 1, 1); PG8_STAGE(PG8_SB(1, 0), b3, voffB); PG8_STAGE(PG8_SB(1, 1), b3 + hstepB, voffB); PG8_STAGE(PG8_SA(1, 0), a3, voffA);
            PG8_WAIT_V(8); PG8_WAIT_L(0); PG8_BAR; PG8_MMA(1, 0, At, B0); PG8_MMA(1, 1, At, B1); PG8_BAR; PG8_SCHED;
            } else {
            PG8_LDB(B0, 0, 0); PG8_SCHED; PG8_LDA(At, 0, 0); PG8_STAGE(PG8_SA(1, 1), a1 + hstepA, voffA);
            PG8_WAIT_L(8); PG8_BAR; PG8_WAIT_L(0); PG8_MMA(0, 0, At, B0); PG8_BAR; PG8_SCHED;
            PG8_LDB(B1, 0, 1); PG8_STAGE(PG8_SB(0, 0), b2, voffB);
            PG8_BAR; PG8_WAIT_L(0); PG8_MMA(0, 1, At, B1); PG8_BAR;
            PG8_LDA(At, 0, 1); PG8_STAGE(PG8_SA(0, 0), a2, voffA);
            PG8_BAR; PG8_WAIT_L(0); PG8_MMA(1, 0, At, B0); PG8_BAR; PG8_SCHED;
            PG8_STAGE(PG8_SB(0, 1), b2 + hstepB, voffB);
            PG8_WAIT_V(6); PG8_BAR; PG8_MMA(1, 1, At, B1); PG8_BAR;
            PG8_LDB(B0, 1, 0); PG8_SCHED; PG8_LDA(At, 1, 0); PG8_STAGE(PG8_SA(0, 1), a2 + hstepA, voffA);
            PG8_WAIT_L(8); PG8_BAR; PG8_WAIT_L(0); PG8_MMA(0, 0, At, B0); PG8_BAR; PG8_SCHED;
            PG8_LDB(B1, 1, 1); PG8_STAGE(PG8_SB(1, 0), b3, voffB);
            PG8_BAR; PG8_WAIT_L(0); PG8_MMA(0, 1, At, B1); PG8_BAR;
            PG8_LDA(At, 1, 1); PG8_STAGE(PG8_SA(1, 0), a3, voffA);
            PG8_BAR; PG8_WAIT_L(0); PG8_MMA(1, 0, At, B0); PG8_BAR; PG8_SCHED;
            PG8_STAGE(PG8_SB(1, 1), b3 + hstepB, voffB);
            PG8_WAIT_V(6); PG8_BAR; PG8_MMA(1, 1, At, B1); PG8_BAR;
            }
        }
        if constexpr (ALIGN_EPI) { if (wr == 0) PG8_BAR; }
        if constexpr (!Epi::AFTER_DRAIN) { E(acc, cur, wr, wc, fr, fq); S.done(cur); }
        if (!has_next) break;
#pragma unroll
        for (int a = 0; a < 2; ++a)
#pragma unroll
            for (int b = 0; b < 2; ++b)
#pragma unroll
                for (int m = 0; m < 4; ++m)
#pragma unroll
                    for (int n = 0; n < 2; ++n) acc[a][b][m][n] = (f32x4){0.f, 0.f, 0.f, 0.f};
        cur = nxt; cA = nA; cB = nB; ++ui;
        if constexpr (ALIGN_EPI) { if (wr == 1) PG8_BAR; }
    }
    PG8_WAIT_V(0);
    if constexpr (!ALIGN_EPI) { if (wr == 0) PG8_BAR; }
    PG8_BAR;
    if constexpr (Epi::AFTER_DRAIN) { E.fused(acc, cur, wr, wc, fr, fq, lds, wid, lane); S.done(cur); }
#undef PG8_SA
#undef PG8_SB
#undef PG8_STAGE
#undef PG8_LDA
#undef PG8_LDB
#undef PG8_MMA
#undef PG8_WAIT_V
#undef PG8_WAIT_L
#undef PG8_BAR
#undef PG8_SCHED
}
}
typedef float f32x4 __attribute__((ext_vector_type(4)));
typedef unsigned u32x4 __attribute__((ext_vector_type(4)));
constexpr int T_ = 16384, D_ = 1024, NIN_ = 6912;
constexpr size_t MiB_ = 1u << 20;
constexpr size_t X_BASE = 230 * MiB_;
constexpr size_t X_WINT = X_BASE, X_WCAT = X_WINT + (size_t)NIN_ * 1024 * 2, X_WOT = X_WCAT + (size_t)1024 * 3072 * 2, X_WST = X_WOT + (size_t)1024 * 1024 * 2,
                 X_WCOMB = X_WST + (size_t)2048 * 1024 * 2, X_WIQT = X_WCOMB + (size_t)2048 * 256 * 2, X_END = X_WIQT + (size_t)512 * 256 * 2;
constexpr size_t X_EXPI = X_WINT, X_GATE = X_EXPI + (size_t)16384 * 128 * 4;
static_assert(X_GATE + (size_t)16384 * 128 * 4 <= X_WOT, "routing results fit over WinT | WcatT");
constexpr size_t X_WUK = WsMap<CfgFull>::A0, X_WUQ = X_WUK + (size_t)256 * 1024 * 2, X_WBT = X_WUQ + (size_t)256 * 1024 * 2,
                 X_WUV = X_WBT + (size_t)1024 * 1024 * 2, X_SKB = X_WUV + (size_t)256 * 1024 * 2, X_PWQ = X_SKB + (size_t)2048 * 256 * 2, X_TMP_END = X_PWQ + (size_t)1024 * 2048 * 2;
static_assert(WsMap<CfgFull>::END <= X_BASE && X_END <= 260 * MiB_ && X_TMP_END <= WsMap<CfgFull>::A2, "extra workspace map (d_ws >= 266.9 MiB = the sum of the inputs)");
struct OP {
    bf16_t *WinT, *WcatT, *WoT, *WsT, *WcombT, *WiqT, *wuk, *wuq, *wbT, *wuv, *skb, *pwq; float* S; bf16_t* RAWB; unsigned char *Ub, *Vb; int* EXPI2; float* GATE2; bf16_t *QA0, *QA1; unsigned* qword;
};
typedef __bf16 bf16x2h_t __attribute__((ext_vector_type(2)));
typedef float f32x2h_t __attribute__((ext_vector_type(2)));
__device__ __forceinline__ unsigned pk2bf(float lo, float hi) { const f32x2h_t v = {lo, hi}; return __builtin_bit_cast(unsigned, __builtin_convertvector(v, bf16x2h_t)); }
__device__ __forceinline__ bf16_t f2bfd(float f) { return (bf16_t)(pk2bf(f, 0.f) & 0xffffu); }

__device__ __forceinline__ int inproj_src(int n) {
    if (n < 3072) return n;
    if (n < 3328) return 4112 + (n - 3072);
    if (n < 3584) return 4368 + (n - 3328);
    if (n < 3648) return 4624 + (n - 3584);
    if (n < 3656) return 4096 + (n - 3648);
    if (n < 3664) return 4104 + (n - 3656);
    if (n < 3672) return 4688 + (n - 3664);
    if (n < 3840) return -1;
    if (n < 4864) return 3072 + (n - 3840);
    if (n < 5888) return 4696 + (n - 4864);
    return 5720 + (n - 5888);
}
template <int MAP> __device__ __forceinline__ void transpose_item(const float* W, int ldn, bf16_t* WT, int ldk, int n0, int k0, LAS float* scr, int lane) {
    const int j = lane & 31; int sc = n0 + j; if (MAP == 1) sc = inproj_src(n0 + j);
#pragma unroll 8
    for (int i = 0; i < 32; ++i) { const int kk = 2 * i + (lane >> 5); scr[kk * 33 + j] = (sc >= 0) ? W[(size_t)(k0 + kk) * ldn + sc] : 0.f; }
    asm volatile("s_waitcnt lgkmcnt(0)" ::: "memory");
    const int c = lane & 7;
#pragma unroll
    for (int q = 0; q < 4; ++q) { const int n = (lane >> 3) + 8 * q; const LAS float* s = scr + (8 * c) * 33 + n;
        u32x4 o; o.x = pk2bf(s[0 * 33], s[1 * 33]); o.y = pk2bf(s[2 * 33], s[3 * 33]); o.z = pk2bf(s[4 * 33], s[5 * 33]); o.w = pk2bf(s[6 * 33], s[7 * 33]);
        *(u32x4*)(WT + (size_t)(n0 + n) * ldk + k0 + 8 * c) = o; }
    asm volatile("s_waitcnt lgkmcnt(0)" ::: "memory");
}
__device__ __forceinline__ void p0_weights(const NP& P, const OP& Q, LAS unsigned char* lds, int gw, int NGW, int gt, int NGT, int wave, int lane) {
    LAS float* scr = (LAS float*)(lds + wave * 16384);
    constexpr int I_IN = (NIN_ / 32) * 16, I_SQ = 32 * 16;
    constexpr int I_IQ = 16 * 4;
    for (int it = gw; it < I_IN + 3 * I_SQ + I_IQ; it += NGW) {
        int r = it;
        if (r < I_IN) { transpose_item<1>(P.w_in, 6744, Q.WinT, 1024, (r / 16) * 32, (r % 16) * 64, scr, lane); continue; } r -= I_IN;
        if (r < I_SQ) { transpose_item<0>(P.w_a_out, 1024, Q.WcatT, 3072, (r / 16) * 32, (r % 16) * 64, scr, lane); continue; } r -= I_SQ;
        if (r < I_SQ) { transpose_item<0>(P.w_o, 1024, Q.WoT, 1024, (r / 16) * 32, (r % 16) * 64, scr, lane); continue; } r -= I_SQ;
        if (r < I_SQ) { transpose_item<0>(P.w_b_out, 1024, Q.wbT, 1024, (r / 16) * 32, (r % 16) * 64, scr, lane); continue; } r -= I_SQ;
        transpose_item<0>(P.w_iq, 512, Q.WiqT, 256, (r / 4) * 32, (r % 4) * 64, scr, lane);
    }
    for (int i = gt; i < 256 * 1024 / 4; i += NGT) { const f32x4 a = ((const f32x4*)P.w_uk)[i], b = ((const f32x4*)P.w_uq)[i], c = ((const f32x4*)P.w_uv)[i];
        ((uint2*)Q.wuk)[i] = make_uint2(pk2bf(a.x, a.y), pk2bf(a.z, a.w)); ((uint2*)Q.wuq)[i] = make_uint2(pk2bf(b.x, b.y), pk2bf(b.z, b.w)); ((uint2*)Q.wuv)[i] = make_uint2(pk2bf(c.x, c.y), pk2bf(c.z, c.w)); }
    for (int i = gt; i < 1024 * 2048 / 4; i += NGT) { const f32x4 a = ((const f32x4*)P.peer_w_q)[i]; ((uint2*)Q.pwq)[i] = make_uint2(pk2bf(a.x, a.y), pk2bf(a.z, a.w)); }
    for (int i = gt; i < 2048 * 256 / 4; i += NGT) { const int row = i / 64, c4 = (i % 64) * 4, g = row >> 7; uint2 o = make_uint2(0u, 0u);
        if ((c4 >> 7) == (g & 1)) { const f32x4 a = *(const f32x4*)(P.peer_sub_keys + (size_t)row * 128 + (c4 & 127)); o = make_uint2(pk2bf(a.x, a.y), pk2bf(a.z, a.w)); }
        ((uint2*)Q.skb)[i] = o; }
}
struct GridSched {
    int nM, nN, nwg, G, c; const char* A; const char* B; size_t sA, sB;
    const char* A2 = nullptr; int splitA = 1 << 30;
    __device__ void init(int nM_, int nN_, int G_, int c_, const void* A_, size_t sA_, const void* B_, size_t sB_) { nM = nM_; nN = nN_; nwg = nM * nN; G = G_; c = c_; A = (const char*)A_; B = (const char*)B_; sA = sA_; sB = sB_; }
    __device__ bool next(int i, pg8::Unit& u) const {
        const long L = (long)i * G + c; if (L >= nwg) return false;
        int wgid = (int)L; { const int q = nwg / 8, r = nwg % 8, xcd = wgid % 8, off = wgid / 8; wgid = (xcd < r ? xcd * (q + 1) : r * (q + 1) + (xcd - r) * q) + off; }
        const int nig = 8 * nN, gid = wgid / nig, fm = gid * 8, gsz = (nM - fm) < 8 ? (nM - fm) : 8;
        u.pm = fm + ((wgid % nig) % gsz); u.pn = (wgid % nig) / gsz; u.a = (u.pm < splitA) ? A + (size_t)u.pm * sA : A2 + (size_t)(u.pm - splitA) * sA; u.b = B + (size_t)u.pn * sB; return true;
    }
    __device__ __forceinline__ void a_ready(const pg8::Unit&) const {}
    __device__ __forceinline__ void done(const pg8::Unit&) const {}
};
struct WSched {
    int kind, c; const bf16_t *wuk, *wuq, *wbT, *wuv, *skb, *pwq;
    __device__ bool next(int i, pg8::Unit& u) const {
        if (i > 0 || c < 0) return false;
        if (kind == 0) {
            if (c < 8) { u.pm = c; u.pn = 100; u.a = (const char*)(wuk + c * 128); u.b = (const char*)(wuq + c * 128); return true; }
            if (c < 40) { const int h = (c - 8) >> 2, mt = (c - 8) & 3; u.pm = mt; u.pn = 200 + h; u.a = (const char*)(wbT + (size_t)mt * 256 * 1024 + h * 128); u.b = (const char*)(wuv + h * 128); return true; }
            return false;
        }
        if (c < 32) { const int pm = c >> 2, nt = c & 3; u.pm = pm; u.pn = nt; u.a = (const char*)(skb + (size_t)pm * 256 * 256); u.b = (const char*)(pwq + (size_t)nt * 256 * 2048 + pm * 256); return true; }
        return false;
    }
    __device__ __forceinline__ void a_ready(const pg8::Unit&) const {}
    __device__ __forceinline__ void done(const pg8::Unit&) const {}
};
template <class F> struct EpiG {
    static constexpr bool PERM = true, AFTER_DRAIN = false; F f;
    __device__ __forceinline__ void operator()(const f32x4 (&acc)[2][2][4][2], const pg8::Unit& u, int wr, int wc, int fr, int fq) const {
#pragma unroll
        for (int ai = 0; ai < 2; ++ai)
#pragma unroll
            for (int m = 0; m < 4; ++m)
#pragma unroll
                for (int bj = 0; bj < 2; ++bj) f.st(u, ai * 128 + wr * 64 + m * 16 + fr, bj * 128 + wc * 32 + 8 * fq, acc[ai][bj][m][0], acc[ai][bj][m][1]);
    }
};
__device__ __forceinline__ u32x4 pack8(f32x4 v0, f32x4 v1) { u32x4 w; w.x = pk2bf(v0[0], v0[1]); w.y = pk2bf(v0[2], v0[3]); w.z = pk2bf(v1[0], v1[1]); w.w = pk2bf(v1[2], v1[3]); return w; }
struct FWeights {
    bf16_t *WcombT, *WcatT, *WsT;
    __device__ __forceinline__ void st(const pg8::Unit& u, int row, int col, f32x4 v0, f32x4 v1) const {
        bf16_t* p; float sc = 1.f;
        if (u.pn == 100) { p = WcombT + (size_t)(u.pm * 256 + row) * 256 + col; sc = 0.08838834764831845f; }
        else if (u.pn >= 200) { p = WcatT + (size_t)(u.pm * 256 + row) * 3072 + 1024 + (u.pn - 200) * 256 + col; }
        else { p = WsT + (size_t)(u.pm * 256 + row) * 1024 + u.pn * 256 + col; }
        *(u32x4*)p = pack8(v0 * sc, v1 * sc);
    }
};
struct FInprojA {
    bf16_t* QKVP; bf16_t* RAW;
    __device__ __forceinline__ void st(const pg8::Unit& u, int row, int col, f32x4 v0, f32x4 v1) const {
        const size_t t = (size_t)u.pm * 256 + row;
        if (u.pn < 12) { *(u32x4*)(QKVP + t * 3072 + u.pn * 256 + col) = pack8(v0, v1); }
        else { *(u32x4*)(RAW + t * 768 + (u.pn - 12) * 256 + col) = pack8(v0, v1); }
    }
};
struct FInprojB {
    bf16_t *Z, *GA, *GB;
    __device__ __forceinline__ void st(const pg8::Unit& u, int row, int col, f32x4 v0, f32x4 v1) const {
        const size_t t = (size_t)u.pm * 256 + row; const int which = u.pn >> 2, c = (u.pn & 3) * 256 + col;
        bf16_t* base = Z + (size_t)which * ((size_t)16384 * 1024);
        *(u32x4*)(base + t * 1024 + c) = pack8(v0, v1);
    }
};
struct FStoreBf16 { bf16_t* O; int ldc; bf16_t* O2; int split;
    __device__ __forceinline__ void st(const pg8::Unit& u, int row, int col, f32x4 v0, f32x4 v1) const { bf16_t* base = (u.pm < split) ? O + (size_t)(u.pm * 256) * ldc : O2 + (size_t)((u.pm - split) * 256) * ldc;
        *(u32x4*)(base + (size_t)row * ldc + u.pn * 256 + col) = pack8(v0, v1); } };
struct FStoreF32 { float* O; int ldc;
    __device__ __forceinline__ void st(const pg8::Unit& u, int row, int col, f32x4 v0, f32x4 v1) const { float* p = O + (size_t)(u.pm * 256 + row) * ldc + u.pn * 256 + col; *(f32x4*)p = v0; *(f32x4*)(p + 4) = v1; } };
__device__ __forceinline__ f32x4 bf4(uint2 w) { f32x4 r; r[0] = bf2f((bf16_t)(w.x & 0xffff)); r[1] = bf2f((bf16_t)(w.x >> 16)); r[2] = bf2f((bf16_t)(w.y & 0xffff)); r[3] = bf2f((bf16_t)(w.y >> 16)); return r; }
__device__ __forceinline__ f32x4 sig4(f32x4 v) { return (f32x4){sigmf(v[0]), sigmf(v[1]), sigmf(v[2]), sigmf(v[3])}; }
template <int SECOND> struct FMerge {
    const bf16_t* Gt; bf16_t* M;
    __device__ __forceinline__ void st(const pg8::Unit& u, int row, int col, f32x4 v0, f32x4 v1) const {
        const size_t o = (size_t)(u.pm * 256 + row) * 1024 + u.pn * 256 + col; const u32x4 g = *(const u32x4*)(Gt + o);
        f32x4 r0 = sig4(bf4(make_uint2(g.x, g.y))) * v0, r1 = sig4(bf4(make_uint2(g.z, g.w))) * v1;
        if (SECOND) { const u32x4 m = *(const u32x4*)(M + o); r0 += bf4(make_uint2(m.x, m.y)); r1 += bf4(make_uint2(m.z, m.w)); }
        *(u32x4*)(M + o) = pack8(r0, r1);
    }
};
struct FWo {
    const float* MOD; const float* x; float* X1;
    __device__ __forceinline__ void st(const pg8::Unit& u, int row, int col, f32x4 v0, f32x4 v1) const {
        const size_t t = (size_t)u.pm * 256 + row; const int c = u.pn * 256 + col; const int b = (int)(t >> 13);
        const float* gt = MOD + (size_t)b * 6144 + 2048 + c; const float* xr = x + t * 1024 + c; float* o = X1 + t * 1024 + c;
        *(f32x4*)o = *(const f32x4*)xr + *(const f32x4*)gt * v0; *(f32x4*)(o + 4) = *(const f32x4*)(xr + 4) + *(const f32x4*)(gt + 4) * v1;
    }
};
namespace idxk {
typedef short bf16x8 __attribute__((ext_vector_type(8)));
constexpr int NQ = 16, CAP = 768, CAPS = 772, THRESH = 512, KSEL = 256, L_ = 8192;
constexpr int L_VAL = 0, L_IDX = NQ * CAPS * 4, L_QF = 2 * NQ * CAPS * 4, L_HIST = L_QF + 16 * 64 * 16, L_CNT = L_HIST + 8 * 1024, L_TAU = L_CNT + 64, L_FLAG = L_TAU + 64, L_END = L_FLAG + 64, L_SIDX = 131072;
static_assert(L_END <= 131072, "indexer LDS map");
__device__ __forceinline__ unsigned sortable(float f) { const unsigned u = __builtin_bit_cast(unsigned, f); return (u & 0x80000000u) ? ~u : (u | 0x80000000u); }
__device__ __forceinline__ unsigned lanemask_lt_lo() { return __builtin_amdgcn_mbcnt_lo(~0u, 0u); }
__device__ __forceinline__ int mbcnt64(unsigned long long m) { return (int)__builtin_amdgcn_mbcnt_hi((unsigned)(m >> 32), __builtin_amdgcn_mbcnt_lo((unsigned)m, 0u)); }

__device__ __forceinline__ float compact_query(LAS float* val, LAS unsigned* idx, LAS unsigned* hist, int cnt, int lane) {
    float v[12]; unsigned ix[12]; unsigned long long key[12];
#pragma unroll
    for (int r = 0; r < 12; ++r) { const int e = r * 64 + lane; v[r] = 0.f; ix[r] = 0u; key[r] = 0ull;
        if (e < cnt) { v[r] = val[e]; ix[r] = idx[e]; key[r] = ((unsigned long long)sortable(v[r]) << 13) | (unsigned long long)(8191u - ix[r]); } }
    int need = KSEL; unsigned long long prefix = 0ull; int fshift = 0; bool done = false;
#define RS_PASS(SHIFT, BITS) if (!done) { \
        hist[lane * 4 + 0] = 0u; hist[lane * 4 + 1] = 0u; hist[lane * 4 + 2] = 0u; hist[lane * 4 + 3] = 0u; \
        asm volatile("s_waitcnt lgkmcnt(0)" ::: "memory"); \
        _Pragma("unroll") for (int r = 0; r < 12; ++r) { const int e = r * 64 + lane; \
            if (e < cnt && ((SHIFT + BITS >= 45) || ((key[r] >> (SHIFT + BITS)) == (prefix >> (SHIFT + BITS))))) atomicAdd((unsigned*)&hist[(unsigned)(key[r] >> SHIFT) & ((1u << BITS) - 1u)], 1u); } \
        asm volatile("s_waitcnt lgkmcnt(0)" ::: "memory"); \
        const unsigned c0 = hist[lane * 4 + 0], c1 = hist[lane * 4 + 1], c2 = hist[lane * 4 + 2], c3 = hist[lane * 4 + 3]; \
        const unsigned loc = c0 + c1 + c2 + c3; unsigned suf = loc;     \
        suf += (unsigned)__builtin_amdgcn_update_dpp(0, (int)suf, 0x101, 0xF, 0xF, true); suf += (unsigned)__builtin_amdgcn_update_dpp(0, (int)suf, 0x102, 0xF, 0xF, true); \
        suf += (unsigned)__builtin_amdgcn_update_dpp(0, (int)suf, 0x104, 0xF, 0xF, true); suf += (unsigned)__builtin_amdgcn_update_dpp(0, (int)suf, 0x108, 0xF, 0xF, true); \
        { const unsigned t1 = (unsigned)__builtin_amdgcn_readlane((int)suf, 16), t2 = (unsigned)__builtin_amdgcn_readlane((int)suf, 32), t3 = (unsigned)__builtin_amdgcn_readlane((int)suf, 48); \
          const int rw = lane >> 4; suf += (rw == 0) ? (t1 + t2 + t3) : (rw == 1) ? (t2 + t3) : (rw == 2) ? t3 : 0u; } \
        unsigned cum = suf - loc; int fb = -1, fneed = 0, fcnt = 0; \
        if (cum < (unsigned)need && (unsigned)need <= cum + c3) { fb = lane * 4 + 3; fneed = need - (int)cum; fcnt = (int)c3; } cum += c3; \
        if (cum < (unsigned)need && (unsigned)need <= cum + c2) { fb = lane * 4 + 2; fneed = need - (int)cum; fcnt = (int)c2; } cum += c2; \
        if (cum < (unsigned)need && (unsigned)need <= cum + c1) { fb = lane * 4 + 1; fneed = need - (int)cum; fcnt = (int)c1; } cum += c1; \
        if (cum < (unsigned)need && (unsigned)need <= cum + c0) { fb = lane * 4 + 0; fneed = need - (int)cum; fcnt = (int)c0; } \
        const unsigned long long bm = __ballot(fb >= 0); const int src = bm ? (int)__builtin_ctzll(bm) : 0; \
        const int bin = __builtin_amdgcn_readlane(fb, src), nneed = __builtin_amdgcn_readlane(fneed, src), ncnt = __builtin_amdgcn_readlane(fcnt, src); \
        prefix |= (unsigned long long)(unsigned)bin << SHIFT; need = nneed; fshift = SHIFT; if (ncnt == nneed) done = true; }
    RS_PASS(37, 8) RS_PASS(29, 8) RS_PASS(21, 8) RS_PASS(13, 8) RS_PASS(5, 8) RS_PASS(0, 5)
#undef RS_PASS
    int base = 0; float mn = 3.0e38f;
#pragma unroll
    for (int r = 0; r < 12; ++r) { const int e = r * 64 + lane; const bool keep = (e < cnt) && ((key[r] >> fshift) >= (prefix >> fshift));
        const unsigned long long m = __ballot(keep); const int pos = base + mbcnt64(m);
        if (keep) { val[pos] = v[r]; idx[pos] = ix[r]; mn = fminf(mn, v[r]); } base += (int)__builtin_popcountll(m); }
#pragma unroll
    for (int o = 1; o < 64; o <<= 1) mn = fminf(mn, __shfl_xor(mn, o));
    return mn;
}

struct IdxArgs { const bf16_t* QLATN; const bf16_t* KIDXN; const float* WIDX; const bf16_t* WiqT; int* IDX; };

__device__ __forceinline__ void index_task(const IdxArgs& A, LAS unsigned char* lds, int b, int q0) {
    int tx = threadIdx.x; asm volatile("" : "+v"(tx));
    const int wave = __builtin_amdgcn_readfirstlane(tx >> 6), lane = tx & 63, n = lane & 15, g = lane >> 4;
    LAS float* VAL = (LAS float*)(lds + L_VAL); LAS unsigned* IDXB = (LAS unsigned*)(lds + L_IDX); LAS unsigned* HIST = (LAS unsigned*)(lds + L_HIST) + wave * 256;
    LAS unsigned* CNT = (LAS unsigned*)(lds + L_CNT); LAS float* TAU = (LAS float*)(lds + L_TAU); LAS unsigned* FLAG = (LAS unsigned*)(lds + L_FLAG);
    const size_t trow = (size_t)b * L_ + q0;
    if (tx < NQ) { CNT[tx] = 0u; TAU[tx] = -__builtin_inff(); } if (tx < 3) FLAG[tx] = 0u;
    {
        bf16x8 qb[8];
#pragma unroll
        for (int kk = 0; kk < 8; ++kk) qb[kk] = *(const bf16x8*)(A.QLATN + (trow + n) * 256 + kk * 32 + 8 * g);
#pragma unroll
        for (int s = 0; s < 2; ++s) {
            f32x4 x1 = {0.f, 0.f, 0.f, 0.f}, x2 = {0.f, 0.f, 0.f, 0.f};
            const int r = n, d1 = 32 * s + 8 * (r >> 2) + (r & 3), d2 = d1 + 4;
            const bf16_t* w1 = A.WiqT + (size_t)(wave * 64 + d1) * 256 + 8 * g; const bf16_t* w2 = A.WiqT + (size_t)(wave * 64 + d2) * 256 + 8 * g;
#pragma unroll
            for (int kk = 0; kk < 8; ++kk) { const bf16x8 a1 = *(const bf16x8*)(w1 + kk * 32), a2 = *(const bf16x8*)(w2 + kk * 32);
                x1 = __builtin_amdgcn_mfma_f32_16x16x32_bf16(a1, qb[kk], x1, 0, 0, 0); x2 = __builtin_amdgcn_mfma_f32_16x16x32_bf16(a2, qb[kk], x2, 0, 0, 0); }
            u32x4 fr; fr.x = pk2bf(x1[0], x1[1]); fr.y = pk2bf(x1[2], x1[3]); fr.z = pk2bf(x2[0], x2[1]); fr.w = pk2bf(x2[2], x2[3]);
            *(LAS u32x4*)(lds + L_QF + ((wave * 2 + s) * 64 + lane) * 16) = fr;
        }
    }
    __syncthreads();
    bf16x8 qf[8][2];
#pragma unroll
    for (int h = 0; h < 8; ++h)
#pragma unroll
        for (int s = 0; s < 2; ++s) qf[h][s] = *(const LAS bf16x8*)(lds + L_QF + ((h * 2 + s) * 64 + lane) * 16);
    float wq[8];
    { const f32x4 w0 = *(const f32x4*)(A.WIDX + (trow + n) * 8), w1 = *(const f32x4*)(A.WIDX + (trow + n) * 8 + 4);
      wq[0] = w0[0]; wq[1] = w0[1]; wq[2] = w0[2]; wq[3] = w0[3]; wq[4] = w1[0]; wq[5] = w1[1]; wq[6] = w1[2]; wq[7] = w1[3]; }
    const int qpos = q0 + n, kmax = q0 + 15;
    const int nst = (kmax >> 8) + 1;
    const bf16_t* kbase = A.KIDXN + (size_t)b * L_ * 64;
    bf16x8 ka[2][2];
#pragma unroll
    for (int blk = 0; blk < 2; ++blk) { const int kb = 32 * wave + 16 * blk; if (kb <= kmax) { const bf16_t* kr = kbase + (size_t)(kb + n) * 64 + 8 * g; ka[blk][0] = *(const bf16x8*)kr; ka[blk][1] = *(const bf16x8*)(kr + 32); } }
    for (int j = 0, jf = 0; j < nst; ++j, jf = (jf == 2) ? 0 : jf + 1) {
        const float tau = TAU[n];
        bf16x8 kc[2][2];
#pragma unroll
        for (int blk = 0; blk < 2; ++blk) { kc[blk][0] = ka[blk][0]; kc[blk][1] = ka[blk][1];
            const int kbn = 256 * (j + 1) + 32 * wave + 16 * blk; if (kbn <= kmax) { const bf16_t* kr = kbase + (size_t)(kbn + n) * 64 + 8 * g; ka[blk][0] = *(const bf16x8*)kr; ka[blk][1] = *(const bf16x8*)(kr + 32); } }
#pragma unroll
        for (int blk = 0; blk < 2; ++blk) {
            const int kb = 256 * j + 32 * wave + 16 * blk;
            if (kb <= kmax) {
                const bf16x8 a0 = kc[blk][0], a1 = kc[blk][1];
                float sc[4] = {0.f, 0.f, 0.f, 0.f};
                f32x4 acc[8];
#pragma unroll
                for (int h = 0; h < 8; ++h) acc[h] = __builtin_amdgcn_mfma_f32_16x16x32_bf16(a0, qf[h][0], (f32x4){0.f, 0.f, 0.f, 0.f}, 0, 0, 0);
#pragma unroll
                for (int h = 0; h < 8; ++h) acc[h] = __builtin_amdgcn_mfma_f32_16x16x32_bf16(a1, qf[h][1], acc[h], 0, 0, 0);
                __builtin_amdgcn_sched_barrier(0);
#pragma unroll
                for (int h = 0; h < 8; ++h) {
#pragma unroll
                    for (int i = 0; i < 4; ++i) sc[i] = fmaf(wq[h], fmaxf(acc[h][i], 0.f), sc[i]); }
                bool ps[4]; int np = 0;
#pragma unroll
                for (int i = 0; i < 4; ++i) { const int key = kb + 4 * g + i; ps[i] = (key <= qpos) && (sc[i] > tau); np += ps[i] ? 1 : 0; }
                if (np) {
                    unsigned pos = __hip_atomic_fetch_add((unsigned*)&CNT[n], (unsigned)np, __ATOMIC_RELAXED, __HIP_MEMORY_SCOPE_WORKGROUP);
                    if (pos + np > THRESH) FLAG[jf] = 1u;
#pragma unroll
                    for (int i = 0; i < 4; ++i) if (ps[i]) { VAL[n * CAPS + pos] = sc[i]; IDXB[n * CAPS + pos] = (unsigned)(kb + 4 * g + i); ++pos; }
                }
            }
        }
        asm volatile("s_waitcnt lgkmcnt(0)\n\ts_barrier" ::: "memory");
        if (tx == 0) FLAG[jf == 0 ? 2 : jf - 1] = 0u;
        if (FLAG[jf]) {
#pragma unroll
            for (int qq = 0; qq < 2; ++qq) { const int q = wave * 2 + qq; const int c = (int)CNT[q];
                if (c > 384) { const float t = compact_query(VAL + q * CAPS, IDXB + q * CAPS, HIST, c, lane); if (lane == 0) { TAU[q] = t; CNT[q] = KSEL; } } }
            __syncthreads();
        }
    }
#pragma unroll
    for (int qq = 0; qq < 2; ++qq) { const int q = wave * 2 + qq; int c = (int)CNT[q];
        if (c > KSEL) { (void)compact_query(VAL + q * CAPS, IDXB + q * CAPS, HIST, c, lane); c = KSEL; }
        asm volatile("s_waitcnt lgkmcnt(0)" ::: "memory");
        HIST[lane * 4 + 0] = 0u; HIST[lane * 4 + 1] = 0u; HIST[lane * 4 + 2] = 0u; HIST[lane * 4 + 3] = 0u;
        asm volatile("s_waitcnt lgkmcnt(0)" ::: "memory");
        for (int e = lane; e < c; e += 64) { const unsigned k = IDXB[q * CAPS + e]; atomicOr((unsigned*)&HIST[k >> 5], 1u << (k & 31u)); }
        asm volatile("s_waitcnt lgkmcnt(0)" ::: "memory");
        unsigned wd[4]; int pc = 0;
#pragma unroll
        for (int i = 0; i < 4; ++i) { wd[i] = HIST[lane * 4 + i]; pc += (int)__builtin_popcount(wd[i]); }
        int incl = pc;
#pragma unroll
        for (int o = 1; o < 64; o <<= 1) { const int t = __shfl_up(incl, o); if (lane >= o) incl += t; }
        LAS int* out = (LAS int*)(lds + L_SIDX) + q * KSEL; int pos = incl - pc;
#pragma unroll
        for (int i = 0; i < 4; ++i) { unsigned w = wd[i]; while (w) { const int bit = __builtin_ctz(w); w &= w - 1u; out[pos++] = (lane * 4 + i) * 32 + bit; } }
#pragma unroll
        for (int e = lane; e < KSEL; e += 64) if (e >= c) out[e] = -1; }
    __syncthreads();
}
__device__ __forceinline__ void index_phase(const IdxArgs& A, LAS unsigned char* lds, int bx, int G) {
    if (G == 256) { for (int k = 0; k < 4; ++k) { const int b = k >> 1, qt = (k & 1) ? 511 - bx : bx; index_task(A, lds, b, qt * 16); } }
    else { for (int id = bx; id < 1024; id += G) index_task(A, lds, id >> 9, (id & 511) * 16); }
}
}
namespace sattn {
typedef short bf16x8 __attribute__((ext_vector_type(8)));
typedef short s16x4 __attribute__((ext_vector_type(4)));
typedef unsigned u32x2_t __attribute__((ext_vector_type(2)));
typedef __attribute__((ext_vector_type(4))) short v4i16_t;
__device__ __forceinline__ s16x4 vtr(LAS unsigned char* p) { return __builtin_bit_cast(s16x4, __builtin_amdgcn_ds_read_tr16_b64_v4i16((LAS v4i16_t*)p)); }
constexpr int QSPLIT = 12288;
__device__ __forceinline__ void dma16(const void* gsrc, unsigned lds_dst) { unsigned keep; asm volatile("s_mov_b32 %0, m0\n\ts_mov_b32 m0, %2\n\ts_nop 0\n\tglobal_load_lds_dwordx4 %1, off\n\ts_mov_b32 m0, %0" : "=&s"(keep) : "v"(gsrc), "s"(lds_dst) : "memory"); }
struct AArgs { const bf16_t* CKVN; bf16_t* Q0; bf16_t* Q1; };

__device__ __forceinline__ void attn_query(const AArgs& A, LAS unsigned char* tile, int t, int lane, const LAS int* sidx) {
    const int n = lane & 15, g = lane >> 4, b = t >> 13, l = t & 8191;
    const int nv = (l + 1 < 256) ? l + 1 : 256;
    const bf16_t* ckv = A.CKVN + (size_t)b * 8192 * 256;
    bf16_t* qrow = (t < QSPLIT) ? A.Q0 + (size_t)t * 2048 : A.Q1 + (size_t)(t - QSPLIT) * 2048;
    bf16x8 qf[8];
#pragma unroll
    for (int s = 0; s < 8; ++s) { qf[s] = (bf16x8){0, 0, 0, 0, 0, 0, 0, 0}; if (n < 8) qf[s] = *(const bf16x8*)(qrow + n * 256 + 32 * s + 8 * g); }
    f32x4 o[16];
#pragma unroll
    for (int c = 0; c < 16; ++c) o[c] = (f32x4){0.f, 0.f, 0.f, 0.f};
    float mrun = -3.0e38f, lsum = 0.f;
    const int nblk = (nv + 15) >> 4;
    asm volatile("s_waitcnt vmcnt(0) lgkmcnt(0)" ::: "memory");
#pragma unroll
    for (int s = 0; s < 8; ++s) asm volatile("" : "+v"(qf[s]));
#define ATT_ISSUE(J) do { const int k_ = (J) * 16 + n; int my_ = (k_ < nv) ? sidx[k_] : 0; if (my_ < 0) my_ = 0; const unsigned dst_ = tbase + ((J) & 1) * 8192u; \
        _Pragma("unroll") for (int i = 0; i < 8; ++i) { const int r = 2 * i + (lane >> 5); const int row = __shfl(my_, r); \
            const bf16_t* src = ckv + (size_t)row * 256 + (((lane & 31) ^ r) << 3); \
            dma16(src, dst_ + i * 1024u); } } while (0)
    const unsigned tbase = (unsigned)__builtin_amdgcn_readfirstlane((int)(unsigned)(size_t)tile);
    ATT_ISSUE(0);
    for (int j = 0; j < nblk; ++j) {
        LAS unsigned char* buf = tile + (j & 1) * 8192;
        if (j + 1 < nblk) { ATT_ISSUE(j + 1); asm volatile("s_waitcnt vmcnt(8)" ::: "memory"); }
        else asm volatile("s_waitcnt vmcnt(0)" ::: "memory");
        __builtin_amdgcn_sched_barrier(0);
        f32x4 s0 = {0.f, 0.f, 0.f, 0.f};
#pragma unroll
        for (int s = 0; s < 8; ++s) s0 = __builtin_amdgcn_mfma_f32_16x16x32_bf16(*(const LAS bf16x8*)(buf + n * 512 + (((4 * s + g) ^ n) << 4)), qf[s], s0, 0, 0, 0);
        const int k0 = j * 16 + 4 * g;
        float bm = -3.0e38f;
#pragma unroll
        for (int i = 0; i < 4; ++i) { if (k0 + i >= nv) s0[i] = -3.0e38f; bm = fmaxf(bm, s0[i]); }
        bm = fmaxf(bm, __shfl_xor(bm, 16)); bm = fmaxf(bm, __shfl_xor(bm, 32));
        const float mnew = fmaxf(mrun, bm), alpha = __expf(mrun - mnew); const bool grow = mnew > mrun; mrun = mnew;
        float p[4]; float ps = 0.f;
#pragma unroll
        for (int i = 0; i < 4; ++i) { p[i] = (k0 + i < nv) ? __expf(s0[i] - mnew) : 0.f; ps += p[i]; }
        lsum = lsum * alpha + ps;
        const s16x4 pf = __builtin_bit_cast(s16x4, (u32x2_t){pk2bf(p[0], p[1]), pk2bf(p[2], p[3])});
        if (__any(grow)) {
#pragma unroll
            for (int c = 0; c < 16; ++c) o[c] = o[c] * alpha;
        }
        const int q4 = (lane & 15) >> 2, p4 = lane & 3, r0 = 4 * g + q4;
#pragma unroll
        for (int c = 0; c < 16; ++c) { const int ch = 2 * c + (p4 >> 1);
            const s16x4 af = vtr(buf + r0 * 512 + ((ch ^ r0) << 4) + ((p4 & 1) << 3));
            o[c] = __builtin_amdgcn_mfma_f32_16x16x16bf16_1k(af, pf, o[c], 0, 0, 0); }
        asm volatile("s_waitcnt lgkmcnt(0)" ::: "memory");
    }
#undef ATT_ISSUE
    lsum += __shfl_xor(lsum, 16); lsum += __shfl_xor(lsum, 32);
    const float inv = 1.f / lsum;
    if (n < 8) {
#pragma unroll
        for (int c = 0; c < 16; ++c) { const f32x4 v = o[c] * inv; *(uint2*)(qrow + n * 256 + 16 * c + 4 * g) = make_uint2(pk2bf(v[0], v[1]), pk2bf(v[2], v[3])); }
    }
}
}
namespace dsa {
struct DArgs { idxk::IdxArgs I; sattn::AArgs A; unsigned* qword; };
__device__ __forceinline__ void dsa_task(const DArgs& D, LAS unsigned char* lds, int b, int q0) {
    idxk::index_task(D.I, lds, b, q0);
    int tx = threadIdx.x; asm volatile("" : "+v"(tx));
    const int wave = __builtin_amdgcn_readfirstlane(tx >> 6), lane = tx & 63;
#pragma unroll 1
    for (int qq = 0; qq < 2; ++qq) { const int q = 2 * wave + qq;
        sattn::attn_query(D.A, lds + wave * 16384, b * 8192 + q0 + q, lane, (const LAS int*)(lds + idxk::L_SIDX) + q * 256); }
    asm volatile("s_waitcnt vmcnt(0) lgkmcnt(0)" ::: "memory");
    __syncthreads();
}
__device__ __forceinline__ void dsa_queue(const DArgs& D, LAS unsigned char* lds, volatile LAS unsigned* slot) {
    for (;;) {
        if (threadIdx.x == 0) *slot = __hip_atomic_fetch_add(D.qword, 1u, __ATOMIC_RELAXED, __HIP_MEMORY_SCOPE_AGENT);
        __syncthreads();
        const unsigned id = *slot;
        __syncthreads();
        if (id >= 1024u) break;
        dsa_task(D, lds, (int)(id & 1u), (511 - (int)(id >> 1)) * 16);
    }
}
}
namespace dnet {
typedef short bf16x8 __attribute__((ext_vector_type(8)));
typedef unsigned u32x2_t __attribute__((ext_vector_type(2)));
typedef __attribute__((ext_vector_type(4))) short v4i16p_t;
__device__ __forceinline__ float bflo(unsigned w) { return __builtin_bit_cast(float, w << 16); }
__device__ __forceinline__ float bfhi(unsigned w) { return __builtin_bit_cast(float, w & 0xffff0000u); }
__device__ __forceinline__ void conv_phase(const bf16_t* QKVP, bf16_t* QKVN, const float* convw, int gw, int NGW, int lane) {
    for (int it = gw; it < 1024 * 6; it += NGW) {
        const int slab = it % 6, tb = it / 6, t0 = tb * 16, ch = slab * 512 + lane * 8;
        float w[4][8];
#pragma unroll
        for (int i = 0; i < 4; ++i) { const f32x4 a = *(const f32x4*)(convw + (size_t)i * 3072 + ch), b = *(const f32x4*)(convw + (size_t)i * 3072 + ch + 4);
            w[i][0] = a[0]; w[i][1] = a[1]; w[i][2] = a[2]; w[i][3] = a[3]; w[i][4] = b[0]; w[i][5] = b[1]; w[i][6] = b[2]; w[i][7] = b[3]; }
        u32x4 r0 = {0u, 0u, 0u, 0u}, r1 = r0, r2 = r0;
        if ((t0 & 8191) != 0) { r0 = *(const u32x4*)(QKVP + (size_t)(t0 - 3) * 3072 + ch); r1 = *(const u32x4*)(QKVP + (size_t)(t0 - 2) * 3072 + ch); r2 = *(const u32x4*)(QKVP + (size_t)(t0 - 1) * 3072 + ch); }
        for (int tt = 0; tt < 16; ++tt) {
            const u32x4 r3 = *(const u32x4*)(QKVP + (size_t)(t0 + tt) * 3072 + ch);
            float y[8];
#pragma unroll
            for (int e = 0; e < 4; ++e) {
                const float a0 = bflo(r0[e]) * w[0][2 * e] + bflo(r1[e]) * w[1][2 * e] + bflo(r2[e]) * w[2][2 * e] + bflo(r3[e]) * w[3][2 * e];
                const float a1 = bfhi(r0[e]) * w[0][2 * e + 1] + bfhi(r1[e]) * w[1][2 * e + 1] + bfhi(r2[e]) * w[2][2 * e + 1] + bfhi(r3[e]) * w[3][2 * e + 1];
                y[2 * e] = a0 / (1.f + __expf(-a0)); y[2 * e + 1] = a1 / (1.f + __expf(-a1)); }
            if (slab < 4) {
                float ss = 0.f;
#pragma unroll
                for (int e = 0; e < 8; ++e) ss += y[e] * y[e];
                ss += __shfl_xor(ss, 1); ss += __shfl_xor(ss, 2); ss += __shfl_xor(ss, 4); ss += __shfl_xor(ss, 8);
                const float rs = 1.f / sqrtf(ss + 1e-6f);
#pragma unroll
                for (int e = 0; e < 8; ++e) y[e] *= rs;
            }
            u32x4 o; o.x = pk2bf(y[0], y[1]); o.y = pk2bf(y[2], y[3]); o.z = pk2bf(y[4], y[5]); o.w = pk2bf(y[6], y[7]);
            *(u32x4*)(QKVN + (size_t)(t0 + tt) * 3072 + ch) = o;
            r0 = r1; r1 = r2; r2 = r3;
        }
    }
}
constexpr int PR = 272, L_QN = 0, L_KN = 64 * PR, L_V = 2 * 64 * PR, L_A = 3 * 64 * PR, L_SM = 4 * 64 * PR, L_TI = L_SM + 5 * 256, L_PEND = L_TI + 4 * 16 * 16 * 2;
struct PrepArgs { bf16_t* QKVN; const float* BETA; const float* G; bf16_t* W; bf16_t* ATT; float* GL; };
__device__ __forceinline__ float dpp_swap1(float v) { return __builtin_bit_cast(float, __builtin_amdgcn_update_dpp(0, __builtin_bit_cast(int, v), 0xB1, 0xF, 0xF, false)); }
__device__ __forceinline__ void prep_chunk(const PrepArgs& A, LAS unsigned char* lds, int cid) {
    int tx = threadIdx.x; asm volatile("" : "+v"(tx));
    const int wave = __builtin_amdgcn_readfirstlane(tx >> 6), lane = tx & 63, n = lane & 15, g = lane >> 4;
    const int nc = cid & 127, h = (cid >> 7) & 7, b = cid >> 10; const size_t t0 = (size_t)b * 8192 + nc * 64;
    LAS float* SM = (LAS float*)(lds + L_SM);
    for (int i = tx; i < 3 * 64 * 16; i += 512) { const int which = i / 1024, r = (i >> 4) & 63, c16 = i & 15;
        const u32x4 v = *(const u32x4*)(A.QKVN + (t0 + r) * 3072 + which * 1024 + h * 128 + c16 * 8);
        *(LAS u32x4*)(lds + which * 64 * PR + r * PR + c16 * 16) = v; }
    if (wave == 0) {
        float gg = A.G[(t0 + lane) * 8 + h]; const float be = A.BETA[(t0 + lane) * 8 + h];
#pragma unroll
        for (int o = 1; o < 64; o <<= 1) { const float t = __shfl_up(gg, o); if (lane >= o) gg += t; }
        const float gl = __shfl(gg, 63);
        SM[lane] = be; SM[64 + lane] = gg; SM[128 + lane] = __expf(gg); SM[192 + lane] = __expf(gl - gg);
        if (lane == 0) A.GL[cid] = __expf(gl);
    }
    __syncthreads();
#pragma unroll
    for (int q = 0; q < 4; ++q) {
        const int tl = wave * 4 + q, isq = tl >> 4, mi = (tl >> 2) & 3, nj = tl & 3;
        if (nj > mi) continue;
        f32x4 acc = {0.f, 0.f, 0.f, 0.f};
        const LAS unsigned char* ar = lds + (isq ? L_QN : L_KN) + (16 * mi + n) * PR + 16 * g; const LAS unsigned char* br = lds + L_KN + (16 * nj + n) * PR + 16 * g;
#pragma unroll
        for (int s = 0; s < 4; ++s) acc = __builtin_amdgcn_mfma_f32_16x16x32_bf16(*(const LAS bf16x8*)(ar + 64 * s), *(const LAS bf16x8*)(br + 64 * s), acc, 0, 0, 0);
        const int j = 16 * nj + n; const float gcj = SM[64 + j];
#pragma unroll
        for (int r = 0; r < 4; ++r) { const int i = 16 * mi + 4 * g + r; const float dec = __expf(fminf(SM[64 + i] - gcj, 0.f));
            if (isq) A.ATT[(size_t)cid * 4096 + i * 64 + j] = f2bfd((j <= i) ? acc[r] * 0.08838834764831845f * dec : 0.f);
            else *(LAS float*)(lds + L_A + i * PR + j * 4) = (j < i) ? SM[i] * acc[r] * dec : 0.f; }
    }
    for (int i = tx; i < 64 * 64; i += 512) { const int r = i >> 6, c = i & 63; if ((c >> 4) > (r >> 4)) { *(LAS float*)(lds + L_A + r * PR + c * 4) = 0.f; A.ATT[(size_t)cid * 4096 + r * 64 + c] = 0; } }
    __syncthreads();
    if (wave < 4 && lane < 16) {
        float tcol[16];
#pragma unroll
        for (int i = 0; i < 16; ++i) { float s = (i == lane) ? 1.f : 0.f;
#pragma unroll
            for (int j = 0; j < i; ++j) s = fmaf(-*(const LAS float*)(lds + L_A + (16 * wave + i) * PR + (16 * wave + j) * 4), tcol[j], s);
            tcol[i] = s; }
#pragma unroll
        for (int i = 0; i < 16; ++i) *(LAS bf16_t*)(lds + L_TI + ((wave * 16 + i) * 16 + lane) * 2) = f2bfd(tcol[i] - ((i == lane) ? 1.f : 0.f));
    }
    __syncthreads();
    {
        const int q4 = n >> 2, p4 = n & 3;
#pragma unroll 1
        for (int tt = 0; tt < 2; ++tt) {
            const int col0 = 32 * wave + 16 * tt; const bool isw = col0 >= 128;
            const LAS unsigned char* srcm = lds + (isw ? L_KN + (col0 - 128) * 2 : L_V + col0 * 2);
            typedef short s16x4_t __attribute__((ext_vector_type(4)));
            s16x4_t xb[4];
#pragma unroll
            for (int bb = 0; bb < 4; ++bb) {
                const s16x4_t r4 = __builtin_bit_cast(s16x4_t, __builtin_amdgcn_ds_read_tr16_b64_v4i16((LAS v4i16p_t*)(srcm + (16 * bb + 4 * g + q4) * PR + 8 * p4)));
                f32x4 acc;
#pragma unroll
                for (int r = 0; r < 4; ++r) { const int i = 16 * bb + 4 * g + r; float sc = SM[i]; if (isw) sc *= SM[128 + i]; acc[r] = __builtin_bit_cast(float, (unsigned)(unsigned short)r4[r] << 16) * sc; }
#pragma unroll
                for (int bp = 0; bp < bb; ++bp) { const f32x4 av = *(const LAS f32x4*)(lds + L_A + (16 * bb + n) * PR + (16 * bp + 4 * g) * 4);
                    u32x2_t w; w.x = pk2bf(-av[0], -av[1]); w.y = pk2bf(-av[2], -av[3]);
                    acc = __builtin_amdgcn_mfma_f32_16x16x16bf16_1k(__builtin_bit_cast(s16x4_t, w), xb[bp], acc, 0, 0, 0); }
                { u32x2_t w; w.x = pk2bf(acc[0], acc[1]); w.y = pk2bf(acc[2], acc[3]);
                  const s16x4_t ti = *(const LAS s16x4_t*)(lds + L_TI + ((bb * 16 + n) * 16 + 4 * g) * 2);
                  acc = __builtin_amdgcn_mfma_f32_16x16x16bf16_1k(ti, __builtin_bit_cast(s16x4_t, w), acc, 0, 0, 0); }
                { u32x2_t w; w.x = pk2bf(acc[0], acc[1]); w.y = pk2bf(acc[2], acc[3]); xb[bb] = __builtin_bit_cast(s16x4_t, w); }
                if (!isw) {
#pragma unroll
                    for (int r = 0; r < 4; ++r) A.QKVN[(t0 + 16 * bb + 4 * g + r) * 3072 + 2048 + h * 128 + col0 + n] = f2bfd(acc[r]);
                } else {
#pragma unroll
                    for (int r = 0; r < 4; ++r) A.W[((size_t)cid * 64 + 16 * bb + 4 * g + r) * 128 + (col0 - 128) + n] = f2bfd(acc[r]);
                }
            }
        }
    }
    for (int i = tx; i < 2 * 64 * 16; i += 512) { const int which = i >> 10, r = (i >> 4) & 63, c16 = i & 15;
        const u32x4 v = *(const LAS u32x4*)(lds + which * 64 * PR + r * PR + c16 * 16); const float f = which ? SM[192 + r] : SM[128 + r] * 0.08838834764831845f;
        u32x4 o; o.x = pk2bf(bflo(v.x) * f, bfhi(v.x) * f); o.y = pk2bf(bflo(v.y) * f, bfhi(v.y) * f); o.z = pk2bf(bflo(v.z) * f, bfhi(v.z) * f); o.w = pk2bf(bflo(v.w) * f, bfhi(v.w) * f);
        *(u32x4*)(A.QKVN + (t0 + r) * 3072 + which * 1024 + h * 128 + c16 * 8) = o; }
    __syncthreads();
}
__device__ __forceinline__ void prep_phase(const PrepArgs& A, LAS unsigned char* lds, int bx, int G) { for (int cid = bx; cid < 2048; cid += G) prep_chunk(A, lds, cid); }
}
namespace dnet {
typedef short s16x4 __attribute__((ext_vector_type(4)));
typedef __attribute__((ext_vector_type(4))) short v4i16_t;
__device__ __forceinline__ s16x4 vtr(const LAS unsigned char* p) { return __builtin_bit_cast(s16x4, __builtin_amdgcn_ds_read_tr16_b64_v4i16((LAS v4i16_t*)p)); }
constexpr int PA = 144, S_W = 0, S_QD = 64 * PR, S_KD = 2 * 64 * PR, S_U = 3 * 64 * PR, S_ATT = 4 * 64 * PR, S_OBUF = S_ATT + 64 * PA, S_END = S_OBUF + 64 * PR;
static_assert(S_END <= 131072, "scan LDS map");
struct ScanArgs { const bf16_t* QKVN; const bf16_t* W; const bf16_t* ATT; const float* GL; bf16_t* O; };
typedef unsigned u32x2 __attribute__((ext_vector_type(2)));
__device__ __forceinline__ bf16x8 frag2(const LAS unsigned char* p) { const u32x2 lo = *(const LAS u32x2*)p, hi = *(const LAS u32x2*)(p + 32); u32x4 w = {lo.x, lo.y, hi.x, hi.y}; return __builtin_bit_cast(bf16x8, w); }
__device__ __forceinline__ void scan_bh(const ScanArgs& A, LAS unsigned char* lds, int bh) {
    int tx = threadIdx.x; asm volatile("" : "+v"(tx));
    const int wave = __builtin_amdgcn_readfirstlane(tx >> 6), lane = tx & 63, n = lane & 15, g = lane >> 4, q4 = n >> 2, p4 = n & 3;
    const int b = bh >> 3, h = bh & 7, e0 = 16 * wave;
    const int sr = tx >> 3, sc = tx & 7;
    (void)sr; (void)sc;
    u32x4 pfA[9], pfB[9];
    auto issue = [&](u32x4 (&pf)[9], int nc_) { const int nc = nc_ < 127 ? nc_ : 127;
        const size_t t0 = (size_t)b * 8192 + nc * 64; const int cid = bh * 128 + nc;
#pragma unroll
        for (int i = 0; i < 2; ++i) { const int p = tx + 512 * i, r = p >> 4, c = p & 15;
            pf[i] = *(const u32x4*)(A.W + ((size_t)cid * 64 + r) * 128 + c * 8);
            pf[2 + i] = *(const u32x4*)(A.QKVN + (t0 + r) * 3072 + h * 128 + c * 8);
            pf[4 + i] = *(const u32x4*)(A.QKVN + (t0 + r) * 3072 + 1024 + h * 128 + c * 8);
            pf[6 + i] = *(const u32x4*)(A.QKVN + (t0 + r) * 3072 + 2048 + h * 128 + c * 8); }
        pf[8] = *(const u32x4*)(A.ATT + (size_t)cid * 4096 + tx * 8);
    };
    auto commit = [&](const u32x4 (&pf)[9]) {
#pragma unroll
        for (int i = 0; i < 2; ++i) { const int p = tx + 512 * i, r = p >> 4, c = p & 15;
            *(LAS u32x4*)(lds + S_W + r * PR + c * 16) = pf[i]; *(LAS u32x4*)(lds + S_QD + r * PR + c * 16) = pf[2 + i];
            *(LAS u32x4*)(lds + S_KD + r * PR + c * 16) = pf[4 + i]; *(LAS u32x4*)(lds + S_U + r * PR + c * 16) = pf[6 + i]; }
        *(LAS u32x4*)(lds + S_ATT + (tx >> 3) * PA + (tx & 7) * 16) = pf[8];
    };
    const float gl_lo = A.GL[bh * 128 + lane], gl_hi = A.GL[bh * 128 + 64 + lane];
    f32x4 S[8];
#pragma unroll
    for (int d = 0; d < 8; ++d) S[d] = (f32x4){0.f, 0.f, 0.f, 0.f};
    auto compute = [&](int nc) {
        const float gl = __builtin_bit_cast(float, (nc < 64) ? __builtin_amdgcn_readlane(__builtin_bit_cast(int, gl_lo), nc & 63) : __builtin_amdgcn_readlane(__builtin_bit_cast(int, gl_hi), nc & 63));
        const size_t t0 = (size_t)b * 8192 + nc * 64;
        bf16x8 sp[4];
#pragma unroll
        for (int s = 0; s < 4; ++s) { u32x4 w; w.x = pk2bf(S[2 * s][0], S[2 * s][1]); w.y = pk2bf(S[2 * s][2], S[2 * s][3]); w.z = pk2bf(S[2 * s + 1][0], S[2 * s + 1][1]); w.w = pk2bf(S[2 * s + 1][2], S[2 * s + 1][3]);
            sp[s] = __builtin_bit_cast(bf16x8, w); }
        f32x4 vn[4];
#pragma unroll
        for (int mt = 0; mt < 4; ++mt) {
            const s16x4 u4 = vtr(lds + S_U + (16 * mt + 4 * g + q4) * PR + (e0 + 4 * p4) * 2);
            f32x4 acc; acc[0] = __builtin_bit_cast(float, ((unsigned)(unsigned short)u4[0] << 16) ^ 0x80000000u); acc[1] = __builtin_bit_cast(float, ((unsigned)(unsigned short)u4[1] << 16) ^ 0x80000000u);
            acc[2] = __builtin_bit_cast(float, ((unsigned)(unsigned short)u4[2] << 16) ^ 0x80000000u); acc[3] = __builtin_bit_cast(float, ((unsigned)(unsigned short)u4[3] << 16) ^ 0x80000000u);
            const LAS unsigned char* wr = lds + S_W + (16 * mt + n) * PR + 8 * g;
#pragma unroll
            for (int s = 0; s < 4; ++s) acc = __builtin_amdgcn_mfma_f32_16x16x32_bf16(frag2(wr + 64 * s), sp[s], acc, 0, 0, 0);
            vn[mt] = acc;
        }
        bf16x8 vp[2];
#pragma unroll
        for (int s = 0; s < 2; ++s) { u32x4 w; w.x = pk2bf(vn[2 * s][0], vn[2 * s][1]); w.y = pk2bf(vn[2 * s][2], vn[2 * s][3]); w.z = pk2bf(vn[2 * s + 1][0], vn[2 * s + 1][1]); w.w = pk2bf(vn[2 * s + 1][2], vn[2 * s + 1][3]);
            w.x ^= 0x80008000u; w.y ^= 0x80008000u; w.z ^= 0x80008000u; w.w ^= 0x80008000u; vp[s] = __builtin_bit_cast(bf16x8, w); }
#pragma unroll
        for (int mt = 0; mt < 4; ++mt) {
            f32x4 acc = {0.f, 0.f, 0.f, 0.f};
            const LAS unsigned char* qr = lds + S_QD + (16 * mt + n) * PR + 8 * g; const LAS unsigned char* ar = lds + S_ATT + (16 * mt + n) * PA + 8 * g;
#pragma unroll
            for (int s = 0; s < 4; ++s) acc = __builtin_amdgcn_mfma_f32_16x16x32_bf16(frag2(qr + 64 * s), sp[s], acc, 0, 0, 0);
#pragma unroll
            for (int s = 0; s < 2; ++s) acc = __builtin_amdgcn_mfma_f32_16x16x32_bf16(frag2(ar + 64 * s), vp[s], acc, 0, 0, 0);
#pragma unroll
            for (int r = 0; r < 4; ++r) *(LAS bf16_t*)(lds + S_OBUF + (16 * mt + 4 * g + r) * PR + (e0 + n) * 2) = f2bfd(acc[r]);
        }
#pragma unroll
        for (int d = 0; d < 8; ++d) {
            f32x4 acc = S[d] * gl;
#pragma unroll
            for (int s = 0; s < 2; ++s) { const LAS unsigned char* kp = lds + S_KD + (32 * s + 4 * g + q4) * PR + (16 * d + 4 * p4) * 2;
                const s16x4 k0 = vtr(kp), k1 = vtr(kp + 16 * PR); const bf16x8 af = {k0[0], k0[1], k0[2], k0[3], k1[0], k1[1], k1[2], k1[3]};
                acc = __builtin_amdgcn_mfma_f32_16x16x32_bf16(af, vp[s], acc, 0, 0, 0); }
            S[d] = acc;
        }
    };
    auto flush = [&](int nc) {
        const int row = tx >> 3, c = tx & 7; const size_t t0 = (size_t)b * 8192 + nc * 64;
        const u32x4 v0 = *(const LAS u32x4*)(lds + S_OBUF + row * PR + c * 16), v1 = *(const LAS u32x4*)(lds + S_OBUF + row * PR + (c + 8) * 16);
        bf16_t* op = A.O + (t0 + row) * 1024 + h * 128; *(u32x4*)(op + c * 8) = v0; *(u32x4*)(op + (c + 8) * 8) = v1; };
    issue(pfA, 0); issue(pfB, 1); commit(pfA); __syncthreads();
#define LBAR() asm volatile("s_waitcnt lgkmcnt(0)\n\ts_barrier" ::: "memory")
    for (int nc = 0; nc < 128; nc += 2) {
        issue(pfA, nc + 2); compute(nc);
        LBAR(); flush(nc); commit(pfB); LBAR();
        issue(pfB, nc + 3); compute(nc + 1);
        LBAR(); flush(nc + 1); commit(pfA); LBAR();
    }
#undef LBAR
    __syncthreads();
}
__device__ __forceinline__ void scan_phase(const ScanArgs& A, LAS unsigned char* lds, int bx, int G) { for (int bh = bx; bh < 16; bh += G) scan_bh(A, lds, bh); }
}
namespace peer {
typedef __bf16 bf16x2_t __attribute__((ext_vector_type(2)));
__device__ __forceinline__ float dppf(float v, const int ctrl_unused) { return v; }
#define DPP_ADD(v, CTRL, RMASK) v += __builtin_bit_cast(float, __builtin_amdgcn_update_dpp(0, __builtin_bit_cast(int, v), CTRL, RMASK, 0xF, false))
__device__ __forceinline__ float wave_sum_u(float v) {
    DPP_ADD(v, 0xB1, 0xF); DPP_ADD(v, 0x4E, 0xF); DPP_ADD(v, 0x141, 0xF); DPP_ADD(v, 0x140, 0xF);
    DPP_ADD(v, 0x142, 0xA); DPP_ADD(v, 0x143, 0xC);
    return __builtin_bit_cast(float, __builtin_amdgcn_readlane(__builtin_bit_cast(int, v), 63));
}
__device__ __forceinline__ float dot2bf(unsigned a, unsigned b, float c) { return __builtin_amdgcn_fdot2_f32_bf16(__builtin_bit_cast(bf16x2_t, a), __builtin_bit_cast(bf16x2_t, b), c, false); }
__device__ __forceinline__ float dot16(const u32x4& a0, const u32x4& a1, const u32x4& h0, const u32x4& h1) {
    float s = 0.f;
#pragma unroll
    for (int i = 0; i < 4; ++i) { const unsigned x0 = a0[i], y0 = h0[i], x1 = a1[i], y1 = h1[i]; s = dot2bf(x0, y0, s); s = dot2bf(x1, y1, s); }
    return s;
}
__device__ __forceinline__ void axpy16(float (&acc)[16], float a, const u32x4& v0, const u32x4& v1) {
#pragma unroll
    for (int i = 0; i < 4; ++i) { acc[2 * i] = fmaf(a, __builtin_bit_cast(float, v0[i] << 16), acc[2 * i]); acc[2 * i + 1] = fmaf(a, __builtin_bit_cast(float, v0[i] & 0xffff0000u), acc[2 * i + 1]);
        acc[8 + 2 * i] = fmaf(a, __builtin_bit_cast(float, v1[i] << 16), acc[8 + 2 * i]); acc[8 + 2 * i + 1] = fmaf(a, __builtin_bit_cast(float, v1[i] & 0xffff0000u), acc[8 + 2 * i + 1]); }
}
constexpr float SU_ = 512.f, SV_ = 64.f;
__device__ __forceinline__ unsigned pk4fp8(f32x4 v, float s) { int p = __builtin_amdgcn_cvt_pk_fp8_f32(v[0] * s, v[1] * s, 0, false); p = __builtin_amdgcn_cvt_pk_fp8_f32(v[2] * s, v[3] * s, p, true); return (unsigned)p; }
__device__ __forceinline__ void convert_tables(const float* u, const float* v, unsigned char* ub, unsigned char* vb, int gt, int NGT) {
    for (int i = gt; i < 16384 * 1024 / 16; i += NGT) {
        const f32x4* us = (const f32x4*)u + 4 * (size_t)i; const f32x4* vs = (const f32x4*)v + 4 * (size_t)i;
        u32x4 o; o.x = pk4fp8(us[0], SU_); o.y = pk4fp8(us[1], SU_); o.z = pk4fp8(us[2], SU_); o.w = pk4fp8(us[3], SU_); ((u32x4*)ub)[i] = o;
        o.x = pk4fp8(vs[0], SV_); o.y = pk4fp8(vs[1], SV_); o.z = pk4fp8(vs[2], SV_); o.w = pk4fp8(vs[3], SV_); ((u32x4*)vb)[i] = o; }
}
struct PeerArgs { const unsigned char* Ub; const unsigned char* Vb; const bf16_t* H2; const float* X1; const float* MOD; const float* S; const float* fnw; float* out; };
__device__ __forceinline__ void route_token(const float* Srow, int lane, int& e_lo, int& e_hi, float& g_lo, float& g_hi);
__device__ __forceinline__ void expert_token(const PeerArgs& A, int t, int lane) {
    const int b = t >> 13;
    const u32x4 h0 = *(const u32x4*)(A.H2 + (size_t)t * 1024 + 16 * lane), h1 = *(const u32x4*)(A.H2 + (size_t)t * 1024 + 16 * lane + 8);
    int e_lo, e_hi; float g_lo, g_hi; route_token(A.S + (size_t)(t & 8191) * 2048, lane, e_lo, e_hi, g_lo, g_hi);
    f32x2h_t acc2[8], hf2[8];
#pragma unroll
    for (int i = 0; i < 4; ++i) { const unsigned a = h0[i], b2 = h1[i]; hf2[i] = (f32x2h_t){__builtin_bit_cast(float, a << 16), __builtin_bit_cast(float, a & 0xffff0000u)};
        hf2[4 + i] = (f32x2h_t){__builtin_bit_cast(float, b2 << 16), __builtin_bit_cast(float, b2 & 0xffff0000u)}; }
#pragma unroll
    for (int i = 0; i < 8; ++i) acc2[i] = (f32x2h_t){0.f, 0.f};
    for (int s0 = 0; s0 < 128; s0 += 4) {
        int e[4]; float gt[4]; u32x4 uu[4], vv[4];
#pragma unroll
        for (int q = 0; q < 4; ++q) { const int s = s0 + q;
            e[q] = (s0 < 64) ? __builtin_amdgcn_readlane(e_lo, s & 63) : __builtin_amdgcn_readlane(e_hi, s & 63);
            gt[q] = __builtin_bit_cast(float, (s0 < 64) ? __builtin_amdgcn_readlane(__builtin_bit_cast(int, g_lo), s & 63) : __builtin_amdgcn_readlane(__builtin_bit_cast(int, g_hi), s & 63));
            uu[q] = *(const u32x4*)(A.Ub + (size_t)e[q] * 1024 + 16 * lane); vv[q] = *(const u32x4*)(A.Vb + (size_t)e[q] * 1024 + 16 * lane); }
        float d[4];
#pragma unroll
        for (int q = 0; q < 4; ++q) { f32x2h_t s2 = {0.f, 0.f};
#pragma unroll
            for (int i = 0; i < 4; ++i) { const int w = (int)uu[q][i]; const f32x2h_t lo = __builtin_amdgcn_cvt_pk_f32_fp8(w, false), hi = __builtin_amdgcn_cvt_pk_f32_fp8(w, true);
                s2 = __builtin_elementwise_fma(lo, hf2[2 * i], s2); s2 = __builtin_elementwise_fma(hi, hf2[2 * i + 1], s2); }
            d[q] = s2[0] + s2[1]; }
#pragma unroll
        for (int q = 0; q < 4; ++q) d[q] = wave_sum_u(d[q]) * (1.f / SU_);
#pragma unroll
        for (int q = 0; q < 4; ++q) { const float a = 0.5f * d[q] * (1.f + erff(d[q] * 0.70710678118654752f)) * gt[q] * (1.f / SV_); const f32x2h_t a2 = {a, a};
#pragma unroll
            for (int i = 0; i < 4; ++i) { const int w = (int)vv[q][i]; const f32x2h_t lo = __builtin_amdgcn_cvt_pk_f32_fp8(w, false), hi = __builtin_amdgcn_cvt_pk_f32_fp8(w, true);
                acc2[2 * i] = __builtin_elementwise_fma(a2, lo, acc2[2 * i]); acc2[2 * i + 1] = __builtin_elementwise_fma(a2, hi, acc2[2 * i + 1]); } }
    }
    float acc[16];
#pragma unroll
    for (int i = 0; i < 8; ++i) { acc[2 * i] = acc2[i][0]; acc[2 * i + 1] = acc2[i][1]; }
    const float* xr = A.X1 + (size_t)t * 1024 + 16 * lane; const float* g2 = A.MOD + (size_t)b * 6144 + 5120 + 16 * lane; const float* fw = A.fnw + 16 * lane;
    float x2[16]; float ss = 0.f;
#pragma unroll
    for (int i = 0; i < 4; ++i) { const f32x4 xv = *(const f32x4*)(xr + 4 * i), gv = *(const f32x4*)(g2 + 4 * i);
#pragma unroll
        for (int k = 0; k < 4; ++k) { const float y = xv[k] + gv[k] * acc[4 * i + k]; x2[4 * i + k] = y; ss += y * y; } }
    ss = wave_sum_u(ss);
    const float rstd = 1.f / sqrtf(ss * (1.f / 1024.f) + 1e-6f);
    float* orow = A.out + (size_t)t * 1024 + 16 * lane;
#pragma unroll
    for (int i = 0; i < 4; ++i) { const f32x4 wv = *(const f32x4*)(fw + 4 * i); f32x4 o; o[0] = x2[4 * i] * rstd * wv[0]; o[1] = x2[4 * i + 1] * rstd * wv[1]; o[2] = x2[4 * i + 2] * rstd * wv[2]; o[3] = x2[4 * i + 3] * rstd * wv[3];
        *(f32x4*)(orow + 4 * i) = o; }
}
__device__ __forceinline__ void expert_phase(const PeerArgs& A, int half, int bx, int G) {
    int tx = threadIdx.x; asm volatile("" : "+v"(tx));
    const int wave = __builtin_amdgcn_readfirstlane(tx >> 6), lane = tx & 63;
    for (int t = wave * G + bx; t < 8192; t += 8 * G) expert_token(A, half * 8192 + t, lane);
}
}
namespace peer {
__device__ __forceinline__ unsigned sortable(float f) { const unsigned u = __builtin_bit_cast(unsigned, f); return (u & 0x80000000u) ? ~u : (u | 0x80000000u); }
#define DPP_UMAX(v, CTRL) { const unsigned t_ = (unsigned)__builtin_amdgcn_update_dpp(0, (int)(v), CTRL, 0xF, 0xF, false); v = (v) > t_ ? (v) : t_; }
#define DPP_FMAX(v, CTRL) { const float t_ = __builtin_bit_cast(float, __builtin_amdgcn_update_dpp(0, __builtin_bit_cast(int, v), CTRL, 0xF, 0xF, false)); v = fmaxf(v, t_); }
#define CE_(a, b) { const unsigned hi_ = (a) > (b) ? (a) : (b), lo_ = (a) > (b) ? (b) : (a); a = hi_; b = lo_; }
__device__ __forceinline__ void route_token(const float* Srow, int lane, int& e_lo, int& e_hi, float& g_lo, float& g_hi) {
    const int r = lane >> 4, i = lane & 15;
    int ic, jc; { const int c = lane; ic = (c < 16) ? 0 : (c < 24) ? 1 : (c < 29) ? 2 : (c < 33) ? 3 : (c < 36) ? 4 : (c < 38) ? 5 : (c < 40) ? 6 : (c < 42) ? 7 : (c - 34);
        const int st = (ic == 0) ? 0 : (ic == 1) ? 16 : (ic == 2) ? 24 : (ic == 3) ? 29 : (ic == 4) ? 33 : (ic == 5) ? 36 : (ic == 6) ? 38 : (ic == 7) ? 40 : (c); jc = c - st; if (ic > 15) { ic = 15; jc = 0; } }
    const int flat = ic * 16 + jc; const bool cvalid = lane < 50;
    e_lo = 0; e_hi = 0; g_lo = 0.f; g_hi = 0.f;
#pragma unroll 1
    for (int k = 0; k < 4; ++k) {
        const float* lp = Srow + (4 * k + r) * 128;
        const f32x4 va = *(const f32x4*)(lp + 8 * i), vb = *(const f32x4*)(lp + 8 * i + 4);
        unsigned k0 = (sortable(va[0]) & 0xFFFFFF80u) | (unsigned)(127 - (8 * i + 0)), k1 = (sortable(va[1]) & 0xFFFFFF80u) | (unsigned)(127 - (8 * i + 1)),
                 k2 = (sortable(va[2]) & 0xFFFFFF80u) | (unsigned)(127 - (8 * i + 2)), k3 = (sortable(va[3]) & 0xFFFFFF80u) | (unsigned)(127 - (8 * i + 3)),
                 k4 = (sortable(vb[0]) & 0xFFFFFF80u) | (unsigned)(127 - (8 * i + 4)), k5 = (sortable(vb[1]) & 0xFFFFFF80u) | (unsigned)(127 - (8 * i + 5)),
                 k6 = (sortable(vb[2]) & 0xFFFFFF80u) | (unsigned)(127 - (8 * i + 6)), k7 = (sortable(vb[3]) & 0xFFFFFF80u) | (unsigned)(127 - (8 * i + 7));
        CE_(k0, k1) CE_(k2, k3) CE_(k4, k5) CE_(k6, k7)  CE_(k0, k2) CE_(k1, k3) CE_(k4, k6) CE_(k5, k7)  CE_(k1, k2) CE_(k5, k6)
        CE_(k0, k4) CE_(k1, k5) CE_(k2, k6) CE_(k3, k7)  CE_(k2, k4) CE_(k3, k5)  CE_(k1, k2) CE_(k3, k4) CE_(k5, k6)
        unsigned sel = 0u;
#pragma unroll
        for (int it = 0; it < 16; ++it) { unsigned M = k0; DPP_UMAX(M, 0x128) DPP_UMAX(M, 0x124) DPP_UMAX(M, 0x122) DPP_UMAX(M, 0x121)
            sel = (i == it) ? M : sel; const bool own = (k0 == M);
            k0 = own ? k1 : k0; k1 = own ? k2 : k1; k2 = own ? k3 : k2; k3 = own ? k4 : k3; k4 = own ? k5 : k4; k5 = own ? k6 : k5; k6 = own ? k7 : k6; k7 = own ? 0u : k7; }
        const int sidx = 127 - (int)(sel & 127u); const float sval = lp[sidx];
#pragma unroll
        for (int hh = 0; hh < 2; ++hh) {
            const int h = 2 * k + hh, l0 = 32 * hh, l1 = 32 * hh + 16;
            const float ca = __shfl(sval, l0 + ic), cb = __shfl(sval, l1 + jc); const float cs = ca + cb;
            unsigned key = cvalid ? ((sortable(cs) & 0xFFFFFF00u) | (unsigned)(255 - flat)) : 0u; unsigned top = 0u;
#pragma unroll
            for (int it = 0; it < 16; ++it) { unsigned M = key; DPP_UMAX(M, 0x128) DPP_UMAX(M, 0x124) DPP_UMAX(M, 0x122) DPP_UMAX(M, 0x121)
                const unsigned m0 = (unsigned)__builtin_amdgcn_readlane((int)M, 0), m1 = (unsigned)__builtin_amdgcn_readlane((int)M, 16), m2 = (unsigned)__builtin_amdgcn_readlane((int)M, 32), m3 = (unsigned)__builtin_amdgcn_readlane((int)M, 48);
                const unsigned ma = m0 > m1 ? m0 : m1, mb = m2 > m3 ? m2 : m3, mm = ma > mb ? ma : mb;
                top = (lane == it) ? mm : top; key = (key == mm) ? 0u : key; }
            const int fl = 255 - (int)(top & 255u), ti = fl >> 4, tj = fl & 15;
            const float tv = __shfl(sval, l0 + ti) + __shfl(sval, l1 + tj);
            const int ex = __shfl(sidx, l0 + ti) * 128 + __shfl(sidx, l1 + tj);
            float mx = tv; DPP_FMAX(mx, 0x128) DPP_FMAX(mx, 0x124) DPP_FMAX(mx, 0x122) DPP_FMAX(mx, 0x121)
            float p = __expf(tv - mx), ps = p; DPP_ADD(ps, 0x128, 0xF); DPP_ADD(ps, 0x124, 0xF); DPP_ADD(ps, 0x122, 0xF); DPP_ADD(ps, 0x121, 0xF);
            const float gate = p / ps;
            const int ex_m = __shfl(ex, i); const float g_m = __shfl(gate, i);
            if (r == (h & 3)) { if (h < 4) { e_lo = ex_m; g_lo = g_m; } else { e_hi = ex_m; g_hi = g_m; } }
        }
    }
}
}
namespace ew {
using peer::wave_sum_u;
__device__ __forceinline__ void mod_phase(const float* c, const float* w_ada, const float* b_ada, float* MOD, LAS unsigned char* lds, int bx, int G) {
    int tx = threadIdx.x; asm volatile("" : "+v"(tx));
    LAS float* red = (LAS float*)lds;
    for (int it = bx; it < 192; it += G) {
        const int col = tx & 31, kg = tx >> 5, j = it * 32 + col; float a0 = 0.f, a1 = 0.f, b0 = 0.f, b1 = 0.f;
#pragma unroll 4
        for (int k = kg * 64; k < kg * 64 + 64; k += 2) { const float w0 = w_ada[(size_t)k * 6144 + j], w1 = w_ada[(size_t)(k + 1) * 6144 + j]; const float c00 = c[k], c01 = c[k + 1], c10 = c[1024 + k], c11 = c[1024 + k + 1];
            a0 = fmaf(c00 / (1.f + __expf(-c00)), w0, a0); b0 = fmaf(c01 / (1.f + __expf(-c01)), w1, b0); a1 = fmaf(c10 / (1.f + __expf(-c10)), w0, a1); b1 = fmaf(c11 / (1.f + __expf(-c11)), w1, b1); }
        red[(kg * 2 + 0) * 32 + col] = a0 + b0; red[(kg * 2 + 1) * 32 + col] = a1 + b1;
        __syncthreads();
        if (tx < 64) { const int bb = tx >> 5; float s = b_ada[j];
#pragma unroll
            for (int q = 0; q < 16; ++q) s += red[(q * 2 + bb) * 32 + col];
            MOD[(size_t)bb * 6144 + j] = s; }
        __syncthreads();
    }
}
__device__ __forceinline__ void modnorm_phase(const float* X, const float* nw, const float* MOD, int which, bf16_t* H, int gw, int NGW, int lane) {
    for (int t = gw; t < 16384; t += NGW) {
        const int b = t >> 13; const float* xr = X + (size_t)t * 1024 + 16 * lane; const float* sh = MOD + (size_t)b * 6144 + (which ? 3072 : 0) + 16 * lane; const float* sc = sh + 1024; const float* wr = nw + 16 * lane;
        f32x4 v[4]; float ss = 0.f;
#pragma unroll
        for (int i = 0; i < 4; ++i) { v[i] = *(const f32x4*)(xr + 4 * i); ss += v[i][0] * v[i][0] + v[i][1] * v[i][1] + v[i][2] * v[i][2] + v[i][3] * v[i][3]; }
        ss = wave_sum_u(ss); const float rstd = 1.f / sqrtf(ss * (1.f / 1024.f) + 1e-6f);
        float y[16];
#pragma unroll
        for (int i = 0; i < 4; ++i) { const f32x4 w = *(const f32x4*)(wr + 4 * i), s1 = *(const f32x4*)(sc + 4 * i), s0 = *(const f32x4*)(sh + 4 * i);
#pragma unroll
            for (int k = 0; k < 4; ++k) y[4 * i + k] = v[i][k] * rstd * w[k] * (1.f + s1[k]) + s0[k]; }
        u32x4 o0, o1; o0.x = pk2bf(y[0], y[1]); o0.y = pk2bf(y[2], y[3]); o0.z = pk2bf(y[4], y[5]); o0.w = pk2bf(y[6], y[7]); o1.x = pk2bf(y[8], y[9]); o1.y = pk2bf(y[10], y[11]); o1.z = pk2bf(y[12], y[13]); o1.w = pk2bf(y[14], y[15]);
        *(u32x4*)(H + (size_t)t * 1024 + 16 * lane) = o0; *(u32x4*)(H + (size_t)t * 1024 + 16 * lane + 8) = o1;
    }
}
struct SmallArgs { const bf16_t* RAW; const float *qw, *kvw, *kiw, *a_log, *dt_bias; bf16_t *QLATN, *CKVN, *KIDXN; float *BETA, *G, *WIDX; };
__device__ __forceinline__ void small_phase(const SmallArgs& A, int gw, int NGW, int lane) {
    for (int t = gw; t < 16384; t += NGW) {
        const bf16_t* r = A.RAW + (size_t)t * 768;
        const uint2 qp = *(const uint2*)(r + 4 * lane), kp = *(const uint2*)(r + 256 + 4 * lane);
        const float q0 = __builtin_bit_cast(float, qp.x << 16), q1 = __builtin_bit_cast(float, qp.x & 0xffff0000u), q2 = __builtin_bit_cast(float, qp.y << 16), q3 = __builtin_bit_cast(float, qp.y & 0xffff0000u);
        const float k0 = __builtin_bit_cast(float, kp.x << 16), k1 = __builtin_bit_cast(float, kp.x & 0xffff0000u), k2 = __builtin_bit_cast(float, kp.y << 16), k3 = __builtin_bit_cast(float, kp.y & 0xffff0000u);
        const float ki = bf2f(r[512 + lane]);
        const float sq = wave_sum_u(q0 * q0 + q1 * q1 + q2 * q2 + q3 * q3), skv = wave_sum_u(k0 * k0 + k1 * k1 + k2 * k2 + k3 * k3), ski = wave_sum_u(ki * ki);
        const float rq = 1.f / sqrtf(sq * (1.f / 256.f) + 1e-6f), rkv = 1.f / sqrtf(skv * (1.f / 256.f) + 1e-6f), rki = 1.f / sqrtf(ski * (1.f / 64.f) + 1e-6f);
        const f32x4 wq = *(const f32x4*)(A.qw + 4 * lane), wkv = *(const f32x4*)(A.kvw + 4 * lane);
        *(uint2*)(A.QLATN + (size_t)t * 256 + 4 * lane) = make_uint2(pk2bf(q0 * rq * wq[0], q1 * rq * wq[1]), pk2bf(q2 * rq * wq[2], q3 * rq * wq[3]));
        *(uint2*)(A.CKVN + (size_t)t * 256 + 4 * lane) = make_uint2(pk2bf(k0 * rkv * wkv[0], k1 * rkv * wkv[1]), pk2bf(k2 * rkv * wkv[2], k3 * rkv * wkv[3]));
        A.KIDXN[(size_t)t * 64 + lane] = f2bfd(ki * rki * A.kiw[lane]);
        if (lane < 8) { const float be = bf2f(r[576 + lane]), de = bf2f(r[584 + lane]), wi = bf2f(r[592 + lane]);
            A.BETA[(size_t)t * 8 + lane] = 1.f / (1.f + __expf(-be));
            const float xs = de + A.dt_bias[lane]; A.G[(size_t)t * 8 + lane] = -__expf(A.a_log[lane]) * (xs > 20.f ? xs : log1pf(__expf(xs)));
            A.WIDX[(size_t)t * 8 + lane] = wi * 0.04419417382415922f; }
    }
}
__device__ __forceinline__ void ogate_phase(const bf16_t* O, const bf16_t* Z, const float* ow, bf16_t* OG, int gw, int NGW, int lane) {
    for (int t = gw; t < 16384; t += NGW) {
        const u32x4 o0 = *(const u32x4*)(O + (size_t)t * 1024 + 16 * lane), o1 = *(const u32x4*)(O + (size_t)t * 1024 + 16 * lane + 8);
        const u32x4 z0 = *(const u32x4*)(Z + (size_t)t * 1024 + 16 * lane), z1 = *(const u32x4*)(Z + (size_t)t * 1024 + 16 * lane + 8);
        float ov[16], zv[16]; float ss = 0.f;
#pragma unroll
        for (int i = 0; i < 4; ++i) { const unsigned a = o0[i], b = o1[i], c = z0[i], d = z1[i];
            ov[2 * i] = __builtin_bit_cast(float, a << 16); ov[2 * i + 1] = __builtin_bit_cast(float, a & 0xffff0000u); ov[8 + 2 * i] = __builtin_bit_cast(float, b << 16); ov[8 + 2 * i + 1] = __builtin_bit_cast(float, b & 0xffff0000u);
            zv[2 * i] = __builtin_bit_cast(float, c << 16); zv[2 * i + 1] = __builtin_bit_cast(float, c & 0xffff0000u); zv[8 + 2 * i] = __builtin_bit_cast(float, d << 16); zv[8 + 2 * i + 1] = __builtin_bit_cast(float, d & 0xffff0000u); }
#pragma unroll
        for (int i = 0; i < 16; ++i) ss += ov[i] * ov[i];
        DPP_ADD(ss, 0xB1, 0xF); DPP_ADD(ss, 0x4E, 0xF); DPP_ADD(ss, 0x141, 0xF);
        const float rs = 1.f / sqrtf(ss * (1.f / 128.f) + 1e-6f); const float* w = ow + 16 * (lane & 7);
        float y[16];
#pragma unroll
        for (int i = 0; i < 16; ++i) y[i] = ov[i] * rs * w[i] * (zv[i] / (1.f + __expf(-zv[i])));
        u32x4 r0, r1; r0.x = pk2bf(y[0], y[1]); r0.y = pk2bf(y[2], y[3]); r0.z = pk2bf(y[4], y[5]); r0.w = pk2bf(y[6], y[7]); r1.x = pk2bf(y[8], y[9]); r1.y = pk2bf(y[10], y[11]); r1.z = pk2bf(y[12], y[13]); r1.w = pk2bf(y[14], y[15]);
        *(u32x4*)(OG + (size_t)t * 1024 + 16 * lane) = r0; *(u32x4*)(OG + (size_t)t * 1024 + 16 * lane + 8) = r1;
    }
}
}
constexpr int NTHR = 512;
constexpr int LDS_BYTES = 155648;
constexpr size_t CTL_ZERO_BYTES = 32768;
struct MArgs { NP P; NP P2; OP Q; unsigned* ctl; };

typedef const __attribute__((address_space(4))) MArgs* KAP;
typedef const __attribute__((address_space(4))) unsigned long long* KW;
#define KA(ka) KAP ka = (KAP)__builtin_amdgcn_kernarg_segment_ptr(); asm volatile("" : "+s"(ka))
template <class TT, class SS> __device__ __forceinline__ void ka_copy(TT& dst, SS src) { static_assert(sizeof(TT) % 8 == 0, "8-byte words");
    void** d = (void**)&dst; KW s = (KW)src;
#pragma unroll
    for (int i = 0; i < (int)(sizeof(TT) / 8); ++i) d[i] = (void*)(__attribute__((address_space(1))) void*)s[i]; }
#define LOADP(P, ka) NP P; ka_copy(P, &ka->P)
#define LOADQ(Q, ka) OP Q; ka_copy(Q, &ka->Q)
__global__ void __launch_bounds__(NTHR, 2) mega(MArgs a_unused) {
    typedef CfgFull C; typedef WsMap<C> W;
    extern __shared__ __attribute__((aligned(16))) unsigned char lds_raw[];
    LAS unsigned char* lds = (LAS unsigned char*)lds_raw;
    volatile LAS unsigned* MISC = (volatile LAS unsigned*)(lds + LDS_BYTES - 256);
    if (threadIdx.x < 64) MISC[threadIdx.x] = 0u;
    __syncthreads();
    XcdBarrier bar; { KA(ka); bar = xcd_barrier_post((unsigned*)(__attribute__((address_space(1))) unsigned*)(unsigned long long)ka->ctl, MISC + 8); }
    const int G = gridDim.x, NTall = G * NTHR, bx = blockIdx.x;
#define TIDS() int tx_ = threadIdx.x; asm volatile("" : "+v"(tx_)); const int wave = __builtin_amdgcn_readfirstlane(tx_ >> 6), lane = tx_ & 63; \
        const int tid = (wave * G + bx) * 64 + lane;
#define NAIVE_(WHICH, st) do { KA(ka_); NP PP_; ka_copy(PP_, &ka_->WHICH); TIDS(); const long n_ = stage_items<C>(st); const int words_ = stage_scr_words<C>(st); \
        int nt_ = NTall; if (words_) { const long cap_ = (long)(W::SCR_BYTES / (4 * (size_t)words_)); if (cap_ < nt_) nt_ = (int)cap_; } \
        if (tid < nt_) for (long it_ = tid; it_ < n_; it_ += nt_) run_item<C>(PP_, st, it_, tid, nt_); } while (0)
#define NAIVE(st) NAIVE_(P, st)
#define BAR() xcd_barrier(bar)
    { KA(ka); LOADP(P, ka); ew::mod_phase(P.c, P.w_ada, P.b_ada, P.MOD, lds, bx, G); }
    { KA(ka); LOADP(P, ka); LOADQ(Q, ka); TIDS(); (void)tid; p0_weights(P, Q, lds, bx * 8 + wave, G * 8, bx * NTHR + tx_, NTall, wave, lane); }
    BAR();
    { KA(ka); LOADP(P, ka); TIDS(); (void)tid; ew::modnorm_phase(P.x, P.norm1_w, P.MOD, 0, P.H1, bx * 8 + wave, G * 8, lane); }
    { KA(ka); LOADQ(Q, ka); const int c0 = bx < 40 ? bx : -1; WSched S0{0, c0, Q.wuk, Q.wuq, Q.wbT, Q.wuv, Q.skb, Q.pwq}; EpiG<FWeights> E{FWeights{Q.WcombT, Q.WcatT, Q.WsT}};
      pg8::gemm_phase<EpiG<FWeights>, WSched, false, true>(lds, pg8::Gemm{1024, 1024, 128}, S0, E);
      const int c1 = (bx >= 40 && bx < 72) ? bx - 40 : -1; WSched S1{1, c1, Q.wuk, Q.wuq, Q.wbT, Q.wuv, Q.skb, Q.pwq};
      pg8::gemm_phase<EpiG<FWeights>, WSched, false, true>(lds, pg8::Gemm{256, 2048, 256}, S1, E); }
    BAR();
    { KA(ka); LOADP(P, ka); LOADQ(Q, ka); GridSched S; S.init(64, 15, G, bx, P.H1, (size_t)256 * 1024 * 2, Q.WinT, (size_t)256 * 1024 * 2); EpiG<FInprojA> E{FInprojA{P.QKVP, Q.RAWB}};
      pg8::gemm_phase<EpiG<FInprojA>, GridSched, true, true>(lds, pg8::Gemm{1024, 1024, 1024}, S, E); }
    BAR();
    { KA(ka); LOADP(P, ka); LOADQ(Q, ka); TIDS(); (void)tid; ew::SmallArgs SA{Q.RAWB, P.q_norm_w, P.kv_norm_w, P.idx_k_norm_w, P.dn_a_log, P.dn_dt_bias, P.QLATN, P.CKVN, P.KIDXN, P.BETA, P.G, P.WIDX}; ew::small_phase(SA, bx * 8 + wave, G * 8, lane); }
    { KA(ka); LOADP(P, ka); TIDS(); (void)tid; dnet::conv_phase(P.QKVP, P.QKVN, P.dn_conv_w, bx * 8 + wave, G * 8, lane); }
    BAR();
    { KA(ka); LOADP(P, ka); dnet::PrepArgs PA{P.QKVN, P.BETA, P.G, P.W, P.ATT, P.GL}; dnet::prep_phase(PA, lds, bx, G); }
    { KA(ka); LOADP(P, ka); LOADQ(Q, ka); GridSched S; S.init(64, 8, G, bx, P.QLATN, (size_t)256 * 256 * 2, Q.WcombT, (size_t)256 * 256 * 2); EpiG<FStoreBf16> E{FStoreBf16{Q.QA0, 2048, Q.QA1, sattn::QSPLIT / 256}};
      pg8::gemm_phase<EpiG<FStoreBf16>, GridSched, false, true>(lds, pg8::Gemm{256, 256, 256}, S, E); }
    BAR();
    { KA(ka); LOADP(P, ka); dnet::ScanArgs SA{P.QKVN, P.W, P.ATT, P.GL, P.O}; dnet::scan_phase(SA, lds, bx, G); }
    { KA(ka); LOADP(P, ka); LOADQ(Q, ka); dsa::DArgs DA{idxk::IdxArgs{P.QLATN, P.KIDXN, P.WIDX, Q.WiqT, nullptr}, sattn::AArgs{P.CKVN, Q.QA0, Q.QA1}, Q.qword};
      dsa::dsa_queue(DA, lds, MISC + 16); }
    BAR();
    { KA(ka); LOADP(P, ka); LOADQ(Q, ka); GridSched S; S.init(64, 12, G, bx, P.H1, (size_t)256 * 1024 * 2, Q.WinT + (size_t)3840 * 1024, (size_t)256 * 1024 * 2); EpiG<FInprojB> E{FInprojB{P.Z, P.GA, P.GB}};
      pg8::gemm_phase<EpiG<FInprojB>, GridSched, true, true>(lds, pg8::Gemm{1024, 1024, 1024}, S, E); }
    BAR();
    { KA(ka); LOADP(P, ka); TIDS(); (void)tid; ew::ogate_phase(P.O, P.Z, P.dn_onorm_w, P.OG, bx * 8 + wave, G * 8, lane); }
    BAR();
    { KA(ka); LOADP(P, ka); LOADQ(Q, ka); GridSched S; S.init(64, 4, G, bx, P.OG, (size_t)256 * 1024 * 2, Q.WcatT, (size_t)256 * 3072 * 2); EpiG<FMerge<0>> E{FMerge<0>{P.GA, P.M}};
      pg8::gemm_phase<EpiG<FMerge<0>>, GridSched, false, true>(lds, pg8::Gemm{1024, 3072, 1024}, S, E); }
    { KA(ka); LOADP(P, ka); LOADQ(Q, ka); GridSched S; S.init(64, 4, G, bx, Q.QA0, (size_t)256 * 2048 * 2, Q.WcatT + 1024, (size_t)256 * 3072 * 2); S.A2 = (const char*)Q.QA1; S.splitA = sattn::QSPLIT / 256; EpiG<FMerge<1>> E{FMerge<1>{P.GB, P.M}};
      pg8::gemm_phase<EpiG<FMerge<1>>, GridSched, false, true>(lds, pg8::Gemm{2048, 3072, 2048}, S, E); }
    BAR();
    { KA(ka); LOADP(P, ka); LOADQ(Q, ka); GridSched S; S.init(64, 4, G, bx, P.M, (size_t)256 * 1024 * 2, Q.WoT, (size_t)256 * 1024 * 2); EpiG<FWo> E{FWo{P.MOD, P.x, P.X1}};
      pg8::gemm_phase<EpiG<FWo>, GridSched, false, true>(lds, pg8::Gemm{1024, 1024, 1024}, S, E); }
    BAR();
    { KA(ka); LOADP(P, ka); LOADQ(Q, ka); TIDS(); (void)tid; ew::modnorm_phase(P.X1, P.norm2_w, P.MOD, 1, P.H2, bx * 8 + wave, G * 8, lane);
      peer::convert_tables(P.peer_u, P.peer_v, Q.Ub, Q.Vb, bx * NTHR + tx_, NTall); }
    BAR();
#pragma unroll 1
    for (int half = 0; half < 2; ++half) {
        { KA(ka); LOADP(P, ka); LOADQ(Q, ka); GridSched S; S.init(32, 8, G, bx, P.H2 + (size_t)half * 8192 * 1024, (size_t)256 * 1024 * 2, Q.WsT, (size_t)256 * 1024 * 2); EpiG<FStoreF32> E{FStoreF32{Q.S, 2048}};
          pg8::gemm_phase<EpiG<FStoreF32>, GridSched, true, true>(lds, pg8::Gemm{1024, 1024, 1024}, S, E); }
        BAR();
        { KA(ka); LOADP(P, ka); LOADQ(Q, ka); peer::PeerArgs EA{Q.Ub, Q.Vb, P.H2, P.X1, P.MOD, Q.S, P.final_norm_w, P.out}; peer::expert_phase(EA, half, bx, G); }
        if (half == 0) BAR();
    }
#undef NAIVE
#undef NAIVE_
#undef BAR
}
extern "C" void kernel_launch(void* const* d_in, const int* in_sizes, int n_in, void* d_out, int out_size, void* d_ws, size_t ws_size, hipStream_t stream) {
    typedef CfgFull C; typedef WsMap<C> W;
    static int grid = 0;
    if (grid == 0) {
        if (n_in != 26 || ws_size < X_END) { fprintf(stderr, "kernel_launch: need 26 inputs and %zu bytes of workspace, got %d / %zu\n", (size_t)X_END, n_in, ws_size); grid = -1; return; }
        int dev = 0, cus = 0, per_cu = 0;
        if (hipGetDevice(&dev) != hipSuccess || hipDeviceGetAttribute(&cus, hipDeviceAttributeMultiprocessorCount, dev) != hipSuccess) { grid = -1; return; }
        if (hipFuncSetAttribute((const void*)mega, hipFuncAttributeMaxDynamicSharedMemorySize, LDS_BYTES) != hipSuccess) { fprintf(stderr, "kernel_launch: hipFuncSetAttribute failed\n"); grid = -1; return; }
        if (hipOccupancyMaxActiveBlocksPerMultiprocessor(&per_cu, (const void*)mega, NTHR, LDS_BYTES) != hipSuccess || per_cu < 1) { fprintf(stderr, "kernel_launch: occupancy query says %d\n", per_cu); }
        (void)hipGetLastError();
        grid = cus;
    }
    if (grid < 0) return;
    hipMemsetAsync(d_ws, 0, CTL_ZERO_BYTES, stream);
    MArgs a{}; np_setup<C>(a.P, d_in, d_out, d_ws);
    char* ws = (char*)d_ws;
    a.Q.WinT = (bf16_t*)(ws + X_WINT); a.Q.WcatT = (bf16_t*)(ws + X_WCAT); a.Q.WoT = (bf16_t*)(ws + X_WOT); a.Q.WsT = (bf16_t*)(ws + X_WST); a.Q.WcombT = (bf16_t*)(ws + X_WCOMB); a.Q.WiqT = (bf16_t*)(ws + X_WIQT);
    a.Q.wuk = (bf16_t*)(ws + X_WUK); a.Q.wuq = (bf16_t*)(ws + X_WUQ); a.Q.wbT = (bf16_t*)(ws + X_WBT); a.Q.wuv = (bf16_t*)(ws + X_WUV); a.Q.skb = (bf16_t*)(ws + X_SKB); a.Q.pwq = (bf16_t*)(ws + X_PWQ);
    a.Q.S = (float*)(ws + W::A0 + (size_t)64 * 1048576);
    a.Q.Ub = (unsigned char*)(ws + W::A0); a.Q.Vb = (unsigned char*)(ws + W::A0 + (size_t)16 * 1048576);
    a.Q.EXPI2 = (int*)(ws + X_EXPI); a.Q.GATE2 = (float*)(ws + X_GATE);
    a.P.ATT = (bf16_t*)(ws + W::A0); a.P.W = (bf16_t*)(ws + W::A0 + (size_t)16 * 1048576);
    a.Q.QA0 = (bf16_t*)(ws + W::A0 + (size_t)48 * 1048576); a.Q.QA1 = (bf16_t*)(ws + W::A3); a.Q.qword = (unsigned*)d_ws + 6144;
    a.P.Z = (bf16_t*)(ws + W::A1); a.P.GA = (bf16_t*)(ws + W::A1 + (size_t)32 * 1048576); a.P.GB = (bf16_t*)(ws + W::A1 + (size_t)64 * 1048576);
    a.Q.RAWB = (bf16_t*)((char*)d_out + (size_t)32 * 1048576);
    a.P2 = a.P; a.P2.EXPI = a.Q.EXPI2; a.P2.GATE = a.Q.GATE2; a.P2.SCRP = (float*)((char*)d_out + W::d_SCR); a.P2.S = a.Q.S; a.ctl = (unsigned*)d_ws;
    hipLaunchKernelGGL(mega, dim3(grid), dim3(NTHR), LDS_BYTES, stream, a);
}
```

```cpp
#include <hip/hip_runtime.h>
#include <cstdio>
#include <cstdint>
#define HD __host__ __device__ __forceinline__
#ifndef HD
#define HD
#endif

typedef unsigned short bf16_t;
HD float bf2f(bf16_t v) { unsigned u = ((unsigned)v) << 16; float f; __builtin_memcpy(&f, &u, 4); return f; }
HD bf16_t f2bf(float f) { unsigned u; __builtin_memcpy(&u, &f, 4); u = (u + 0x7fffu + ((u >> 16) & 1u)) >> 16; return (bf16_t)u; }
HD float siluf(float x) { return x / (1.f + expf(-x)); }
HD float sigmf(float x) { return 1.f / (1.f + expf(-x)); }
HD float softplusf(float x) { return x > 20.f ? x : log1pf(expf(x)); }
HD float geluf(float x) { return 0.5f * x * (1.f + erff(x * 0.70710678118654752f)); }

struct CfgFull {
    static constexpr int D = 1024, B = 2, L = 8192;
    static constexpr int DNH = 8, DK = 128, DV = 128, CONV = 4, CH = 64;
    static constexpr int MH = 8, MDH = 128, MDV = 128, QL = 256, KVL = 256;
    static constexpr int IH = 8, ID = 64, TOPK_MAX = 256;
    static constexpr int PK = 128, PH = 8, PDQ = 256, PTK = 16;
};
struct CfgSmall {
    static constexpr int D = 64, B = 2, L = 512;
    static constexpr int DNH = 2, DK = 16, DV = 16, CONV = 4, CH = 64;
    static constexpr int MH = 2, MDH = 16, MDV = 16, QL = 32, KVL = 32;
    static constexpr int IH = 4, ID = 16, TOPK_MAX = 64;
    static constexpr int PK = 16, PH = 2, PDQ = 32, PTK = 4;
};
template <class C> struct Dims {
    static constexpr int T = C::B * C::L, HK = C::DNH * C::DK, HV = C::DNH * C::DV, QKVC = 2 * HK + HV;
    static constexpr int NCH = C::L / C::CH, NCHUNKS = C::B * C::DNH * NCH;
    static constexpr int TOPK = (C::TOPK_MAX < C::L / 4) ? C::TOPK_MAX : C::L / 4;
    static constexpr int PE = C::PK * C::PK, SLOTS = C::PH * C::PTK, PD2 = C::PDQ / 2;
    static constexpr int OFF_Q = 0, OFF_K = HK, OFF_V = 2 * HK, OFF_Z = 2 * HK + HV, OFF_B = OFF_Z + HV, OFF_A = OFF_B + C::DNH,
                         OFF_QL = OFF_A + C::DNH, OFF_CKV = OFF_QL + C::QL, OFF_KI = OFF_CKV + C::KVL, OFF_WI = OFF_KI + C::ID,
                         OFF_GA = OFF_WI + C::IH, OFF_GB = OFF_GA + C::D, IN_COLS = OFF_GB + C::D;
    static constexpr float EPS = 1e-6f;
};

struct NP {
    const float *x, *c, *w_ada, *b_ada, *norm1_w, *w_in, *dn_conv_w, *dn_a_log, *dn_dt_bias, *dn_onorm_w, *q_norm_w, *kv_norm_w, *idx_k_norm_w,
        *w_uq, *w_iq, *w_uk, *w_uv, *w_a_out, *w_b_out, *w_o, *norm2_w, *peer_w_q, *peer_sub_keys, *peer_u, *peer_v, *final_norm_w;
    float* out;
    float* MOD; bf16_t* H1; bf16_t* QKVP; bf16_t* QKVN; bf16_t* Z; bf16_t* GA; bf16_t* GB;
    float *BETA, *G, *GC, *GL, *QLATR, *CKVR, *KIDXR, *WIDX; bf16_t *QLATN, *CKVN, *KIDXN;
    float* AMAT; bf16_t* ATT; bf16_t* W; bf16_t* O; bf16_t* OG;
    float *QF, *QIDX; bf16_t* QABS; int* IDX; bf16_t* OLAT; bf16_t* OATT; bf16_t* M; float* X1; bf16_t* H2;
    float* PQ; int* EXPI; float* GATE; float* ACT; float* S; float* RAW;
    float* SCRP;
};
#define SCR(w) P.SCRP[(size_t)(w) * NT + tid]

template <class C> struct WsMap {
    typedef Dims<C> Dm;
    static constexpr size_t al(size_t x) { return (x + 255) & ~(size_t)255; }
    static constexpr size_t mx(size_t a, size_t b) { return a > b ? a : b; }
    static constexpr size_t SZ_QKV = al((size_t)Dm::T * Dm::QKVC * 2);
    static constexpr size_t S1a = al(mx((size_t)Dm::T * C::MH * C::KVL * 2, (size_t)Dm::T * C::D * 4));
    static constexpr size_t S1b = al(mx(mx((size_t)Dm::T * Dm::TOPK * 4, (size_t)Dm::T * C::MH * C::MDV * 2), (size_t)Dm::T * C::D * 2));
    static constexpr size_t RAW = al((size_t)Dm::T * C::QL * 4) + al((size_t)Dm::T * C::KVL * 4) + al((size_t)Dm::T * C::ID * 4);
    static constexpr size_t SZ_A1 = mx(mx(SZ_QKV, RAW), S1a + S1b);
    static constexpr size_t SZ_AAW = al((size_t)Dm::NCHUNKS * C::CH * C::CH * 4) + al((size_t)Dm::NCHUNKS * C::CH * C::CH * 2) + al((size_t)Dm::NCHUNKS * C::CH * C::DK * 2);
    static constexpr size_t SZ_QQ = al((size_t)Dm::T * C::MH * C::MDH * 4) + al((size_t)Dm::T * C::IH * C::ID * 4);
    static constexpr size_t SZ_ZGG = al((size_t)Dm::T * Dm::HV * 2) + 2 * al((size_t)Dm::T * C::D * 2);
    static constexpr size_t SZ_A0 = mx(mx(SZ_QKV, SZ_AAW), mx(SZ_QQ, SZ_ZGG));
    static constexpr size_t A1 = 1 << 20, A0 = A1 + SZ_A1, A2 = A0 + SZ_A0;
    static constexpr size_t o_MOD = 65536, o_BETA = A2, o_G = o_BETA + al((size_t)Dm::T * C::DNH * 4), o_GC = o_G + al((size_t)Dm::T * C::DNH * 4),
        o_GL = o_GC + al((size_t)Dm::T * C::DNH * 4), o_WIDX = o_GL + al((size_t)Dm::NCHUNKS * 4), o_QLATN = o_WIDX + al((size_t)Dm::T * C::IH * 4),
        o_CKVN = o_QLATN + al((size_t)Dm::T * C::QL * 2), o_KIDXN = o_CKVN + al((size_t)Dm::T * C::KVL * 2), A3 = o_KIDXN + al((size_t)Dm::T * C::ID * 2);
    static constexpr size_t SCR_BYTES = 16u << 20;
    static constexpr size_t o_PQ = A0;
    static constexpr size_t END = mx(A3 + SCR_BYTES, o_PQ + al((size_t)Dm::T * C::PH * C::PDQ * 4));
    static_assert(o_MOD + (size_t)C::B * 6 * C::D * 4 <= A1, "MOD in the first MiB");
    static constexpr size_t o_QLATR = A1, o_CKVR = o_QLATR + al((size_t)Dm::T * C::QL * 4), o_KIDXR = o_CKVR + al((size_t)Dm::T * C::KVL * 4);
    static constexpr size_t o_AMAT = A0, o_ATT = o_AMAT + al((size_t)Dm::NCHUNKS * C::CH * C::CH * 4), o_W = o_ATT + al((size_t)Dm::NCHUNKS * C::CH * C::CH * 2);
    static constexpr size_t o_QF = A0, o_QIDX = o_QF + al((size_t)Dm::T * C::MH * C::MDH * 4);
    static constexpr size_t o_QABS = A1, o_IDX = A1 + S1a;
    static constexpr size_t o_Z = A0, o_GA = o_Z + al((size_t)Dm::T * Dm::HV * 2), o_GB = o_GA + al((size_t)Dm::T * C::D * 2);
    static constexpr size_t o_OATT = o_IDX, o_X1 = A1, o_H2 = o_IDX;
    static constexpr size_t d_H1 = 0, d_O = al((size_t)Dm::T * C::D * 2), d_OG = 0, d_M = d_O;
    static constexpr size_t d_EXPI = 0, d_GATE = al((size_t)Dm::T * Dm::SLOTS * 4), d_ACT = 2 * d_GATE, d_SCR = (size_t)Dm::T * C::D * 2;
    static_assert(d_O + (size_t)Dm::T * Dm::HV * 2 <= (size_t)Dm::T * C::D * 4 && d_ACT + (size_t)Dm::T * Dm::SLOTS * 4 <= d_SCR, "d_out scratch");
};

template <class C> inline void np_setup(NP& P, void* const* d_in, void* d_out, void* d_ws) {
    typedef WsMap<C> W;
    const float** f = (const float**)&P.x;
    for (int i = 0; i < 26; ++i) f[i] = (const float*)d_in[i];
    char* ws = (char*)d_ws; char* dob = (char*)d_out;
    P.out = (float*)d_out;
    P.MOD = (float*)(ws + W::o_MOD); P.H1 = (bf16_t*)(dob + W::d_H1); P.QKVP = (bf16_t*)(ws + W::A0); P.QKVN = (bf16_t*)(ws + W::A1);
    P.Z = (bf16_t*)(ws + W::o_Z); P.GA = (bf16_t*)(ws + W::o_GA); P.GB = (bf16_t*)(ws + W::o_GB);
    P.BETA = (float*)(ws + W::o_BETA); P.G = (float*)(ws + W::o_G); P.GC = (float*)(ws + W::o_GC); P.GL = (float*)(ws + W::o_GL);
    P.QLATR = (float*)(ws + W::o_QLATR); P.CKVR = (float*)(ws + W::o_CKVR); P.KIDXR = (float*)(ws + W::o_KIDXR); P.WIDX = (float*)(ws + W::o_WIDX);
    P.QLATN = (bf16_t*)(ws + W::o_QLATN); P.CKVN = (bf16_t*)(ws + W::o_CKVN); P.KIDXN = (bf16_t*)(ws + W::o_KIDXN);
    P.AMAT = (float*)(ws + W::o_AMAT); P.ATT = (bf16_t*)(ws + W::o_ATT); P.W = (bf16_t*)(ws + W::o_W); P.O = (bf16_t*)(dob + W::d_O); P.OG = (bf16_t*)(dob + W::d_OG);
    P.QF = (float*)(ws + W::o_QF); P.QIDX = (float*)(ws + W::o_QIDX); P.QABS = (bf16_t*)(ws + W::o_QABS); P.IDX = (int*)(ws + W::o_IDX); P.OLAT = P.QABS;
    P.OATT = (bf16_t*)(ws + W::o_OATT); P.M = (bf16_t*)(dob + W::d_M); P.X1 = (float*)(ws + W::o_X1); P.H2 = (bf16_t*)(ws + W::o_H2);
    P.PQ = (float*)(ws + W::o_PQ); P.EXPI = (int*)(dob + W::d_EXPI); P.GATE = (float*)(dob + W::d_GATE); P.ACT = (float*)(dob + W::d_ACT);
    P.SCRP = (float*)(ws + W::A3); P.S = nullptr; P.RAW = (float*)(ws + W::A1);
}

enum { ST_MOD = 0, ST_H1, ST_INPROJ_A, ST_DSANORM, ST_CONV, ST_GC, ST_AMAT, ST_SOLVE, ST_SCALE, ST_SCAN, ST_Q, ST_QABS, ST_INDEX, ST_ATTN,
       ST_INPROJ_B, ST_QIDX, ST_SMALL, ST_OGATE, ST_OATT, ST_MERGE, ST_WO, ST_H2, ST_PEERQ, ST_ROUTE, ST_PACT, ST_POUT, ST_FINAL, ST_COUNT };

template <class C> HD void n_mod(const NP& P, int item) {
    const int D = C::D; const int b = item / (6 * D), j = item % (6 * D);
    float acc = P.b_ada[j];
    for (int i = 0; i < D; ++i) acc += siluf(P.c[b * D + i]) * P.w_ada[(size_t)i * 6 * D + j];
    P.MOD[item] = acc;
}
template <class C> HD void n_h1(const NP& P, int t) {
    const int D = C::D; const int b = t / C::L; const float* xr = P.x + (size_t)t * D;
    float ss = 0.f; for (int i = 0; i < D; ++i) ss += xr[i] * xr[i];
    const float rstd = 1.f / sqrtf(ss / D + Dims<C>::EPS);
    const float* sh = P.MOD + (size_t)b * 6 * D; const float* sc = sh + D;
    for (int i = 0; i < D; ++i) P.H1[(size_t)t * D + i] = f2bf(xr[i] * rstd * P.norm1_w[i] * (1.f + sc[i]) + sh[i]);
}
template <class C> HD void inproj_store(const NP& P, int t, int n, float v) {
    typedef Dims<C> Dm;
    if (n < Dm::OFF_Z) P.QKVP[(size_t)t * Dm::QKVC + n] = f2bf(v);
    else if (n < Dm::OFF_B) P.Z[(size_t)t * Dm::HV + (n - Dm::OFF_Z)] = f2bf(v);
    else if (n < Dm::OFF_A) P.BETA[(size_t)t * C::DNH + (n - Dm::OFF_B)] = sigmf(v);
    else if (n < Dm::OFF_QL) { const int h = n - Dm::OFF_A; P.G[(size_t)t * C::DNH + h] = -expf(P.dn_a_log[h]) * softplusf(v + P.dn_dt_bias[h]); }
    else if (n < Dm::OFF_CKV) P.QLATR[(size_t)t * C::QL + (n - Dm::OFF_QL)] = v;
    else if (n < Dm::OFF_KI) P.CKVR[(size_t)t * C::KVL + (n - Dm::OFF_CKV)] = v;
    else if (n < Dm::OFF_WI) P.KIDXR[(size_t)t * C::ID + (n - Dm::OFF_KI)] = v;
    else if (n < Dm::OFF_GA) P.WIDX[(size_t)t * C::IH + (n - Dm::OFF_WI)] = v * (1.f / sqrtf((float)C::IH) / sqrtf((float)C::ID));
    else if (n < Dm::OFF_GB) P.GA[(size_t)t * C::D + (n - Dm::OFF_GA)] = f2bf(v);
    else P.GB[(size_t)t * C::D + (n - Dm::OFF_GB)] = f2bf(v);
}
template <class C> HD void n_inproj(const NP& P, int item, int c0, int c1) {
    typedef Dims<C> Dm; const int ng = (c1 - c0) / 4; const int t = item / ng, n = c0 + 4 * (item % ng);
    float a0 = 0, a1 = 0, a2 = 0, a3 = 0; const bf16_t* hr = P.H1 + (size_t)t * C::D;
    for (int k = 0; k < C::D; ++k) { const float h = bf2f(hr[k]); const float* w = P.w_in + (size_t)k * Dm::IN_COLS + n; a0 += h * w[0]; a1 += h * w[1]; a2 += h * w[2]; a3 += h * w[3]; }
    inproj_store<C>(P, t, n, a0); inproj_store<C>(P, t, n + 1, a1); inproj_store<C>(P, t, n + 2, a2); inproj_store<C>(P, t, n + 3, a3);
}
template <class C> HD void n_dsanorm(const NP& P, int t) {
    typedef Dims<C> Dm;
    { const float* r = P.QLATR + (size_t)t * C::QL; float ss = 0; for (int i = 0; i < C::QL; ++i) ss += r[i] * r[i]; const float rs = 1.f / sqrtf(ss / C::QL + Dm::EPS);
      for (int i = 0; i < C::QL; ++i) P.QLATN[(size_t)t * C::QL + i] = f2bf(r[i] * rs * P.q_norm_w[i]); }
    { const float* r = P.CKVR + (size_t)t * C::KVL; float ss = 0; for (int i = 0; i < C::KVL; ++i) ss += r[i] * r[i]; const float rs = 1.f / sqrtf(ss / C::KVL + Dm::EPS);
      for (int i = 0; i < C::KVL; ++i) P.CKVN[(size_t)t * C::KVL + i] = f2bf(r[i] * rs * P.kv_norm_w[i]); }
    { const float* r = P.KIDXR + (size_t)t * C::ID; float ss = 0; for (int i = 0; i < C::ID; ++i) ss += r[i] * r[i]; const float rs = 1.f / sqrtf(ss / C::ID + Dm::EPS);
      for (int i = 0; i < C::ID; ++i) P.KIDXN[(size_t)t * C::ID + i] = f2bf(r[i] * rs * P.idx_k_norm_w[i]); }
}

template <class C> HD void n_small(const NP& P, int t) {
    typedef Dims<C> Dm; const float* r = P.RAW + (size_t)t * 768;
    { float ss = 0; for (int i = 0; i < C::QL; ++i) ss += r[i] * r[i]; const float rs = 1.f / sqrtf(ss / C::QL + Dm::EPS);
      for (int i = 0; i < C::QL; ++i) P.QLATN[(size_t)t * C::QL + i] = f2bf(r[i] * rs * P.q_norm_w[i]); }
    { const float* q = r + 256; float ss = 0; for (int i = 0; i < C::KVL; ++i) ss += q[i] * q[i]; const float rs = 1.f / sqrtf(ss / C::KVL + Dm::EPS);
      for (int i = 0; i < C::KVL; ++i) P.CKVN[(size_t)t * C::KVL + i] = f2bf(q[i] * rs * P.kv_norm_w[i]); }
    { const float* q = r + 512; float ss = 0; for (int i = 0; i < C::ID; ++i) ss += q[i] * q[i]; const float rs = 1.f / sqrtf(ss / C::ID + Dm::EPS);
      for (int i = 0; i < C::ID; ++i) P.KIDXN[(size_t)t * C::ID + i] = f2bf(q[i] * rs * P.idx_k_norm_w[i]); }
    for (int h = 0; h < C::DNH; ++h) { P.BETA[(size_t)t * C::DNH + h] = sigmf(r[576 + h]); P.G[(size_t)t * C::DNH + h] = -expf(P.dn_a_log[h]) * softplusf(r[584 + h] + P.dn_dt_bias[h]); }
    for (int h = 0; h < C::IH; ++h) P.WIDX[(size_t)t * C::IH + h] = r[592 + h] * (1.f / sqrtf((float)C::IH) / sqrtf((float)C::ID));
}
template <class C> HD float conv_at(const NP& P, int t, int ch) {
    typedef Dims<C> Dm; const int l = t % C::L; float acc = 0.f;
    for (int i = 0; i < C::CONV; ++i) { const int ll = l - (C::CONV - 1) + i; if (ll >= 0) acc += bf2f(P.QKVP[(size_t)(t - (C::CONV - 1) + i) * Dm::QKVC + ch]) * P.dn_conv_w[(size_t)i * Dm::QKVC + ch]; }
    return siluf(acc);
}
template <class C> HD void n_conv(const NP& P, int item) {
    typedef Dims<C> Dm; const int which = item % 3, h = (item / 3) % C::DNH, t = item / (3 * C::DNH);
    const int dim = (which == 2) ? C::DV : C::DK; const int ch0 = (which == 0 ? 0 : which == 1 ? Dm::HK : 2 * Dm::HK) + h * dim;
    float rs = 1.f;
    if (which < 2) { float ss = 0.f; for (int d = 0; d < dim; ++d) { const float v = conv_at<C>(P, t, ch0 + d); ss += v * v; } rs = 1.f / sqrtf(ss + Dm::EPS); }
    for (int d = 0; d < dim; ++d) P.QKVN[(size_t)t * Dm::QKVC + ch0 + d] = f2bf(conv_at<C>(P, t, ch0 + d) * rs);
}
template <class C> HD void n_gc(const NP& P, int item) {
    typedef Dims<C> Dm; const int n = item % Dm::NCH, h = (item / Dm::NCH) % C::DNH, b = item / (Dm::NCH * C::DNH);
    float s = 0.f; for (int i = 0; i < C::CH; ++i) { const size_t t = (size_t)b * C::L + n * C::CH + i; s += P.G[t * C::DNH + h]; P.GC[t * C::DNH + h] = s; }
    P.GL[item] = expf(s);
}
template <class C> HD void n_amat(const NP& P, int item) {
    typedef Dims<C> Dm; const int j = item % C::CH, i = (item / C::CH) % C::CH, cid = item / (C::CH * C::CH);
    const int n = cid % Dm::NCH, h = (cid / Dm::NCH) % C::DNH, b = cid / (Dm::NCH * C::DNH);
    const size_t ti = (size_t)b * C::L + n * C::CH + i, tj = (size_t)b * C::L + n * C::CH + j;
    float a = 0.f, at = 0.f;
    if (j <= i) {
        const bf16_t* ki = P.QKVN + ti * Dm::QKVC + Dm::HK + h * C::DK; const bf16_t* kj = P.QKVN + tj * Dm::QKVC + Dm::HK + h * C::DK; const bf16_t* qi = P.QKVN + ti * Dm::QKVC + h * C::DK;
        float kk = 0.f, qk = 0.f; for (int d = 0; d < C::DK; ++d) { const float kjd = bf2f(kj[d]); kk += bf2f(ki[d]) * kjd; qk += bf2f(qi[d]) * kjd; }
        const float dec = expf(P.GC[ti * C::DNH + h] - P.GC[tj * C::DNH + h]);
        if (j < i) a = P.BETA[ti * C::DNH + h] * kk * dec;
        at = qk * (1.f / sqrtf((float)C::DK)) * dec;
    }
    P.AMAT[(size_t)cid * C::CH * C::CH + i * C::CH + j] = a;
    P.ATT[(size_t)cid * C::CH * C::CH + i * C::CH + j] = f2bf(at);
}
template <class C> HD void n_solve(const NP& P, int item, int tid, int NT) {
    typedef Dims<C> Dm; const int NC = C::DV + C::DK; const int col = item % NC, cid = item / NC;
    const int n = cid % Dm::NCH, h = (cid / Dm::NCH) % C::DNH, b = cid / (Dm::NCH * C::DNH);
    const float* A = P.AMAT + (size_t)cid * C::CH * C::CH;
    for (int i = 0; i < C::CH; ++i) {
        const size_t t = (size_t)b * C::L + n * C::CH + i; const float beta = P.BETA[t * C::DNH + h];
        float r;
        if (col < C::DV) r = bf2f(P.QKVN[t * Dm::QKVC + 2 * Dm::HK + h * C::DV + col]) * beta;
        else r = bf2f(P.QKVN[t * Dm::QKVC + Dm::HK + h * C::DK + (col - C::DV)]) * beta * expf(P.GC[t * C::DNH + h]);
        for (int j = 0; j < i; ++j) r -= A[i * C::CH + j] * SCR(j);
        SCR(i) = r;
    }
    for (int i = 0; i < C::CH; ++i) {
        const size_t t = (size_t)b * C::L + n * C::CH + i;
        if (col < C::DV) P.QKVN[t * Dm::QKVC + 2 * Dm::HK + h * C::DV + col] = f2bf(SCR(i));
        else P.W[((size_t)cid * C::CH + i) * C::DK + (col - C::DV)] = f2bf(SCR(i));
    }
}
template <class C> HD void n_scale(const NP& P, int item) {
    typedef Dims<C> Dm; const int h = item % C::DNH; const size_t t = item / C::DNH; const int l = (int)(t % C::L), b = (int)(t / C::L), n = l / C::CH;
    const float gc = P.GC[t * C::DNH + h]; const size_t tl = (size_t)b * C::L + n * C::CH + C::CH - 1; const float gl = P.GC[tl * C::DNH + h];
    const float fq = expf(gc) * (1.f / sqrtf((float)C::DK)), fk = expf(gl - gc);
    bf16_t* q = P.QKVN + t * Dm::QKVC + h * C::DK; bf16_t* k = P.QKVN + t * Dm::QKVC + Dm::HK + h * C::DK;
    for (int d = 0; d < C::DK; ++d) { q[d] = f2bf(bf2f(q[d]) * fq); k[d] = f2bf(bf2f(k[d]) * fk); }
}
template <class C> HD void n_scan(const NP& P, int item, int tid, int NT) {
    typedef Dims<C> Dm; const int e = item % C::DV, h = (item / C::DV) % C::DNH, b = item / (C::DV * C::DNH);
    for (int d = 0; d < C::DK; ++d) SCR(d) = 0.f;
    for (int n = 0; n < Dm::NCH; ++n) {
        const int cid = (b * C::DNH + h) * Dm::NCH + n; const size_t t0 = (size_t)b * C::L + n * C::CH;
        const bf16_t* Wc = P.W + (size_t)cid * C::CH * C::DK; const bf16_t* At = P.ATT + (size_t)cid * C::CH * C::CH;
        for (int r = 0; r < C::CH; ++r) { float acc = bf2f(P.QKVN[(t0 + r) * Dm::QKVC + 2 * Dm::HK + h * C::DV + e]);
            for (int d = 0; d < C::DK; ++d) acc -= bf2f(Wc[r * C::DK + d]) * SCR(d);
            SCR(C::DK + r) = acc; }
        for (int r = 0; r < C::CH; ++r) { float o = 0.f; const bf16_t* qd = P.QKVN + (t0 + r) * Dm::QKVC + h * C::DK;
            for (int d = 0; d < C::DK; ++d) o += bf2f(qd[d]) * SCR(d);
            for (int s = 0; s <= r; ++s) o += bf2f(At[r * C::CH + s]) * SCR(C::DK + s);
            P.O[(t0 + r) * Dm::HV + h * C::DV + e] = f2bf(o); }
        const float gl = P.GL[cid];
        for (int d = 0; d < C::DK; ++d) { float acc = SCR(d) * gl;
            for (int r = 0; r < C::CH; ++r) acc += bf2f(P.QKVN[(t0 + r) * Dm::QKVC + Dm::HK + h * C::DK + d]) * SCR(C::DK + r);
            SCR(d) = acc; }
    }
}
template <class C> HD void n_ogate(const NP& P, int item) {
    typedef Dims<C> Dm; const int h = item % C::DNH; const size_t t = item / C::DNH; const bf16_t* o = P.O + t * Dm::HV + h * C::DV;
    float ss = 0.f; for (int d = 0; d < C::DV; ++d) { const float v = bf2f(o[d]); ss += v * v; } const float rs = 1.f / sqrtf(ss / C::DV + Dm::EPS);
    for (int d = 0; d < C::DV; ++d) P.OG[t * Dm::HV + h * C::DV + d] = f2bf(bf2f(o[d]) * rs * P.dn_onorm_w[d] * siluf(bf2f(P.Z[t * Dm::HV + h * C::DV + d])));
}
template <class C> HD void n_q(const NP& P, int item) {
    const int NJ = C::MH * C::MDH + C::IH * C::ID; const int j = item % NJ; const size_t t = item / NJ; const bf16_t* ql = P.QLATN + t * C::QL;
    float acc = 0.f;
    if (j < C::MH * C::MDH) { for (int k = 0; k < C::QL; ++k) acc += bf2f(ql[k]) * P.w_uq[(size_t)k * C::MH * C::MDH + j]; P.QF[t * C::MH * C::MDH + j] = acc; }
    else { const int jj = j - C::MH * C::MDH; for (int k = 0; k < C::QL; ++k) acc += bf2f(ql[k]) * P.w_iq[(size_t)k * C::IH * C::ID + jj]; P.QIDX[t * C::IH * C::ID + jj] = acc; }
}
template <class C> HD void n_qabs(const NP& P, int item) {
    const int c = item % C::KVL, h = (item / C::KVL) % C::MH; const size_t t = item / (C::KVL * C::MH);
    float acc = 0.f; for (int d = 0; d < C::MDH; ++d) acc += P.QF[t * C::MH * C::MDH + h * C::MDH + d] * P.w_uk[((size_t)c * C::MH + h) * C::MDH + d];
    P.QABS[(t * C::MH + h) * C::KVL + c] = f2bf(acc * (1.f / sqrtf((float)C::MDH)));
}
template <class C> HD void n_index(const NP& P, int t, int tid, int NT) {
    typedef Dims<C> Dm; const int K = Dm::TOPK; const int l = t % C::L, b = t / C::L; int cnt = 0;
    const float* qi = P.QIDX + (size_t)t * C::IH * C::ID; const float* wi = P.WIDX + (size_t)t * C::IH;
#define HV_(i) SCR(i)
#define HI_(i) SCR(K + (i))
#define WORSE(v1, i1, v2, i2) ((v1) < (v2) || ((v1) == (v2) && (i1) > (i2)))
    for (int s = 0; s <= l; ++s) {
        const bf16_t* kr = P.KIDXN + ((size_t)b * C::L + s) * C::ID; float sc = 0.f;
        for (int h = 0; h < C::IH; ++h) { float dot = 0.f; for (int d = 0; d < C::ID; ++d) dot += qi[h * C::ID + d] * bf2f(kr[d]); sc += wi[h] * (dot > 0.f ? dot : 0.f); }
        const float fs = (float)s;
        if (cnt < K) {
            int i = cnt++; HV_(i) = sc; HI_(i) = fs;
            while (i > 0) { const int p = (i - 1) >> 1; const float pv = HV_(p), pi = HI_(p), cv = HV_(i), ci = HI_(i);
                if (WORSE(cv, ci, pv, pi)) { HV_(p) = cv; HI_(p) = ci; HV_(i) = pv; HI_(i) = pi; i = p; } else break; }
        } else if (HV_(0) < sc) {
            int i = 0; HV_(0) = sc; HI_(0) = fs;
            for (;;) { const int a = 2 * i + 1, c2 = a + 1; int w = i; float wv = HV_(i), wx = HI_(i);
                if (a < K) { const float av = HV_(a), ai = HI_(a); if (WORSE(av, ai, wv, wx)) { w = a; wv = av; wx = ai; } }
                if (c2 < K) { const float bv = HV_(c2), bi = HI_(c2); if (WORSE(bv, bi, wv, wx)) { w = c2; wv = bv; wx = bi; } }
                if (w == i) break; const float tv = HV_(i), ti = HI_(i); HV_(i) = wv; HI_(i) = wx; HV_(w) = tv; HI_(w) = ti; i = w; }
        }
    }
    for (int k = 0; k < K; ++k) P.IDX[(size_t)t * K + k] = (k < cnt) ? (int)HI_(k) : -1;
#undef HV_
#undef HI_
#undef WORSE
}
template <class C> HD void n_attn(const NP& P, int item, int tid, int NT) {
    typedef Dims<C> Dm; const int K = Dm::TOPK; const int h = item % C::MH; const size_t t = item / C::MH; const int b = (int)(t / C::L);
    const int* idx = P.IDX + t * K; bf16_t* qa = P.QABS + (t * C::MH + h) * C::KVL;
    int nv = 0; float m = -3.0e38f;
    for (int k = 0; k < K; ++k) { const int s = idx[k]; if (s < 0) break; ++nv;
        const bf16_t* kv = P.CKVN + ((size_t)b * C::L + s) * C::KVL; float lg = 0.f; for (int c = 0; c < C::KVL; ++c) lg += bf2f(qa[c]) * bf2f(kv[c]);
        SCR(k) = lg; m = lg > m ? lg : m; }
    float sum = 0.f; for (int k = 0; k < nv; ++k) { const float p = expf(SCR(k) - m); SCR(k) = p; sum += p; }
    const float inv = 1.f / sum;
    for (int c = 0; c < C::KVL; ++c) { float acc = 0.f; for (int k = 0; k < nv; ++k) acc += SCR(k) * bf2f(P.CKVN[((size_t)b * C::L + idx[k]) * C::KVL + c]);
        SCR(K + c) = acc * inv; }
    for (int c = 0; c < C::KVL; ++c) qa[c] = f2bf(SCR(K + c));
}
template <class C> HD void n_oatt(const NP& P, int item) {
    const int d = item % C::MDV, h = (item / C::MDV) % C::MH; const size_t t = item / (C::MDV * C::MH);
    float acc = 0.f; for (int c = 0; c < C::KVL; ++c) acc += bf2f(P.OLAT[(t * C::MH + h) * C::KVL + c]) * P.w_uv[((size_t)c * C::MH + h) * C::MDV + d];
    P.OATT[t * C::MH * C::MDV + h * C::MDV + d] = f2bf(acc);
}
template <class C> HD void n_merge(const NP& P, int item) {
    typedef Dims<C> Dm; const int n = item % C::D; const size_t t = item / C::D;
    float ya = 0.f, yb = 0.f;
    for (int k = 0; k < Dm::HV; ++k) ya += bf2f(P.OG[t * Dm::HV + k]) * P.w_a_out[(size_t)k * C::D + n];
    for (int k = 0; k < C::MH * C::MDV; ++k) yb += bf2f(P.OATT[t * C::MH * C::MDV + k]) * P.w_b_out[(size_t)k * C::D + n];
    P.M[t * C::D + n] = f2bf(sigmf(bf2f(P.GA[t * C::D + n])) * ya + sigmf(bf2f(P.GB[t * C::D + n])) * yb);
}
template <class C> HD void n_wo(const NP& P, int item) {
    const int n = item % C::D; const size_t t = item / C::D; const int b = (int)(t / C::L);
    float acc = 0.f; for (int k = 0; k < C::D; ++k) acc += bf2f(P.M[t * C::D + k]) * P.w_o[(size_t)k * C::D + n];
    P.X1[t * C::D + n] = P.x[t * C::D + n] + P.MOD[(size_t)b * 6 * C::D + 2 * C::D + n] * acc;
}
template <class C> HD void n_h2(const NP& P, int t) {
    const int D = C::D; const int b = t / C::L; const float* xr = P.X1 + (size_t)t * D;
    float ss = 0.f; for (int i = 0; i < D; ++i) ss += xr[i] * xr[i];
    const float rstd = 1.f / sqrtf(ss / D + Dims<C>::EPS);
    const float* sh = P.MOD + (size_t)b * 6 * D + 3 * D; const float* sc = sh + D;
    for (int i = 0; i < D; ++i) P.H2[(size_t)t * D + i] = f2bf(xr[i] * rstd * P.norm2_w[i] * (1.f + sc[i]) + sh[i]);
}
template <class C> HD void n_peerq(const NP& P, int item) {
    const int NJ = C::PH * C::PDQ; const int j = item % NJ; const size_t t = item / NJ;
    float acc = 0.f; for (int k = 0; k < C::D; ++k) acc += bf2f(P.H2[t * C::D + k]) * P.peer_w_q[(size_t)k * NJ + j];
    P.PQ[t * NJ + j] = acc;
}
template <class C> HD void n_route(const NP& P, int item, int tid, int NT) {
    typedef Dims<C> Dm; const int PK = C::PK, TK = C::PTK; const int h = item % C::PH; const size_t t = item / C::PH;
    const int oS = 0, oSV = 2 * PK, oSI = oSV + 2 * TK, oC = oSI + 2 * TK;
    for (int p = 0; p < 2; ++p) for (int n = 0; n < PK; ++n) {
        float acc = 0.f;
        if (P.S) acc = P.S[t * (size_t)(C::PH * 2 * PK) + (h * 2 + p) * PK + n];
        else { const float* q = P.PQ + t * C::PH * C::PDQ + (h * 2 + p) * Dm::PD2; const float* key = P.peer_sub_keys + (((size_t)h * 2 + p) * PK + n) * Dm::PD2;
            for (int d = 0; d < Dm::PD2; ++d) acc += q[d] * key[d]; }
        SCR(oS + p * PK + n) = acc; }
    for (int p = 0; p < 2; ++p) for (int k = 0; k < TK; ++k) { int bi = 0; float bv = -3.0e38f;
        for (int n = 0; n < PK; ++n) { const float v = SCR(oS + p * PK + n); if (v > bv) { bv = v; bi = n; } }
        SCR(oSV + p * TK + k) = bv; SCR(oSI + p * TK + k) = (float)bi; SCR(oS + p * PK + bi) = -3.0e38f; }
    for (int i = 0; i < TK; ++i) for (int j = 0; j < TK; ++j) SCR(oC + i * TK + j) = SCR(oSV + i) + SCR(oSV + TK + j);
    float tv[C::PTK]; int te[C::PTK]; float mx = -3.0e38f;
#pragma unroll
    for (int k = 0; k < TK; ++k) { int bi = 0; float bv = -3.0e38f;
        for (int n = 0; n < TK * TK; ++n) { const float v = SCR(oC + n); if (v > bv) { bv = v; bi = n; } }
        SCR(oC + bi) = -3.0e38f; tv[k] = bv; te[k] = (int)SCR(oSI + bi / TK) * PK + (int)SCR(oSI + TK + bi % TK); mx = bv > mx ? bv : mx; }
    float sum = 0.f;
#pragma unroll
    for (int k = 0; k < TK; ++k) { tv[k] = expf(tv[k] - mx); sum += tv[k]; }
#pragma unroll
    for (int k = 0; k < TK; ++k) { P.EXPI[t * Dm::SLOTS + h * TK + k] = te[k]; P.GATE[t * Dm::SLOTS + h * TK + k] = tv[k] / sum; }
}
template <class C> HD void n_pact(const NP& P, int item) {
    typedef Dims<C> Dm; const int sl = item % Dm::SLOTS; const size_t t = item / Dm::SLOTS; const int e = P.EXPI[t * Dm::SLOTS + sl];
    const float* u = P.peer_u + (size_t)e * C::D; float acc = 0.f; for (int d = 0; d < C::D; ++d) acc += u[d] * bf2f(P.H2[t * C::D + d]);
    P.ACT[t * Dm::SLOTS + sl] = geluf(acc) * P.GATE[t * Dm::SLOTS + sl];
}
template <class C> HD void n_pout(const NP& P, int item) {
    typedef Dims<C> Dm; const int d = item % C::D; const size_t t = item / C::D; const int b = (int)(t / C::L);
    float acc = 0.f; for (int s = 0; s < Dm::SLOTS; ++s) acc += P.ACT[t * Dm::SLOTS + s] * P.peer_v[(size_t)P.EXPI[t * Dm::SLOTS + s] * C::D + d];
    P.X1[t * C::D + d] += P.MOD[(size_t)b * 6 * C::D + 5 * C::D + d] * acc;
}
template <class C> HD void n_final(const NP& P, int t) {
    const int D = C::D; const float* xr = P.X1 + (size_t)t * D; float ss = 0.f; for (int i = 0; i < D; ++i) ss += xr[i] * xr[i];
    const float rstd = 1.f / sqrtf(ss / D + Dims<C>::EPS);
    for (int i = 0; i < D; ++i) P.out[(size_t)t * D + i] = xr[i] * rstd * P.final_norm_w[i];
}

template <class C> HD long stage_items(int st) {
    typedef Dims<C> Dm; const long T = Dm::T;
    switch (st) {
        case ST_MOD: return (long)C::B * 6 * C::D; case ST_H1: return T;
        case ST_INPROJ_A: return T * ((Dm::OFF_GA - 0) / 4) - T * (Dm::HV / 4);
        case ST_DSANORM: return T; case ST_CONV: return T * C::DNH * 3; case ST_GC: return Dm::NCHUNKS; case ST_AMAT: return (long)Dm::NCHUNKS * C::CH * C::CH;
        case ST_SOLVE: return (long)Dm::NCHUNKS * (C::DV + C::DK); case ST_SCALE: return T * C::DNH; case ST_SCAN: return (long)C::B * C::DNH * C::DV;
        case ST_Q: return T * (C::MH * C::MDH + C::IH * C::ID); case ST_QIDX: return T * (C::IH * C::ID); case ST_SMALL: return T; case ST_QABS: return T * C::MH * C::KVL; case ST_INDEX: return T; case ST_ATTN: return T * C::MH;
        case ST_INPROJ_B: return T * ((Dm::HV + 2 * C::D) / 4); case ST_OGATE: return T * C::DNH; case ST_OATT: return T * C::MH * C::MDV; case ST_MERGE: return T * C::D;
        case ST_WO: return T * C::D; case ST_H2: return T; case ST_PEERQ: return T * C::PH * C::PDQ; case ST_ROUTE: return T * C::PH; case ST_PACT: return T * Dm::SLOTS;
        case ST_POUT: return T * C::D; case ST_FINAL: return T;
    }
    return 0;
}
template <class C> HD int stage_scr_words(int st) {
    typedef Dims<C> Dm;
    switch (st) { case ST_SOLVE: return C::CH; case ST_SCAN: return C::DK + C::CH; case ST_INDEX: return 2 * Dm::TOPK; case ST_ATTN: return Dm::TOPK + C::KVL;
        case ST_ROUTE: return 2 * C::PK + 4 * C::PTK + C::PTK * C::PTK; }
    return 0;
}
template <class C> HD void run_item(const NP& P, int st, long item, int tid, int NT) {
    typedef Dims<C> Dm;
    switch (st) {
        case ST_MOD: n_mod<C>(P, (int)item); break; case ST_H1: n_h1<C>(P, (int)item); break;
        case ST_INPROJ_A: { const int ngA = Dm::OFF_Z / 4, ngB = (Dm::OFF_GA - Dm::OFF_B) / 4, ng = ngA + ngB; const int t = (int)(item / ng), g = (int)(item % ng);
            if (g < ngA) n_inproj<C>(P, t * ngA + g, 0, Dm::OFF_Z); else n_inproj<C>(P, t * ngB + (g - ngA), Dm::OFF_B, Dm::OFF_GA); } break;
        case ST_DSANORM: n_dsanorm<C>(P, (int)item); break; case ST_CONV: n_conv<C>(P, (int)item); break; case ST_GC: n_gc<C>(P, (int)item); break;
        case ST_AMAT: n_amat<C>(P, (int)item); break; case ST_SOLVE: n_solve<C>(P, (int)item, tid, NT); break; case ST_SCALE: n_scale<C>(P, (int)item); break;
        case ST_SCAN: n_scan<C>(P, (int)item, tid, NT); break; case ST_Q: n_q<C>(P, (int)item); break; case ST_QIDX: { const int NI = C::IH * C::ID, NJ = C::MH * C::MDH + NI; n_q<C>(P, (int)((item / NI) * NJ + C::MH * C::MDH + item % NI)); } break; case ST_QABS: n_qabs<C>(P, (int)item); break; case ST_SMALL: n_small<C>(P, (int)item); break;
        case ST_INDEX: n_index<C>(P, (int)item, tid, NT); break; case ST_ATTN: n_attn<C>(P, (int)item, tid, NT); break;
        case ST_INPROJ_B: { const int ngA = Dm::HV / 4, ngB = 2 * C::D / 4, ng = ngA + ngB; const int t = (int)(item / ng), g = (int)(item % ng);
            if (g < ngA) n_inproj<C>(P, t * ngA + g, Dm::OFF_Z, Dm::OFF_B); else n_inproj<C>(P, t * ngB + (g - ngA), Dm::OFF_GA, Dm::IN_COLS); } break;
        case ST_OGATE: n_ogate<C>(P, (int)item); break; case ST_OATT: n_oatt<C>(P, (int)item); break; case ST_MERGE: n_merge<C>(P, (int)item); break;
        case ST_WO: n_wo<C>(P, (int)item); break; case ST_H2: n_h2<C>(P, (int)item); break; case ST_PEERQ: n_peerq<C>(P, (int)item); break;
        case ST_ROUTE: n_route<C>(P, (int)item, tid, NT); break; case ST_PACT: n_pact<C>(P, (int)item); break; case ST_POUT: n_pout<C>(P, (int)item); break;
        case ST_FINAL: n_final<C>(P, (int)item); break;
    }
}
#define GAS __attribute__((address_space(1)))
#define LAS __attribute__((address_space(3)))
#define XB_TMO      128
#define XB_XCNT(j)  (256  + 64 * (j))
#define XB_XSUB(j)  (1280 + 64 * (j))
#define XB_XGEN(j)  (2304 + 64 * (j))
#define XB_TOP      3328
#define XB_TOPGEN   3392
#define XCD_BAR_WORDS 3456
#ifndef XB_SPIN_CAP
#define XB_SPIN_CAP (1u << 26)
#endif
__device__ __forceinline__ unsigned xb_ld(unsigned* p)              { return __hip_atomic_load(p, __ATOMIC_RELAXED, __HIP_MEMORY_SCOPE_AGENT); }
__device__ __forceinline__ unsigned xb_add(unsigned* p, unsigned v) { return __hip_atomic_fetch_add(p, v, __ATOMIC_RELAXED, __HIP_MEMORY_SCOPE_AGENT); }
__device__ __forceinline__ unsigned xb_xcc_id() { return (unsigned)__builtin_amdgcn_s_getreg((3 << 11) | 20) & 0xFu; }
#define XB_SPIN(cond, bar) do { unsigned _sp = 0; while (cond) { __builtin_amdgcn_s_sleep(1); \
    if ((++_sp & 255u) == 0u) { if (xb_ld(&(bar)[XB_TMO])) break; if (_sp > XB_SPIN_CAP) { atomicAdd(&(bar)[XB_TMO], 1u); break; } } } } while (0)
struct XcdBarrier { unsigned* bar; unsigned x; volatile LAS unsigned* st; };
__device__ __forceinline__ XcdBarrier xcd_barrier_post(unsigned* bar, volatile LAS unsigned* st) {
    XcdBarrier b; b.bar = bar; b.x = xb_xcc_id(); b.st = st;
    if (threadIdx.x == 0) (void)xb_add(&bar[XB_XCNT(b.x)], 1u);
    return b;
}
__device__ __forceinline__ void xcd_barrier_complete(unsigned* bar, unsigned x, unsigned& nloc, unsigned& nx) {
    const unsigned G = gridDim.x * gridDim.y * gridDim.z;
    unsigned sum, cnt, mine, sp = 0u;
    for (;;) {
        sum = 0u; cnt = 0u; mine = 0u;
#pragma unroll
        for (unsigned j = 0; j < 16; ++j) { const unsigned c = xb_ld(&bar[XB_XCNT(j)]); sum += c; cnt += (c > 0u) ? 1u : 0u; mine = (j == x) ? c : mine; }
        if (sum == G) break;
        __builtin_amdgcn_s_sleep(1);
        if ((++sp & 255u) == 0u) { if (xb_ld(&bar[XB_TMO])) break; if (sp > XB_SPIN_CAP) { atomicAdd(&bar[XB_TMO], 1u); break; } }
    }
    nloc = mine > 0u ? mine : 1u; nx = cnt > 0u ? cnt : 1u;
}
__device__ __forceinline__ void xcd_barrier(const XcdBarrier& b) {
    asm volatile("s_waitcnt vmcnt(0)" ::: "memory");
    __syncthreads();
    if (threadIdx.x == 0) {
        unsigned* bar = b.bar;
        __builtin_amdgcn_s_waitcnt(0);
        unsigned nloc = b.st[0], nx = b.st[1];
        if (nloc == 0u) { xcd_barrier_complete(bar, b.x, nloc, nx); b.st[0] = nloc; b.st[1] = nx; }
        const unsigned old = xb_add(&bar[XB_XSUB(b.x)], 1u);
        const unsigned gen = old / nloc;
        if (old + 1u == (gen + 1u) * nloc) {
            __builtin_amdgcn_fence(__ATOMIC_RELEASE, "agent");
            asm volatile("s_waitcnt vmcnt(0)" ::: "memory");
            const unsigned og = xb_add(&bar[XB_TOP], 1u);
            const unsigned tg = og / nx;
            if (og + 1u == (tg + 1u) * nx) xb_add(&bar[XB_TOPGEN], 1u);
            else XB_SPIN(xb_ld(&bar[XB_TOPGEN]) == tg, bar);
            __builtin_amdgcn_fence(__ATOMIC_ACQUIRE, "agent");
            xb_add(&bar[XB_XGEN(b.x)], 1u);
            asm volatile("s_waitcnt vmcnt(0)" ::: "memory");
        } else {
            XB_SPIN(xb_ld(&bar[XB_XGEN(b.x)]) == gen, bar);
            __builtin_amdgcn_fence(__ATOMIC_ACQUIRE, "agent");
            asm volatile("s_waitcnt vmcnt(0)" ::: "memory");
        }
    }
    __syncthreads();
}
namespace pg8 {
#define PG8_LAS __attribute__((address_space(3)))
typedef unsigned short bf16_t;
typedef short bf16x8 __attribute__((ext_vector_type(8)));
typedef float f32x4 __attribute__((ext_vector_type(4)));
typedef unsigned u32x4 __attribute__((ext_vector_type(4)));
constexpr int BM = 256, BK = 64, HALF = 128, HTB = HALF * BK * 2  , STAGE_BYTES = 8 * HTB, NXCD = 8, WGM = 8;

__host__ __device__ __forceinline__ int lds_byte(int r, int c) { const int st = (r >> 4) * 2 + (c >> 5), rr = r & 15, cc = c & 31, ob = rr * 64 + cc * 2; return st * 1024 + (ob ^ (((ob >> 9) & 1) << 5)); }
__host__ __device__ __forceinline__ void stage_rc(int b, int& R, int& C) { const int st = b / 1024, sb = b % 1024, swz = sb ^ (((sb >> 9) & 1) << 5); R = (st >> 1) * 16 + swz / 64; C = (st & 1) * 32 + (swz % 64) / 2; }
__host__ __device__ __forceinline__ int perm32(int rho) { const int n = rho >> 4, i = rho & 15; return 8 * (i >> 2) + 4 * n + (i & 3); }
__device__ __forceinline__ unsigned cvt_pk_bf16(float lo, float hi) { unsigned r; asm volatile("v_cvt_pk_bf16_f32 %0, %1, %2" : "=v"(r) : "v"(lo), "v"(hi)); return r; }
struct Unit { int pm, pn; const char* a; const char* b; };
struct Gemm { int lda, ldb, K; };
template <class Epi, class Sched, bool ALIGN_EPI = false, bool SP2 = false>
__device__ __forceinline__ void gemm_phase(PG8_LAS unsigned char* lds, const Gemm g, const Sched& S, const Epi& E) {
    int tid = threadIdx.x; asm volatile("" : "+v"(tid));
    const int wid = __builtin_amdgcn_readfirstlane(tid >> 6), lane = tid & 63, wr = wid >> 2, wc = wid & 3, fr = lane & 15, fq = lane >> 4;
    const int K = g.K, nt = K / BK;
    unsigned voffA[2], voffB[2];
#pragma unroll
    for (int i = 0; i < 2; ++i) { int R, C; stage_rc(tid * 16 + i * 8192, R, C); const int Rb = Epi::PERM ? ((R & ~31) + perm32(R & 31)) : R;
        voffA[i] = (unsigned)(R * g.lda + C) * 2u; voffB[i] = (unsigned)(Rb * g.ldb + C) * 2u; }
    const size_t kstep = (size_t)(BK * 2);
    const size_t hstepA = (size_t)HALF * g.lda * 2, hstepB = (size_t)HALF * g.ldb * 2;
    const unsigned ldsw = (unsigned)wid * 1024u;
    const int aoff = lds_byte(wr * 64 + fr, fq * 8), boff = lds_byte(wc * 32 + fr, fq * 8);
#define PG8_SA(b, h) (((b) * 2 + (h)) * HTB)
#define PG8_SB(b, h) ((4 + (b) * 2 + (h)) * HTB)
#define PG8_STAGE(bufoff, gbase, voff) do { _Pragma("unroll") for (int _i = 0; _i < 2; ++_i) \
        __builtin_amdgcn_global_load_lds((const unsigned*)((const char*)(gbase) + (voff)[_i]), (PG8_LAS unsigned*)(lds + (bufoff) + ldsw + _i * 8192), 16, 0, 0); } while (0)
#define PG8_LDA(dst, b, h) do { _Pragma("unroll") for (int m = 0; m < 4; ++m) _Pragma("unroll") for (int k = 0; k < 2; ++k) dst[m][k] = *(const PG8_LAS bf16x8*)(lds + PG8_SA(b, h) + aoff + m * 2048 + k * 1024); } while (0)
#define PG8_LDB(dst, b, h) do { _Pragma("unroll") for (int n = 0; n < 2; ++n) _Pragma("unroll") for (int k = 0; k < 2; ++k) dst[n][k] = *(const PG8_LAS bf16x8*)(lds + PG8_SB(b, h) + boff + n * 2048 + k * 1024); } while (0)
#define PG8_MMA(ai, bj, At, Bt) do { __builtin_amdgcn_s_setprio(1); _Pragma("unroll") for (int m = 0; m < 4; ++m) _Pragma("unroll") for (int n = 0; n < 2; ++n) _Pragma("unroll") for (int k = 0; k < 2; ++k) \
        acc[ai][bj][m][n] = __builtin_amdgcn_mfma_f32_16x16x32_bf16(Bt[n][k], At[m][k], acc[ai][bj][m][n], 0, 0, 0); __builtin_amdgcn_s_setprio(0); } while (0)
#define PG8_WAIT_V(n) asm volatile("s_waitcnt vmcnt(" #n ")" ::: "memory")
#define PG8_WAIT_L(n) asm volatile("s_waitcnt lgkmcnt(" #n ")" ::: "memory")
#define PG8_BAR __builtin_amdgcn_s_barrier()
#define PG8_SCHED __builtin_amdgcn_sched_barrier(0)
    Unit cur, nxt; int ui = 0;
    if (!S.next(0, cur)) return;
    f32x4 acc[2][2][4][2];
#pragma unroll
    for (int a = 0; a < 2; ++a)
#pragma unroll
        for (int b = 0; b < 2; ++b)
#pragma unroll
            for (int m = 0; m < 4; ++m)
#pragma unroll
                for (int n = 0; n < 2; ++n) acc[a][b][m][n] = (f32x4){0.f, 0.f, 0.f, 0.f};
    bf16x8 At[4][2], B0[2][2], B1[2][2];
    const char* cA = cur.a; const char* cB = cur.b;
    S.a_ready(cur);
    if constexpr (SP2) {
        PG8_STAGE(PG8_SB(0, 0), cB, voffB); PG8_STAGE(PG8_SB(0, 1), cB + hstepB, voffB); PG8_STAGE(PG8_SA(0, 0), cA, voffA); PG8_STAGE(PG8_SA(0, 1), cA + hstepA, voffA);
        if (wr == 1) PG8_BAR;
        PG8_WAIT_V(2); PG8_BAR;
        PG8_STAGE(PG8_SB(1, 0), cB + kstep, voffB); PG8_STAGE(PG8_SA(1, 0), cA + kstep, voffA); PG8_STAGE(PG8_SB(1, 1), cB + hstepB + kstep, voffB);
        PG8_WAIT_V(6); PG8_BAR;
    } else {
        PG8_STAGE(PG8_SB(0, 0), cB, voffB); PG8_STAGE(PG8_SA(0, 0), cA, voffA); PG8_STAGE(PG8_SB(0, 1), cB + hstepB, voffB); PG8_STAGE(PG8_SA(0, 1), cA + hstepA, voffA);
        if (wr == 1) PG8_BAR;
        PG8_WAIT_V(4); PG8_BAR;
        PG8_STAGE(PG8_SB(1, 0), cB + kstep, voffB); PG8_STAGE(PG8_SA(1, 0), cA + kstep, voffA); PG8_STAGE(PG8_SB(1, 1), cB + hstepB + kstep, voffB);
        PG8_WAIT_V(6); PG8_BAR;
    }
    for (;;) {
        const bool has_next = S.next(ui + 1, nxt);
        const char* nA = has_next ? nxt.a : cA; const char* nB = has_next ? nxt.b : cB;
        for (int t = 0; t < nt; t += 2) {
            const bool last = (t == nt - 2);
            const char* a1 = cA + (size_t)(t + 1) * kstep;
            const char* a2 = last ? nA : cA + (size_t)(t + 2) * kstep; const char* b2 = last ? nB : cB + (size_t)(t + 2) * kstep;
            const char* a3 = a2 + kstep; const char* b3 = b2 + kstep;
            if (last && has_next) S.a_ready(nxt);
            if constexpr (SP2) {
            PG8_LDB(B0, 0, 0); PG8_LDB(B1, 0, 1); PG8_SCHED; PG8_LDA(At, 0, 0); PG8_STAGE(PG8_SA(1, 1), a1 + hstepA, voffA);
            PG8_WAIT_V(8); PG8_WAIT_L(0); PG8_BAR; PG8_MMA(0, 0, At, B0); PG8_MMA(0, 1, At, B1); PG8_BAR; PG8_SCHED;
            PG8_LDA(At, 0, 1); PG8_STAGE(PG8_SB(0, 0), b2, voffB); PG8_STAGE(PG8_SB(0, 1), b2 + hstepB, voffB); PG8_STAGE(PG8_SA(0, 0), a2, voffA);
            PG8_WAIT_V(8); PG8_WAIT_L(0); PG8_BAR; PG8_MMA(1, 0, At, B0); PG8_MMA(1, 1, At, B1); PG8_BAR; PG8_SCHED;
            PG8_LDB(B0, 1, 0); PG8_LDB(B1, 1, 1); PG8_SCHED; PG8_LDA(At, 1, 0); PG8_STAGE(PG8_SA(0, 1), a2 + hstepA, voffA);
            PG8_WAIT_V(8); PG8_WAIT_L(0); PG8_BAR; PG8_MMA(0, 0, At, B0); PG8_MMA(0, 1, At, B1); PG8_BAR; PG8_SCHED;
            PG8_LDA(At, 1, 1); PG8_STAGE(PG8_SB(1, 0), b3, voffB); PG8_STAGE(PG8_SB(1, 1), b3 + hstepB, voffB); PG8_STAGE(PG8_SA(1, 0), a3, voffA);
            PG8_WAIT_V(8); PG8_WAIT_L(0); PG8_BAR; PG8_MMA(1, 0, At, B0); PG8_MMA(1, 1, At, B1); PG8_BAR; PG8_SCHED;
            } else {
            PG8_LDB(B0, 0, 0); PG8_SCHED; PG8_LDA(At, 0, 0); PG8_STAGE(PG8_SA(1, 1), a1 + hstepA, voffA);
            PG8_WAIT_L(8); PG8_BAR; PG8_WAIT_L(0); PG8_MMA(0, 0, At, B0); PG8_BAR; PG8_SCHED;
            PG8_LDB(B1, 0, 1); PG8_STAGE(PG8_SB(0, 0), b2, voffB);
            PG8_BAR; PG8_WAIT_L(0); PG8_MMA(0, 1, At, B1); PG8_BAR;
            PG8_LDA(At, 0, 1); PG8_STAGE(PG8_SA(0, 0), a2, voffA);
            PG8_BAR; PG8_WAIT_L(0); PG8_MMA(1, 0, At, B0); PG8_BAR; PG8_SCHED;
            PG8_STAGE(PG8_SB(0, 1), b2 + hstepB, voffB);
            PG8_WAIT_V(6); PG8_BAR; PG8_MMA(1, 1, At, B1); PG8_BAR;
            PG8_LDB(B0, 1, 0); PG8_SCHED; PG8_LDA(At, 1, 0); PG8_STAGE(PG8_SA(0, 1), a2 + hstepA, voffA);
            PG8_WAIT_L(8); PG8_BAR; PG8_WAIT_L(0); PG8_MMA(0, 0, At, B0); PG8_BAR; PG8_SCHED;
            PG8_LDB(B1, 1, 1); PG8_STAGE(PG8_SB(1, 0), b3, voffB);
            PG8_BAR; PG8_WAIT_L(0); PG8_MMA(0, 1, At, B1); PG8_BAR;
            PG8_LDA(At, 1, 1); PG8_STAGE(PG8_SA(1, 0), a3, voffA);
            PG8_BAR; PG8_WAIT_L(0); PG8_MMA(1, 0, At, B0); PG8_BAR; PG8_SCHED;
            PG8_STAGE(PG8_SB(1, 1), b3 + hstepB, voffB);
            PG8_WAIT_V(6); PG8_BAR; PG8_MMA(1, 1, At, B1); PG8_BAR;
            }
        }
        if constexpr (ALIGN_EPI) { if (wr == 0) PG8_BAR; }
        if constexpr (!Epi::AFTER_DRAIN) { E(acc, cur, wr, wc, fr, fq); S.done(cur); }
        if (!has_next) break;
#pragma unroll
        for (int a = 0; a < 2; ++a)
#pragma unroll
            for (int b = 0; b < 2; ++b)
#pragma unroll
                for (int m = 0; m < 4; ++m)
#pragma unroll
                    for (int n = 0; n < 2; ++n) acc[a][b][m][n] = (f32x4){0.f, 0.f, 0.f, 0.f};
        cur = nxt; cA = nA; cB = nB; ++ui;
        if constexpr (ALIGN_EPI) { if (wr == 1) PG8_BAR; }
    }
    PG8_WAIT_V(0);
    if constexpr (!ALIGN_EPI) { if (wr == 0) PG8_BAR; }
    PG8_BAR;
    if constexpr (Epi::AFTER_DRAIN) { E.fused(acc, cur, wr, wc, fr, fq, lds, wid, lane); S.done(cur); }
#undef PG8_SA
#undef PG8_SB
#undef PG8_STAGE
#undef PG8_LDA
#undef PG8_LDB
#undef PG8_MMA
#undef PG8_WAIT_V
#undef PG8_WAIT_L
#undef PG8_BAR
#undef PG8_SCHED
}
}
typedef float f32x4 __attribute__((ext_vector_type(4)));
typedef unsigned u32x4 __attribute__((ext_vector_type(4)));
constexpr int T_ = 16384, D_ = 1024, NIN_ = 6912;
constexpr size_t MiB_ = 1u << 20;
constexpr size_t X_BASE = 230 * MiB_;
constexpr size_t X_WINT = X_BASE, X_WCAT = X_WINT + (size_t)NIN_ * 1024 * 2, X_WOT = X_WCAT + (size_t)1024 * 3072 * 2, X_WST = X_WOT + (size_t)1024 * 1024 * 2,
                 X_WCOMB = X_WST + (size_t)2048 * 1024 * 2, X_WIQT = X_WCOMB + (size_t)2048 * 256 * 2, X_END = X_WIQT + (size_t)512 * 256 * 2;
constexpr size_t X_EXPI = X_WINT, X_GATE = X_EXPI + (size_t)16384 * 128 * 4;
static_assert(X_GATE + (size_t)16384 * 128 * 4 <= X_WOT, "routing results fit over WinT | WcatT");
constexpr size_t X_WUK = WsMap<CfgFull>::A0, X_WUQ = X_WUK + (size_t)256 * 1024 * 2, X_WBT = X_WUQ + (size_t)256 * 1024 * 2,
                 X_WUV = X_WBT + (size_t)1024 * 1024 * 2, X_SKB = X_WUV + (size_t)256 * 1024 * 2, X_PWQ = X_SKB + (size_t)2048 * 256 * 2, X_TMP_END = X_PWQ + (size_t)1024 * 2048 * 2;
static_assert(WsMap<CfgFull>::END <= X_BASE && X_END <= 260 * MiB_ && X_TMP_END <= WsMap<CfgFull>::A2, "extra workspace map (d_ws >= 266.9 MiB = the sum of the inputs)");
struct OP {
    bf16_t *WinT, *WcatT, *WoT, *WsT, *WcombT, *WiqT, *wuk, *wuq, *wbT, *wuv, *skb, *pwq; float* S; bf16_t* RAWB; unsigned char *Ub, *Vb; int* EXPI2; float* GATE2; bf16_t *QA0, *QA1; unsigned* qword;
};
typedef __bf16 bf16x2h_t __attribute__((ext_vector_type(2)));
typedef float f32x2h_t __attribute__((ext_vector_type(2)));
__device__ __forceinline__ unsigned pk2bf(float lo, float hi) { const f32x2h_t v = {lo, hi}; return __builtin_bit_cast(unsigned, __builtin_convertvector(v, bf16x2h_t)); }
__device__ __forceinline__ bf16_t f2bfd(float f) { return (bf16_t)(pk2bf(f, 0.f) & 0xffffu); }

__device__ __forceinline__ int inproj_src(int n) {
    if (n < 3072) return n;
    if (n < 3328) return 4112 + (n - 3072);
    if (n < 3584) return 4368 + (n - 3328);
    if (n < 3648) return 4624 + (n - 3584);
    if (n < 3656) return 4096 + (n - 3648);
    if (n < 3664) return 4104 + (n - 3656);
    if (n < 3672) return 4688 + (n - 3664);
    if (n < 3840) return -1;
    if (n < 4864) return 3072 + (n - 3840);
    if (n < 5888) return 4696 + (n - 4864);
    return 5720 + (n - 5888);
}
template <int MAP> __device__ __forceinline__ void transpose_item(const float* W, int ldn, bf16_t* WT, int ldk, int n0, int k0, LAS float* scr, int lane) {
    const int j = lane & 31; int sc = n0 + j; if (MAP == 1) sc = inproj_src(n0 + j);
#pragma unroll 8
    for (int i = 0; i < 32; ++i) { const int kk = 2 * i + (lane >> 5); scr[kk * 33 + j] = (sc >= 0) ? W[(size_t)(k0 + kk) * ldn + sc] : 0.f; }
    asm volatile("s_waitcnt lgkmcnt(0)" ::: "memory");
    const int c = lane & 7;
#pragma unroll
    for (int q = 0; q < 4; ++q) { const int n = (lane >> 3) + 8 * q; const LAS float* s = scr + (8 * c) * 33 + n;
        u32x4 o; o.x = pk2bf(s[0 * 33], s[1 * 33]); o.y = pk2bf(s[2 * 33], s[3 * 33]); o.z = pk2bf(s[4 * 33], s[5 * 33]); o.w = pk2bf(s[6 * 33], s[7 * 33]);
        *(u32x4*)(WT + (size_t)(n0 + n) * ldk + k0 + 8 * c) = o; }
    asm volatile("s_waitcnt lgkmcnt(0)" ::: "memory");
}
__device__ __forceinline__ void p0_weights(const NP& P, const OP& Q, LAS unsigned char* lds, int gw, int NGW, int gt, int NGT, int wave, int lane) {
    LAS float* scr = (LAS float*)(lds + wave * 16384);
    constexpr int I_IN = (NIN_ / 32) * 16, I_SQ = 32 * 16;
    constexpr int I_IQ = 16 * 4;
    for (int it = gw; it < I_IN + 3 * I_SQ + I_IQ; it += NGW) {
        int r = it;
        if (r < I_IN) { transpose_item<1>(P.w_in, 6744, Q.WinT, 1024, (r / 16) * 32, (r % 16) * 64, scr, lane); continue; } r -= I_IN;
        if (r < I_SQ) { transpose_item<0>(P.w_a_out, 1024, Q.WcatT, 3072, (r / 16) * 32, (r % 16) * 64, scr, lane); continue; } r -= I_SQ;
        if (r < I_SQ) { transpose_item<0>(P.w_o, 1024, Q.WoT, 1024, (r / 16) * 32, (r % 16) * 64, scr, lane); continue; } r -= I_SQ;
        if (r < I_SQ) { transpose_item<0>(P.w_b_out, 1024, Q.wbT, 1024, (r / 16) * 32, (r % 16) * 64, scr, lane); continue; } r -= I_SQ;
        transpose_item<0>(P.w_iq, 512, Q.WiqT, 256, (r / 4) * 32, (r % 4) * 64, scr, lane);
    }
    for (int i = gt; i < 256 * 1024 / 4; i += NGT) { const f32x4 a = ((const f32x4*)P.w_uk)[i], b = ((const f32x4*)P.w_uq)[i], c = ((const f32x4*)P.w_uv)[i];
        ((uint2*)Q.wuk)[i] = make_uint2(pk2bf(a.x, a.y), pk2bf(a.z, a.w)); ((uint2*)Q.wuq)[i] = make_uint2(pk2bf(b.x, b.y), pk2bf(b.z, b.w)); ((uint2*)Q.wuv)[i] = make_uint2(pk2bf(c.x, c.y), pk2bf(c.z, c.w)); }
    for (int i = gt; i < 1024 * 2048 / 4; i += NGT) { const f32x4 a = ((const f32x4*)P.peer_w_q)[i]; ((uint2*)Q.pwq)[i] = make_uint2(pk2bf(a.x, a.y), pk2bf(a.z, a.w)); }
    for (int i = gt; i < 2048 * 256 / 4; i += NGT) { const int row = i / 64, c4 = (i % 64) * 4, g = row >> 7; uint2 o = make_uint2(0u, 0u);
        if ((c4 >> 7) == (g & 1)) { const f32x4 a = *(const f32x4*)(P.peer_sub_keys + (size_t)row * 128 + (c4 & 127)); o = make_uint2(pk2bf(a.x, a.y), pk2bf(a.z, a.w)); }
        ((uint2*)Q.skb)[i] = o; }
}
struct GridSched {
    int nM, nN, nwg, G, c; const char* A; const char* B; size_t sA, sB;
    const char* A2 = nullptr; int splitA = 1 << 30;
    __device__ void init(int nM_, int nN_, int G_, int c_, const void* A_, size_t sA_, const void* B_, size_t sB_) { nM = nM_; nN = nN_; nwg = nM * nN; G = G_; c = c_; A = (const char*)A_; B = (const char*)B_; sA = sA_; sB = sB_; }
    __device__ bool next(int i, pg8::Unit& u) const {
        const long L = (long)i * G + c; if (L >= nwg) return false;
        int wgid = (int)L; { const int q = nwg / 8, r = nwg % 8, xcd = wgid % 8, off = wgid / 8; wgid = (xcd < r ? xcd * (q + 1) : r * (q + 1) + (xcd - r) * q) + off; }
        const int nig = 8 * nN, gid = wgid / nig, fm = gid * 8, gsz = (nM - fm) < 8 ? (nM - fm) : 8;
        u.pm = fm + ((wgid % nig) % gsz); u.pn = (wgid % nig) / gsz; u.a = (u.pm < splitA) ? A + (size_t)u.pm * sA : A2 + (size_t)(u.pm - splitA) * sA; u.b = B + (size_t)u.pn * sB; return true;
    }
    __device__ __forceinline__ void a_ready(const pg8::Unit&) const {}
    __device__ __forceinline__ void done(const pg8::Unit&) const {}
};
struct WSched {
    int kind, c; const bf16_t *wuk, *wuq, *wbT, *wuv, *skb, *pwq;
    __device__ bool next(int i, pg8::Unit& u) const {
        if (i > 0 || c < 0) return false;
        if (kind == 0) {
            if (c < 8) { u.pm = c; u.pn = 100; u.a = (const char*)(wuk + c * 128); u.b = (const char*)(wuq + c * 128); return true; }
            if (c < 40) { const int h = (c - 8) >> 2, mt = (c - 8) & 3; u.pm = mt; u.pn = 200 + h; u.a = (const char*)(wbT + (size_t)mt * 256 * 1024 + h * 128); u.b = (const char*)(wuv + h * 128); return true; }
            return false;
        }
        if (c < 32) { const int pm = c >> 2, nt = c & 3; u.pm = pm; u.pn = nt; u.a = (const char*)(skb + (size_t)pm * 256 * 256); u.b = (const char*)(pwq + (size_t)nt * 256 * 2048 + pm * 256); return true; }
        return false;
    }
    __device__ __forceinline__ void a_ready(const pg8::Unit&) const {}
    __device__ __forceinline__ void done(const pg8::Unit&) const {}
};
template <class F> struct EpiG {
    static constexpr bool PERM = true, AFTER_DRAIN = false; F f;
    __device__ __forceinline__ void operator()(const f32x4 (&acc)[2][2][4][2], const pg8::Unit& u, int wr, int wc, int fr, int fq) const {
#pragma unroll
        for (int ai = 0; ai < 2; ++ai)
#pragma unroll
            for (int m = 0; m < 4; ++m)
#pragma unroll
                for (int bj = 0; bj < 2; ++bj) f.st(u, ai * 128 + wr * 64 + m * 16 + fr, bj * 128 + wc * 32 + 8 * fq, acc[ai][bj][m][0], acc[ai][bj][m][1]);
    }
};
__device__ __forceinline__ u32x4 pack8(f32x4 v0, f32x4 v1) { u32x4 w; w.x = pk2bf(v0[0], v0[1]); w.y = pk2bf(v0[2], v0[3]); w.z = pk2bf(v1[0], v1[1]); w.w = pk2bf(v1[2], v1[3]); return w; }
struct FWeights {
    bf16_t *WcombT, *WcatT, *WsT;
    __device__ __forceinline__ void st(const pg8::Unit& u, int row, int col, f32x4 v0, f32x4 v1) const {
        bf16_t* p; float sc = 1.f;
        if (u.pn == 100) { p = WcombT + (size_t)(u.pm * 256 + row) * 256 + col; sc = 0.08838834764831845f; }
        else if (u.pn >= 200) { p = WcatT + (size_t)(u.pm * 256 + row) * 3072 + 1024 + (u.pn - 200) * 256 + col; }
        else { p = WsT + (size_t)(u.pm * 256 + row) * 1024 + u.pn * 256 + col; }
        *(u32x4*)p = pack8(v0 * sc, v1 * sc);
    }
};
struct FInprojA {
    bf16_t* QKVP; bf16_t* RAW;
    __device__ __forceinline__ void st(const pg8::Unit& u, int row, int col, f32x4 v0, f32x4 v1) const {
        const size_t t = (size_t)u.pm * 256 + row;
        if (u.pn < 12) { *(u32x4*)(QKVP + t * 3072 + u.pn * 256 + col) = pack8(v0, v1); }
        else { *(u32x4*)(RAW + t * 768 + (u.pn - 12) * 256 + col) = pack8(v0, v1); }
    }
};
__device__ __forceinline__ f32x4 bf4(uint2 w) { f32x4 r; r[0] = bf2f((bf16_t)(w.x & 0xffff)); r[1] = bf2f((bf16_t)(w.x >> 16)); r[2] = bf2f((bf16_t)(w.y & 0xffff)); r[3] = bf2f((bf16_t)(w.y >> 16)); return r; }
struct FInprojB {
    bf16_t *Z, *GA, *GB; const bf16_t* ON;
    __device__ __forceinline__ void st(const pg8::Unit& u, int row, int col, f32x4 v0, f32x4 v1) const {
        const size_t t = (size_t)u.pm * 256 + row; const int which = u.pn >> 2, c = (u.pn & 3) * 256 + col;
        bf16_t* dst = Z + (size_t)which * ((size_t)16384 * 1024) + t * 1024 + c;
        if (which == 0) { const u32x4 on = *(const u32x4*)(ON + t * 1024 + c);
            f32x4 a0 = bf4(make_uint2(on.x, on.y)), a1 = bf4(make_uint2(on.z, on.w));
#pragma unroll
            for (int k = 0; k < 4; ++k) { a0[k] *= v0[k] / (1.f + __expf(-v0[k])); a1[k] *= v1[k] / (1.f + __expf(-v1[k])); }
            *(u32x4*)dst = pack8(a0, a1); }
        else *(u32x4*)dst = pack8(v0, v1);
    }
};
struct FStoreBf16 { bf16_t* O; int ldc; bf16_t* O2; int split;
    __device__ __forceinline__ void st(const pg8::Unit& u, int row, int col, f32x4 v0, f32x4 v1) const { bf16_t* base = (u.pm < split) ? O + (size_t)(u.pm * 256) * ldc : O2 + (size_t)((u.pm - split) * 256) * ldc;
        *(u32x4*)(base + (size_t)row * ldc + u.pn * 256 + col) = pack8(v0, v1); } };
struct FStoreF32 { float* O; int ldc;
    __device__ __forceinline__ void st(const pg8::Unit& u, int row, int col, f32x4 v0, f32x4 v1) const { float* p = O + (size_t)(u.pm * 256 + row) * ldc + u.pn * 256 + col; *(f32x4*)p = v0; *(f32x4*)(p + 4) = v1; } };
__device__ __forceinline__ f32x4 sig4(f32x4 v) { return (f32x4){sigmf(v[0]), sigmf(v[1]), sigmf(v[2]), sigmf(v[3])}; }
template <int SECOND> struct FMerge {
    const bf16_t* Gt; bf16_t* M;
    __device__ __forceinline__ void st(const pg8::Unit& u, int row, int col, f32x4 v0, f32x4 v1) const {
        const size_t o = (size_t)(u.pm * 256 + row) * 1024 + u.pn * 256 + col; const u32x4 g = *(const u32x4*)(Gt + o);
        f32x4 r0 = sig4(bf4(make_uint2(g.x, g.y))) * v0, r1 = sig4(bf4(make_uint2(g.z, g.w))) * v1;
        if (SECOND) { const u32x4 m = *(const u32x4*)(M + o); r0 += bf4(make_uint2(m.x, m.y)); r1 += bf4(make_uint2(m.z, m.w)); }
        *(u32x4*)(M + o) = pack8(r0, r1);
    }
};
struct FWo {
    const float* MOD; const float* x; float* X1;
    __device__ __forceinline__ void st(const pg8::Unit& u, int row, int col, f32x4 v0, f32x4 v1) const {
        const size_t t = (size_t)u.pm * 256 + row; const int c = u.pn * 256 + col; const int b = (int)(t >> 13);
        const float* gt = MOD + (size_t)b * 6144 + 2048 + c; const float* xr = x + t * 1024 + c; float* o = X1 + t * 1024 + c;
        *(f32x4*)o = *(const f32x4*)xr + *(const f32x4*)gt * v0; *(f32x4*)(o + 4) = *(const f32x4*)(xr + 4) + *(const f32x4*)(gt + 4) * v1;
    }
};
namespace idxk {
typedef short bf16x8 __attribute__((ext_vector_type(8)));
constexpr int NQ = 16, CAP = 768, CAPS = 772, THRESH = 512, KSEL = 256, L_ = 8192;
constexpr int L_VAL = 0, L_IDX = NQ * CAPS * 4, L_QF = 2 * NQ * CAPS * 4, L_HIST = L_QF + 16 * 64 * 16, L_CNT = L_HIST + 8 * 1024, L_TAU = L_CNT + 64, L_FLAG = L_TAU + 64, L_END = L_FLAG + 64, L_SIDX = 131072;
static_assert(L_END <= 131072, "indexer LDS map");
__device__ __forceinline__ unsigned sortable(float f) { const unsigned u = __builtin_bit_cast(unsigned, f); return (u & 0x80000000u) ? ~u : (u | 0x80000000u); }
__device__ __forceinline__ unsigned lanemask_lt_lo() { return __builtin_amdgcn_mbcnt_lo(~0u, 0u); }
__device__ __forceinline__ int mbcnt64(unsigned long long m) { return (int)__builtin_amdgcn_mbcnt_hi((unsigned)(m >> 32), __builtin_amdgcn_mbcnt_lo((unsigned)m, 0u)); }

#define DPPX_(v, CTRL) __builtin_amdgcn_update_dpp(0, (int)(v), CTRL, 0xF, 0xF, false)
__device__ __forceinline__ unsigned wave_and(unsigned v) { v &= (unsigned)DPPX_(v, 0xB1); v &= (unsigned)DPPX_(v, 0x4E); v &= (unsigned)DPPX_(v, 0x141); v &= (unsigned)DPPX_(v, 0x140);
    const unsigned a = (unsigned)__builtin_amdgcn_readlane((int)v, 0), b = (unsigned)__builtin_amdgcn_readlane((int)v, 16), c = (unsigned)__builtin_amdgcn_readlane((int)v, 32), d = (unsigned)__builtin_amdgcn_readlane((int)v, 48); return a & b & c & d; }
__device__ __forceinline__ unsigned wave_or(unsigned v) { v |= (unsigned)DPPX_(v, 0xB1); v |= (unsigned)DPPX_(v, 0x4E); v |= (unsigned)DPPX_(v, 0x141); v |= (unsigned)DPPX_(v, 0x140);
    const unsigned a = (unsigned)__builtin_amdgcn_readlane((int)v, 0), b = (unsigned)__builtin_amdgcn_readlane((int)v, 16), c = (unsigned)__builtin_amdgcn_readlane((int)v, 32), d = (unsigned)__builtin_amdgcn_readlane((int)v, 48); return a | b | c | d; }
__device__ __forceinline__ float wave_fmin(float v) {
#define FM_(CTRL) v = fminf(v, __builtin_bit_cast(float, DPPX_(__builtin_bit_cast(int, v), CTRL)))
    FM_(0xB1); FM_(0x4E); FM_(0x141); FM_(0x140);
#undef FM_
    const float a = __builtin_bit_cast(float, __builtin_amdgcn_readlane(__builtin_bit_cast(int, v), 0)), b = __builtin_bit_cast(float, __builtin_amdgcn_readlane(__builtin_bit_cast(int, v), 16)),
                c = __builtin_bit_cast(float, __builtin_amdgcn_readlane(__builtin_bit_cast(int, v), 32)), d = __builtin_bit_cast(float, __builtin_amdgcn_readlane(__builtin_bit_cast(int, v), 48));
    return fminf(fminf(a, b), fminf(c, d)); }
__device__ __forceinline__ float compact_query(LAS float* val, LAS unsigned* idx, LAS unsigned* hist, int cnt, int lane) {
    float v[12]; unsigned ix[12]; unsigned long long key[12];
    unsigned a_hi = ~0u, a_lo = ~0u, o_hi = 0u, o_lo = 0u;
#pragma unroll
    for (int r = 0; r < 12; ++r) { const int e = r * 64 + lane; v[r] = 0.f; ix[r] = 0u; key[r] = 0ull;
        if (e < cnt) { v[r] = val[e]; ix[r] = idx[e]; key[r] = ((unsigned long long)sortable(v[r]) << 13) | (unsigned long long)(8191u - ix[r]);
            a_hi &= (unsigned)(key[r] >> 32); a_lo &= (unsigned)key[r]; o_hi |= (unsigned)(key[r] >> 32); o_lo |= (unsigned)key[r]; } }
    const unsigned long long kand = ((unsigned long long)wave_and(a_hi) << 32) | wave_and(a_lo), kor = ((unsigned long long)wave_or(o_hi) << 32) | wave_or(o_lo);
    const unsigned long long diff = kand ^ kor;
    int fixed = 64 - (int)__builtin_clzll(diff);
    unsigned long long prefix = (fixed < 64) ? ((kor >> fixed) << fixed) : 0ull;
    int need = KSEL; bool done = false;
    while (!done) {
        const int shift = (fixed >= 8) ? fixed - 8 : 0; const unsigned mask = (1u << (fixed - shift)) - 1u;
        hist[lane * 4 + 0] = 0u; hist[lane * 4 + 1] = 0u; hist[lane * 4 + 2] = 0u; hist[lane * 4 + 3] = 0u;
        asm volatile("s_waitcnt lgkmcnt(0)" ::: "memory");
#pragma unroll
        for (int r = 0; r < 12; ++r) { const int e = r * 64 + lane;
            if (e < cnt && ((fixed >= 64) || ((key[r] >> fixed) == (prefix >> fixed)))) atomicAdd((unsigned*)&hist[(unsigned)(key[r] >> shift) & mask], 1u); }
        asm volatile("s_waitcnt lgkmcnt(0)" ::: "memory");
        const unsigned c0 = hist[lane * 4 + 0], c1 = hist[lane * 4 + 1], c2 = hist[lane * 4 + 2], c3 = hist[lane * 4 + 3];
        const unsigned loc = c0 + c1 + c2 + c3; unsigned suf = loc;
        suf += (unsigned)__builtin_amdgcn_update_dpp(0, (int)suf, 0x101, 0xF, 0xF, true); suf += (unsigned)__builtin_amdgcn_update_dpp(0, (int)suf, 0x102, 0xF, 0xF, true);
        suf += (unsigned)__builtin_amdgcn_update_dpp(0, (int)suf, 0x104, 0xF, 0xF, true); suf += (unsigned)__builtin_amdgcn_update_dpp(0, (int)suf, 0x108, 0xF, 0xF, true);
        { const unsigned t1 = (unsigned)__builtin_amdgcn_readlane((int)suf, 16), t2 = (unsigned)__builtin_amdgcn_readlane((int)suf, 32), t3 = (unsigned)__builtin_amdgcn_readlane((int)suf, 48);
          const int rw = lane >> 4; suf += (rw == 0) ? (t1 + t2 + t3) : (rw == 1) ? (t2 + t3) : (rw == 2) ? t3 : 0u; }
        unsigned cum = suf - loc; int fb = -1, fneed = 0, fcnt = 0;
        if (cum < (unsigned)need && (unsigned)need <= cum + c3) { fb = lane * 4 + 3; fneed = need - (int)cum; fcnt = (int)c3; } cum += c3;
        if (cum < (unsigned)need && (unsigned)need <= cum + c2) { fb = lane * 4 + 2; fneed = need - (int)cum; fcnt = (int)c2; } cum += c2;
        if (cum < (unsigned)need && (unsigned)need <= cum + c1) { fb = lane * 4 + 1; fneed = need - (int)cum; fcnt = (int)c1; } cum += c1;
        if (cum < (unsigned)need && (unsigned)need <= cum + c0) { fb = lane * 4 + 0; fneed = need - (int)cum; fcnt = (int)c0; }
        const unsigned long long bm = __ballot(fb >= 0); const int src = bm ? (int)__builtin_ctzll(bm) : 0;
        const int bin = __builtin_amdgcn_readlane(fb, src), nneed = __builtin_amdgcn_readlane(fneed, src), ncnt = __builtin_amdgcn_readlane(fcnt, src);
        prefix |= (unsigned long long)(unsigned)bin << shift; need = nneed; fixed = shift;
        if (ncnt == nneed || shift == 0) done = true;
    }
    int base = 0; float mn = 3.0e38f;
#pragma unroll
    for (int r = 0; r < 12; ++r) { const int e = r * 64 + lane; const bool keep = (e < cnt) && ((key[r] >> fixed) >= (prefix >> fixed));
        const unsigned long long m = __ballot(keep); const int pos = base + mbcnt64(m);
        if (keep) { val[pos] = v[r]; idx[pos] = ix[r]; mn = fminf(mn, v[r]); } base += (int)__builtin_popcountll(m); }
    return wave_fmin(mn);
}

struct IdxArgs { const bf16_t* QLATN; const bf16_t* KIDXN; const float* WIDX; const bf16_t* WiqT; int* IDX; };

__device__ __forceinline__ void index_task(const IdxArgs& A, LAS unsigned char* lds, int b, int q0) {
    int tx = threadIdx.x; asm volatile("" : "+v"(tx));
    const int wave = __builtin_amdgcn_readfirstlane(tx >> 6), lane = tx & 63, n = lane & 15, g = lane >> 4;
    LAS float* VAL = (LAS float*)(lds + L_VAL); LAS unsigned* IDXB = (LAS unsigned*)(lds + L_IDX); LAS unsigned* HIST = (LAS unsigned*)(lds + L_HIST) + wave * 256;
    LAS unsigned* CNT = (LAS unsigned*)(lds + L_CNT); LAS float* TAU = (LAS float*)(lds + L_TAU); LAS unsigned* FLAG = (LAS unsigned*)(lds + L_FLAG);
    const size_t trow = (size_t)b * L_ + q0;
    if (tx < NQ) { CNT[tx] = 0u; TAU[tx] = -__builtin_inff(); } if (tx < 3) FLAG[tx] = 0u;
    {
        bf16x8 qb[8];
#pragma unroll
        for (int kk = 0; kk < 8; ++kk) qb[kk] = *(const bf16x8*)(A.QLATN + (trow + n) * 256 + kk * 32 + 8 * g);
#pragma unroll
        for (int s = 0; s < 2; ++s) {
            f32x4 x1 = {0.f, 0.f, 0.f, 0.f}, x2 = {0.f, 0.f, 0.f, 0.f};
            const int r = n, d1 = 32 * s + 8 * (r >> 2) + (r & 3), d2 = d1 + 4;
            const bf16_t* w1 = A.WiqT + (size_t)(wave * 64 + d1) * 256 + 8 * g; const bf16_t* w2 = A.WiqT + (size_t)(wave * 64 + d2) * 256 + 8 * g;
#pragma unroll
            for (int kk = 0; kk < 8; ++kk) { const bf16x8 a1 = *(const bf16x8*)(w1 + kk * 32), a2 = *(const bf16x8*)(w2 + kk * 32);
                x1 = __builtin_amdgcn_mfma_f32_16x16x32_bf16(a1, qb[kk], x1, 0, 0, 0); x2 = __builtin_amdgcn_mfma_f32_16x16x32_bf16(a2, qb[kk], x2, 0, 0, 0); }
            u32x4 fr; fr.x = pk2bf(x1[0], x1[1]); fr.y = pk2bf(x1[2], x1[3]); fr.z = pk2bf(x2[0], x2[1]); fr.w = pk2bf(x2[2], x2[3]);
            *(LAS u32x4*)(lds + L_QF + ((wave * 2 + s) * 64 + lane) * 16) = fr;
        }
    }
    __syncthreads();
    bf16x8 qf[8][2];
#pragma unroll
    for (int h = 0; h < 8; ++h)
#pragma unroll
        for (int s = 0; s < 2; ++s) qf[h][s] = *(const LAS bf16x8*)(lds + L_QF + ((h * 2 + s) * 64 + lane) * 16);
    float wq[8];
    { const f32x4 w0 = *(const f32x4*)(A.WIDX + (trow + n) * 8), w1 = *(const f32x4*)(A.WIDX + (trow + n) * 8 + 4);
      wq[0] = w0[0]; wq[1] = w0[1]; wq[2] = w0[2]; wq[3] = w0[3]; wq[4] = w1[0]; wq[5] = w1[1]; wq[6] = w1[2]; wq[7] = w1[3]; }
    const int qpos = q0 + n, kmax = q0 + 15;
    const int nst = (kmax >> 8) + 1;
    const bf16_t* kbase = A.KIDXN + (size_t)b * L_ * 64;
    bf16x8 ka[2][2];
#pragma unroll
    for (int blk = 0; blk < 2; ++blk) { const int kb = 32 * wave + 16 * blk; if (kb <= kmax) { const bf16_t* kr = kbase + (size_t)(kb + n) * 64 + 8 * g; ka[blk][0] = *(const bf16x8*)kr; ka[blk][1] = *(const bf16x8*)(kr + 32); } }
    for (int j = 0, jf = 0; j < nst; ++j, jf = (jf == 2) ? 0 : jf + 1) {
        const float tau = TAU[n];
        bf16x8 kc[2][2];
#pragma unroll
        for (int blk = 0; blk < 2; ++blk) { kc[blk][0] = ka[blk][0]; kc[blk][1] = ka[blk][1];
            const int kbn = 256 * (j + 1) + 32 * wave + 16 * blk; if (kbn <= kmax) { const bf16_t* kr = kbase + (size_t)(kbn + n) * 64 + 8 * g; ka[blk][0] = *(const bf16x8*)kr; ka[blk][1] = *(const bf16x8*)(kr + 32); } }
#pragma unroll
        for (int blk = 0; blk < 2; ++blk) {
            const int kb = 256 * j + 32 * wave + 16 * blk;
            if (kb <= kmax) {
                const bf16x8 a0 = kc[blk][0], a1 = kc[blk][1];
                float sc[4] = {0.f, 0.f, 0.f, 0.f};
                f32x4 acc[8];
#pragma unroll
                for (int h = 0; h < 8; ++h) acc[h] = __builtin_amdgcn_mfma_f32_16x16x32_bf16(a0, qf[h][0], (f32x4){0.f, 0.f, 0.f, 0.f}, 0, 0, 0);
#pragma unroll
                for (int h = 0; h < 8; ++h) acc[h] = __builtin_amdgcn_mfma_f32_16x16x32_bf16(a1, qf[h][1], acc[h], 0, 0, 0);
                __builtin_amdgcn_sched_barrier(0);
#pragma unroll
                for (int h = 0; h < 8; ++h) {
#pragma unroll
                    for (int i = 0; i < 4; ++i) sc[i] = fmaf(wq[h], fmaxf(acc[h][i], 0.f), sc[i]); }
                bool ps[4]; int np = 0;
#pragma unroll
                for (int i = 0; i < 4; ++i) { const int key = kb + 4 * g + i; ps[i] = (key <= qpos) && (sc[i] > tau); np += ps[i] ? 1 : 0; }
                if (np) {
                    unsigned pos = __hip_atomic_fetch_add((unsigned*)&CNT[n], (unsigned)np, __ATOMIC_RELAXED, __HIP_MEMORY_SCOPE_WORKGROUP);
                    if (pos + np > THRESH) FLAG[jf] = 1u;
#pragma unroll
                    for (int i = 0; i < 4; ++i) if (ps[i]) { VAL[n * CAPS + pos] = sc[i]; IDXB[n * CAPS + pos] = (unsigned)(kb + 4 * g + i); ++pos; }
                }
            }
        }
        asm volatile("s_waitcnt lgkmcnt(0)\n\ts_barrier" ::: "memory");
        if (tx == 0) FLAG[jf == 0 ? 2 : jf - 1] = 0u;
        if (FLAG[jf]) {
#pragma unroll
            for (int qq = 0; qq < 2; ++qq) { const int q = wave * 2 + qq; const int c = (int)CNT[q];
                if (c > 384) { const float t = compact_query(VAL + q * CAPS, IDXB + q * CAPS, HIST, c, lane); if (lane == 0) { TAU[q] = t; CNT[q] = KSEL; } } }
            __syncthreads();
        }
    }
#pragma unroll
    for (int qq = 0; qq < 2; ++qq) { const int q = wave * 2 + qq; int c = (int)CNT[q];
        if (c > KSEL) { (void)compact_query(VAL + q * CAPS, IDXB + q * CAPS, HIST, c, lane); c = KSEL; }
        asm volatile("s_waitcnt lgkmcnt(0)" ::: "memory");
        HIST[lane * 4 + 0] = 0u; HIST[lane * 4 + 1] = 0u; HIST[lane * 4 + 2] = 0u; HIST[lane * 4 + 3] = 0u;
        asm volatile("s_waitcnt lgkmcnt(0)" ::: "memory");
        for (int e = lane; e < c; e += 64) { const unsigned k = IDXB[q * CAPS + e]; atomicOr((unsigned*)&HIST[k >> 5], 1u << (k & 31u)); }
        asm volatile("s_waitcnt lgkmcnt(0)" ::: "memory");
        unsigned wd[4]; int pc = 0;
#pragma unroll
        for (int i = 0; i < 4; ++i) { wd[i] = HIST[lane * 4 + i]; pc += (int)__builtin_popcount(wd[i]); }
        int incl = pc;
#pragma unroll
        for (int o = 1; o < 64; o <<= 1) { const int t = __shfl_up(incl, o); if (lane >= o) incl += t; }
        LAS int* out = (LAS int*)(lds + L_SIDX) + q * KSEL; int pos = incl - pc;
#pragma unroll
        for (int i = 0; i < 4; ++i) { unsigned w = wd[i]; while (w) { const int bit = __builtin_ctz(w); w &= w - 1u; out[pos++] = (lane * 4 + i) * 32 + bit; } }
#pragma unroll
        for (int e = lane; e < KSEL; e += 64) if (e >= c) out[e] = -1; }
    __syncthreads();
}
__device__ __forceinline__ void index_phase(const IdxArgs& A, LAS unsigned char* lds, int bx, int G) {
    if (G == 256) { for (int k = 0; k < 4; ++k) { const int b = k >> 1, qt = (k & 1) ? 511 - bx : bx; index_task(A, lds, b, qt * 16); } }
    else { for (int id = bx; id < 1024; id += G) index_task(A, lds, id >> 9, (id & 511) * 16); }
}
}
namespace sattn {
typedef short bf16x8 __attribute__((ext_vector_type(8)));
typedef short s16x4 __attribute__((ext_vector_type(4)));
typedef unsigned u32x2_t __attribute__((ext_vector_type(2)));
typedef __attribute__((ext_vector_type(4))) short v4i16_t;
__device__ __forceinline__ s16x4 vtr(LAS unsigned char* p) { return __builtin_bit_cast(s16x4, __builtin_amdgcn_ds_read_tr16_b64_v4i16((LAS v4i16_t*)p)); }
constexpr int QSPLIT = 12288;
__device__ __forceinline__ void dma16(const void* gsrc, unsigned lds_dst) { unsigned keep; asm volatile("s_mov_b32 %0, m0\n\ts_mov_b32 m0, %2\n\ts_nop 0\n\tglobal_load_lds_dwordx4 %1, off\n\ts_mov_b32 m0, %0" : "=&s"(keep) : "v"(gsrc), "s"(lds_dst) : "memory"); }
struct AArgs { const bf16_t* CKVN; bf16_t* Q0; bf16_t* Q1; };

__device__ __forceinline__ void attn_query(const AArgs& A, LAS unsigned char* tile, int t, int lane, const LAS int* sidx) {
    const int n = lane & 15, g = lane >> 4, b = t >> 13, l = t & 8191;
    const int nv = (l + 1 < 256) ? l + 1 : 256;
    const bf16_t* ckv = A.CKVN + (size_t)b * 8192 * 256;
    bf16_t* qrow = (t < QSPLIT) ? A.Q0 + (size_t)t * 2048 : A.Q1 + (size_t)(t - QSPLIT) * 2048;
    bf16x8 qf[8];
#pragma unroll
    for (int s = 0; s < 8; ++s) { qf[s] = (bf16x8){0, 0, 0, 0, 0, 0, 0, 0}; if (n < 8) qf[s] = *(const bf16x8*)(qrow + n * 256 + 32 * s + 8 * g); }
    f32x4 o[16];
#pragma unroll
    for (int c = 0; c < 16; ++c) o[c] = (f32x4){0.f, 0.f, 0.f, 0.f};
    float mrun = -3.0e38f, lsum = 0.f;
    const int nblk = (nv + 15) >> 4;
    asm volatile("s_waitcnt vmcnt(0) lgkmcnt(0)" ::: "memory");
#pragma unroll
    for (int s = 0; s < 8; ++s) asm volatile("" : "+v"(qf[s]));
#define ATT_ISSUE(J) do { const int k_ = (J) * 16 + n; int my_ = (k_ < nv) ? sidx[k_] : 0; if (my_ < 0) my_ = 0; const unsigned dst_ = tbase + ((J) & 1) * 8192u; \
        _Pragma("unroll") for (int i = 0; i < 8; ++i) { const int r = 2 * i + (lane >> 5); const int row = __shfl(my_, r); \
            const bf16_t* src = ckv + (size_t)row * 256 + (((lane & 31) ^ r) << 3); \
            dma16(src, dst_ + i * 1024u); } } while (0)
    const unsigned tbase = (unsigned)__builtin_amdgcn_readfirstlane((int)(unsigned)(size_t)tile);
    ATT_ISSUE(0);
    for (int j = 0; j < nblk; ++j) {
        LAS unsigned char* buf = tile + (j & 1) * 8192;
        if (j + 1 < nblk) { ATT_ISSUE(j + 1); asm volatile("s_waitcnt vmcnt(8)" ::: "memory"); }
        else asm volatile("s_waitcnt vmcnt(0)" ::: "memory");
        __builtin_amdgcn_sched_barrier(0);
        f32x4 s0 = {0.f, 0.f, 0.f, 0.f};
#pragma unroll
        for (int s = 0; s < 8; ++s) s0 = __builtin_amdgcn_mfma_f32_16x16x32_bf16(*(const LAS bf16x8*)(buf + n * 512 + (((4 * s + g) ^ n) << 4)), qf[s], s0, 0, 0, 0);
        const int k0 = j * 16 + 4 * g;
        float bm = -3.0e38f;
#pragma unroll
        for (int i = 0; i < 4; ++i) { if (k0 + i >= nv) s0[i] = -3.0e38f; bm = fmaxf(bm, s0[i]); }
        bm = fmaxf(bm, __shfl_xor(bm, 16)); bm = fmaxf(bm, __shfl_xor(bm, 32));
        const float mnew = fmaxf(mrun, bm), alpha = __expf(mrun - mnew); const bool grow = mnew > mrun; mrun = mnew;
        float p[4]; float ps = 0.f;
#pragma unroll
        for (int i = 0; i < 4; ++i) { p[i] = (k0 + i < nv) ? __expf(s0[i] - mnew) : 0.f; ps += p[i]; }
        lsum = lsum * alpha + ps;
        const s16x4 pf = __builtin_bit_cast(s16x4, (u32x2_t){pk2bf(p[0], p[1]), pk2bf(p[2], p[3])});
        if (__any(grow)) {
#pragma unroll
            for (int c = 0; c < 16; ++c) o[c] = o[c] * alpha;
        }
        const int q4 = (lane & 15) >> 2, p4 = lane & 3, r0 = 4 * g + q4;
#pragma unroll
        for (int c = 0; c < 16; ++c) { const int ch = 2 * c + (p4 >> 1);
            const s16x4 af = vtr(buf + r0 * 512 + ((ch ^ r0) << 4) + ((p4 & 1) << 3));
            o[c] = __builtin_amdgcn_mfma_f32_16x16x16bf16_1k(af, pf, o[c], 0, 0, 0); }
        asm volatile("s_waitcnt lgkmcnt(0)" ::: "memory");
    }
#undef ATT_ISSUE
    lsum += __shfl_xor(lsum, 16); lsum += __shfl_xor(lsum, 32);
    const float inv = 1.f / lsum;
    if (n < 8) {
#pragma unroll
        for (int c = 0; c < 16; ++c) { const f32x4 v = o[c] * inv; *(uint2*)(qrow + n * 256 + 16 * c + 4 * g) = make_uint2(pk2bf(v[0], v[1]), pk2bf(v[2], v[3])); }
    }
}
}
namespace dsa {
struct DArgs { idxk::IdxArgs I; sattn::AArgs A; unsigned* qword; };
__device__ __forceinline__ void dsa_task(const DArgs& D, LAS unsigned char* lds, int b, int q0) {
    idxk::index_task(D.I, lds, b, q0);
    int tx = threadIdx.x; asm volatile("" : "+v"(tx));
    const int wave = __builtin_amdgcn_readfirstlane(tx >> 6), lane = tx & 63;
#pragma unroll 1
    for (int qq = 0; qq < 2; ++qq) { const int q = 2 * wave + qq;
        sattn::attn_query(D.A, lds + wave * 16384, b * 8192 + q0 + q, lane, (const LAS int*)(lds + idxk::L_SIDX) + q * 256); }
    asm volatile("s_waitcnt vmcnt(0) lgkmcnt(0)" ::: "memory");
    __syncthreads();
}
__device__ __forceinline__ void dsa_queue(const DArgs& D, LAS unsigned char* lds, volatile LAS unsigned* slot) {
    for (;;) {
        if (threadIdx.x == 0) *slot = __hip_atomic_fetch_add(D.qword, 1u, __ATOMIC_RELAXED, __HIP_MEMORY_SCOPE_AGENT);
        __syncthreads();
        const unsigned id = *slot;
        __syncthreads();
        if (id >= 1024u) break;
        dsa_task(D, lds, (int)(id & 1u), (511 - (int)(id >> 1)) * 16);
    }
}
}
namespace dnet {
typedef short bf16x8 __attribute__((ext_vector_type(8)));
typedef unsigned u32x2_t __attribute__((ext_vector_type(2)));
typedef __attribute__((ext_vector_type(4))) short v4i16p_t;
__device__ __forceinline__ float bflo(unsigned w) { return __builtin_bit_cast(float, w << 16); }
__device__ __forceinline__ float bfhi(unsigned w) { return __builtin_bit_cast(float, w & 0xffff0000u); }
#define DPP_ADDF(v, CTRL) v += __builtin_bit_cast(float, __builtin_amdgcn_update_dpp(0, __builtin_bit_cast(int, v), CTRL, 0xF, 0xF, false))
__device__ __forceinline__ void conv_phase(const bf16_t* QKVP, bf16_t* QKVN, const float* convw, int gw, int NGW, int lane) {
    for (int it = gw; it < 1024 * 6; it += NGW) {
        const int slab = it % 6, tb = it / 6, t0 = tb * 16, ch = slab * 512 + lane * 8;
        float w[4][8];
#pragma unroll
        for (int i = 0; i < 4; ++i) { const f32x4 a = *(const f32x4*)(convw + (size_t)i * 3072 + ch), b = *(const f32x4*)(convw + (size_t)i * 3072 + ch + 4);
            w[i][0] = a[0]; w[i][1] = a[1]; w[i][2] = a[2]; w[i][3] = a[3]; w[i][4] = b[0]; w[i][5] = b[1]; w[i][6] = b[2]; w[i][7] = b[3]; }
        u32x4 r0 = {0u, 0u, 0u, 0u}, r1 = r0, r2 = r0;
        if ((t0 & 8191) != 0) { r0 = *(const u32x4*)(QKVP + (size_t)(t0 - 3) * 3072 + ch); r1 = *(const u32x4*)(QKVP + (size_t)(t0 - 2) * 3072 + ch); r2 = *(const u32x4*)(QKVP + (size_t)(t0 - 1) * 3072 + ch); }
        u32x4 rows[16];
#pragma unroll
        for (int tt = 0; tt < 16; ++tt) rows[tt] = *(const u32x4*)(QKVP + (size_t)(t0 + tt) * 3072 + ch);
#pragma unroll
        for (int tt = 0; tt < 16; ++tt) {
            const u32x4 r3 = rows[tt];
            float y[8];
#pragma unroll
            for (int e = 0; e < 4; ++e) {
                const float a0 = bflo(r0[e]) * w[0][2 * e] + bflo(r1[e]) * w[1][2 * e] + bflo(r2[e]) * w[2][2 * e] + bflo(r3[e]) * w[3][2 * e];
                const float a1 = bfhi(r0[e]) * w[0][2 * e + 1] + bfhi(r1[e]) * w[1][2 * e + 1] + bfhi(r2[e]) * w[2][2 * e + 1] + bfhi(r3[e]) * w[3][2 * e + 1];
                y[2 * e] = a0 / (1.f + __expf(-a0)); y[2 * e + 1] = a1 / (1.f + __expf(-a1)); }
            if (slab < 4) {
                float ss = 0.f;
#pragma unroll
                for (int e = 0; e < 8; ++e) ss += y[e] * y[e];
                DPP_ADDF(ss, 0xB1); DPP_ADDF(ss, 0x4E); DPP_ADDF(ss, 0x141); DPP_ADDF(ss, 0x140);
                const float rs = 1.f / sqrtf(ss + 1e-6f);
#pragma unroll
                for (int e = 0; e < 8; ++e) y[e] *= rs;
            }
            u32x4 o; o.x = pk2bf(y[0], y[1]); o.y = pk2bf(y[2], y[3]); o.z = pk2bf(y[4], y[5]); o.w = pk2bf(y[6], y[7]);
            *(u32x4*)(QKVN + (size_t)(t0 + tt) * 3072 + ch) = o;
            r0 = r1; r1 = r2; r2 = r3;
        }
    }
}
constexpr int PR = 272, L_QN = 0, L_KN = 64 * PR, L_V = 2 * 64 * PR, L_A = 3 * 64 * PR, L_SM = 4 * 64 * PR, L_TI = L_SM + 5 * 256, L_PEND = L_TI + 4 * 16 * 16 * 2;
struct PrepArgs { bf16_t* QKVN; const float* BETA; const float* G; bf16_t* W; bf16_t* ATT; float* GL; };
__device__ __forceinline__ float dpp_swap1(float v) { return __builtin_bit_cast(float, __builtin_amdgcn_update_dpp(0, __builtin_bit_cast(int, v), 0xB1, 0xF, 0xF, false)); }
__device__ __forceinline__ void prep_chunk(const PrepArgs& A, LAS unsigned char* lds, int cid) {
    int tx = threadIdx.x; asm volatile("" : "+v"(tx));
    const int wave = __builtin_amdgcn_readfirstlane(tx >> 6), lane = tx & 63, n = lane & 15, g = lane >> 4;
    const int nc = cid & 127, h = (cid >> 7) & 7, b = cid >> 10; const size_t t0 = (size_t)b * 8192 + nc * 64;
    LAS float* SM = (LAS float*)(lds + L_SM);
    for (int i = tx; i < 3 * 64 * 16; i += 512) { const int which = i / 1024, r = (i >> 4) & 63, c16 = i & 15;
        const u32x4 v = *(const u32x4*)(A.QKVN + (t0 + r) * 3072 + which * 1024 + h * 128 + c16 * 8);
        *(LAS u32x4*)(lds + which * 64 * PR + r * PR + c16 * 16) = v; }
    if (wave == 0) {
        float gg = A.G[(t0 + lane) * 8 + h]; const float be = A.BETA[(t0 + lane) * 8 + h];
#pragma unroll
        for (int o = 1; o < 64; o <<= 1) { const float t = __shfl_up(gg, o); if (lane >= o) gg += t; }
        const float gl = __shfl(gg, 63);
        SM[lane] = be; SM[64 + lane] = gg; SM[128 + lane] = __expf(gg); SM[192 + lane] = __expf(gl - gg);
        if (lane == 0) A.GL[cid] = __expf(gl);
    }
    __syncthreads();
#pragma unroll
    for (int q = 0; q < 4; ++q) {
        const int tl = wave * 4 + q, isq = tl >> 4, mi = (tl >> 2) & 3, nj = tl & 3;
        if (nj > mi) continue;
        f32x4 acc = {0.f, 0.f, 0.f, 0.f};
        const LAS unsigned char* ar = lds + (isq ? L_QN : L_KN) + (16 * mi + n) * PR + 16 * g; const LAS unsigned char* br = lds + L_KN + (16 * nj + n) * PR + 16 * g;
#pragma unroll
        for (int s = 0; s < 4; ++s) acc = __builtin_amdgcn_mfma_f32_16x16x32_bf16(*(const LAS bf16x8*)(ar + 64 * s), *(const LAS bf16x8*)(br + 64 * s), acc, 0, 0, 0);
        const int j = 16 * nj + n; const float gcj = SM[64 + j];
#pragma unroll
        for (int r = 0; r < 4; ++r) { const int i = 16 * mi + 4 * g + r; const float dec = __expf(fminf(SM[64 + i] - gcj, 0.f));
            if (isq) A.ATT[(size_t)cid * 4096 + i * 64 + j] = f2bfd((j <= i) ? acc[r] * 0.08838834764831845f * dec : 0.f);
            else *(LAS float*)(lds + L_A + i * PR + j * 4) = (j < i) ? SM[i] * acc[r] * dec : 0.f; }
    }
    for (int i = tx; i < 64 * 64; i += 512) { const int r = i >> 6, c = i & 63; if ((c >> 4) > (r >> 4)) { *(LAS float*)(lds + L_A + r * PR + c * 4) = 0.f; A.ATT[(size_t)cid * 4096 + r * 64 + c] = 0; } }
    __syncthreads();
    if (wave < 4 && lane < 16) {
        float tcol[16];
#pragma unroll
        for (int i = 0; i < 16; ++i) { float s = (i == lane) ? 1.f : 0.f;
#pragma unroll
            for (int j = 0; j < i; ++j) s = fmaf(-*(const LAS float*)(lds + L_A + (16 * wave + i) * PR + (16 * wave + j) * 4), tcol[j], s);
            tcol[i] = s; }
#pragma unroll
        for (int i = 0; i < 16; ++i) *(LAS bf16_t*)(lds + L_TI + ((wave * 16 + i) * 16 + lane) * 2) = f2bfd(tcol[i] - ((i == lane) ? 1.f : 0.f));
    }
    __syncthreads();
    {
        const int q4 = n >> 2, p4 = n & 3;
#pragma unroll 1
        for (int tt = 0; tt < 2; ++tt) {
            const int col0 = 32 * wave + 16 * tt; const bool isw = col0 >= 128;
            const LAS unsigned char* srcm = lds + (isw ? L_KN + (col0 - 128) * 2 : L_V + col0 * 2);
            typedef short s16x4_t __attribute__((ext_vector_type(4)));
            s16x4_t xb[4];
#pragma unroll
            for (int bb = 0; bb < 4; ++bb) {
                const s16x4_t r4 = __builtin_bit_cast(s16x4_t, __builtin_amdgcn_ds_read_tr16_b64_v4i16((LAS v4i16p_t*)(srcm + (16 * bb + 4 * g + q4) * PR + 8 * p4)));
                f32x4 acc;
#pragma unroll
                for (int r = 0; r < 4; ++r) { const int i = 16 * bb + 4 * g + r; float sc = SM[i]; if (isw) sc *= SM[128 + i]; acc[r] = __builtin_bit_cast(float, (unsigned)(unsigned short)r4[r] << 16) * sc; }
#pragma unroll
                for (int bp = 0; bp < bb; ++bp) { const f32x4 av = *(const LAS f32x4*)(lds + L_A + (16 * bb + n) * PR + (16 * bp + 4 * g) * 4);
                    u32x2_t w; w.x = pk2bf(-av[0], -av[1]); w.y = pk2bf(-av[2], -av[3]);
                    acc = __builtin_amdgcn_mfma_f32_16x16x16bf16_1k(__builtin_bit_cast(s16x4_t, w), xb[bp], acc, 0, 0, 0); }
                { u32x2_t w; w.x = pk2bf(acc[0], acc[1]); w.y = pk2bf(acc[2], acc[3]);
                  const s16x4_t ti = *(const LAS s16x4_t*)(lds + L_TI + ((bb * 16 + n) * 16 + 4 * g) * 2);
                  acc = __builtin_amdgcn_mfma_f32_16x16x16bf16_1k(ti, __builtin_bit_cast(s16x4_t, w), acc, 0, 0, 0); }
                { u32x2_t w; w.x = pk2bf(acc[0], acc[1]); w.y = pk2bf(acc[2], acc[3]); xb[bb] = __builtin_bit_cast(s16x4_t, w); }
                if (!isw) {
#pragma unroll
                    for (int r = 0; r < 4; ++r) A.QKVN[(t0 + 16 * bb + 4 * g + r) * 3072 + 2048 + h * 128 + col0 + n] = f2bfd(acc[r]);
                } else {
#pragma unroll
                    for (int r = 0; r < 4; ++r) A.W[((size_t)cid * 64 + 16 * bb + 4 * g + r) * 128 + (col0 - 128) + n] = f2bfd(acc[r]);
                }
            }
        }
    }
    for (int i = tx; i < 2 * 64 * 16; i += 512) { const int which = i >> 10, r = (i >> 4) & 63, c16 = i & 15;
        const u32x4 v = *(const LAS u32x4*)(lds + which * 64 * PR + r * PR + c16 * 16); const float f = which ? SM[192 + r] : SM[128 + r] * 0.08838834764831845f;
        u32x4 o; o.x = pk2bf(bflo(v.x) * f, bfhi(v.x) * f); o.y = pk2bf(bflo(v.y) * f, bfhi(v.y) * f); o.z = pk2bf(bflo(v.z) * f, bfhi(v.z) * f); o.w = pk2bf(bflo(v.w) * f, bfhi(v.w) * f);
        *(u32x4*)(A.QKVN + (t0 + r) * 3072 + which * 1024 + h * 128 + c16 * 8) = o; }
    __syncthreads();
}
__device__ __forceinline__ void prep_phase(const PrepArgs& A, LAS unsigned char* lds, int bx, int G) { for (int cid = bx; cid < 2048; cid += G) prep_chunk(A, lds, cid); }
}
namespace dnet {
typedef short s16x4 __attribute__((ext_vector_type(4)));
typedef __attribute__((ext_vector_type(4))) short v4i16_t;
__device__ __forceinline__ s16x4 vtr(const LAS unsigned char* p) { return __builtin_bit_cast(s16x4, __builtin_amdgcn_ds_read_tr16_b64_v4i16((LAS v4i16_t*)p)); }
constexpr int PA = 144, S_W = 0, S_QD = 64 * PR, S_KD = 2 * 64 * PR, S_U = 3 * 64 * PR, S_ATT = 4 * 64 * PR, S_OBUF = S_ATT + 64 * PA, S_END = S_OBUF + 64 * PR;
static_assert(S_END <= 131072, "scan LDS map");
struct ScanArgs { const bf16_t* QKVN; const bf16_t* W; const bf16_t* ATT; const float* GL; bf16_t* O; const float* onw; };
__device__ __forceinline__ bf16x8 frag2(const LAS unsigned char* p) { return *(const LAS bf16x8*)p; }
typedef unsigned u32x2 __attribute__((ext_vector_type(2)));
__device__ __forceinline__ int perm_half(int c, int hh) { const int k = 8 * c + 4 * hh; return (k < 16) ? 16 * (k >> 2) : 16 * ((k - 16) >> 2) + 8; }
__device__ __forceinline__ void scan_bh(const ScanArgs& A, LAS unsigned char* lds, int bh) {
    int tx = threadIdx.x; asm volatile("" : "+v"(tx));
    const int wave = __builtin_amdgcn_readfirstlane(tx >> 6), lane = tx & 63, n = lane & 15, g = lane >> 4, q4 = n >> 2, p4 = n & 3;
    const int b = bh >> 3, h = bh & 7, e0 = 16 * wave;
    const int sr = tx >> 3, sc = tx & 7;
    (void)sr; (void)sc;
    u32x4 pfA[9], pfB[9];
    auto issue = [&](u32x4 (&pf)[9], int nc_) { const int nc = nc_ < 127 ? nc_ : 127;
        const size_t t0 = (size_t)b * 8192 + nc * 64; const int cid = bh * 128 + nc;
#pragma unroll
        for (int i = 0; i < 2; ++i) { const int p = tx + 512 * i, r = p >> 4, c = p & 15;
            pf[i] = *(const u32x4*)(A.W + ((size_t)cid * 64 + r) * 128 + c * 8);
            pf[2 + i] = *(const u32x4*)(A.QKVN + (t0 + r) * 3072 + h * 128 + c * 8);
            pf[4 + i] = *(const u32x4*)(A.QKVN + (t0 + r) * 3072 + 1024 + h * 128 + c * 8);
            pf[6 + i] = *(const u32x4*)(A.QKVN + (t0 + r) * 3072 + 2048 + h * 128 + c * 8); }
        pf[8] = *(const u32x4*)(A.ATT + (size_t)cid * 4096 + tx * 8);
    };
    auto commit = [&](const u32x4 (&pf)[9]) {
#pragma unroll
        for (int i = 0; i < 2; ++i) { const int p = tx + 512 * i, r = p >> 4, c = p & 15, kg = c >> 2, cc = c & 3;
            LAS unsigned char* wq = lds + r * PR + kg * 64;
            *(LAS u32x2*)(wq + S_W + perm_half(cc, 0)) = (u32x2){pf[i].x, pf[i].y}; *(LAS u32x2*)(wq + S_W + perm_half(cc, 1)) = (u32x2){pf[i].z, pf[i].w};
            *(LAS u32x2*)(wq + S_QD + perm_half(cc, 0)) = (u32x2){pf[2 + i].x, pf[2 + i].y}; *(LAS u32x2*)(wq + S_QD + perm_half(cc, 1)) = (u32x2){pf[2 + i].z, pf[2 + i].w};
            *(LAS u32x4*)(lds + S_KD + r * PR + c * 16) = pf[4 + i]; *(LAS u32x4*)(lds + S_U + r * PR + c * 16) = pf[6 + i]; }
        { const int r = tx >> 3, c = tx & 7, kg = c >> 2, cc = c & 3; LAS unsigned char* wa = lds + S_ATT + r * PA + kg * 64;
          *(LAS u32x2*)(wa + perm_half(cc, 0)) = (u32x2){pf[8].x, pf[8].y}; *(LAS u32x2*)(wa + perm_half(cc, 1)) = (u32x2){pf[8].z, pf[8].w}; }
    };
    const float gl_lo = A.GL[bh * 128 + lane], gl_hi = A.GL[bh * 128 + 64 + lane];
    f32x4 S[8];
#pragma unroll
    for (int d = 0; d < 8; ++d) S[d] = (f32x4){0.f, 0.f, 0.f, 0.f};
    auto compute = [&](int nc) {
        const float gl = __builtin_bit_cast(float, (nc < 64) ? __builtin_amdgcn_readlane(__builtin_bit_cast(int, gl_lo), nc & 63) : __builtin_amdgcn_readlane(__builtin_bit_cast(int, gl_hi), nc & 63));
        const size_t t0 = (size_t)b * 8192 + nc * 64;
        bf16x8 sp[4];
#pragma unroll
        for (int s = 0; s < 4; ++s) { u32x4 w; w.x = pk2bf(S[2 * s][0], S[2 * s][1]); w.y = pk2bf(S[2 * s][2], S[2 * s][3]); w.z = pk2bf(S[2 * s + 1][0], S[2 * s + 1][1]); w.w = pk2bf(S[2 * s + 1][2], S[2 * s + 1][3]);
            sp[s] = __builtin_bit_cast(bf16x8, w); }
        f32x4 vn[4];
#pragma unroll
        for (int mt = 0; mt < 4; ++mt) {
            const s16x4 u4 = vtr(lds + S_U + (16 * mt + 4 * g + q4) * PR + (e0 + 4 * p4) * 2);
            f32x4 acc; acc[0] = __builtin_bit_cast(float, ((unsigned)(unsigned short)u4[0] << 16) ^ 0x80000000u); acc[1] = __builtin_bit_cast(float, ((unsigned)(unsigned short)u4[1] << 16) ^ 0x80000000u);
            acc[2] = __builtin_bit_cast(float, ((unsigned)(unsigned short)u4[2] << 16) ^ 0x80000000u); acc[3] = __builtin_bit_cast(float, ((unsigned)(unsigned short)u4[3] << 16) ^ 0x80000000u);
            const LAS unsigned char* wr = lds + S_W + (16 * mt + n) * PR + 16 * g;
#pragma unroll
            for (int s = 0; s < 4; ++s) acc = __builtin_amdgcn_mfma_f32_16x16x32_bf16(frag2(wr + 64 * s), sp[s], acc, 0, 0, 0);
            vn[mt] = acc;
        }
        bf16x8 vp[2];
#pragma unroll
        for (int s = 0; s < 2; ++s) { u32x4 w; w.x = pk2bf(vn[2 * s][0], vn[2 * s][1]); w.y = pk2bf(vn[2 * s][2], vn[2 * s][3]); w.z = pk2bf(vn[2 * s + 1][0], vn[2 * s + 1][1]); w.w = pk2bf(vn[2 * s + 1][2], vn[2 * s + 1][3]);
            w.x ^= 0x80008000u; w.y ^= 0x80008000u; w.z ^= 0x80008000u; w.w ^= 0x80008000u; vp[s] = __builtin_bit_cast(bf16x8, w); }
#pragma unroll
        for (int mt = 0; mt < 4; ++mt) {
            f32x4 acc = {0.f, 0.f, 0.f, 0.f};
            const LAS unsigned char* qr = lds + S_QD + (16 * mt + n) * PR + 16 * g; const LAS unsigned char* ar = lds + S_ATT + (16 * mt + n) * PA + 16 * g;
#pragma unroll
            for (int s = 0; s < 4; ++s) acc = __builtin_amdgcn_mfma_f32_16x16x32_bf16(frag2(qr + 64 * s), sp[s], acc, 0, 0, 0);
#pragma unroll
            for (int s = 0; s < 2; ++s) acc = __builtin_amdgcn_mfma_f32_16x16x32_bf16(frag2(ar + 64 * s), vp[s], acc, 0, 0, 0);
#pragma unroll
            for (int r = 0; r < 4; ++r) *(LAS bf16_t*)(lds + S_OBUF + (16 * mt + 4 * g + r) * PR + (e0 + n) * 2) = f2bfd(acc[r]);
        }
#pragma unroll
        for (int d = 0; d < 8; ++d) {
            f32x4 acc = S[d] * gl;
#pragma unroll
            for (int s = 0; s < 2; ++s) { const LAS unsigned char* kp = lds + S_KD + (32 * s + 4 * g + q4) * PR + (16 * d + 4 * p4) * 2;
                const s16x4 k0 = vtr(kp), k1 = vtr(kp + 16 * PR); const bf16x8 af = {k0[0], k0[1], k0[2], k0[3], k1[0], k1[1], k1[2], k1[3]};
                acc = __builtin_amdgcn_mfma_f32_16x16x32_bf16(af, vp[s], acc, 0, 0, 0); }
            S[d] = acc;
        }
    };
    auto flush = [&](int nc) {
        const int row = tx >> 3, c = tx & 7; const size_t t0 = (size_t)b * 8192 + nc * 64;
        const u32x4 v0 = *(const LAS u32x4*)(lds + S_OBUF + row * PR + c * 16), v1 = *(const LAS u32x4*)(lds + S_OBUF + row * PR + (c + 8) * 16);
        float f[16]; float ss = 0.f;
#pragma unroll
        for (int i = 0; i < 4; ++i) { const unsigned a = v0[i], d = v1[i]; f[2 * i] = bflo(a); f[2 * i + 1] = bfhi(a); f[8 + 2 * i] = bflo(d); f[8 + 2 * i + 1] = bfhi(d); }
#pragma unroll
        for (int i = 0; i < 16; ++i) ss += f[i] * f[i];
        DPP_ADDF(ss, 0xB1); DPP_ADDF(ss, 0x4E); DPP_ADDF(ss, 0x141);
        const float rs = 1.f / sqrtf(ss * (1.f / 128.f) + 1e-6f);
        const f32x4 w0 = *(const f32x4*)(A.onw + 8 * c), w1 = *(const f32x4*)(A.onw + 8 * c + 4), w2 = *(const f32x4*)(A.onw + 64 + 8 * c), w3 = *(const f32x4*)(A.onw + 64 + 8 * c + 4);
        u32x4 r0, r1;
        r0.x = pk2bf(f[0] * rs * w0[0], f[1] * rs * w0[1]); r0.y = pk2bf(f[2] * rs * w0[2], f[3] * rs * w0[3]); r0.z = pk2bf(f[4] * rs * w1[0], f[5] * rs * w1[1]); r0.w = pk2bf(f[6] * rs * w1[2], f[7] * rs * w1[3]);
        r1.x = pk2bf(f[8] * rs * w2[0], f[9] * rs * w2[1]); r1.y = pk2bf(f[10] * rs * w2[2], f[11] * rs * w2[3]); r1.z = pk2bf(f[12] * rs * w3[0], f[13] * rs * w3[1]); r1.w = pk2bf(f[14] * rs * w3[2], f[15] * rs * w3[3]);
        bf16_t* op = A.O + (t0 + row) * 1024 + h * 128; *(u32x4*)(op + c * 8) = r0; *(u32x4*)(op + (c + 8) * 8) = r1; };
    issue(pfA, 0); issue(pfB, 1); commit(pfA); __syncthreads();
#define LBAR() asm volatile("s_waitcnt lgkmcnt(0)\n\ts_barrier" ::: "memory")
    for (int nc = 0; nc < 128; nc += 2) {
        issue(pfA, nc + 2); compute(nc);
        LBAR(); flush(nc); commit(pfB); LBAR();
        issue(pfB, nc + 3); compute(nc + 1);
        LBAR(); flush(nc + 1); commit(pfA); LBAR();
    }
#undef LBAR
    __syncthreads();
}
__device__ __forceinline__ void scan_phase(const ScanArgs& A, LAS unsigned char* lds, int bx, int G) { for (int bh = bx; bh < 16; bh += G) scan_bh(A, lds, bh); }
}
namespace peer {
typedef __bf16 bf16x2_t __attribute__((ext_vector_type(2)));
__device__ __forceinline__ float dppf(float v, const int ctrl_unused) { return v; }
#define DPP_ADD(v, CTRL, RMASK) v += __builtin_bit_cast(float, __builtin_amdgcn_update_dpp(0, __builtin_bit_cast(int, v), CTRL, RMASK, 0xF, false))
__device__ __forceinline__ float wave_sum_u(float v) {
    DPP_ADD(v, 0xB1, 0xF); DPP_ADD(v, 0x4E, 0xF); DPP_ADD(v, 0x141, 0xF); DPP_ADD(v, 0x140, 0xF);
    DPP_ADD(v, 0x142, 0xA); DPP_ADD(v, 0x143, 0xC);
    return __builtin_bit_cast(float, __builtin_amdgcn_readlane(__builtin_bit_cast(int, v), 63));
}
__device__ __forceinline__ float dot2bf(unsigned a, unsigned b, float c) { return __builtin_amdgcn_fdot2_f32_bf16(__builtin_bit_cast(bf16x2_t, a), __builtin_bit_cast(bf16x2_t, b), c, false); }
__device__ __forceinline__ float dot16(const u32x4& a0, const u32x4& a1, const u32x4& h0, const u32x4& h1) {
    float s = 0.f;
#pragma unroll
    for (int i = 0; i < 4; ++i) { const unsigned x0 = a0[i], y0 = h0[i], x1 = a1[i], y1 = h1[i]; s = dot2bf(x0, y0, s); s = dot2bf(x1, y1, s); }
    return s;
}
__device__ __forceinline__ void axpy16(float (&acc)[16], float a, const u32x4& v0, const u32x4& v1) {
#pragma unroll
    for (int i = 0; i < 4; ++i) { acc[2 * i] = fmaf(a, __builtin_bit_cast(float, v0[i] << 16), acc[2 * i]); acc[2 * i + 1] = fmaf(a, __builtin_bit_cast(float, v0[i] & 0xffff0000u), acc[2 * i + 1]);
        acc[8 + 2 * i] = fmaf(a, __builtin_bit_cast(float, v1[i] << 16), acc[8 + 2 * i]); acc[8 + 2 * i + 1] = fmaf(a, __builtin_bit_cast(float, v1[i] & 0xffff0000u), acc[8 + 2 * i + 1]); }
}
constexpr float SU_ = 512.f, SV_ = 64.f;
__device__ __forceinline__ unsigned pk4fp8(f32x4 v, float s) { int p = __builtin_amdgcn_cvt_pk_fp8_f32(v[0] * s, v[1] * s, 0, false); p = __builtin_amdgcn_cvt_pk_fp8_f32(v[2] * s, v[3] * s, p, true); return (unsigned)p; }
__device__ __forceinline__ void convert_tables(const float* u, const float* v, unsigned char* ub, unsigned char* vb, int gt, int NGT) {
    for (int i = gt; i < 16384 * 1024 / 16; i += NGT) {
        const f32x4* us = (const f32x4*)u + 4 * (size_t)i; const f32x4* vs = (const f32x4*)v + 4 * (size_t)i;
        u32x4 o; o.x = pk4fp8(us[0], SU_); o.y = pk4fp8(us[1], SU_); o.z = pk4fp8(us[2], SU_); o.w = pk4fp8(us[3], SU_); ((u32x4*)ub)[i] = o;
        o.x = pk4fp8(vs[0], SV_); o.y = pk4fp8(vs[1], SV_); o.z = pk4fp8(vs[2], SV_); o.w = pk4fp8(vs[3], SV_); ((u32x4*)vb)[i] = o; }
}
struct PeerArgs { const unsigned char* Ub; const unsigned char* Vb; const bf16_t* H2; const float* X1; const float* MOD; const float* S; const float* fnw; float* out; };
__device__ __forceinline__ void route_token(const float* Srow, int lane, int& e_lo, int& e_hi, float& g_lo, float& g_hi);
__device__ __forceinline__ void expert_token(const PeerArgs& A, int t, int lane) {
    const int b = t >> 13;
    const u32x4 h0 = *(const u32x4*)(A.H2 + (size_t)t * 1024 + 16 * lane), h1 = *(const u32x4*)(A.H2 + (size_t)t * 1024 + 16 * lane + 8);
    int e_lo, e_hi; float g_lo, g_hi; route_token(A.S + (size_t)(t & 8191) * 2048, lane, e_lo, e_hi, g_lo, g_hi);
    f32x2h_t acc2[8], hf2[8];
#pragma unroll
    for (int i = 0; i < 4; ++i) { const unsigned a = h0[i], b2 = h1[i]; hf2[i] = (f32x2h_t){__builtin_bit_cast(float, a << 16), __builtin_bit_cast(float, a & 0xffff0000u)};
        hf2[4 + i] = (f32x2h_t){__builtin_bit_cast(float, b2 << 16), __builtin_bit_cast(float, b2 & 0xffff0000u)}; }
#pragma unroll
    for (int i = 0; i < 8; ++i) acc2[i] = (f32x2h_t){0.f, 0.f};
    for (int s0 = 0; s0 < 128; s0 += 4) {
        int e[4]; float gt[4]; u32x4 uu[4], vv[4];
#pragma unroll
        for (int q = 0; q < 4; ++q) { const int s = s0 + q;
            e[q] = (s0 < 64) ? __builtin_amdgcn_readlane(e_lo, s & 63) : __builtin_amdgcn_readlane(e_hi, s & 63);
            gt[q] = __builtin_bit_cast(float, (s0 < 64) ? __builtin_amdgcn_readlane(__builtin_bit_cast(int, g_lo), s & 63) : __builtin_amdgcn_readlane(__builtin_bit_cast(int, g_hi), s & 63));
            uu[q] = *(const u32x4*)(A.Ub + (size_t)e[q] * 1024 + 16 * lane); vv[q] = *(const u32x4*)(A.Vb + (size_t)e[q] * 1024 + 16 * lane); }
        float d[4];
#pragma unroll
        for (int q = 0; q < 4; ++q) { f32x2h_t s2 = {0.f, 0.f};
#pragma unroll
            for (int i = 0; i < 4; ++i) { const int w = (int)uu[q][i]; const f32x2h_t lo = __builtin_amdgcn_cvt_pk_f32_fp8(w, false), hi = __builtin_amdgcn_cvt_pk_f32_fp8(w, true);
                s2 = __builtin_elementwise_fma(lo, hf2[2 * i], s2); s2 = __builtin_elementwise_fma(hi, hf2[2 * i + 1], s2); }
            d[q] = s2[0] + s2[1]; }
#pragma unroll
        for (int q = 0; q < 4; ++q) d[q] = wave_sum_u(d[q]) * (1.f / SU_);
#pragma unroll
        for (int q = 0; q < 4; ++q) { const float a = 0.5f * d[q] * (1.f + erff(d[q] * 0.70710678118654752f)) * gt[q] * (1.f / SV_); const f32x2h_t a2 = {a, a};
#pragma unroll
            for (int i = 0; i < 4; ++i) { const int w = (int)vv[q][i]; const f32x2h_t lo = __builtin_amdgcn_cvt_pk_f32_fp8(w, false), hi = __builtin_amdgcn_cvt_pk_f32_fp8(w, true);
                acc2[2 * i] = __builtin_elementwise_fma(a2, lo, acc2[2 * i]); acc2[2 * i + 1] = __builtin_elementwise_fma(a2, hi, acc2[2 * i + 1]); } }
    }
    float acc[16];
#pragma unroll
    for (int i = 0; i < 8; ++i) { acc[2 * i] = acc2[i][0]; acc[2 * i + 1] = acc2[i][1]; }
    const float* xr = A.X1 + (size_t)t * 1024 + 16 * lane; const float* g2 = A.MOD + (size_t)b * 6144 + 5120 + 16 * lane; const float* fw = A.fnw + 16 * lane;
    float x2[16]; float ss = 0.f;
#pragma unroll
    for (int i = 0; i < 4; ++i) { const f32x4 xv = *(const f32x4*)(xr + 4 * i), gv = *(const f32x4*)(g2 + 4 * i);
#pragma unroll
        for (int k = 0; k < 4; ++k) { const float y = xv[k] + gv[k] * acc[4 * i + k]; x2[4 * i + k] = y; ss += y * y; } }
    ss = wave_sum_u(ss);
    const float rstd = 1.f / sqrtf(ss * (1.f / 1024.f) + 1e-6f);
    float* orow = A.out + (size_t)t * 1024 + 16 * lane;
#pragma unroll
    for (int i = 0; i < 4; ++i) { const f32x4 wv = *(const f32x4*)(fw + 4 * i); f32x4 o; o[0] = x2[4 * i] * rstd * wv[0]; o[1] = x2[4 * i + 1] * rstd * wv[1]; o[2] = x2[4 * i + 2] * rstd * wv[2]; o[3] = x2[4 * i + 3] * rstd * wv[3];
        *(f32x4*)(orow + 4 * i) = o; }
}
__device__ __forceinline__ void expert_phase(const PeerArgs& A, int half, int bx, int G) {
    int tx = threadIdx.x; asm volatile("" : "+v"(tx));
    const int wave = __builtin_amdgcn_readfirstlane(tx >> 6), lane = tx & 63;
    for (int t = wave * G + bx; t < 8192; t += 8 * G) expert_token(A, half * 8192 + t, lane);
}
}
namespace peer {
__device__ __forceinline__ unsigned sortable(float f) { const unsigned u = __builtin_bit_cast(unsigned, f); return (u & 0x80000000u) ? ~u : (u | 0x80000000u); }
#define DPP_UMAX(v, CTRL) { const unsigned t_ = (unsigned)__builtin_amdgcn_update_dpp(0, (int)(v), CTRL, 0xF, 0xF, false); v = (v) > t_ ? (v) : t_; }
#define DPP_FMAX(v, CTRL) { const float t_ = __builtin_bit_cast(float, __builtin_amdgcn_update_dpp(0, __builtin_bit_cast(int, v), CTRL, 0xF, 0xF, false)); v = fmaxf(v, t_); }
#define CE_(a, b) { const unsigned hi_ = (a) > (b) ? (a) : (b), lo_ = (a) > (b) ? (b) : (a); a = hi_; b = lo_; }
__device__ __forceinline__ void route_token(const float* Srow, int lane, int& e_lo, int& e_hi, float& g_lo, float& g_hi) {
    const int r = lane >> 4, i = lane & 15;
    int ic, jc; { const int c = lane; ic = (c < 16) ? 0 : (c < 24) ? 1 : (c < 29) ? 2 : (c < 33) ? 3 : (c < 36) ? 4 : (c < 38) ? 5 : (c < 40) ? 6 : (c < 42) ? 7 : (c - 34);
        const int st = (ic == 0) ? 0 : (ic == 1) ? 16 : (ic == 2) ? 24 : (ic == 3) ? 29 : (ic == 4) ? 33 : (ic == 5) ? 36 : (ic == 6) ? 38 : (ic == 7) ? 40 : (c); jc = c - st; if (ic > 15) { ic = 15; jc = 0; } }
    const int flat = ic * 16 + jc; const bool cvalid = lane < 50;
    e_lo = 0; e_hi = 0; g_lo = 0.f; g_hi = 0.f;
#pragma unroll 1
    for (int k = 0; k < 4; ++k) {
        const float* lp = Srow + (4 * k + r) * 128;
        const f32x4 va = *(const f32x4*)(lp + 8 * i), vb = *(const f32x4*)(lp + 8 * i + 4);
        unsigned k0 = (sortable(va[0]) & 0xFFFFFF80u) | (unsigned)(127 - (8 * i + 0)), k1 = (sortable(va[1]) & 0xFFFFFF80u) | (unsigned)(127 - (8 * i + 1)),
                 k2 = (sortable(va[2]) & 0xFFFFFF80u) | (unsigned)(127 - (8 * i + 2)), k3 = (sortable(va[3]) & 0xFFFFFF80u) | (unsigned)(127 - (8 * i + 3)),
                 k4 = (sortable(vb[0]) & 0xFFFFFF80u) | (unsigned)(127 - (8 * i + 4)), k5 = (sortable(vb[1]) & 0xFFFFFF80u) | (unsigned)(127 - (8 * i + 5)),
                 k6 = (sortable(vb[2]) & 0xFFFFFF80u) | (unsigned)(127 - (8 * i + 6)), k7 = (sortable(vb[3]) & 0xFFFFFF80u) | (unsigned)(127 - (8 * i + 7));
        CE_(k0, k1) CE_(k2, k3) CE_(k4, k5) CE_(k6, k7)  CE_(k0, k2) CE_(k1, k3) CE_(k4, k6) CE_(k5, k7)  CE_(k1, k2) CE_(k5, k6)
        CE_(k0, k4) CE_(k1, k5) CE_(k2, k6) CE_(k3, k7)  CE_(k2, k4) CE_(k3, k5)  CE_(k1, k2) CE_(k3, k4) CE_(k5, k6)
        unsigned sel = 0u;
#pragma unroll
        for (int it = 0; it < 16; ++it) { unsigned M = k0; DPP_UMAX(M, 0x128) DPP_UMAX(M, 0x124) DPP_UMAX(M, 0x122) DPP_UMAX(M, 0x121)
            sel = (i == it) ? M : sel; const bool own = (k0 == M);
            k0 = own ? k1 : k0; k1 = own ? k2 : k1; k2 = own ? k3 : k2; k3 = own ? k4 : k3; k4 = own ? k5 : k4; k5 = own ? k6 : k5; k6 = own ? k7 : k6; k7 = own ? 0u : k7; }
        const int sidx = 127 - (int)(sel & 127u); const float sval = lp[sidx];
#pragma unroll
        for (int hh = 0; hh < 2; ++hh) {
            const int h = 2 * k + hh, l0 = 32 * hh, l1 = 32 * hh + 16;
            const float ca = __shfl(sval, l0 + ic), cb = __shfl(sval, l1 + jc); const float cs = ca + cb;
            unsigned key = cvalid ? ((sortable(cs) & 0xFFFFFF00u) | (unsigned)(255 - flat)) : 0u; unsigned top = 0u;
#pragma unroll
            for (int it = 0; it < 16; ++it) { unsigned M = key; DPP_UMAX(M, 0x128) DPP_UMAX(M, 0x124) DPP_UMAX(M, 0x122) DPP_UMAX(M, 0x121)
                const unsigned m0 = (unsigned)__builtin_amdgcn_readlane((int)M, 0), m1 = (unsigned)__builtin_amdgcn_readlane((int)M, 16), m2 = (unsigned)__builtin_amdgcn_readlane((int)M, 32), m3 = (unsigned)__builtin_amdgcn_readlane((int)M, 48);
                const unsigned ma = m0 > m1 ? m0 : m1, mb = m2 > m3 ? m2 : m3, mm = ma > mb ? ma : mb;
                top = (lane == it) ? mm : top; key = (key == mm) ? 0u : key; }
            const int fl = 255 - (int)(top & 255u), ti = fl >> 4, tj = fl & 15;
            const float tv = __shfl(sval, l0 + ti) + __shfl(sval, l1 + tj);
            const int ex = __shfl(sidx, l0 + ti) * 128 + __shfl(sidx, l1 + tj);
            float mx = tv; DPP_FMAX(mx, 0x128) DPP_FMAX(mx, 0x124) DPP_FMAX(mx, 0x122) DPP_FMAX(mx, 0x121)
            float p = __expf(tv - mx), ps = p; DPP_ADD(ps, 0x128, 0xF); DPP_ADD(ps, 0x124, 0xF); DPP_ADD(ps, 0x122, 0xF); DPP_ADD(ps, 0x121, 0xF);
            const float gate = p / ps;
            const int ex_m = __shfl(ex, i); const float g_m = __shfl(gate, i);
            if (r == (h & 3)) { if (h < 4) { e_lo = ex_m; g_lo = g_m; } else { e_hi = ex_m; g_hi = g_m; } }
        }
    }
}
}
namespace ew {
using peer::wave_sum_u;
__device__ __forceinline__ void mod_phase(const float* c, const float* w_ada, const float* b_ada, float* MOD, LAS unsigned char* lds, int bx, int G) {
    int tx = threadIdx.x; asm volatile("" : "+v"(tx));
    LAS float* red = (LAS float*)lds;
    for (int it = bx; it < 192; it += G) {
        const int col = tx & 31, kg = tx >> 5, j = it * 32 + col; float a0 = 0.f, a1 = 0.f, b0 = 0.f, b1 = 0.f;
#pragma unroll 4
        for (int k = kg * 64; k < kg * 64 + 64; k += 2) { const float w0 = w_ada[(size_t)k * 6144 + j], w1 = w_ada[(size_t)(k + 1) * 6144 + j]; const float c00 = c[k], c01 = c[k + 1], c10 = c[1024 + k], c11 = c[1024 + k + 1];
            a0 = fmaf(c00 / (1.f + __expf(-c00)), w0, a0); b0 = fmaf(c01 / (1.f + __expf(-c01)), w1, b0); a1 = fmaf(c10 / (1.f + __expf(-c10)), w0, a1); b1 = fmaf(c11 / (1.f + __expf(-c11)), w1, b1); }
        red[(kg * 2 + 0) * 32 + col] = a0 + b0; red[(kg * 2 + 1) * 32 + col] = a1 + b1;
        __syncthreads();
        if (tx < 64) { const int bb = tx >> 5; float s = b_ada[j];
#pragma unroll
            for (int q = 0; q < 16; ++q) s += red[(q * 2 + bb) * 32 + col];
            MOD[(size_t)bb * 6144 + j] = s; }
        __syncthreads();
    }
}
__device__ __forceinline__ void modnorm_row(const f32x4 (&v)[4], const float* nw, const float* MOD, int which, bf16_t* H, int t, int lane) {
    const int b = t >> 13; const float* sh = MOD + (size_t)b * 6144 + (which ? 3072 : 0) + 16 * lane; const float* sc = sh + 1024; const float* wr = nw + 16 * lane;
    float ss = 0.f;
#pragma unroll
    for (int i = 0; i < 4; ++i) ss += v[i][0] * v[i][0] + v[i][1] * v[i][1] + v[i][2] * v[i][2] + v[i][3] * v[i][3];
    ss = wave_sum_u(ss); const float rstd = 1.f / sqrtf(ss * (1.f / 1024.f) + 1e-6f);
    float y[16];
#pragma unroll
    for (int i = 0; i < 4; ++i) { const f32x4 w = *(const f32x4*)(wr + 4 * i), s1 = *(const f32x4*)(sc + 4 * i), s0 = *(const f32x4*)(sh + 4 * i);
#pragma unroll
        for (int k = 0; k < 4; ++k) y[4 * i + k] = v[i][k] * rstd * w[k] * (1.f + s1[k]) + s0[k]; }
    u32x4 o0, o1; o0.x = pk2bf(y[0], y[1]); o0.y = pk2bf(y[2], y[3]); o0.z = pk2bf(y[4], y[5]); o0.w = pk2bf(y[6], y[7]); o1.x = pk2bf(y[8], y[9]); o1.y = pk2bf(y[10], y[11]); o1.z = pk2bf(y[12], y[13]); o1.w = pk2bf(y[14], y[15]);
    *(u32x4*)(H + (size_t)t * 1024 + 16 * lane) = o0; *(u32x4*)(H + (size_t)t * 1024 + 16 * lane + 8) = o1;
}
__device__ __forceinline__ void modnorm_phase(const float* X, const float* nw, const float* MOD, int which, bf16_t* H, int gw, int NGW, int lane) {
    for (int t = gw; t < 16384; t += 4 * NGW) {
        f32x4 v[4][4];
#pragma unroll
        for (int u = 0; u < 4; ++u) { const int tu = t + u * NGW; if (tu < 16384) {
#pragma unroll
            for (int i = 0; i < 4; ++i) v[u][i] = *(const f32x4*)(X + (size_t)tu * 1024 + 16 * lane + 4 * i); } }
#pragma unroll
        for (int u = 0; u < 4; ++u) { const int tu = t + u * NGW; if (tu < 16384) modnorm_row(v[u], nw, MOD, which, H, tu, lane); }
    }
}
struct SmallArgs { const bf16_t* RAW; const float *qw, *kvw, *kiw, *a_log, *dt_bias; bf16_t *QLATN, *CKVN, *KIDXN; float *BETA, *G, *WIDX; };
__device__ __forceinline__ void small_phase(const SmallArgs& A, int gw, int NGW, int lane) {
    for (int t = gw; t < 16384; t += NGW) {
        const bf16_t* r = A.RAW + (size_t)t * 768;
        const uint2 qp = *(const uint2*)(r + 4 * lane), kp = *(const uint2*)(r + 256 + 4 * lane);
        const float q0 = __builtin_bit_cast(float, qp.x << 16), q1 = __builtin_bit_cast(float, qp.x & 0xffff0000u), q2 = __builtin_bit_cast(float, qp.y << 16), q3 = __builtin_bit_cast(float, qp.y & 0xffff0000u);
        const float k0 = __builtin_bit_cast(float, kp.x << 16), k1 = __builtin_bit_cast(float, kp.x & 0xffff0000u), k2 = __builtin_bit_cast(float, kp.y << 16), k3 = __builtin_bit_cast(float, kp.y & 0xffff0000u);
        const float ki = bf2f(r[512 + lane]);
        const float sq = wave_sum_u(q0 * q0 + q1 * q1 + q2 * q2 + q3 * q3), skv = wave_sum_u(k0 * k0 + k1 * k1 + k2 * k2 + k3 * k3), ski = wave_sum_u(ki * ki);
        const float rq = 1.f / sqrtf(sq * (1.f / 256.f) + 1e-6f), rkv = 1.f / sqrtf(skv * (1.f / 256.f) + 1e-6f), rki = 1.f / sqrtf(ski * (1.f / 64.f) + 1e-6f);
        const f32x4 wq = *(const f32x4*)(A.qw + 4 * lane), wkv = *(const f32x4*)(A.kvw + 4 * lane);
        *(uint2*)(A.QLATN + (size_t)t * 256 + 4 * lane) = make_uint2(pk2bf(q0 * rq * wq[0], q1 * rq * wq[1]), pk2bf(q2 * rq * wq[2], q3 * rq * wq[3]));
        *(uint2*)(A.CKVN + (size_t)t * 256 + 4 * lane) = make_uint2(pk2bf(k0 * rkv * wkv[0], k1 * rkv * wkv[1]), pk2bf(k2 * rkv * wkv[2], k3 * rkv * wkv[3]));
        A.KIDXN[(size_t)t * 64 + lane] = f2bfd(ki * rki * A.kiw[lane]);
        if (lane < 8) { const float be = bf2f(r[576 + lane]), de = bf2f(r[584 + lane]), wi = bf2f(r[592 + lane]);
            A.BETA[(size_t)t * 8 + lane] = 1.f / (1.f + __expf(-be));
            const float xs = de + A.dt_bias[lane]; A.G[(size_t)t * 8 + lane] = -__expf(A.a_log[lane]) * (xs > 20.f ? xs : log1pf(__expf(xs)));
            A.WIDX[(size_t)t * 8 + lane] = wi * 0.04419417382415922f; }
    }
}
__device__ __forceinline__ void ogate_phase(const bf16_t* O, const bf16_t* Z, const float* ow, bf16_t* OG, int gw, int NGW, int lane) {
    for (int t = gw; t < 16384; t += NGW) {
        const u32x4 o0 = *(const u32x4*)(O + (size_t)t * 1024 + 16 * lane), o1 = *(const u32x4*)(O + (size_t)t * 1024 + 16 * lane + 8);
        const u32x4 z0 = *(const u32x4*)(Z + (size_t)t * 1024 + 16 * lane), z1 = *(const u32x4*)(Z + (size_t)t * 1024 + 16 * lane + 8);
        float ov[16], zv[16]; float ss = 0.f;
#pragma unroll
        for (int i = 0; i < 4; ++i) { const unsigned a = o0[i], b = o1[i], c = z0[i], d = z1[i];
            ov[2 * i] = __builtin_bit_cast(float, a << 16); ov[2 * i + 1] = __builtin_bit_cast(float, a & 0xffff0000u); ov[8 + 2 * i] = __builtin_bit_cast(float, b << 16); ov[8 + 2 * i + 1] = __builtin_bit_cast(float, b & 0xffff0000u);
            zv[2 * i] = __builtin_bit_cast(float, c << 16); zv[2 * i + 1] = __builtin_bit_cast(float, c & 0xffff0000u); zv[8 + 2 * i] = __builtin_bit_cast(float, d << 16); zv[8 + 2 * i + 1] = __builtin_bit_cast(float, d & 0xffff0000u); }
#pragma unroll
        for (int i = 0; i < 16; ++i) ss += ov[i] * ov[i];
        DPP_ADD(ss, 0xB1, 0xF); DPP_ADD(ss, 0x4E, 0xF); DPP_ADD(ss, 0x141, 0xF);
        const float rs = 1.f / sqrtf(ss * (1.f / 128.f) + 1e-6f); const float* w = ow + 16 * (lane & 7);
        float y[16];
#pragma unroll
        for (int i = 0; i < 16; ++i) y[i] = ov[i] * rs * w[i] * (zv[i] / (1.f + __expf(-zv[i])));
        u32x4 r0, r1; r0.x = pk2bf(y[0], y[1]); r0.y = pk2bf(y[2], y[3]); r0.z = pk2bf(y[4], y[5]); r0.w = pk2bf(y[6], y[7]); r1.x = pk2bf(y[8], y[9]); r1.y = pk2bf(y[10], y[11]); r1.z = pk2bf(y[12], y[13]); r1.w = pk2bf(y[14], y[15]);
        *(u32x4*)(OG + (size_t)t * 1024 + 16 * lane) = r0; *(u32x4*)(OG + (size_t)t * 1024 + 16 * lane + 8) = r1;
    }
}
}
constexpr int NTHR = 512;
constexpr int LDS_BYTES = 155648;
constexpr size_t CTL_ZERO_BYTES = 32768;
struct MArgs { NP P; NP P2; OP Q; unsigned* ctl; };

typedef const __attribute__((address_space(4))) MArgs* KAP;
typedef const __attribute__((address_space(4))) unsigned long long* KW;
#define KA(ka) KAP ka = (KAP)__builtin_amdgcn_kernarg_segment_ptr(); asm volatile("" : "+s"(ka))
template <class TT, class SS> __device__ __forceinline__ void ka_copy(TT& dst, SS src) { static_assert(sizeof(TT) % 8 == 0, "8-byte words");
    void** d = (void**)&dst; KW s = (KW)src;
#pragma unroll
    for (int i = 0; i < (int)(sizeof(TT) / 8); ++i) d[i] = (void*)(__attribute__((address_space(1))) void*)s[i]; }
#define LOADP(P, ka) NP P; ka_copy(P, &ka->P)
#define LOADQ(Q, ka) OP Q; ka_copy(Q, &ka->Q)
__global__ void __launch_bounds__(NTHR, 2) mega(MArgs a_unused) {
    typedef CfgFull C; typedef WsMap<C> W;
    extern __shared__ __attribute__((aligned(16))) unsigned char lds_raw[];
    LAS unsigned char* lds = (LAS unsigned char*)lds_raw;
    volatile LAS unsigned* MISC = (volatile LAS unsigned*)(lds + LDS_BYTES - 256);
    if (threadIdx.x < 64) MISC[threadIdx.x] = 0u;
    __syncthreads();
    XcdBarrier bar; { KA(ka); bar = xcd_barrier_post((unsigned*)(__attribute__((address_space(1))) unsigned*)(unsigned long long)ka->ctl, MISC + 8); }
    const int G = gridDim.x, NTall = G * NTHR, bx = blockIdx.x;
#define TIDS() int tx_ = threadIdx.x; asm volatile("" : "+v"(tx_)); const int wave = __builtin_amdgcn_readfirstlane(tx_ >> 6), lane = tx_ & 63; \
        const int tid = (wave * G + bx) * 64 + lane;
#define NAIVE_(WHICH, st) do { KA(ka_); NP PP_; ka_copy(PP_, &ka_->WHICH); TIDS(); const long n_ = stage_items<C>(st); const int words_ = stage_scr_words<C>(st); \
        int nt_ = NTall; if (words_) { const long cap_ = (long)(W::SCR_BYTES / (4 * (size_t)words_)); if (cap_ < nt_) nt_ = (int)cap_; } \
        if (tid < nt_) for (long it_ = tid; it_ < n_; it_ += nt_) run_item<C>(PP_, st, it_, tid, nt_); } while (0)
#define NAIVE(st) NAIVE_(P, st)
#define BAR() xcd_barrier(bar)
    { KA(ka); LOADP(P, ka); ew::mod_phase(P.c, P.w_ada, P.b_ada, P.MOD, lds, bx, G); }
    { KA(ka); LOADP(P, ka); LOADQ(Q, ka); TIDS(); (void)tid; p0_weights(P, Q, lds, bx * 8 + wave, G * 8, bx * NTHR + tx_, NTall, wave, lane); }
    BAR();
    { KA(ka); LOADP(P, ka); TIDS(); (void)tid; ew::modnorm_phase(P.x, P.norm1_w, P.MOD, 0, P.H1, bx * 8 + wave, G * 8, lane); }
    { KA(ka); LOADQ(Q, ka); const int c0 = bx < 40 ? bx : -1; WSched S0{0, c0, Q.wuk, Q.wuq, Q.wbT, Q.wuv, Q.skb, Q.pwq}; EpiG<FWeights> E{FWeights{Q.WcombT, Q.WcatT, Q.WsT}};
      pg8::gemm_phase<EpiG<FWeights>, WSched, false, true>(lds, pg8::Gemm{1024, 1024, 128}, S0, E);
      const int c1 = (bx >= 40 && bx < 72) ? bx - 40 : -1; WSched S1{1, c1, Q.wuk, Q.wuq, Q.wbT, Q.wuv, Q.skb, Q.pwq};
      pg8::gemm_phase<EpiG<FWeights>, WSched, false, true>(lds, pg8::Gemm{256, 2048, 256}, S1, E); }
    BAR();
    { KA(ka); LOADP(P, ka); LOADQ(Q, ka); GridSched S; S.init(64, 15, G, bx, P.H1, (size_t)256 * 1024 * 2, Q.WinT, (size_t)256 * 1024 * 2); EpiG<FInprojA> E{FInprojA{P.QKVP, Q.RAWB}};
      pg8::gemm_phase<EpiG<FInprojA>, GridSched, true, true>(lds, pg8::Gemm{1024, 1024, 1024}, S, E); }
    BAR();
    { KA(ka); LOADP(P, ka); LOADQ(Q, ka); TIDS(); (void)tid; ew::SmallArgs SA{Q.RAWB, P.q_norm_w, P.kv_norm_w, P.idx_k_norm_w, P.dn_a_log, P.dn_dt_bias, P.QLATN, P.CKVN, P.KIDXN, P.BETA, P.G, P.WIDX}; ew::small_phase(SA, bx * 8 + wave, G * 8, lane); }
    { KA(ka); LOADP(P, ka); TIDS(); (void)tid; dnet::conv_phase(P.QKVP, P.QKVN, P.dn_conv_w, bx * 8 + wave, G * 8, lane); }
    BAR();
    { KA(ka); LOADP(P, ka); dnet::PrepArgs PA{P.QKVN, P.BETA, P.G, P.W, P.ATT, P.GL}; dnet::prep_phase(PA, lds, bx, G); }
    { KA(ka); LOADP(P, ka); LOADQ(Q, ka); GridSched S; S.init(64, 8, G, bx, P.QLATN, (size_t)256 * 256 * 2, Q.WcombT, (size_t)256 * 256 * 2); EpiG<FStoreBf16> E{FStoreBf16{Q.QA0, 2048, Q.QA1, sattn::QSPLIT / 256}};
      pg8::gemm_phase<EpiG<FStoreBf16>, GridSched, false, true>(lds, pg8::Gemm{256, 256, 256}, S, E); }
    BAR();
    { KA(ka); LOADP(P, ka); dnet::ScanArgs SA{P.QKVN, P.W, P.ATT, P.GL, P.O, P.dn_onorm_w}; dnet::scan_phase(SA, lds, bx, G); }
    { KA(ka); LOADP(P, ka); LOADQ(Q, ka); dsa::DArgs DA{idxk::IdxArgs{P.QLATN, P.KIDXN, P.WIDX, Q.WiqT, nullptr}, sattn::AArgs{P.CKVN, Q.QA0, Q.QA1}, Q.qword};
      dsa::dsa_queue(DA, lds, MISC + 16); }
    BAR();
    { KA(ka); LOADP(P, ka); LOADQ(Q, ka); GridSched S; S.init(64, 12, G, bx, P.H1, (size_t)256 * 1024 * 2, Q.WinT + (size_t)3840 * 1024, (size_t)256 * 1024 * 2); EpiG<FInprojB> E{FInprojB{P.Z, P.GA, P.GB, P.O}};
      pg8::gemm_phase<EpiG<FInprojB>, GridSched, true, true>(lds, pg8::Gemm{1024, 1024, 1024}, S, E); }
    BAR();
    { KA(ka); LOADP(P, ka); LOADQ(Q, ka); GridSched S; S.init(64, 4, G, bx, P.Z, (size_t)256 * 1024 * 2, Q.WcatT, (size_t)256 * 3072 * 2); EpiG<FMerge<0>> E{FMerge<0>{P.GA, P.M}};
      pg8::gemm_phase<EpiG<FMerge<0>>, GridSched, false, true>(lds, pg8::Gemm{1024, 3072, 1024}, S, E); }
    { KA(ka); LOADP(P, ka); LOADQ(Q, ka); GridSched S; S.init(64, 4, G, bx, Q.QA0, (size_t)256 * 2048 * 2, Q.WcatT + 1024, (size_t)256 * 3072 * 2); S.A2 = (const char*)Q.QA1; S.splitA = sattn::QSPLIT / 256; EpiG<FMerge<1>> E{FMerge<1>{P.GB, P.M}};
      pg8::gemm_phase<EpiG<FMerge<1>>, GridSched, false, true>(lds, pg8::Gemm{2048, 3072, 2048}, S, E); }
    BAR();
    { KA(ka); LOADP(P, ka); LOADQ(Q, ka); GridSched S; S.init(64, 4, G, bx, P.M, (size_t)256 * 1024 * 2, Q.WoT, (size_t)256 * 1024 * 2); EpiG<FWo> E{FWo{P.MOD, P.x, P.X1}};
      pg8::gemm_phase<EpiG<FWo>, GridSched, false, true>(lds, pg8::Gemm{1024, 1024, 1024}, S, E); }
    BAR();
    { KA(ka); LOADP(P, ka); LOADQ(Q, ka); TIDS(); (void)tid; ew::modnorm_phase(P.X1, P.norm2_w, P.MOD, 1, P.H2, bx * 8 + wave, G * 8, lane);
      peer::convert_tables(P.peer_u, P.peer_v, Q.Ub, Q.Vb, bx * NTHR + tx_, NTall); }
    BAR();
#pragma unroll 1
    for (int half = 0; half < 2; ++half) {
        { KA(ka); LOADP(P, ka); LOADQ(Q, ka); GridSched S; S.init(32, 8, G, bx, P.H2 + (size_t)half * 8192 * 1024, (size_t)256 * 1024 * 2, Q.WsT, (size_t)256 * 1024 * 2); EpiG<FStoreF32> E{FStoreF32{Q.S, 2048}};
          pg8::gemm_phase<EpiG<FStoreF32>, GridSched, true, true>(lds, pg8::Gemm{1024, 1024, 1024}, S, E); }
        BAR();
        { KA(ka); LOADP(P, ka); LOADQ(Q, ka); peer::PeerArgs EA{Q.Ub, Q.Vb, P.H2, P.X1, P.MOD, Q.S, P.final_norm_w, P.out}; peer::expert_phase(EA, half, bx, G); }
        if (half == 0) BAR();
    }
#undef NAIVE
#undef NAIVE_
#undef BAR
}
extern "C" void kernel_launch(void* const* d_in, const int* in_sizes, int n_in, void* d_out, int out_size, void* d_ws, size_t ws_size, hipStream_t stream) {
    typedef CfgFull C; typedef WsMap<C> W;
    static int grid = 0;
    if (grid == 0) {
        if (n_in != 26 || ws_size < X_END) { fprintf(stderr, "kernel_launch: need 26 inputs and %zu bytes of workspace, got %d / %zu\n", (size_t)X_END, n_in, ws_size); grid = -1; return; }
        int dev = 0, cus = 0, per_cu = 0;
        if (hipGetDevice(&dev) != hipSuccess || hipDeviceGetAttribute(&cus, hipDeviceAttributeMultiprocessorCount, dev) != hipSuccess) { grid = -1; return; }
        if (hipFuncSetAttribute((const void*)mega, hipFuncAttributeMaxDynamicSharedMemorySize, LDS_BYTES) != hipSuccess) { fprintf(stderr, "kernel_launch: hipFuncSetAttribute failed\n"); grid = -1; return; }
        if (hipOccupancyMaxActiveBlocksPerMultiprocessor(&per_cu, (const void*)mega, NTHR, LDS_BYTES) != hipSuccess || per_cu < 1) { fprintf(stderr, "kernel_launch: occupancy query says %d\n", per_cu); }
        (void)hipGetLastError();
        grid = cus;
    }
    if (grid < 0) return;
    hipMemsetAsync(d_ws, 0, CTL_ZERO_BYTES, stream);
    MArgs a{}; np_setup<C>(a.P, d_in, d_out, d_ws);
    char* ws = (char*)d_ws;
    a.Q.WinT = (bf16_t*)(ws + X_WINT); a.Q.WcatT = (bf16_t*)(ws + X_WCAT); a.Q.WoT = (bf16_t*)(ws + X_WOT); a.Q.WsT = (bf16_t*)(ws + X_WST); a.Q.WcombT = (bf16_t*)(ws + X_WCOMB); a.Q.WiqT = (bf16_t*)(ws + X_WIQT);
    a.Q.wuk = (bf16_t*)(ws + X_WUK); a.Q.wuq = (bf16_t*)(ws + X_WUQ); a.Q.wbT = (bf16_t*)(ws + X_WBT); a.Q.wuv = (bf16_t*)(ws + X_WUV); a.Q.skb = (bf16_t*)(ws + X_SKB); a.Q.pwq = (bf16_t*)(ws + X_PWQ);
    a.Q.S = (float*)(ws + W::A0 + (size_t)64 * 1048576);
    a.Q.Ub = (unsigned char*)(ws + W::A0); a.Q.Vb = (unsigned char*)(ws + W::A0 + (size_t)16 * 1048576);
    a.Q.EXPI2 = (int*)(ws + X_EXPI); a.Q.GATE2 = (float*)(ws + X_GATE);
    a.P.ATT = (bf16_t*)(ws + W::A0); a.P.W = (bf16_t*)(ws + W::A0 + (size_t)16 * 1048576);
    a.Q.QA0 = (bf16_t*)(ws + W::A0 + (size_t)48 * 1048576); a.Q.QA1 = (bf16_t*)(ws + W::A3); a.Q.qword = (unsigned*)d_ws + 6144;
    a.P.Z = (bf16_t*)(ws + W::A1); a.P.GA = (bf16_t*)(ws + W::A1 + (size_t)32 * 1048576); a.P.GB = (bf16_t*)(ws + W::A1 + (size_t)64 * 1048576);
    a.Q.RAWB = (bf16_t*)((char*)d_out + (size_t)32 * 1048576);
    a.P2 = a.P; a.P2.EXPI = a.Q.EXPI2; a.P2.GATE = a.Q.GATE2; a.P2.SCRP = (float*)((char*)d_out + W::d_SCR); a.P2.S = a.Q.S; a.ctl = (unsigned*)d_ws;
    hipLaunchKernelGGL(mega, dim3(grid), dim3(NTHR), LDS_BYTES, stream, a);
}
```

```cpp
#include <hip/hip_runtime.h>
#include <cstdio>
#include <cstdint>
#define HD __host__ __device__ __forceinline__
#ifndef HD
#define HD
#endif

typedef unsigned short bf16_t;
HD float bf2f(bf16_t v) { unsigned u = ((unsigned)v) << 16; float f; __builtin_memcpy(&f, &u, 4); return f; }
HD bf16_t f2bf(float f) { unsigned u; __builtin_memcpy(&u, &f, 4); u = (u + 0x7fffu + ((u >> 16) & 1u)) >> 16; return (bf16_t)u; }
HD float siluf(float x) { return x / (1.f + expf(-x)); }
HD float sigmf(float x) { return 1.f / (1.f + expf(-x)); }
HD float softplusf(float x) { return x > 20.f ? x : log1pf(expf(x)); }
HD float geluf(float x) { return 0.5f * x * (1.f + erff(x * 0.70710678118654752f)); }

struct CfgFull {
    static constexpr int D = 1024, B = 2, L = 8192;
    static constexpr int DNH = 8, DK = 128, DV = 128, CONV = 4, CH = 64;
    static constexpr int MH = 8, MDH = 128, MDV = 128, QL = 256, KVL = 256;
    static constexpr int IH = 8, ID = 64, TOPK_MAX = 256;
    static constexpr int PK = 128, PH = 8, PDQ = 256, PTK = 16;
};
struct CfgSmall {
    static constexpr int D = 64, B = 2, L = 512;
    static constexpr int DNH = 2, DK = 16, DV = 16, CONV = 4, CH = 64;
    static constexpr int MH = 2, MDH = 16, MDV = 16, QL = 32, KVL = 32;
    static constexpr int IH = 4, ID = 16, TOPK_MAX = 64;
    static constexpr int PK = 16, PH = 2, PDQ = 32, PTK = 4;
};
template <class C> struct Dims {
    static constexpr int T = C::B * C::L, HK = C::DNH * C::DK, HV = C::DNH * C::DV, QKVC = 2 * HK + HV;
    static constexpr int NCH = C::L / C::CH, NCHUNKS = C::B * C::DNH * NCH;
    static constexpr int TOPK = (C::TOPK_MAX < C::L / 4) ? C::TOPK_MAX : C::L / 4;
    static constexpr int PE = C::PK * C::PK, SLOTS = C::PH * C::PTK, PD2 = C::PDQ / 2;
    static constexpr int OFF_Q = 0, OFF_K = HK, OFF_V = 2 * HK, OFF_Z = 2 * HK + HV, OFF_B = OFF_Z + HV, OFF_A = OFF_B + C::DNH,
                         OFF_QL = OFF_A + C::DNH, OFF_CKV = OFF_QL + C::QL, OFF_KI = OFF_CKV + C::KVL, OFF_WI = OFF_KI + C::ID,
                         OFF_GA = OFF_WI + C::IH, OFF_GB = OFF_GA + C::D, IN_COLS = OFF_GB + C::D;
    static constexpr float EPS = 1e-6f;
};

struct NP {
    const float *x, *c, *w_ada, *b_ada, *norm1_w, *w_in, *dn_conv_w, *dn_a_log, *dn_dt_bias, *dn_onorm_w, *q_norm_w, *kv_norm_w, *idx_k_norm_w,
        *w_uq, *w_iq, *w_uk, *w_uv, *w_a_out, *w_b_out, *w_o, *norm2_w, *peer_w_q, *peer_sub_keys, *peer_u, *peer_v, *final_norm_w;
    float* out;
    float* MOD; bf16_t* H1; bf16_t* QKVP; bf16_t* QKVN; bf16_t* Z; bf16_t* GA; bf16_t* GB;
    float *BETA, *G, *GC, *GL, *QLATR, *CKVR, *KIDXR, *WIDX; bf16_t *QLATN, *CKVN, *KIDXN;
    float* AMAT; bf16_t* ATT; bf16_t* W; bf16_t* O; bf16_t* OG;
    float *QF, *QIDX; bf16_t* QABS; int* IDX; bf16_t* OLAT; bf16_t* OATT; bf16_t* M; float* X1; bf16_t* H2;
    float* PQ; int* EXPI; float* GATE; float* ACT; float* S; float* RAW;
    float* SCRP;
};
#define SCR(w) P.SCRP[(size_t)(w) * NT + tid]

template <class C> struct WsMap {
    typedef Dims<C> Dm;
    static constexpr size_t al(size_t x) { return (x + 255) & ~(size_t)255; }
    static constexpr size_t mx(size_t a, size_t b) { return a > b ? a : b; }
    static constexpr size_t SZ_QKV = al((size_t)Dm::T * Dm::QKVC * 2);
    static constexpr size_t S1a = al(mx((size_t)Dm::T * C::MH * C::KVL * 2, (size_t)Dm::T * C::D * 4));
    static constexpr size_t S1b = al(mx(mx((size_t)Dm::T * Dm::TOPK * 4, (size_t)Dm::T * C::MH * C::MDV * 2), (size_t)Dm::T * C::D * 2));
    static constexpr size_t RAW = al((size_t)Dm::T * C::QL * 4) + al((size_t)Dm::T * C::KVL * 4) + al((size_t)Dm::T * C::ID * 4);
    static constexpr size_t SZ_A1 = mx(mx(SZ_QKV, RAW), S1a + S1b);
    static constexpr size_t SZ_AAW = al((size_t)Dm::NCHUNKS * C::CH * C::CH * 4) + al((size_t)Dm::NCHUNKS * C::CH * C::CH * 2) + al((size_t)Dm::NCHUNKS * C::CH * C::DK * 2);
    static constexpr size_t SZ_QQ = al((size_t)Dm::T * C::MH * C::MDH * 4) + al((size_t)Dm::T * C::IH * C::ID * 4);
    static constexpr size_t SZ_ZGG = al((size_t)Dm::T * Dm::HV * 2) + 2 * al((size_t)Dm::T * C::D * 2);
    static constexpr size_t SZ_A0 = mx(mx(SZ_QKV, SZ_AAW), mx(SZ_QQ, SZ_ZGG));
    static constexpr size_t A1 = 1 << 20, A0 = A1 + SZ_A1, A2 = A0 + SZ_A0;
    static constexpr size_t o_MOD = 65536, o_BETA = A2, o_G = o_BETA + al((size_t)Dm::T * C::DNH * 4), o_GC = o_G + al((size_t)Dm::T * C::DNH * 4),
        o_GL = o_GC + al((size_t)Dm::T * C::DNH * 4), o_WIDX = o_GL + al((size_t)Dm::NCHUNKS * 4), o_QLATN = o_WIDX + al((size_t)Dm::T * C::IH * 4),
        o_CKVN = o_QLATN + al((size_t)Dm::T * C::QL * 2), o_KIDXN = o_CKVN + al((size_t)Dm::T * C::KVL * 2), A3 = o_KIDXN + al((size_t)Dm::T * C::ID * 2);
    static constexpr size_t SCR_BYTES = 16u << 20;
    static constexpr size_t o_PQ = A0;
    static constexpr size_t END = mx(A3 + SCR_BYTES, o_PQ + al((size_t)Dm::T * C::PH * C::PDQ * 4));
    static_assert(o_MOD + (size_t)C::B * 6 * C::D * 4 <= A1, "MOD in the first MiB");
    static constexpr size_t o_QLATR = A1, o_CKVR = o_QLATR + al((size_t)Dm::T * C::QL * 4), o_KIDXR = o_CKVR + al((size_t)Dm::T * C::KVL * 4);
    static constexpr size_t o_AMAT = A0, o_ATT = o_AMAT + al((size_t)Dm::NCHUNKS * C::CH * C::CH * 4), o_W = o_ATT + al((size_t)Dm::NCHUNKS * C::CH * C::CH * 2);
    static constexpr size_t o_QF = A0, o_QIDX = o_QF + al((size_t)Dm::T * C::MH * C::MDH * 4);
    static constexpr size_t o_QABS = A1, o_IDX = A1 + S1a;
    static constexpr size_t o_Z = A0, o_GA = o_Z + al((size_t)Dm::T * Dm::HV * 2), o_GB = o_GA + al((size_t)Dm::T * C::D * 2);
    static constexpr size_t o_OATT = o_IDX, o_X1 = A1, o_H2 = o_IDX;
    static constexpr size_t d_H1 = 0, d_O = al((size_t)Dm::T * C::D * 2), d_OG = 0, d_M = d_O;
    static constexpr size_t d_EXPI = 0, d_GATE = al((size_t)Dm::T * Dm::SLOTS * 4), d_ACT = 2 * d_GATE, d_SCR = (size_t)Dm::T * C::D * 2;
    static_assert(d_O + (size_t)Dm::T * Dm::HV * 2 <= (size_t)Dm::T * C::D * 4 && d_ACT + (size_t)Dm::T * Dm::SLOTS * 4 <= d_SCR, "d_out scratch");
};

template <class C> inline void np_setup(NP& P, void* const* d_in, void* d_out, void* d_ws) {
    typedef WsMap<C> W;
    const float** f = (const float**)&P.x;
    for (int i = 0; i < 26; ++i) f[i] = (const float*)d_in[i];
    char* ws = (char*)d_ws; char* dob = (char*)d_out;
    P.out = (float*)d_out;
    P.MOD = (float*)(ws + W::o_MOD); P.H1 = (bf16_t*)(dob + W::d_H1); P.QKVP = (bf16_t*)(ws + W::A0); P.QKVN = (bf16_t*)(ws + W::A1);
    P.Z = (bf16_t*)(ws + W::o_Z); P.GA = (bf16_t*)(ws + W::o_GA); P.GB = (bf16_t*)(ws + W::o_GB);
    P.BETA = (float*)(ws + W::o_BETA); P.G = (float*)(ws + W::o_G); P.GC = (float*)(ws + W::o_GC); P.GL = (float*)(ws + W::o_GL);
    P.QLATR = (float*)(ws + W::o_QLATR); P.CKVR = (float*)(ws + W::o_CKVR); P.KIDXR = (float*)(ws + W::o_KIDXR); P.WIDX = (float*)(ws + W::o_WIDX);
    P.QLATN = (bf16_t*)(ws + W::o_QLATN); P.CKVN = (bf16_t*)(ws + W::o_CKVN); P.KIDXN = (bf16_t*)(ws + W::o_KIDXN);
    P.AMAT = (float*)(ws + W::o_AMAT); P.ATT = (bf16_t*)(ws + W::o_ATT); P.W = (bf16_t*)(ws + W::o_W); P.O = (bf16_t*)(dob + W::d_O); P.OG = (bf16_t*)(dob + W::d_OG);
    P.QF = (float*)(ws + W::o_QF); P.QIDX = (float*)(ws + W::o_QIDX); P.QABS = (bf16_t*)(ws + W::o_QABS); P.IDX = (int*)(ws + W::o_IDX); P.OLAT = P.QABS;
    P.OATT = (bf16_t*)(ws + W::o_OATT); P.M = (bf16_t*)(dob + W::d_M); P.X1 = (float*)(ws + W::o_X1); P.H2 = (bf16_t*)(ws + W::o_H2);
    P.PQ = (float*)(ws + W::o_PQ); P.EXPI = (int*)(dob + W::d_EXPI); P.GATE = (float*)(dob + W::d_GATE); P.ACT = (float*)(dob + W::d_ACT);
    P.SCRP = (float*)(ws + W::A3); P.S = nullptr; P.RAW = (float*)(ws + W::A1);
}

enum { ST_MOD = 0, ST_H1, ST_INPROJ_A, ST_DSANORM, ST_CONV, ST_GC, ST_AMAT, ST_SOLVE, ST_SCALE, ST_SCAN, ST_Q, ST_QABS, ST_INDEX, ST_ATTN,
       ST_INPROJ_B, ST_QIDX, ST_SMALL, ST_OGATE, ST_OATT, ST_MERGE, ST_WO, ST_H2, ST_PEERQ, ST_ROUTE, ST_PACT, ST_POUT, ST_FINAL, ST_COUNT };

template <class C> HD void n_mod(const NP& P, int item) {
    const int D = C::D; const int b = item / (6 * D), j = item % (6 * D);
    float acc = P.b_ada[j];
    for (int i = 0; i < D; ++i) acc += siluf(P.c[b * D + i]) * P.w_ada[(size_t)i * 6 * D + j];
    P.MOD[item] = acc;
}
template <class C> HD void n_h1(const NP& P, int t) {
    const int D = C::D; const int b = t / C::L; const float* xr = P.x + (size_t)t * D;
    float ss = 0.f; for (int i = 0; i < D; ++i) ss += xr[i] * xr[i];
    const float rstd = 1.f / sqrtf(ss / D + Dims<C>::EPS);
    const float* sh = P.MOD + (size_t)b * 6 * D; const float* sc = sh + D;
    for (int i = 0; i < D; ++i) P.H1[(size_t)t * D + i] = f2bf(xr[i] * rstd * P.norm1_w[i] * (1.f + sc[i]) + sh[i]);
}
template <class C> HD void inproj_store(const NP& P, int t, int n, float v) {
    typedef Dims<C> Dm;
    if (n < Dm::OFF_Z) P.QKVP[(size_t)t * Dm::QKVC + n] = f2bf(v);
    else if (n < Dm::OFF_B) P.Z[(size_t)t * Dm::HV + (n - Dm::OFF_Z)] = f2bf(v);
    else if (n < Dm::OFF_A) P.BETA[(size_t)t * C::DNH + (n - Dm::OFF_B)] = sigmf(v);
    else if (n < Dm::OFF_QL) { const int h = n - Dm::OFF_A; P.G[(size_t)t * C::DNH + h] = -expf(P.dn_a_log[h]) * softplusf(v + P.dn_dt_bias[h]); }
    else if (n < Dm::OFF_CKV) P.QLATR[(size_t)t * C::QL + (n - Dm::OFF_QL)] = v;
    else if (n < Dm::OFF_KI) P.CKVR[(size_t)t * C::KVL + (n - Dm::OFF_CKV)] = v;
    else if (n < Dm::OFF_WI) P.KIDXR[(size_t)t * C::ID + (n - Dm::OFF_KI)] = v;
    else if (n < Dm::OFF_GA) P.WIDX[(size_t)t * C::IH + (n - Dm::OFF_WI)] = v * (1.f / sqrtf((float)C::IH) / sqrtf((float)C::ID));
    else if (n < Dm::OFF_GB) P.GA[(size_t)t * C::D + (n - Dm::OFF_GA)] = f2bf(v);
    else P.GB[(size_t)t * C::D + (n - Dm::OFF_GB)] = f2bf(v);
}
template <class C> HD void n_inproj(const NP& P, int item, int c0, int c1) {
    typedef Dims<C> Dm; const int ng = (c1 - c0) / 4; const int t = item / ng, n = c0 + 4 * (item % ng);
    float a0 = 0, a1 = 0, a2 = 0, a3 = 0; const bf16_t* hr = P.H1 + (size_t)t * C::D;
    for (int k = 0; k < C::D; ++k) { const float h = bf2f(hr[k]); const float* w = P.w_in + (size_t)k * Dm::IN_COLS + n; a0 += h * w[0]; a1 += h * w[1]; a2 += h * w[2]; a3 += h * w[3]; }
    inproj_store<C>(P, t, n, a0); inproj_store<C>(P, t, n + 1, a1); inproj_store<C>(P, t, n + 2, a2); inproj_store<C>(P, t, n + 3, a3);
}
template <class C> HD void n_dsanorm(const NP& P, int t) {
    typedef Dims<C> Dm;
    { const float* r = P.QLATR + (size_t)t * C::QL; float ss = 0; for (int i = 0; i < C::QL; ++i) ss += r[i] * r[i]; const float rs = 1.f / sqrtf(ss / C::QL + Dm::EPS);
      for (int i = 0; i < C::QL; ++i) P.QLATN[(size_t)t * C::QL + i] = f2bf(r[i] * rs * P.q_norm_w[i]); }
    { const float* r = P.CKVR + (size_t)t * C::KVL; float ss = 0; for (int i = 0; i < C::KVL; ++i) ss += r[i] * r[i]; const float rs = 1.f / sqrtf(ss / C::KVL + Dm::EPS);
      for (int i = 0; i < C::KVL; ++i) P.CKVN[(size_t)t * C::KVL + i] = f2bf(r[i] * rs * P.kv_norm_w[i]); }
    { const float* r = P.KIDXR + (size_t)t * C::ID; float ss = 0; for (int i = 0; i < C::ID; ++i) ss += r[i] * r[i]; const float rs = 1.f / sqrtf(ss / C::ID + Dm::EPS);
      for (int i = 0; i < C::ID; ++i) P.KIDXN[(size_t)t * C::ID + i] = f2bf(r[i] * rs * P.idx_k_norm_w[i]); }
}

template <class C> HD void n_small(const NP& P, int t) {
    typedef Dims<C> Dm; const float* r = P.RAW + (size_t)t * 768;
    { float ss = 0; for (int i = 0; i < C::QL; ++i) ss += r[i] * r[i]; const float rs = 1.f / sqrtf(ss / C::QL + Dm::EPS);
      for (int i = 0; i < C::QL; ++i) P.QLATN[(size_t)t * C::QL + i] = f2bf(r[i] * rs * P.q_norm_w[i]); }
    { const float* q = r + 256; float ss = 0; for (int i = 0; i < C::KVL; ++i) ss += q[i] * q[i]; const float rs = 1.f / sqrtf(ss / C::KVL + Dm::EPS);
      for (int i = 0; i < C::KVL; ++i) P.CKVN[(size_t)t * C::KVL + i] = f2bf(q[i] * rs * P.kv_norm_w[i]); }
    { const float* q = r + 512; float ss = 0; for (int i = 0; i < C::ID; ++i) ss += q[i] * q[i]; const float rs = 1.f / sqrtf(ss / C::ID + Dm::EPS);
      for (int i = 0; i < C::ID; ++i) P.KIDXN[(size_t)t * C::ID + i] = f2bf(q[i] * rs * P.idx_k_norm_w[i]); }
    for (int h = 0; h < C::DNH; ++h) { P.BETA[(size_t)t * C::DNH + h] = sigmf(r[576 + h]); P.G[(size_t)t * C::DNH + h] = -expf(P.dn_a_log[h]) * softplusf(r[584 + h] + P.dn_dt_bias[h]); }
    for (int h = 0; h < C::IH; ++h) P.WIDX[(size_t)t * C::IH + h] = r[592 + h] * (1.f / sqrtf((float)C::IH) / sqrtf((float)C::ID));
}
template <class C> HD float conv_at(const NP& P, int t, int ch) {
    typedef Dims<C> Dm; const int l = t % C::L; float acc = 0.f;
    for (int i = 0; i < C::CONV; ++i) { const int ll = l - (C::CONV - 1) + i; if (ll >= 0) acc += bf2f(P.QKVP[(size_t)(t - (C::CONV - 1) + i) * Dm::QKVC + ch]) * P.dn_conv_w[(size_t)i * Dm::QKVC + ch]; }
    return siluf(acc);
}
template <class C> HD void n_conv(const NP& P, int item) {
    typedef Dims<C> Dm; const int which = item % 3, h = (item / 3) % C::DNH, t = item / (3 * C::DNH);
    const int dim = (which == 2) ? C::DV : C::DK; const int ch0 = (which == 0 ? 0 : which == 1 ? Dm::HK : 2 * Dm::HK) + h * dim;
    float rs = 1.f;
    if (which < 2) { float ss = 0.f; for (int d = 0; d < dim; ++d) { const float v = conv_at<C>(P, t, ch0 + d); ss += v * v; } rs = 1.f / sqrtf(ss + Dm::EPS); }
    for (int d = 0; d < dim; ++d) P.QKVN[(size_t)t * Dm::QKVC + ch0 + d] = f2bf(conv_at<C>(P, t, ch0 + d) * rs);
}
template <class C> HD void n_gc(const NP& P, int item) {
    typedef Dims<C> Dm; const int n = item % Dm::NCH, h = (item / Dm::NCH) % C::DNH, b = item / (Dm::NCH * C::DNH);
    float s = 0.f; for (int i = 0; i < C::CH; ++i) { const size_t t = (size_t)b * C::L + n * C::CH + i; s += P.G[t * C::DNH + h]; P.GC[t * C::DNH + h] = s; }
    P.GL[item] = expf(s);
}
template <class C> HD void n_amat(const NP& P, int item) {
    typedef Dims<C> Dm; const int j = item % C::CH, i = (item / C::CH) % C::CH, cid = item / (C::CH * C::CH);
    const int n = cid % Dm::NCH, h = (cid / Dm::NCH) % C::DNH, b = cid / (Dm::NCH * C::DNH);
    const size_t ti = (size_t)b * C::L + n * C::CH + i, tj = (size_t)b * C::L + n * C::CH + j;
    float a = 0.f, at = 0.f;
    if (j <= i) {
        const bf16_t* ki = P.QKVN + ti * Dm::QKVC + Dm::HK + h * C::DK; const bf16_t* kj = P.QKVN + tj * Dm::QKVC + Dm::HK + h * C::DK; const bf16_t* qi = P.QKVN + ti * Dm::QKVC + h * C::DK;
        float kk = 0.f, qk = 0.f; for (int d = 0; d < C::DK; ++d) { const float kjd = bf2f(kj[d]); kk += bf2f(ki[d]) * kjd; qk += bf2f(qi[d]) * kjd; }
        const float dec = expf(P.GC[ti * C::DNH + h] - P.GC[tj * C::DNH + h]);
        if (j < i) a = P.BETA[ti * C::DNH + h] * kk * dec;
        at = qk * (1.f / sqrtf((float)C::DK)) * dec;
    }
    P.AMAT[(size_t)cid * C::CH * C::CH + i * C::CH + j] = a;
    P.ATT[(size_t)cid * C::CH * C::CH + i * C::CH + j] = f2bf(at);
}
template <class C> HD void n_solve(const NP& P, int item, int tid, int NT) {
    typedef Dims<C> Dm; const int NC = C::DV + C::DK; const int col = item % NC, cid = item / NC;
    const int n = cid % Dm::NCH, h = (cid / Dm::NCH) % C::DNH, b = cid / (Dm::NCH * C::DNH);
    const float* A = P.AMAT + (size_t)cid * C::CH * C::CH;
    for (int i = 0; i < C::CH; ++i) {
        const size_t t = (size_t)b * C::L + n * C::CH + i; const float beta = P.BETA[t * C::DNH + h];
        float r;
        if (col < C::DV) r = bf2f(P.QKVN[t * Dm::QKVC + 2 * Dm::HK + h * C::DV + col]) * beta;
        else r = bf2f(P.QKVN[t * Dm::QKVC + Dm::HK + h * C::DK + (col - C::DV)]) * beta * expf(P.GC[t * C::DNH + h]);
        for (int j = 0; j < i; ++j) r -= A[i * C::CH + j] * SCR(j);
        SCR(i) = r;
    }
    for (int i = 0; i < C::CH; ++i) {
        const size_t t = (size_t)b * C::L + n * C::CH + i;
        if (col < C::DV) P.QKVN[t * Dm::QKVC + 2 * Dm::HK + h * C::DV + col] = f2bf(SCR(i));
        else P.W[((size_t)cid * C::CH + i) * C::DK + (col - C::DV)] = f2bf(SCR(i));
    }
}
template <class C> HD void n_scale(const NP& P, int item) {
    typedef Dims<C> Dm; const int h = item % C::DNH; const size_t t = item / C::DNH; const int l = (int)(t % C::L), b = (int)(t / C::L), n = l / C::CH;
    const float gc = P.GC[t * C::DNH + h]; const size_t tl = (size_t)b * C::L + n * C::CH + C::CH - 1; const float gl = P.GC[tl * C::DNH + h];
    const float fq = expf(gc) * (1.f / sqrtf((float)C::DK)), fk = expf(gl - gc);
    bf16_t* q = P.QKVN + t * Dm::QKVC + h * C::DK; bf16_t* k = P.QKVN + t * Dm::QKVC + Dm::HK + h * C::DK;
    for (int d = 0; d < C::DK; ++d) { q[d] = f2bf(bf2f(q[d]) * fq); k[d] = f2bf(bf2f(k[d]) * fk); }
}
template <class C> HD void n_scan(const NP& P, int item, int tid, int NT) {
    typedef Dims<C> Dm; const int e = item % C::DV, h = (item / C::DV) % C::DNH, b = item / (C::DV * C::DNH);
    for (int d = 0; d < C::DK; ++d) SCR(d) = 0.f;
    for (int n = 0; n < Dm::NCH; ++n) {
        const int cid = (b * C::DNH + h) * Dm::NCH + n; const size_t t0 = (size_t)b * C::L + n * C::CH;
        const bf16_t* Wc = P.W + (size_t)cid * C::CH * C::DK; const bf16_t* At = P.ATT + (size_t)cid * C::CH * C::CH;
        for (int r = 0; r < C::CH; ++r) { float acc = bf2f(P.QKVN[(t0 + r) * Dm::QKVC + 2 * Dm::HK + h * C::DV + e]);
            for (int d = 0; d < C::DK; ++d) acc -= bf2f(Wc[r * C::DK + d]) * SCR(d);
            SCR(C::DK + r) = acc; }
        for (int r = 0; r < C::CH; ++r) { float o = 0.f; const bf16_t* qd = P.QKVN + (t0 + r) * Dm::QKVC + h * C::DK;
            for (int d = 0; d < C::DK; ++d) o += bf2f(qd[d]) * SCR(d);
            for (int s = 0; s <= r; ++s) o += bf2f(At[r * C::CH + s]) * SCR(C::DK + s);
            P.O[(t0 + r) * Dm::HV + h * C::DV + e] = f2bf(o); }
        const float gl = P.GL[cid];
        for (int d = 0; d < C::DK; ++d) { float acc = SCR(d) * gl;
            for (int r = 0; r < C::CH; ++r) acc += bf2f(P.QKVN[(t0 + r) * Dm::QKVC + Dm::HK + h * C::DK + d]) * SCR(C::DK + r);
            SCR(d) = acc; }
    }
}
template <class C> HD void n_ogate(const NP& P, int item) {
    typedef Dims<C> Dm; const int h = item % C::DNH; const size_t t = item / C::DNH; const bf16_t* o = P.O + t * Dm::HV + h * C::DV;
    float ss = 0.f; for (int d = 0; d < C::DV; ++d) { const float v = bf2f(o[d]); ss += v * v; } const float rs = 1.f / sqrtf(ss / C::DV + Dm::EPS);
    for (int d = 0; d < C::DV; ++d) P.OG[t * Dm::HV + h * C::DV + d] = f2bf(bf2f(o[d]) * rs * P.dn_onorm_w[d] * siluf(bf2f(P.Z[t * Dm::HV + h * C::DV + d])));
}
template <class C> HD void n_q(const NP& P, int item) {
    const int NJ = C::MH * C::MDH + C::IH * C::ID; const int j = item % NJ; const size_t t = item / NJ; const bf16_t* ql = P.QLATN + t * C::QL;
    float acc = 0.f;
    if (j < C::MH * C::MDH) { for (int k = 0; k < C::QL; ++k) acc += bf2f(ql[k]) * P.w_uq[(size_t)k * C::MH * C::MDH + j]; P.QF[t * C::MH * C::MDH + j] = acc; }
    else { const int jj = j - C::MH * C::MDH; for (int k = 0; k < C::QL; ++k) acc += bf2f(ql[k]) * P.w_iq[(size_t)k * C::IH * C::ID + jj]; P.QIDX[t * C::IH * C::ID + jj] = acc; }
}
template <class C> HD void n_qabs(const NP& P, int item) {
    const int c = item % C::KVL, h = (item / C::KVL) % C::MH; const size_t t = item / (C::KVL * C::MH);
    float acc = 0.f; for (int d = 0; d < C::MDH; ++d) acc += P.QF[t * C::MH * C::MDH + h * C::MDH + d] * P.w_uk[((size_t)c * C::MH + h) * C::MDH + d];
    P.QABS[(t * C::MH + h) * C::KVL + c] = f2bf(acc * (1.f / sqrtf((float)C::MDH)));
}
template <class C> HD void n_index(const NP& P, int t, int tid, int NT) {
    typedef Dims<C> Dm; const int K = Dm::TOPK; const int l = t % C::L, b = t / C::L; int cnt = 0;
    const float* qi = P.QIDX + (size_t)t * C::IH * C::ID; const float* wi = P.WIDX + (size_t)t * C::IH;
#define HV_(i) SCR(i)
#define HI_(i) SCR(K + (i))
#define WORSE(v1, i1, v2, i2) ((v1) < (v2) || ((v1) == (v2) && (i1) > (i2)))
    for (int s = 0; s <= l; ++s) {
        const bf16_t* kr = P.KIDXN + ((size_t)b * C::L + s) * C::ID; float sc = 0.f;
        for (int h = 0; h < C::IH; ++h) { float dot = 0.f; for (int d = 0; d < C::ID; ++d) dot += qi[h * C::ID + d] * bf2f(kr[d]); sc += wi[h] * (dot > 0.f ? dot : 0.f); }
        const float fs = (float)s;
        if (cnt < K) {
            int i = cnt++; HV_(i) = sc; HI_(i) = fs;
            while (i > 0) { const int p = (i - 1) >> 1; const float pv = HV_(p), pi = HI_(p), cv = HV_(i), ci = HI_(i);
                if (WORSE(cv, ci, pv, pi)) { HV_(p) = cv; HI_(p) = ci; HV_(i) = pv; HI_(i) = pi; i = p; } else break; }
        } else if (HV_(0) < sc) {
            int i = 0; HV_(0) = sc; HI_(0) = fs;
            for (;;) { const int a = 2 * i + 1, c2 = a + 1; int w = i; float wv = HV_(i), wx = HI_(i);
                if (a < K) { const float av = HV_(a), ai = HI_(a); if (WORSE(av, ai, wv, wx)) { w = a; wv = av; wx = ai; } }
                if (c2 < K) { const float bv = HV_(c2), bi = HI_(c2); if (WORSE(bv, bi, wv, wx)) { w = c2; wv = bv; wx = bi; } }
                if (w == i) break; const float tv = HV_(i), ti = HI_(i); HV_(i) = wv; HI_(i) = wx; HV_(w) = tv; HI_(w) = ti; i = w; }
        }
    }
    for (int k = 0; k < K; ++k) P.IDX[(size_t)t * K + k] = (k < cnt) ? (int)HI_(k) : -1;
#undef HV_
#undef HI_
#undef WORSE
}
template <class C> HD void n_attn(const NP& P, int item, int tid, int NT) {
    typedef Dims<C> Dm; const int K = Dm::TOPK; const int h = item % C::MH; const size_t t = item / C::MH; const int b = (int)(t / C::L);
    const int* idx = P.IDX + t * K; bf16_t* qa = P.QABS + (t * C::MH + h) * C::KVL;
    int nv = 0; float m = -3.0e38f;
    for (int k = 0; k < K; ++k) { const int s = idx[k]; if (s < 0) break; ++nv;
        const bf16_t* kv = P.CKVN + ((size_t)b * C::L + s) * C::KVL; float lg = 0.f; for (int c = 0; c < C::KVL; ++c) lg += bf2f(qa[c]) * bf2f(kv[c]);
        SCR(k) = lg; m = lg > m ? lg : m; }
    float sum = 0.f; for (int k = 0; k < nv; ++k) { const float p = expf(SCR(k) - m); SCR(k) = p; sum += p; }
    const float inv = 1.f / sum;
    for (int c = 0; c < C::KVL; ++c) { float acc = 0.f; for (int k = 0; k < nv; ++k) acc += SCR(k) * bf2f(P.CKVN[((size_t)b * C::L + idx[k]) * C::KVL + c]);
        SCR(K + c) = acc * inv; }
    for (int c = 0; c < C::KVL; ++c) qa[c] = f2bf(SCR(K + c));
}
template <class C> HD void n_oatt(const NP& P, int item) {
    const int d = item % C::MDV, h = (item / C::MDV) % C::MH; const size_t t = item / (C::MDV * C::MH);
    float acc = 0.f; for (int c = 0; c < C::KVL; ++c) acc += bf2f(P.OLAT[(t * C::MH + h) * C::KVL + c]) * P.w_uv[((size_t)c * C::MH + h) * C::MDV + d];
    P.OATT[t * C::MH * C::MDV + h * C::MDV + d] = f2bf(acc);
}
template <class C> HD void n_merge(const NP& P, int item) {
    typedef Dims<C> Dm; const int n = item % C::D; const size_t t = item / C::D;
    float ya = 0.f, yb = 0.f;
    for (int k = 0; k < Dm::HV; ++k) ya += bf2f(P.OG[t * Dm::HV + k]) * P.w_a_out[(size_t)k * C::D + n];
    for (int k = 0; k < C::MH * C::MDV; ++k) yb += bf2f(P.OATT[t * C::MH * C::MDV + k]) * P.w_b_out[(size_t)k * C::D + n];
    P.M[t * C::D + n] = f2bf(sigmf(bf2f(P.GA[t * C::D + n])) * ya + sigmf(bf2f(P.GB[t * C::D + n])) * yb);
}
template <class C> HD void n_wo(const NP& P, int item) {
    const int n = item % C::D; const size_t t = item / C::D; const int b = (int)(t / C::L);
    float acc = 0.f; for (int k = 0; k < C::D; ++k) acc += bf2f(P.M[t * C::D + k]) * P.w_o[(size_t)k * C::D + n];
    P.X1[t * C::D + n] = P.x[t * C::D + n] + P.MOD[(size_t)b * 6 * C::D + 2 * C::D + n] * acc;
}
template <class C> HD void n_h2(const NP& P, int t) {
    const int D = C::D; const int b = t / C::L; const float* xr = P.X1 + (size_t)t * D;
    float ss = 0.f; for (int i = 0; i < D; ++i) ss += xr[i] * xr[i];
    const float rstd = 1.f / sqrtf(ss / D + Dims<C>::EPS);
    const float* sh = P.MOD + (size_t)b * 6 * D + 3 * D; const float* sc = sh + D;
    for (int i = 0; i < D; ++i) P.H2[(size_t)t * D + i] = f2bf(xr[i] * rstd * P.norm2_w[i] * (1.f + sc[i]) + sh[i]);
}
template <class C> HD void n_peerq(const NP& P, int item) {
    const int NJ = C::PH * C::PDQ; const int j = item % NJ; const size_t t = item / NJ;
    float acc = 0.f; for (int k = 0; k < C::D; ++k) acc += bf2f(P.H2[t * C::D + k]) * P.peer_w_q[(size_t)k * NJ + j];
    P.PQ[t * NJ + j] = acc;
}
template <class C> HD void n_route(const NP& P, int item, int tid, int NT) {
    typedef Dims<C> Dm; const int PK = C::PK, TK = C::PTK; const int h = item % C::PH; const size_t t = item / C::PH;
    const int oS = 0, oSV = 2 * PK, oSI = oSV + 2 * TK, oC = oSI + 2 * TK;
    for (int p = 0; p < 2; ++p) for (int n = 0; n < PK; ++n) {
        float acc = 0.f;
        if (P.S) acc = P.S[t * (size_t)(C::PH * 2 * PK) + (h * 2 + p) * PK + n];
        else { const float* q = P.PQ + t * C::PH * C::PDQ + (h * 2 + p) * Dm::PD2; const float* key = P.peer_sub_keys + (((size_t)h * 2 + p) * PK + n) * Dm::PD2;
            for (int d = 0; d < Dm::PD2; ++d) acc += q[d] * key[d]; }
        SCR(oS + p * PK + n) = acc; }
    for (int p = 0; p < 2; ++p) for (int k = 0; k < TK; ++k) { int bi = 0; float bv = -3.0e38f;
        for (int n = 0; n < PK; ++n) { const float v = SCR(oS + p * PK + n); if (v > bv) { bv = v; bi = n; } }
        SCR(oSV + p * TK + k) = bv; SCR(oSI + p * TK + k) = (float)bi; SCR(oS + p * PK + bi) = -3.0e38f; }
    for (int i = 0; i < TK; ++i) for (int j = 0; j < TK; ++j) SCR(oC + i * TK + j) = SCR(oSV + i) + SCR(oSV + TK + j);
    float tv[C::PTK]; int te[C::PTK]; float mx = -3.0e38f;
#pragma unroll
    for (int k = 0; k < TK; ++k) { int bi = 0; float bv = -3.0e38f;
        for (int n = 0; n < TK * TK; ++n) { const float v = SCR(oC + n); if (v > bv) { bv = v; bi = n; } }
        SCR(oC + bi) = -3.0e38f; tv[k] = bv; te[k] = (int)SCR(oSI + bi / TK) * PK + (int)SCR(oSI + TK + bi % TK); mx = bv > mx ? bv : mx; }
    float sum = 0.f;
#pragma unroll
    for (int k = 0; k < TK; ++k) { tv[k] = expf(tv[k] - mx); sum += tv[k]; }
#pragma unroll
    for (int k = 0; k < TK; ++k) { P.EXPI[t * Dm::SLOTS + h * TK + k] = te[k]; P.GATE[t * Dm::SLOTS + h * TK + k] = tv[k] / sum; }
}
template <class C> HD void n_pact(const NP& P, int item) {
    typedef Dims<C> Dm; const int sl = item % Dm::SLOTS; const size_t t = item / Dm::SLOTS; const int e = P.EXPI[t * Dm::SLOTS + sl];
    const float* u = P.peer_u + (size_t)e * C::D; float acc = 0.f; for (int d = 0; d < C::D; ++d) acc += u[d] * bf2f(P.H2[t * C::D + d]);
    P.ACT[t * Dm::SLOTS + sl] = geluf(acc) * P.GATE[t * Dm::SLOTS + sl];
}
template <class C> HD void n_pout(const NP& P, int item) {
    typedef Dims<C> Dm; const int d = item % C::D; const size_t t = item / C::D; const int b = (int)(t / C::L);
    float acc = 0.f; for (int s = 0; s < Dm::SLOTS; ++s) acc += P.ACT[t * Dm::SLOTS + s] * P.peer_v[(size_t)P.EXPI[t * Dm::SLOTS + s] * C::D + d];
    P.X1[t * C::D + d] += P.MOD[(size_t)b * 6 * C::D + 5 * C::D + d] * acc;
}
template <class C> HD void n_final(const NP& P, int t) {
    const int D = C::D; const float* xr = P.X1 + (size_t)t * D; float ss = 0.f; for (int i = 0; i < D; ++i) ss += xr[i] * xr[i];
    const float rstd = 1.f / sqrtf(ss / D + Dims<C>::EPS);
    for (int i = 0; i < D; ++i) P.out[(size_t)t * D + i] = xr[i] * rstd * P.final_norm_w[i];
}

template <class C> HD long stage_items(int st) {
    typedef Dims<C> Dm; const long T = Dm::T;
    switch (st) {
        case ST_MOD: return (long)C::B * 6 * C::D; case ST_H1: return T;
        case ST_INPROJ_A: return T * ((Dm::OFF_GA - 0) / 4) - T * (Dm::HV / 4);
        case ST_DSANORM: return T; case ST_CONV: return T * C::DNH * 3; case ST_GC: return Dm::NCHUNKS; case ST_AMAT: return (long)Dm::NCHUNKS * C::CH * C::CH;
        case ST_SOLVE: return (long)Dm::NCHUNKS * (C::DV + C::DK); case ST_SCALE: return T * C::DNH; case ST_SCAN: return (long)C::B * C::DNH * C::DV;
        case ST_Q: return T * (C::MH * C::MDH + C::IH * C::ID); case ST_QIDX: return T * (C::IH * C::ID); case ST_SMALL: return T; case ST_QABS: return T * C::MH * C::KVL; case ST_INDEX: return T; case ST_ATTN: return T * C::MH;
        case ST_INPROJ_B: return T * ((Dm::HV + 2 * C::D) / 4); case ST_OGATE: return T * C::DNH; case ST_OATT: return T * C::MH * C::MDV; case ST_MERGE: return T * C::D;
        case ST_WO: return T * C::D; case ST_H2: return T; case ST_PEERQ: return T * C::PH * C::PDQ; case ST_ROUTE: return T * C::PH; case ST_PACT: return T * Dm::SLOTS;
        case ST_POUT: return T * C::D; case ST_FINAL: return T;
    }
    return 0;
}
template <class C> HD int stage_scr_words(int st) {
    typedef Dims<C> Dm;
    switch (st) { case ST_SOLVE: return C::CH; case ST_SCAN: return C::DK + C::CH; case ST_INDEX: return 2 * Dm::TOPK; case ST_ATTN: return Dm::TOPK + C::KVL;
        case ST_ROUTE: return 2 * C::PK + 4 * C::PTK + C::PTK * C::PTK; }
    return 0;
}
template <class C> HD void run_item(const NP& P, int st, long item, int tid, int NT) {
    typedef Dims<C> Dm;
    switch (st) {
        case ST_MOD: n_mod<C>(P, (int)item); break; case ST_H1: n_h1<C>(P, (int)item); break;
        case ST_INPROJ_A: { const int ngA = Dm::OFF_Z / 4, ngB = (Dm::OFF_GA - Dm::OFF_B) / 4, ng = ngA + ngB; const int t = (int)(item / ng), g = (int)(item % ng);
            if (g < ngA) n_inproj<C>(P, t * ngA + g, 0, Dm::OFF_Z); else n_inproj<C>(P, t * ngB + (g - ngA), Dm::OFF_B, Dm::OFF_GA); } break;
        case ST_DSANORM: n_dsanorm<C>(P, (int)item); break; case ST_CONV: n_conv<C>(P, (int)item); break; case ST_GC: n_gc<C>(P, (int)item); break;
        case ST_AMAT: n_amat<C>(P, (int)item); break; case ST_SOLVE: n_solve<C>(P, (int)item, tid, NT); break; case ST_SCALE: n_scale<C>(P, (int)item); break;
        case ST_SCAN: n_scan<C>(P, (int)item, tid, NT); break; case ST_Q: n_q<C>(P, (int)item); break; case ST_QIDX: { const int NI = C::IH * C::ID, NJ = C::MH * C::MDH + NI; n_q<C>(P, (int)((item / NI) * NJ + C::MH * C::MDH + item % NI)); } break; case ST_QABS: n_qabs<C>(P, (int)item); break; case ST_SMALL: n_small<C>(P, (int)item); break;
        case ST_INDEX: n_index<C>(P, (int)item, tid, NT); break; case ST_ATTN: n_attn<C>(P, (int)item, tid, NT); break;
        case ST_INPROJ_B: { const int ngA = Dm::HV / 4, ngB = 2 * C::D / 4, ng = ngA + ngB; const int t = (int)(item / ng), g = (int)(item % ng);
            if (g < ngA) n_inproj<C>(P, t * ngA + g, Dm::OFF_Z, Dm::OFF_B); else n_inproj<C>(P, t * ngB + (g - ngA), Dm::OFF_GA, Dm::IN_COLS); } break;
        case ST_OGATE: n_ogate<C>(P, (int)item); break; case ST_OATT: n_oatt<C>(P, (int)item); break; case ST_MERGE: n_merge<C>(P, (int)item); break;
        case ST_WO: n_wo<C>(P, (int)item); break; case ST_H2: n_h2<C>(P, (int)item); break; case ST_PEERQ: n_peerq<C>(P, (int)item); break;
        case ST_ROUTE: n_route<C>(P, (int)item, tid, NT); break; case ST_PACT: n_pact<C>(P, (int)item); break; case ST_POUT: n_pout<C>(P, (int)item); break;
        case ST_FINAL: n_final<C>(P, (int)item); break;
    }
}
#define GAS __attribute__((address_space(1)))
#define LAS __attribute__((address_space(3)))
#define XB_TMO      128
#define XB_XCNT(j)  (256  + 64 * (j))
#define XB_XSUB(j)  (1280 + 64 * (j))
#define XB_XGEN(j)  (2304 + 64 * (j))
#define XB_TOP      3328
#define XB_TOPGEN   3392
#define XCD_BAR_WORDS 3456
#ifndef XB_SPIN_CAP
#define XB_SPIN_CAP (1u << 26)
#endif
__device__ __forceinline__ unsigned xb_ld(unsigned* p)              { return __hip_atomic_load(p, __ATOMIC_RELAXED, __HIP_MEMORY_SCOPE_AGENT); }
__device__ __forceinline__ unsigned xb_add(unsigned* p, unsigned v) { return __hip_atomic_fetch_add(p, v, __ATOMIC_RELAXED, __HIP_MEMORY_SCOPE_AGENT); }
__device__ __forceinline__ unsigned xb_xcc_id() { return (unsigned)__builtin_amdgcn_s_getreg((3 << 11) | 20) & 0xFu; }
#define XB_SPIN(cond, bar) do { unsigned _sp = 0; while (cond) { __builtin_amdgcn_s_sleep(1); \
    if ((++_sp & 255u) == 0u) { if (xb_ld(&(bar)[XB_TMO])) break; if (_sp > XB_SPIN_CAP) { atomicAdd(&(bar)[XB_TMO], 1u); break; } } } } while (0)
struct XcdBarrier { unsigned* bar; unsigned x; volatile LAS unsigned* st; };
__device__ __forceinline__ XcdBarrier xcd_barrier_post(unsigned* bar, volatile LAS unsigned* st) {
    XcdBarrier b; b.bar = bar; b.x = xb_xcc_id(); b.st = st;
    if (threadIdx.x == 0) (void)xb_add(&bar[XB_XCNT(b.x)], 1u);
    return b;
}
__device__ __forceinline__ void xcd_barrier_complete(unsigned* bar, unsigned x, unsigned& nloc, unsigned& nx) {
    const unsigned G = gridDim.x * gridDim.y * gridDim.z;
    unsigned sum, cnt, mine, sp = 0u;
    for (;;) {
        sum = 0u; cnt = 0u; mine = 0u;
#pragma unroll
        for (unsigned j = 0; j < 16; ++j) { const unsigned c = xb_ld(&bar[XB_XCNT(j)]); sum += c; cnt += (c > 0u) ? 1u : 0u; mine = (j == x) ? c : mine; }
        if (sum == G) break;
        __builtin_amdgcn_s_sleep(1);
        if ((++sp & 255u) == 0u) { if (xb_ld(&bar[XB_TMO])) break; if (sp > XB_SPIN_CAP) { atomicAdd(&bar[XB_TMO], 1u); break; } }
    }
    nloc = mine > 0u ? mine : 1u; nx = cnt > 0u ? cnt : 1u;
}
__device__ __forceinline__ void xcd_barrier(const XcdBarrier& b) {
    asm volatile("s_waitcnt vmcnt(0)" ::: "memory");
    __syncthreads();
    if (threadIdx.x == 0) {
        unsigned* bar = b.bar;
        __builtin_amdgcn_s_waitcnt(0);
        unsigned nloc = b.st[0], nx = b.st[1];
        if (nloc == 0u) { xcd_barrier_complete(bar, b.x, nloc, nx); b.st[0] = nloc; b.st[1] = nx; }
        const unsigned old = xb_add(&bar[XB_XSUB(b.x)], 1u);
        const unsigned gen = old / nloc;
        if (old + 1u == (gen + 1u) * nloc) {
            __builtin_amdgcn_fence(__ATOMIC_RELEASE, "agent");
            asm volatile("s_waitcnt vmcnt(0)" ::: "memory");
            const unsigned og = xb_add(&bar[XB_TOP], 1u);
            const unsigned tg = og / nx;
            if (og + 1u == (tg + 1u) * nx) xb_add(&bar[XB_TOPGEN], 1u);
            else XB_SPIN(xb_ld(&bar[XB_TOPGEN]) == tg, bar);
            __builtin_amdgcn_fence(__ATOMIC_ACQUIRE, "agent");
            xb_add(&bar[XB_XGEN(b.x)], 1u);
            asm volatile("s_waitcnt vmcnt(0)" ::: "memory");
        } else {
            XB_SPIN(xb_ld(&bar[XB_XGEN(b.x)]) == gen, bar);
            __builtin_amdgcn_fence(__ATOMIC_ACQUIRE, "agent");
            asm volatile("s_waitcnt vmcnt(0)" ::: "memory");
        }
    }
    __syncthreads();
}
namespace pg8 {
#define PG8_LAS __attribute__((address_space(3)))
typedef unsigned short bf16_t;
typedef short bf16x8 __attribute__((ext_vector_type(8)));
typedef float f32x4 __attribute__((ext_vector_type(4)));
typedef unsigned u32x4 __attribute__((ext_vector_type(4)));
constexpr int BM = 256, BK = 64, HALF = 128, HTB = HALF * BK * 2  , STAGE_BYTES = 8 * HTB, NXCD = 8, WGM = 8;

__host__ __device__ __forceinline__ int lds_byte(int r, int c) { const int st = (r >> 4) * 2 + (c >> 5), rr = r & 15, cc = c & 31, ob = rr * 64 + cc * 2; return st * 1024 + (ob ^ (((ob >> 9) & 1) << 5)); }
__host__ __device__ __forceinline__ void stage_rc(int b, int& R, int& C) { const int st = b / 1024, sb = b % 1024, swz = sb ^ (((sb >> 9) & 1) << 5); R = (st >> 1) * 16 + swz / 64; C = (st & 1) * 32 + (swz % 64) / 2; }
__host__ __device__ __forceinline__ int perm32(int rho) { const int n = rho >> 4, i = rho & 15; return 8 * (i >> 2) + 4 * n + (i & 3); }
__device__ __forceinline__ unsigned cvt_pk_bf16(float lo, float hi) { unsigned r; asm volatile("v_cvt_pk_bf16_f32 %0, %1, %2" : "=v"(r) : "v"(lo), "v"(hi)); return r; }
struct Unit { int pm, pn; const char* a; const char* b; };
struct Gemm { int lda, ldb, K; };
template <class Epi, class Sched, bool ALIGN_EPI = false, bool SP2 = false>
__device__ __forceinline__ void gemm_phase(PG8_LAS unsigned char* lds, const Gemm g, const Sched& S, const Epi& E) {
    int tid = threadIdx.x; asm volatile("" : "+v"(tid));
    const int wid = __builtin_amdgcn_readfirstlane(tid >> 6), lane = tid & 63, wr = wid >> 2, wc = wid & 3, fr = lane & 15, fq = lane >> 4;
    const int K = g.K, nt = K / BK;
    unsigned voffA[2], voffB[2];
#pragma unroll
    for (int i = 0; i < 2; ++i) { int R, C; stage_rc(tid * 16 + i * 8192, R, C); const int Rb = Epi::PERM ? ((R & ~31) + perm32(R & 31)) : R;
        voffA[i] = (unsigned)(R * g.lda + C) * 2u; voffB[i] = (unsigned)(Rb * g.ldb + C) * 2u; }
    const size_t kstep = (size_t)(BK * 2);
    const size_t hstepA = (size_t)HALF * g.lda * 2, hstepB = (size_t)HALF * g.ldb * 2;
    const unsigned ldsw = (unsigned)wid * 1024u;
    const int aoff = lds_byte(wr * 64 + fr, fq * 8), boff = lds_byte(wc * 32 + fr, fq * 8);
#define PG8_SA(b, h) (((b) * 2 + (h)) * HTB)
#define PG8_SB(b, h) ((4 + (b) * 2 + (h)) * HTB)
#define PG8_STAGE(bufoff, gbase, voff) do { _Pragma("unroll") for (int _i = 0; _i < 2; ++_i) \
        __builtin_amdgcn_global_load_lds((const unsigned*)((const char*)(gbase) + (voff)[_i]), (PG8_LAS unsigned*)(lds + (bufoff) + ldsw + _i * 8192), 16, 0, 0); } while (0)
#define PG8_LDA(dst, b, h) do { _Pragma("unroll") for (int m = 0; m < 4; ++m) _Pragma("unroll") for (int k = 0; k < 2; ++k) dst[m][k] = *(const PG8_LAS bf16x8*)(lds + PG8_SA(b, h) + aoff + m * 2048 + k * 1024); } while (0)
#define PG8_LDB(dst, b, h) do { _Pragma("unroll") for (int n = 0; n < 2; ++n) _Pragma("unroll") for (int k = 0; k < 2; ++k) dst[n][k] = *(const PG8_LAS bf16x8*)(lds + PG8_SB(b, h) + boff + n * 2048 + k * 1024); } while (0)
#define PG8_MMA(ai, bj, At, Bt) do { __builtin_amdgcn_s_setprio(1); _Pragma("unroll") for (int m = 0; m < 4; ++m) _Pragma("unroll") for (int n = 0; n < 2; ++n) _Pragma("unroll") for (int k = 0; k < 2; ++k) \
        acc[ai][bj][m][n] = __builtin_amdgcn_mfma_f32_16x16x32_bf16(Bt[n][k], At[m][k], acc[ai][bj][m][n], 0, 0, 0); __builtin_amdgcn_s_setprio(0); } while (0)
#define PG8_WAIT_V(n) asm volatile("s_waitcnt vmcnt(" #n ")" ::: "memory")
#define PG8_WAIT_L(n) asm volatile("s_waitcnt lgkmcnt(" #n ")" ::: "memory")
#define PG8_BAR __builtin_amdgcn_s_barrier()
#define PG8_SCHED __builtin_amdgcn_sched_barrier(0)
    Unit cur, nxt; int ui = 0;
    if (!S.next(0, cur)) return;
    f32x4 acc[2][2][4][2];
#pragma unroll
    for (int a = 0; a < 2; ++a)
#pragma unroll
        for (int b = 0; b < 2; ++b)
#pragma unroll
            for (int m = 0; m < 4; ++m)
#pragma unroll
                for (int n = 0; n < 2; ++n) acc[a][b][m][n] = (f32x4){0.f, 0.f, 0.f, 0.f};
    bf16x8 At[4][2], B0[2][2], B1[2][2];
    const char* cA = cur.a; const char* cB = cur.b;
    S.a_ready(cur);
    if constexpr (SP2) {
        PG8_STAGE(PG8_SB(0, 0), cB, voffB); PG8_STAGE(PG8_SB(0, 1), cB + hstepB, voffB); PG8_STAGE(PG8_SA(0, 0), cA, voffA); PG8_STAGE(PG8_SA(0, 1), cA + hstepA, voffA);
        if (wr == 1) PG8_BAR;
        PG8_WAIT_V(2); PG8_BAR;
        PG8_STAGE(PG8_SB(1, 0), cB + kstep, voffB); PG8_STAGE(PG8_SA(1, 0), cA + kstep, voffA); PG8_STAGE(PG8_SB(1, 1), cB + hstepB + kstep, voffB);
        PG8_WAIT_V(6); PG8_BAR;
    } else {
        PG8_STAGE(PG8_SB(0, 0), cB, voffB); PG8_STAGE(PG8_SA(0, 0), cA, voffA); PG8_STAGE(PG8_SB(0, 1), cB + hstepB, voffB); PG8_STAGE(PG8_SA(0, 1), cA + hstepA, voffA);
        if (wr == 1) PG8_BAR;
        PG8_WAIT_V(4); PG8_BAR;
        PG8_STAGE(PG8_SB(1, 0), cB + kstep, voffB); PG8_STAGE(PG8_SA(1, 0), cA + kstep, voffA); PG8_STAGE(PG8_SB(1, 1), cB + hstepB + kstep, voffB);
        PG8_WAIT_V(6); PG8_BAR;
    }
    for (;;) {
        const bool has_next = S.next(ui + 1, nxt);
        const char* nA = has_next ? nxt.a : cA; const char* nB = has_next ? nxt.b : cB;
        for (int t = 0; t < nt; t += 2) {
            const bool last = (t == nt - 2);
            const char* a1 = cA + (size_t)(t + 1) * kstep;
            const char* a2 = last ? nA : cA + (size_t)(t + 2) * kstep; const char* b2 = last ? nB : cB + (size_t)(t + 2) * kstep;
            const char* a3 = a2 + kstep; const char* b3 = b2 + kstep;
            if (last && has_next) S.a_ready(nxt);
            if constexpr (SP2) {
            PG8_LDB(B0, 0, 0); PG8_LDB(B1, 0, 1); PG8_SCHED; PG8_LDA(At, 0, 0); PG8_STAGE(PG8_SA(1, 1), a1 + hstepA, voffA);
            PG8_WAIT_V(8); PG8_WAIT_L(0); PG8_BAR; PG8_MMA(0, 0, At, B0); PG8_MMA(0, 1, At, B1); PG8_BAR; PG8_SCHED;
            PG8_LDA(At, 0, 1); PG8_STAGE(PG8_SB(0, 0), b2, voffB); PG8_STAGE(PG8_SB(0, 1), b2 + hstepB, voffB); PG8_STAGE(PG8_SA(0, 0), a2, voffA);
            PG8_WAIT_V(8); PG8_WAIT_L(0); PG8_BAR; PG8_MMA(1, 0, At, B0); PG8_MMA(1, 1, At, B1); PG8_BAR; PG8_SCHED;
            PG8_LDB(B0, 1, 0); PG8_LDB(B1, 1, 1); PG8_SCHED; PG8_LDA(At, 1, 0); PG8_STAGE(PG8_SA(0, 1), a2 + hstepA, voffA);
            PG8_WAIT_V(8); PG8_WAIT_L(0); PG8_BAR; PG8_MMA(0, 0, At, B0); PG8_MMA(0, 1, At, B1); PG8_BAR; PG8_SCHED;
            PG8_LDA(At, 1, 1); PG8_STAGE(PG8_SB(1, 0), b3, voffB); PG8_STAGE(PG8_SB(1, 1), b3 + hstepB, voffB); PG8_STAGE(PG8_SA(1, 0), a3, voffA);
            PG8_WAIT_V(8); PG8_WAIT_L(0); PG8_BAR; PG8_MMA(1, 0, At, B0); PG8_MMA(1, 1, At, B1); PG8_BAR; PG8_SCHED;
            } else {
            PG8_LDB(B0, 0, 0); PG8_SCHED; PG8_LDA(At, 0, 0); PG8_STAGE(PG8_SA(1, 1), a1 + hstepA, voffA);
            PG8_WAIT_L(8); PG8_BAR; PG8_WAIT_L(0); PG8_MMA(0, 0, At, B0); PG8_BAR; PG8_SCHED;
            PG8_LDB(B1, 0, 1); PG8_STAGE(PG8_SB(0, 0), b2, voffB);
            PG8_BAR; PG8_WAIT_L(0); PG8_MMA(0, 1, At, B1); PG8_BAR;
            PG8_LDA(At, 0, 1); PG8_STAGE(PG8_SA(0, 0), a2, voffA);
            PG8_BAR; PG8_WAIT_L(0); PG8_MMA(1, 0, At, B0); PG8_BAR; PG8_SCHED;
            PG8_STAGE(PG8_SB(0, 1), b2 + hstepB, voffB);
            PG8_WAIT_V(6); PG8_BAR; PG8_MMA(1, 1, At, B1); PG8_BAR;
            PG8_LDB(B0, 1, 0); PG8_SCHED; PG8_LDA(At, 1, 0); PG8_STAGE(PG8_SA(0, 1), a2 + hstepA, voffA);
            PG8_WAIT_L(8); PG8_BAR; PG8_WAIT_L(0); PG8_MMA(0, 0, At, B0); PG8_BAR; PG8_SCHED;
            PG8_LDB(B1, 1, 1); PG8_STAGE(PG8_SB(1, 0), b3, voffB);
            PG8_BAR; PG8_WAIT_L(0); PG8_MMA(0, 1, At, B1); PG8_BAR;
            PG8_LDA(At, 1, 1); PG8_STAGE(PG8_SA(1, 0), a3, voffA);
            PG8_BAR; PG8_WAIT_L(0); PG8_MMA(1, 0, At, B0); PG8_BAR; PG8_SCHED;
            PG8_STAGE(PG8_SB(1, 1), b3 + hstepB, voffB);
            PG8_WAIT_V(6); PG8_BAR; PG8_MMA(1, 1, At, B1); PG8_BAR;
            }
        }
        if constexpr (ALIGN_EPI) { if (wr == 0) PG8_BAR; }
        if constexpr (!Epi::AFTER_DRAIN) { E(acc, cur, wr, wc, fr, fq); S.done(cur); }
        if (!has_next) break;
#pragma unroll
        for (int a = 0; a < 2; ++a)
#pragma unroll
            for (int b = 0; b < 2; ++b)
#pragma unroll
                for (int m = 0; m < 4; ++m)
#pragma unroll
                    for (int n = 0; n < 2; ++n) acc[a][b][m][n] = (f32x4){0.f, 0.f, 0.f, 0.f};
        cur = nxt; cA = nA; cB = nB; ++ui;
        if constexpr (ALIGN_EPI) { if (wr == 1) PG8_BAR; }
    }
    PG8_WAIT_V(0);
    if constexpr (!ALIGN_EPI) { if (wr == 0) PG8_BAR; }
    PG8_BAR;
    if constexpr (Epi::AFTER_DRAIN) { E.fused(acc, cur, wr, wc, fr, fq, lds, wid, lane); S.done(cur); }
#undef PG8_SA
#undef PG8_SB
#undef PG8_STAGE
#undef PG8_LDA
#undef PG8_LDB
#undef PG8_MMA
#undef PG8_WAIT_V
#undef PG8_WAIT_L
#undef PG8_BAR
#undef PG8_SCHED
}
}
typedef float f32x4 __attribute__((ext_vector_type(4)));
typedef unsigned u32x4 __attribute__((ext_vector_type(4)));
constexpr int T_ = 16384, D_ = 1024, NIN_ = 6912;
constexpr size_t MiB_ = 1u << 20;
constexpr size_t X_BASE = 230 * MiB_;
constexpr size_t X_WINT = X_BASE, X_WCAT = X_WINT + (size_t)NIN_ * 1024 * 2, X_WOT = X_WCAT + (size_t)1024 * 3072 * 2, X_WST = X_WOT + (size_t)1024 * 1024 * 2,
                 X_WCOMB = X_WST + (size_t)2048 * 1024 * 2, X_WIQT = X_WCOMB + (size_t)2048 * 256 * 2, X_END = X_WIQT + (size_t)512 * 256 * 2;
constexpr size_t X_EXPI = X_WINT, X_GATE = X_EXPI + (size_t)16384 * 128 * 4;
static_assert(X_GATE + (size_t)16384 * 128 * 4 <= X_WOT, "routing results fit over WinT | WcatT");
constexpr size_t X_WUK = WsMap<CfgFull>::A0, X_WUQ = X_WUK + (size_t)256 * 1024 * 2, X_WBT = X_WUQ + (size_t)256 * 1024 * 2,
                 X_WUV = X_WBT + (size_t)1024 * 1024 * 2, X_SKB = X_WUV + (size_t)256 * 1024 * 2, X_PWQ = X_SKB + (size_t)2048 * 256 * 2, X_TMP_END = X_PWQ + (size_t)1024 * 2048 * 2;
static_assert(WsMap<CfgFull>::END <= X_BASE && X_END <= 260 * MiB_ && X_TMP_END <= WsMap<CfgFull>::A2, "extra workspace map (d_ws >= 266.9 MiB = the sum of the inputs)");
struct OP {
    bf16_t *WinT, *WcatT, *WoT, *WsT, *WcombT, *WiqT, *wuk, *wuq, *wbT, *wuv, *skb, *pwq; float* S; bf16_t* RAWB; unsigned char *Ub, *Vb; int* EXPI2; float* GATE2; bf16_t *QA0, *QA1; unsigned* qword;
};
typedef __bf16 bf16x2h_t __attribute__((ext_vector_type(2)));
typedef float f32x2h_t __attribute__((ext_vector_type(2)));
__device__ __forceinline__ unsigned pk2bf(float lo, float hi) { const f32x2h_t v = {lo, hi}; return __builtin_bit_cast(unsigned, __builtin_convertvector(v, bf16x2h_t)); }
__device__ __forceinline__ bf16_t f2bfd(float f) { return (bf16_t)(pk2bf(f, 0.f) & 0xffffu); }

__device__ __forceinline__ int inproj_src(int n) {
    if (n < 3072) return n;
    if (n < 3328) return 4112 + (n - 3072);
    if (n < 3584) return 4368 + (n - 3328);
    if (n < 3648) return 4624 + (n - 3584);
    if (n < 3656) return 4096 + (n - 3648);
    if (n < 3664) return 4104 + (n - 3656);
    if (n < 3672) return 4688 + (n - 3664);
    if (n < 3840) return -1;
    if (n < 4864) return 3072 + (n - 3840);
    if (n < 5888) return 4696 + (n - 4864);
    return 5720 + (n - 5888);
}
template <int MAP> __device__ __forceinline__ void transpose_item(const float* W, int ldn, bf16_t* WT, int ldk, int n0, int k0, LAS float* scr, int lane) {
    const int j = lane & 31; int sc = n0 + j; if (MAP == 1) sc = inproj_src(n0 + j);
#pragma unroll 8
    for (int i = 0; i < 32; ++i) { const int kk = 2 * i + (lane >> 5); scr[kk * 33 + j] = (sc >= 0) ? W[(size_t)(k0 + kk) * ldn + sc] : 0.f; }
    asm volatile("s_waitcnt lgkmcnt(0)" ::: "memory");
    const int c = lane & 7;
#pragma unroll
    for (int q = 0; q < 4; ++q) { const int n = (lane >> 3) + 8 * q; const LAS float* s = scr + (8 * c) * 33 + n;
        u32x4 o; o.x = pk2bf(s[0 * 33], s[1 * 33]); o.y = pk2bf(s[2 * 33], s[3 * 33]); o.z = pk2bf(s[4 * 33], s[5 * 33]); o.w = pk2bf(s[6 * 33], s[7 * 33]);
        *(u32x4*)(WT + (size_t)(n0 + n) * ldk + k0 + 8 * c) = o; }
    asm volatile("s_waitcnt lgkmcnt(0)" ::: "memory");
}
__device__ __forceinline__ void p0_weights(const NP& P, const OP& Q, LAS unsigned char* lds, int gw, int NGW, int gt, int NGT, int wave, int lane) {
    LAS float* scr = (LAS float*)(lds + wave * 16384);
    constexpr int I_IN = (NIN_ / 32) * 16, I_SQ = 32 * 16;
    constexpr int I_IQ = 16 * 4;
    for (int it = gw; it < I_IN + 3 * I_SQ + I_IQ; it += NGW) {
        int r = it;
        if (r < I_IN) { transpose_item<1>(P.w_in, 6744, Q.WinT, 1024, (r / 16) * 32, (r % 16) * 64, scr, lane); continue; } r -= I_IN;
        if (r < I_SQ) { transpose_item<0>(P.w_a_out, 1024, Q.WcatT, 3072, (r / 16) * 32, (r % 16) * 64, scr, lane); continue; } r -= I_SQ;
        if (r < I_SQ) { transpose_item<0>(P.w_o, 1024, Q.WoT, 1024, (r / 16) * 32, (r % 16) * 64, scr, lane); continue; } r -= I_SQ;
        if (r < I_SQ) { transpose_item<0>(P.w_b_out, 1024, Q.wbT, 1024, (r / 16) * 32, (r % 16) * 64, scr, lane); continue; } r -= I_SQ;
        transpose_item<0>(P.w_iq, 512, Q.WiqT, 256, (r / 4) * 32, (r % 4) * 64, scr, lane);
    }
    for (int i = gt; i < 256 * 1024 / 4; i += NGT) { const f32x4 a = ((const f32x4*)P.w_uk)[i], b = ((const f32x4*)P.w_uq)[i], c = ((const f32x4*)P.w_uv)[i];
        ((uint2*)Q.wuk)[i] = make_uint2(pk2bf(a.x, a.y), pk2bf(a.z, a.w)); ((uint2*)Q.wuq)[i] = make_uint2(pk2bf(b.x, b.y), pk2bf(b.z, b.w)); ((uint2*)Q.wuv)[i] = make_uint2(pk2bf(c.x, c.y), pk2bf(c.z, c.w)); }
    for (int i = gt; i < 1024 * 2048 / 4; i += NGT) { const f32x4 a = ((const f32x4*)P.peer_w_q)[i]; ((uint2*)Q.pwq)[i] = make_uint2(pk2bf(a.x, a.y), pk2bf(a.z, a.w)); }
    for (int i = gt; i < 2048 * 256 / 4; i += NGT) { const int row = i / 64, c4 = (i % 64) * 4, g = row >> 7; uint2 o = make_uint2(0u, 0u);
        if ((c4 >> 7) == (g & 1)) { const f32x4 a = *(const f32x4*)(P.peer_sub_keys + (size_t)row * 128 + (c4 & 127)); o = make_uint2(pk2bf(a.x, a.y), pk2bf(a.z, a.w)); }
        ((uint2*)Q.skb)[i] = o; }
}
struct GridSched {
    int nM, nN, nwg, G, c; const char* A; const char* B; size_t sA, sB;
    const char* A2 = nullptr; int splitA = 1 << 30;
    __device__ void init(int nM_, int nN_, int G_, int c_, const void* A_, size_t sA_, const void* B_, size_t sB_) { nM = nM_; nN = nN_; nwg = nM * nN; G = G_; c = c_; A = (const char*)A_; B = (const char*)B_; sA = sA_; sB = sB_; }
    __device__ bool next(int i, pg8::Unit& u) const {
        const long L = (long)i * G + c; if (L >= nwg) return false;
        int wgid = (int)L; { const int q = nwg / 8, r = nwg % 8, xcd = wgid % 8, off = wgid / 8; wgid = (xcd < r ? xcd * (q + 1) : r * (q + 1) + (xcd - r) * q) + off; }
        const int nig = 8 * nN, gid = wgid / nig, fm = gid * 8, gsz = (nM - fm) < 8 ? (nM - fm) : 8;
        u.pm = fm + ((wgid % nig) % gsz); u.pn = (wgid % nig) / gsz; u.a = (u.pm < splitA) ? A + (size_t)u.pm * sA : A2 + (size_t)(u.pm - splitA) * sA; u.b = B + (size_t)u.pn * sB; return true;
    }
    __device__ __forceinline__ void a_ready(const pg8::Unit&) const {}
    __device__ __forceinline__ void done(const pg8::Unit&) const {}
};
struct WSched {
    int kind, c; const bf16_t *wuk, *wuq, *wbT, *wuv, *skb, *pwq;
    __device__ bool next(int i, pg8::Unit& u) const {
        if (i > 0 || c < 0) return false;
        if (kind == 0) {
            if (c < 8) { u.pm = c; u.pn = 100; u.a = (const char*)(wuk + c * 128); u.b = (const char*)(wuq + c * 128); return true; }
            if (c < 40) { const int h = (c - 8) >> 2, mt = (c - 8) & 3; u.pm = mt; u.pn = 200 + h; u.a = (const char*)(wbT + (size_t)mt * 256 * 1024 + h * 128); u.b = (const char*)(wuv + h * 128); return true; }
            return false;
        }
        if (c < 32) { const int pm = c >> 2, nt = c & 3; u.pm = pm; u.pn = nt; u.a = (const char*)(skb + (size_t)pm * 256 * 256); u.b = (const char*)(pwq + (size_t)nt * 256 * 2048 + pm * 256); return true; }
        return false;
    }
    __device__ __forceinline__ void a_ready(const pg8::Unit&) const {}
    __device__ __forceinline__ void done(const pg8::Unit&) const {}
};
template <class F> struct EpiG {
    static constexpr bool PERM = true, AFTER_DRAIN = false; F f;
    __device__ __forceinline__ void operator()(const f32x4 (&acc)[2][2][4][2], const pg8::Unit& u, int wr, int wc, int fr, int fq) const {
#pragma unroll
        for (int ai = 0; ai < 2; ++ai)
#pragma unroll
            for (int m = 0; m < 4; ++m)
#pragma unroll
                for (int bj = 0; bj < 2; ++bj) f.st(u, ai * 128 + wr * 64 + m * 16 + fr, bj * 128 + wc * 32 + 8 * fq, acc[ai][bj][m][0], acc[ai][bj][m][1]);
    }
};
__device__ __forceinline__ u32x4 pack8(f32x4 v0, f32x4 v1) { u32x4 w; w.x = pk2bf(v0[0], v0[1]); w.y = pk2bf(v0[2], v0[3]); w.z = pk2bf(v1[0], v1[1]); w.w = pk2bf(v1[2], v1[3]); return w; }
struct FWeights {
    bf16_t *WcombT, *WcatT, *WsT;
    __device__ __forceinline__ void st(const pg8::Unit& u, int row, int col, f32x4 v0, f32x4 v1) const {
        bf16_t* p; float sc = 1.f;
        if (u.pn == 100) { p = WcombT + (size_t)(u.pm * 256 + row) * 256 + col; sc = 0.08838834764831845f; }
        else if (u.pn >= 200) { p = WcatT + (size_t)(u.pm * 256 + row) * 3072 + 1024 + (u.pn - 200) * 256 + col; }
        else { p = WsT + (size_t)(u.pm * 256 + row) * 1024 + u.pn * 256 + col; }
        *(u32x4*)p = pack8(v0 * sc, v1 * sc);
    }
};
struct FInprojA {
    bf16_t* QKVP; bf16_t* RAW;
    __device__ __forceinline__ void st(const pg8::Unit& u, int row, int col, f32x4 v0, f32x4 v1) const {
        const size_t t = (size_t)u.pm * 256 + row;
        if (u.pn < 12) { *(u32x4*)(QKVP + t * 3072 + u.pn * 256 + col) = pack8(v0, v1); }
        else { *(u32x4*)(RAW + t * 768 + (u.pn - 12) * 256 + col) = pack8(v0, v1); }
    }
};
__device__ __forceinline__ f32x4 bf4(uint2 w) { f32x4 r; r[0] = bf2f((bf16_t)(w.x & 0xffff)); r[1] = bf2f((bf16_t)(w.x >> 16)); r[2] = bf2f((bf16_t)(w.y & 0xffff)); r[3] = bf2f((bf16_t)(w.y >> 16)); return r; }
struct FInprojB {
    bf16_t *Z, *GA, *GB; const bf16_t* ON;
    __device__ __forceinline__ void st(const pg8::Unit& u, int row, int col, f32x4 v0, f32x4 v1) const {
        const size_t t = (size_t)u.pm * 256 + row; const int which = u.pn >> 2, c = (u.pn & 3) * 256 + col;
        bf16_t* dst = Z + (size_t)which * ((size_t)16384 * 1024) + t * 1024 + c;
        if (which == 0) { const u32x4 on = *(const u32x4*)(ON + t * 1024 + c);
            f32x4 a0 = bf4(make_uint2(on.x, on.y)), a1 = bf4(make_uint2(on.z, on.w));
#pragma unroll
            for (int k = 0; k < 4; ++k) { a0[k] *= v0[k] / (1.f + __expf(-v0[k])); a1[k] *= v1[k] / (1.f + __expf(-v1[k])); }
            *(u32x4*)dst = pack8(a0, a1); }
        else *(u32x4*)dst = pack8(v0, v1);
    }
};
struct FStoreBf16 { bf16_t* O; int ldc; bf16_t* O2; int split;
    __device__ __forceinline__ void st(const pg8::Unit& u, int row, int col, f32x4 v0, f32x4 v1) const { bf16_t* base = (u.pm < split) ? O + (size_t)(u.pm * 256) * ldc : O2 + (size_t)((u.pm - split) * 256) * ldc;
        *(u32x4*)(base + (size_t)row * ldc + u.pn * 256 + col) = pack8(v0, v1); } };
struct FStoreF32 { float* O; int ldc;
    __device__ __forceinline__ void st(const pg8::Unit& u, int row, int col, f32x4 v0, f32x4 v1) const { float* p = O + (size_t)(u.pm * 256 + row) * ldc + u.pn * 256 + col; *(f32x4*)p = v0; *(f32x4*)(p + 4) = v1; } };
__device__ __forceinline__ f32x4 sig4(f32x4 v) { return (f32x4){sigmf(v[0]), sigmf(v[1]), sigmf(v[2]), sigmf(v[3])}; }
template <int SECOND> struct FMerge {
    const bf16_t* Gt; bf16_t* M;
    __device__ __forceinline__ void st(const pg8::Unit& u, int row, int col, f32x4 v0, f32x4 v1) const {
        const size_t o = (size_t)(u.pm * 256 + row) * 1024 + u.pn * 256 + col; const u32x4 g = *(const u32x4*)(Gt + o);
        f32x4 r0 = sig4(bf4(make_uint2(g.x, g.y))) * v0, r1 = sig4(bf4(make_uint2(g.z, g.w))) * v1;
        if (SECOND) { const u32x4 m = *(const u32x4*)(M + o); r0 += bf4(make_uint2(m.x, m.y)); r1 += bf4(make_uint2(m.z, m.w)); }
        *(u32x4*)(M + o) = pack8(r0, r1);
    }
};
struct FWo {
    const float* MOD; const float* x; float* X1;
    __device__ __forceinline__ void st(const pg8::Unit& u, int row, int col, f32x4 v0, f32x4 v1) const {
        const size_t t = (size_t)u.pm * 256 + row; const int c = u.pn * 256 + col; const int b = (int)(t >> 13);
        const float* gt = MOD + (size_t)b * 6144 + 2048 + c; const float* xr = x + t * 1024 + c; float* o = X1 + t * 1024 + c;
        *(f32x4*)o = *(const f32x4*)xr + *(const f32x4*)gt * v0; *(f32x4*)(o + 4) = *(const f32x4*)(xr + 4) + *(const f32x4*)(gt + 4) * v1;
    }
};
namespace idxk {
typedef short bf16x8 __attribute__((ext_vector_type(8)));
constexpr int NQ = 16, CAP = 768, CAPS = 772, THRESH = 512, KSEL = 256, L_ = 8192;
constexpr int L_VAL = 0, L_IDX = NQ * CAPS * 4, L_QF = 2 * NQ * CAPS * 4, L_HIST = L_QF + 16 * 64 * 16, L_CNT = L_HIST + 8 * 1024, L_TAU = L_CNT + 64, L_FLAG = L_TAU + 64, L_END = L_FLAG + 64, L_SIDX = 131072;
static_assert(L_END <= 131072, "indexer LDS map");
__device__ __forceinline__ unsigned sortable(float f) { const unsigned u = __builtin_bit_cast(unsigned, f); return (u & 0x80000000u) ? ~u : (u | 0x80000000u); }
__device__ __forceinline__ unsigned lanemask_lt_lo() { return __builtin_amdgcn_mbcnt_lo(~0u, 0u); }
__device__ __forceinline__ int mbcnt64(unsigned long long m) { return (int)__builtin_amdgcn_mbcnt_hi((unsigned)(m >> 32), __builtin_amdgcn_mbcnt_lo((unsigned)m, 0u)); }

#define DPPX_(v, CTRL) __builtin_amdgcn_update_dpp(0, (int)(v), CTRL, 0xF, 0xF, false)
__device__ __forceinline__ unsigned wave_and(unsigned v) { v &= (unsigned)DPPX_(v, 0xB1); v &= (unsigned)DPPX_(v, 0x4E); v &= (unsigned)DPPX_(v, 0x141); v &= (unsigned)DPPX_(v, 0x140);
    const unsigned a = (unsigned)__builtin_amdgcn_readlane((int)v, 0), b = (unsigned)__builtin_amdgcn_readlane((int)v, 16), c = (unsigned)__builtin_amdgcn_readlane((int)v, 32), d = (unsigned)__builtin_amdgcn_readlane((int)v, 48); return a & b & c & d; }
__device__ __forceinline__ unsigned wave_or(unsigned v) { v |= (unsigned)DPPX_(v, 0xB1); v |= (unsigned)DPPX_(v, 0x4E); v |= (unsigned)DPPX_(v, 0x141); v |= (unsigned)DPPX_(v, 0x140);
    const unsigned a = (unsigned)__builtin_amdgcn_readlane((int)v, 0), b = (unsigned)__builtin_amdgcn_readlane((int)v, 16), c = (unsigned)__builtin_amdgcn_readlane((int)v, 32), d = (unsigned)__builtin_amdgcn_readlane((int)v, 48); return a | b | c | d; }
__device__ __forceinline__ float wave_fmin(float v) {
#define FM_(CTRL) v = fminf(v, __builtin_bit_cast(float, DPPX_(__builtin_bit_cast(int, v), CTRL)))
    FM_(0xB1); FM_(0x4E); FM_(0x141); FM_(0x140);
#undef FM_
    const float a = __builtin_bit_cast(float, __builtin_amdgcn_readlane(__builtin_bit_cast(int, v), 0)), b = __builtin_bit_cast(float, __builtin_amdgcn_readlane(__builtin_bit_cast(int, v), 16)),
                c = __builtin_bit_cast(float, __builtin_amdgcn_readlane(__builtin_bit_cast(int, v), 32)), d = __builtin_bit_cast(float, __builtin_amdgcn_readlane(__builtin_bit_cast(int, v), 48));
    return fminf(fminf(a, b), fminf(c, d)); }
__device__ __forceinline__ float compact_query(LAS float* val, LAS unsigned* idx, LAS unsigned* hist, int cnt, int lane) {
    float v[12]; unsigned ix[12]; unsigned long long key[12];
    unsigned a_hi = ~0u, a_lo = ~0u, o_hi = 0u, o_lo = 0u;
#pragma unroll
    for (int r = 0; r < 12; ++r) { const int e = r * 64 + lane; v[r] = 0.f; ix[r] = 0u; key[r] = 0ull;
        if (e < cnt) { v[r] = val[e]; ix[r] = idx[e]; key[r] = ((unsigned long long)sortable(v[r]) << 13) | (unsigned long long)(8191u - ix[r]);
            a_hi &= (unsigned)(key[r] >> 32); a_lo &= (unsigned)key[r]; o_hi |= (unsigned)(key[r] >> 32); o_lo |= (unsigned)key[r]; } }
    const unsigned long long kand = ((unsigned long long)wave_and(a_hi) << 32) | wave_and(a_lo), kor = ((unsigned long long)wave_or(o_hi) << 32) | wave_or(o_lo);
    const unsigned long long diff = kand ^ kor;
    int fixed = 64 - (int)__builtin_clzll(diff);
    unsigned long long prefix = (fixed < 64) ? ((kor >> fixed) << fixed) : 0ull;
    int need = KSEL; bool done = false;
    while (!done) {
        const int shift = (fixed >= 8) ? fixed - 8 : 0; const unsigned mask = (1u << (fixed - shift)) - 1u;
        hist[lane * 4 + 0] = 0u; hist[lane * 4 + 1] = 0u; hist[lane * 4 + 2] = 0u; hist[lane * 4 + 3] = 0u;
        asm volatile("s_waitcnt lgkmcnt(0)" ::: "memory");
#pragma unroll
        for (int r = 0; r < 12; ++r) { const int e = r * 64 + lane;
            if (e < cnt && ((fixed >= 64) || ((key[r] >> fixed) == (prefix >> fixed)))) atomicAdd((unsigned*)&hist[(unsigned)(key[r] >> shift) & mask], 1u); }
        asm volatile("s_waitcnt lgkmcnt(0)" ::: "memory");
        const unsigned c0 = hist[lane * 4 + 0], c1 = hist[lane * 4 + 1], c2 = hist[lane * 4 + 2], c3 = hist[lane * 4 + 3];
        const unsigned loc = c0 + c1 + c2 + c3; unsigned suf = loc;
        suf += (unsigned)__builtin_amdgcn_update_dpp(0, (int)suf, 0x101, 0xF, 0xF, true); suf += (unsigned)__builtin_amdgcn_update_dpp(0, (int)suf, 0x102, 0xF, 0xF, true);
        suf += (unsigned)__builtin_amdgcn_update_dpp(0, (int)suf, 0x104, 0xF, 0xF, true); suf += (unsigned)__builtin_amdgcn_update_dpp(0, (int)suf, 0x108, 0xF, 0xF, true);
        { const unsigned t1 = (unsigned)__builtin_amdgcn_readlane((int)suf, 16), t2 = (unsigned)__builtin_amdgcn_readlane((int)suf, 32), t3 = (unsigned)__builtin_amdgcn_readlane((int)suf, 48);
          const int rw = lane >> 4; suf += (rw == 0) ? (t1 + t2 + t3) : (rw == 1) ? (t2 + t3) : (rw == 2) ? t3 : 0u; }
        unsigned cum = suf - loc; int fb = -1, fneed = 0, fcnt = 0;
        if (cum < (unsigned)need && (unsigned)need <= cum + c3) { fb = lane * 4 + 3; fneed = need - (int)cum; fcnt = (int)c3; } cum += c3;
        if (cum < (unsigned)need && (unsigned)need <= cum + c2) { fb = lane * 4 + 2; fneed = need - (int)cum; fcnt = (int)c2; } cum += c2;
        if (cum < (unsigned)need && (unsigned)need <= cum + c1) { fb = lane * 4 + 1; fneed = need - (int)cum; fcnt = (int)c1; } cum += c1;
        if (cum < (unsigned)need && (unsigned)need <= cum + c0) { fb = lane * 4 + 0; fneed = need - (int)cum; fcnt = (int)c0; }
        const unsigned long long bm = __ballot(fb >= 0); const int src = bm ? (int)__builtin_ctzll(bm) : 0;
        const int bin = __builtin_amdgcn_readlane(fb, src), nneed = __builtin_amdgcn_readlane(fneed, src), ncnt = __builtin_amdgcn_readlane(fcnt, src);
        prefix |= (unsigned long long)(unsigned)bin << shift; need = nneed; fixed = shift;
        if (ncnt == nneed || shift == 0) done = true;
    }
    int base = 0; float mn = 3.0e38f;
#pragma unroll
    for (int r = 0; r < 12; ++r) { const int e = r * 64 + lane; const bool keep = (e < cnt) && ((key[r] >> fixed) >= (prefix >> fixed));
        const unsigned long long m = __ballot(keep); const int pos = base + mbcnt64(m);
        if (keep) { val[pos] = v[r]; idx[pos] = ix[r]; mn = fminf(mn, v[r]); } base += (int)__builtin_popcountll(m); }
    return wave_fmin(mn);
}

struct IdxArgs { const bf16_t* QLATN; const bf16_t* KIDXN; const float* WIDX; const bf16_t* WiqT; int* IDX; };

__device__ __forceinline__ void index_task(const IdxArgs& A, LAS unsigned char* lds, int b, int q0) {
    int tx = threadIdx.x; asm volatile("" : "+v"(tx));
    const int wave = __builtin_amdgcn_readfirstlane(tx >> 6), lane = tx & 63, n = lane & 15, g = lane >> 4;
    LAS float* VAL = (LAS float*)(lds + L_VAL); LAS unsigned* IDXB = (LAS unsigned*)(lds + L_IDX); LAS unsigned* HIST = (LAS unsigned*)(lds + L_HIST) + wave * 256;
    LAS unsigned* CNT = (LAS unsigned*)(lds + L_CNT); LAS float* TAU = (LAS float*)(lds + L_TAU); LAS unsigned* FLAG = (LAS unsigned*)(lds + L_FLAG);
    const size_t trow = (size_t)b * L_ + q0;
    if (tx < NQ) { CNT[tx] = 0u; TAU[tx] = -__builtin_inff(); } if (tx < 3) FLAG[tx] = 0u;
    {
        bf16x8 qb[8];
#pragma unroll
        for (int kk = 0; kk < 8; ++kk) qb[kk] = *(const bf16x8*)(A.QLATN + (trow + n) * 256 + kk * 32 + 8 * g);
#pragma unroll
        for (int s = 0; s < 2; ++s) {
            f32x4 x1 = {0.f, 0.f, 0.f, 0.f}, x2 = {0.f, 0.f, 0.f, 0.f};
            const int r = n, d1 = 32 * s + 8 * (r >> 2) + (r & 3), d2 = d1 + 4;
            const bf16_t* w1 = A.WiqT + (size_t)(wave * 64 + d1) * 256 + 8 * g; const bf16_t* w2 = A.WiqT + (size_t)(wave * 64 + d2) * 256 + 8 * g;
#pragma unroll
            for (int kk = 0; kk < 8; ++kk) { const bf16x8 a1 = *(const bf16x8*)(w1 + kk * 32), a2 = *(const bf16x8*)(w2 + kk * 32);
                x1 = __builtin_amdgcn_mfma_f32_16x16x32_bf16(a1, qb[kk], x1, 0, 0, 0); x2 = __builtin_amdgcn_mfma_f32_16x16x32_bf16(a2, qb[kk], x2, 0, 0, 0); }
            u32x4 fr; fr.x = pk2bf(x1[0], x1[1]); fr.y = pk2bf(x1[2], x1[3]); fr.z = pk2bf(x2[0], x2[1]); fr.w = pk2bf(x2[2], x2[3]);
            *(LAS u32x4*)(lds + L_QF + ((wave * 2 + s) * 64 + lane) * 16) = fr;
        }
    }
    __syncthreads();
    bf16x8 qf[8][2];
#pragma unroll
    for (int h = 0; h < 8; ++h)
#pragma unroll
        for (int s = 0; s < 2; ++s) qf[h][s] = *(const LAS bf16x8*)(lds + L_QF + ((h * 2 + s) * 64 + lane) * 16);
    float wq[8];
    { const f32x4 w0 = *(const f32x4*)(A.WIDX + (trow + n) * 8), w1 = *(const f32x4*)(A.WIDX + (trow + n) * 8 + 4);
      wq[0] = w0[0]; wq[1] = w0[1]; wq[2] = w0[2]; wq[3] = w0[3]; wq[4] = w1[0]; wq[5] = w1[1]; wq[6] = w1[2]; wq[7] = w1[3]; }
    const int qpos = q0 + n, kmax = q0 + 15;
    const int nst = (kmax >> 8) + 1;
    const bf16_t* kbase = A.KIDXN + (size_t)b * L_ * 64;
    bf16x8 ka[2][2];
#pragma unroll
    for (int blk = 0; blk < 2; ++blk) { const int kb = 32 * wave + 16 * blk; if (kb <= kmax) { const bf16_t* kr = kbase + (size_t)(kb + n) * 64 + 8 * g; ka[blk][0] = *(const bf16x8*)kr; ka[blk][1] = *(const bf16x8*)(kr + 32); } }
    for (int j = 0, jf = 0; j < nst; ++j, jf = (jf == 2) ? 0 : jf + 1) {
        const float tau = TAU[n];
        bf16x8 kc[2][2];
#pragma unroll
        for (int blk = 0; blk < 2; ++blk) { kc[blk][0] = ka[blk][0]; kc[blk][1] = ka[blk][1];
            const int kbn = 256 * (j + 1) + 32 * wave + 16 * blk; if (kbn <= kmax) { const bf16_t* kr = kbase + (size_t)(kbn + n) * 64 + 8 * g; ka[blk][0] = *(const bf16x8*)kr; ka[blk][1] = *(const bf16x8*)(kr + 32); } }
#pragma unroll
        for (int blk = 0; blk < 2; ++blk) {
            const int kb = 256 * j + 32 * wave + 16 * blk;
            if (kb <= kmax) {
                const bf16x8 a0 = kc[blk][0], a1 = kc[blk][1];
                float sc[4] = {0.f, 0.f, 0.f, 0.f};
                f32x4 acc[8];
#pragma unroll
                for (int h = 0; h < 8; ++h) acc[h] = __builtin_amdgcn_mfma_f32_16x16x32_bf16(a0, qf[h][0], (f32x4){0.f, 0.f, 0.f, 0.f}, 0, 0, 0);
#pragma unroll
                for (int h = 0; h < 8; ++h) acc[h] = __builtin_amdgcn_mfma_f32_16x16x32_bf16(a1, qf[h][1], acc[h], 0, 0, 0);
                __builtin_amdgcn_sched_barrier(0);
#pragma unroll
                for (int h = 0; h < 8; ++h) {
#pragma unroll
                    for (int i = 0; i < 4; ++i) sc[i] = fmaf(wq[h], fmaxf(acc[h][i], 0.f), sc[i]); }
                bool ps[4]; int np = 0;
#pragma unroll
                for (int i = 0; i < 4; ++i) { const int key = kb + 4 * g + i; ps[i] = (key <= qpos) && (sc[i] > tau); np += ps[i] ? 1 : 0; }
                if (np) {
                    unsigned pos = __hip_atomic_fetch_add((unsigned*)&CNT[n], (unsigned)np, __ATOMIC_RELAXED, __HIP_MEMORY_SCOPE_WORKGROUP);
                    if (pos + np > THRESH) FLAG[jf] = 1u;
#pragma unroll
                    for (int i = 0; i < 4; ++i) if (ps[i]) { VAL[n * CAPS + pos] = sc[i]; IDXB[n * CAPS + pos] = (unsigned)(kb + 4 * g + i); ++pos; }
                }
            }
        }
        asm volatile("s_waitcnt lgkmcnt(0)\n\ts_barrier" ::: "memory");
        if (tx == 0) FLAG[jf == 0 ? 2 : jf - 1] = 0u;
        if (FLAG[jf]) {
#pragma unroll
            for (int qq = 0; qq < 2; ++qq) { const int q = wave * 2 + qq; const int c = (int)CNT[q];
                if (c > 384) { const float t = compact_query(VAL + q * CAPS, IDXB + q * CAPS, HIST, c, lane); if (lane == 0) { TAU[q] = t; CNT[q] = KSEL; } } }
            __syncthreads();
        }
    }
#pragma unroll
    for (int qq = 0; qq < 2; ++qq) { const int q = wave * 2 + qq; int c = (int)CNT[q];
        if (c > KSEL) { (void)compact_query(VAL + q * CAPS, IDXB + q * CAPS, HIST, c, lane); c = KSEL; }
        asm volatile("s_waitcnt lgkmcnt(0)" ::: "memory");
        HIST[lane * 4 + 0] = 0u; HIST[lane * 4 + 1] = 0u; HIST[lane * 4 + 2] = 0u; HIST[lane * 4 + 3] = 0u;
        asm volatile("s_waitcnt lgkmcnt(0)" ::: "memory");
        for (int e = lane; e < c; e += 64) { const unsigned k = IDXB[q * CAPS + e]; atomicOr((unsigned*)&HIST[k >> 5], 1u << (k & 31u)); }
        asm volatile("s_waitcnt lgkmcnt(0)" ::: "memory");
        unsigned wd[4]; int pc = 0;
#pragma unroll
        for (int i = 0; i < 4; ++i) { wd[i] = HIST[lane * 4 + i]; pc += (int)__builtin_popcount(wd[i]); }
        int incl = pc;
#pragma unroll
        for (int o = 1; o < 64; o <<= 1) { const int t = __shfl_up(incl, o); if (lane >= o) incl += t; }
        LAS int* out = (LAS int*)(lds + L_SIDX) + q * KSEL; int pos = incl - pc;
#pragma unroll
        for (int i = 0; i < 4; ++i) { unsigned w = wd[i]; while (w) { const int bit = __builtin_ctz(w); w &= w - 1u; out[pos++] = (lane * 4 + i) * 32 + bit; } }
#pragma unroll
        for (int e = lane; e < KSEL; e += 64) if (e >= c) out[e] = -1; }
    __syncthreads();
}
__device__ __forceinline__ void index_phase(const IdxArgs& A, LAS unsigned char* lds, int bx, int G) {
    if (G == 256) { for (int k = 0; k < 4; ++k) { const int b = k >> 1, qt = (k & 1) ? 511 - bx : bx; index_task(A, lds, b, qt * 16); } }
    else { for (int id = bx; id < 1024; id += G) index_task(A, lds, id >> 9, (id & 511) * 16); }
}
}
namespace sattn {
typedef short bf16x8 __attribute__((ext_vector_type(8)));
typedef short s16x4 __attribute__((ext_vector_type(4)));
typedef unsigned u32x2_t __attribute__((ext_vector_type(2)));
typedef __attribute__((ext_vector_type(4))) short v4i16_t;
__device__ __forceinline__ s16x4 vtr(LAS unsigned char* p) { return __builtin_bit_cast(s16x4, __builtin_amdgcn_ds_read_tr16_b64_v4i16((LAS v4i16_t*)p)); }
constexpr int QSPLIT = 12288;
__device__ __forceinline__ void dma16(const void* gsrc, unsigned lds_dst) { unsigned keep; asm volatile("s_mov_b32 %0, m0\n\ts_mov_b32 m0, %2\n\ts_nop 0\n\tglobal_load_lds_dwordx4 %1, off\n\ts_mov_b32 m0, %0" : "=&s"(keep) : "v"(gsrc), "s"(lds_dst) : "memory"); }
struct AArgs { const bf16_t* CKVN; bf16_t* Q0; bf16_t* Q1; };

__device__ __forceinline__ void attn_query(const AArgs& A, LAS unsigned char* tile, int t, int lane, const LAS int* sidx) {
    const int n = lane & 15, g = lane >> 4, b = t >> 13, l = t & 8191;
    const int nv = (l + 1 < 256) ? l + 1 : 256;
    const bf16_t* ckv = A.CKVN + (size_t)b * 8192 * 256;
    bf16_t* qrow = (t < QSPLIT) ? A.Q0 + (size_t)t * 2048 : A.Q1 + (size_t)(t - QSPLIT) * 2048;
    bf16x8 qf[8];
#pragma unroll
    for (int s = 0; s < 8; ++s) { qf[s] = (bf16x8){0, 0, 0, 0, 0, 0, 0, 0}; if (n < 8) qf[s] = *(const bf16x8*)(qrow + n * 256 + 32 * s + 8 * g); }
    f32x4 o[16];
#pragma unroll
    for (int c = 0; c < 16; ++c) o[c] = (f32x4){0.f, 0.f, 0.f, 0.f};
    float mrun = -3.0e38f, lsum = 0.f;
    const int nblk = (nv + 15) >> 4;
    asm volatile("s_waitcnt vmcnt(0) lgkmcnt(0)" ::: "memory");
#pragma unroll
    for (int s = 0; s < 8; ++s) asm volatile("" : "+v"(qf[s]));
#define ATT_ISSUE(J) do { const int k_ = (J) * 16 + n; int my_ = (k_ < nv) ? sidx[k_] : 0; if (my_ < 0) my_ = 0; const unsigned dst_ = tbase + ((J) & 1) * 8192u; \
        _Pragma("unroll") for (int i = 0; i < 8; ++i) { const int r = 2 * i + (lane >> 5); const int row = __shfl(my_, r); \
            const bf16_t* src = ckv + (size_t)row * 256 + (((lane & 31) ^ r) << 3); \
            dma16(src, dst_ + i * 1024u); } } while (0)
    const unsigned tbase = (unsigned)__builtin_amdgcn_readfirstlane((int)(unsigned)(size_t)tile);
    ATT_ISSUE(0);
    for (int j = 0; j < nblk; ++j) {
        LAS unsigned char* buf = tile + (j & 1) * 8192;
        if (j + 1 < nblk) { ATT_ISSUE(j + 1); asm volatile("s_waitcnt vmcnt(8)" ::: "memory"); }
        else asm volatile("s_waitcnt vmcnt(0)" ::: "memory");
        __builtin_amdgcn_sched_barrier(0);
        f32x4 s0 = {0.f, 0.f, 0.f, 0.f};
#pragma unroll
        for (int s = 0; s < 8; ++s) s0 = __builtin_amdgcn_mfma_f32_16x16x32_bf16(*(const LAS bf16x8*)(buf + n * 512 + (((4 * s + g) ^ n) << 4)), qf[s], s0, 0, 0, 0);
        const int k0 = j * 16 + 4 * g;
        float bm = -3.0e38f;
#pragma unroll
        for (int i = 0; i < 4; ++i) { if (k0 + i >= nv) s0[i] = -3.0e38f; bm = fmaxf(bm, s0[i]); }
        bm = fmaxf(bm, __shfl_xor(bm, 16)); bm = fmaxf(bm, __shfl_xor(bm, 32));
        const float mnew = fmaxf(mrun, bm), alpha = __expf(mrun - mnew); const bool grow = mnew > mrun; mrun = mnew;
        float p[4]; float ps = 0.f;
#pragma unroll
        for (int i = 0; i < 4; ++i) { p[i] = (k0 + i < nv) ? __expf(s0[i] - mnew) : 0.f; ps += p[i]; }
        lsum = lsum * alpha + ps;
        const s16x4 pf = __builtin_bit_cast(s16x4, (u32x2_t){pk2bf(p[0], p[1]), pk2bf(p[2], p[3])});
        if (__any(grow)) {
#pragma unroll
            for (int c = 0; c < 16; ++c) o[c] = o[c] * alpha;
        }
        const int q4 = (lane & 15) >> 2, p4 = lane & 3, r0 = 4 * g + q4;
#pragma unroll
        for (int c = 0; c < 16; ++c) { const int ch = 2 * c + (p4 >> 1);
            const s16x4 af = vtr(buf + r0 * 512 + ((ch ^ r0) << 4) + ((p4 & 1) << 3));
            o[c] = __builtin_amdgcn_mfma_f32_16x16x16bf16_1k(af, pf, o[c], 0, 0, 0); }
        asm volatile("s_waitcnt lgkmcnt(0)" ::: "memory");
    }
#undef ATT_ISSUE
    lsum += __shfl_xor(lsum, 16); lsum += __shfl_xor(lsum, 32);
    const float inv = 1.f / lsum;
    if (n < 8) {
#pragma unroll
        for (int c = 0; c < 16; ++c) { const f32x4 v = o[c] * inv; *(uint2*)(qrow + n * 256 + 16 * c + 4 * g) = make_uint2(pk2bf(v[0], v[1]), pk2bf(v[2], v[3])); }
    }
}
}
namespace dsa {
struct DArgs { idxk::IdxArgs I; sattn::AArgs A; unsigned* qword; };
__device__ __forceinline__ void dsa_task(const DArgs& D, LAS unsigned char* lds, int b, int q0) {
    idxk::index_task(D.I, lds, b, q0);
    int tx = threadIdx.x; asm volatile("" : "+v"(tx));
    const int wave = __builtin_amdgcn_readfirstlane(tx >> 6), lane = tx & 63;
#pragma unroll 1
    for (int qq = 0; qq < 2; ++qq) { const int q = 2 * wave + qq;
        sattn::attn_query(D.A, lds + wave * 16384, b * 8192 + q0 + q, lane, (const LAS int*)(lds + idxk::L_SIDX) + q * 256); }
    asm volatile("s_waitcnt vmcnt(0) lgkmcnt(0)" ::: "memory");
    __syncthreads();
}
__device__ __forceinline__ void dsa_queue(const DArgs& D, LAS unsigned char* lds, volatile LAS unsigned* slot) {
    for (;;) {
        if (threadIdx.x == 0) *slot = __hip_atomic_fetch_add(D.qword, 1u, __ATOMIC_RELAXED, __HIP_MEMORY_SCOPE_AGENT);
        __syncthreads();
        const unsigned id = *slot;
        __syncthreads();
        if (id >= 1024u) break;
        dsa_task(D, lds, (int)(id & 1u), (511 - (int)(id >> 1)) * 16);
    }
}
}
namespace dnet {
typedef short bf16x8 __attribute__((ext_vector_type(8)));
typedef unsigned u32x2_t __attribute__((ext_vector_type(2)));
typedef __attribute__((ext_vector_type(4))) short v4i16p_t;
__device__ __forceinline__ float bflo(unsigned w) { return __builtin_bit_cast(float, w << 16); }
__device__ __forceinline__ float bfhi(unsigned w) { return __builtin_bit_cast(float, w & 0xffff0000u); }
#define DPP_ADDF(v, CTRL) v += __builtin_bit_cast(float, __builtin_amdgcn_update_dpp(0, __builtin_bit_cast(int, v), CTRL, 0xF, 0xF, false))
__device__ __forceinline__ void conv_phase(const bf16_t* QKVP, bf16_t* QKVN, const float* convw, int gw, int NGW, int lane) {
    for (int it = gw; it < 1024 * 6; it += NGW) {
        const int slab = it % 6, tb = it / 6, t0 = tb * 16, ch = slab * 512 + lane * 8;
        float w[4][8];
#pragma unroll
        for (int i = 0; i < 4; ++i) { const f32x4 a = *(const f32x4*)(convw + (size_t)i * 3072 + ch), b = *(const f32x4*)(convw + (size_t)i * 3072 + ch + 4);
            w[i][0] = a[0]; w[i][1] = a[1]; w[i][2] = a[2]; w[i][3] = a[3]; w[i][4] = b[0]; w[i][5] = b[1]; w[i][6] = b[2]; w[i][7] = b[3]; }
        u32x4 r0 = {0u, 0u, 0u, 0u}, r1 = r0, r2 = r0;
        if ((t0 & 8191) != 0) { r0 = *(const u32x4*)(QKVP + (size_t)(t0 - 3) * 3072 + ch); r1 = *(const u32x4*)(QKVP + (size_t)(t0 - 2) * 3072 + ch); r2 = *(const u32x4*)(QKVP + (size_t)(t0 - 1) * 3072 + ch); }
        u32x4 rows[16];
#pragma unroll
        for (int tt = 0; tt < 16; ++tt) rows[tt] = *(const u32x4*)(QKVP + (size_t)(t0 + tt) * 3072 + ch);
#pragma unroll
        for (int tt = 0; tt < 16; ++tt) {
            const u32x4 r3 = rows[tt];
            float y[8];
#pragma unroll
            for (int e = 0; e < 4; ++e) {
                const float a0 = bflo(r0[e]) * w[0][2 * e] + bflo(r1[e]) * w[1][2 * e] + bflo(r2[e]) * w[2][2 * e] + bflo(r3[e]) * w[3][2 * e];
                const float a1 = bfhi(r0[e]) * w[0][2 * e + 1] + bfhi(r1[e]) * w[1][2 * e + 1] + bfhi(r2[e]) * w[2][2 * e + 1] + bfhi(r3[e]) * w[3][2 * e + 1];
                y[2 * e] = a0 / (1.f + __expf(-a0)); y[2 * e + 1] = a1 / (1.f + __expf(-a1)); }
            if (slab < 4) {
                float ss = 0.f;
#pragma unroll
                for (int e = 0; e < 8; ++e) ss += y[e] * y[e];
                DPP_ADDF(ss, 0xB1); DPP_ADDF(ss, 0x4E); DPP_ADDF(ss, 0x141); DPP_ADDF(ss, 0x140);
                const float rs = 1.f / sqrtf(ss + 1e-6f);
#pragma unroll
                for (int e = 0; e < 8; ++e) y[e] *= rs;
            }
            u32x4 o; o.x = pk2bf(y[0], y[1]); o.y = pk2bf(y[2], y[3]); o.z = pk2bf(y[4], y[5]); o.w = pk2bf(y[6], y[7]);
            *(u32x4*)(QKVN + (size_t)(t0 + tt) * 3072 + ch) = o;
            r0 = r1; r1 = r2; r2 = r3;
        }
    }
}
constexpr int PR = 272, L_QN = 0, L_KN = 64 * PR, L_V = 2 * 64 * PR, L_A = 3 * 64 * PR, L_SM = 4 * 64 * PR, L_TI = L_SM + 5 * 256, L_PEND = L_TI + 4 * 16 * 16 * 2;
struct PrepArgs { bf16_t* QKVN; const float* BETA; const float* G; bf16_t* W; bf16_t* ATT; float* GL; };
__device__ __forceinline__ float dpp_swap1(float v) { return __builtin_bit_cast(float, __builtin_amdgcn_update_dpp(0, __builtin_bit_cast(int, v), 0xB1, 0xF, 0xF, false)); }
__device__ __forceinline__ void prep_chunk(const PrepArgs& A, LAS unsigned char* lds, int cid) {
    int tx = threadIdx.x; asm volatile("" : "+v"(tx));
    const int wave = __builtin_amdgcn_readfirstlane(tx >> 6), lane = tx & 63, n = lane & 15, g = lane >> 4;
    const int nc = cid & 127, h = (cid >> 7) & 7, b = cid >> 10; const size_t t0 = (size_t)b * 8192 + nc * 64;
    LAS float* SM = (LAS float*)(lds + L_SM);
    for (int i = tx; i < 3 * 64 * 16; i += 512) { const int which = i / 1024, r = (i >> 4) & 63, c16 = i & 15;
        const u32x4 v = *(const u32x4*)(A.QKVN + (t0 + r) * 3072 + which * 1024 + h * 128 + c16 * 8);
        *(LAS u32x4*)(lds + which * 64 * PR + r * PR + c16 * 16) = v; }
    if (wave == 0) {
        float gg = A.G[(t0 + lane) * 8 + h]; const float be = A.BETA[(t0 + lane) * 8 + h];
#pragma unroll
        for (int o = 1; o < 64; o <<= 1) { const float t = __shfl_up(gg, o); if (lane >= o) gg += t; }
        const float gl = __shfl(gg, 63);
        SM[lane] = be; SM[64 + lane] = gg; SM[128 + lane] = __expf(gg); SM[192 + lane] = __expf(gl - gg);
        if (lane == 0) A.GL[cid] = __expf(gl);
    }
    __syncthreads();
#pragma unroll
    for (int q = 0; q < 4; ++q) {
        const int tl = wave * 4 + q, isq = tl >> 4, mi = (tl >> 2) & 3, nj = tl & 3;
        if (nj > mi) continue;
        f32x4 acc = {0.f, 0.f, 0.f, 0.f};
        const LAS unsigned char* ar = lds + (isq ? L_QN : L_KN) + (16 * mi + n) * PR + 16 * g; const LAS unsigned char* br = lds + L_KN + (16 * nj + n) * PR + 16 * g;
#pragma unroll
        for (int s = 0; s < 4; ++s) acc = __builtin_amdgcn_mfma_f32_16x16x32_bf16(*(const LAS bf16x8*)(ar + 64 * s), *(const LAS bf16x8*)(br + 64 * s), acc, 0, 0, 0);
        const int j = 16 * nj + n; const float gcj = SM[64 + j];
#pragma unroll
        for (int r = 0; r < 4; ++r) { const int i = 16 * mi + 4 * g + r; const float dec = __expf(fminf(SM[64 + i] - gcj, 0.f));
            if (isq) A.ATT[(size_t)cid * 4096 + i * 64 + j] = f2bfd((j <= i) ? acc[r] * 0.08838834764831845f * dec : 0.f);
            else *(LAS float*)(lds + L_A + i * PR + j * 4) = (j < i) ? SM[i] * acc[r] * dec : 0.f; }
    }
    for (int i = tx; i < 64 * 64; i += 512) { const int r = i >> 6, c = i & 63; if ((c >> 4) > (r >> 4)) { *(LAS float*)(lds + L_A + r * PR + c * 4) = 0.f; A.ATT[(size_t)cid * 4096 + r * 64 + c] = 0; } }
    __syncthreads();
    if (wave < 4 && lane < 16) {
        float tcol[16];
#pragma unroll
        for (int i = 0; i < 16; ++i) { float s = (i == lane) ? 1.f : 0.f;
#pragma unroll
            for (int j = 0; j < i; ++j) s = fmaf(-*(const LAS float*)(lds + L_A + (16 * wave + i) * PR + (16 * wave + j) * 4), tcol[j], s);
            tcol[i] = s; }
#pragma unroll
        for (int i = 0; i < 16; ++i) *(LAS bf16_t*)(lds + L_TI + ((wave * 16 + i) * 16 + lane) * 2) = f2bfd(tcol[i] - ((i == lane) ? 1.f : 0.f));
    }
    __syncthreads();
    {
        const int q4 = n >> 2, p4 = n & 3;
#pragma unroll 1
        for (int tt = 0; tt < 2; ++tt) {
            const int col0 = 32 * wave + 16 * tt; const bool isw = col0 >= 128;
            const LAS unsigned char* srcm = lds + (isw ? L_KN + (col0 - 128) * 2 : L_V + col0 * 2);
            typedef short s16x4_t __attribute__((ext_vector_type(4)));
            s16x4_t xb[4];
#pragma unroll
            for (int bb = 0; bb < 4; ++bb) {
                const s16x4_t r4 = __builtin_bit_cast(s16x4_t, __builtin_amdgcn_ds_read_tr16_b64_v4i16((LAS v4i16p_t*)(srcm + (16 * bb + 4 * g + q4) * PR + 8 * p4)));
                f32x4 acc;
#pragma unroll
                for (int r = 0; r < 4; ++r) { const int i = 16 * bb + 4 * g + r; float sc = SM[i]; if (isw) sc *= SM[128 + i]; acc[r] = __builtin_bit_cast(float, (unsigned)(unsigned short)r4[r] << 16) * sc; }
#pragma unroll
                for (int bp = 0; bp < bb; ++bp) { const f32x4 av = *(const LAS f32x4*)(lds + L_A + (16 * bb + n) * PR + (16 * bp + 4 * g) * 4);
                    u32x2_t w; w.x = pk2bf(-av[0], -av[1]); w.y = pk2bf(-av[2], -av[3]);
                    acc = __builtin_amdgcn_mfma_f32_16x16x16bf16_1k(__builtin_bit_cast(s16x4_t, w), xb[bp], acc, 0, 0, 0); }
                { u32x2_t w; w.x = pk2bf(acc[0], acc[1]); w.y = pk2bf(acc[2], acc[3]);
                  const s16x4_t ti = *(const LAS s16x4_t*)(lds + L_TI + ((bb * 16 + n) * 16 + 4 * g) * 2);
                  acc = __builtin_amdgcn_mfma_f32_16x16x16bf16_1k(ti, __builtin_bit_cast(s16x4_t, w), acc, 0, 0, 0); }
                { u32x2_t w; w.x = pk2bf(acc[0], acc[1]); w.y = pk2bf(acc[2], acc[3]); xb[bb] = __builtin_bit_cast(s16x4_t, w); }
                if (!isw) {
#pragma unroll
                    for (int r = 0; r < 4; ++r) A.QKVN[(t0 + 16 * bb + 4 * g + r) * 3072 + 2048 + h * 128 + col0 + n] = f2bfd(acc[r]);
                } else {
#pragma unroll
                    for (int r = 0; r < 4; ++r) A.W[((size_t)cid * 64 + 16 * bb + 4 * g + r) * 128 + (col0 - 128) + n] = f2bfd(acc[r]);
                }
            }
        }
    }
    for (int i = tx; i < 2 * 64 * 16; i += 512) { const int which = i >> 10, r = (i >> 4) & 63, c16 = i & 15;
        const u32x4 v = *(const LAS u32x4*)(lds + which * 64 * PR + r * PR + c16 * 16); const float f = which ? SM[192 + r] : SM[128 + r] * 0.08838834764831845f;
        u32x4 o; o.x = pk2bf(bflo(v.x) * f, bfhi(v.x) * f); o.y = pk2bf(bflo(v.y) * f, bfhi(v.y) * f); o.z = pk2bf(bflo(v.z) * f, bfhi(v.z) * f); o.w = pk2bf(bflo(v.w) * f, bfhi(v.w) * f);
        *(u32x4*)(A.QKVN + (t0 + r) * 3072 + which * 1024 + h * 128 + c16 * 8) = o; }
    __syncthreads();
}
__device__ __forceinline__ void prep_phase(const PrepArgs& A, LAS unsigned char* lds, int bx, int G) { for (int cid = bx; cid < 2048; cid += G) prep_chunk(A, lds, cid); }
}
namespace dnet {
typedef short s16x4 __attribute__((ext_vector_type(4)));
typedef __attribute__((ext_vector_type(4))) short v4i16_t;
__device__ __forceinline__ s16x4 vtr(const LAS unsigned char* p) { return __builtin_bit_cast(s16x4, __builtin_amdgcn_ds_read_tr16_b64_v4i16((LAS v4i16_t*)p)); }
constexpr int PA = 144, S_W = 0, S_QD = 64 * PR, S_KD = 2 * 64 * PR, S_U = 3 * 64 * PR, S_ATT = 4 * 64 * PR, S_OBUF = S_ATT + 64 * PA, S_END = S_OBUF + 64 * PR;
static_assert(S_END <= 131072, "scan LDS map");
struct ScanArgs { const bf16_t* QKVN; const bf16_t* W; const bf16_t* ATT; const float* GL; bf16_t* O; const float* onw; };
__device__ __forceinline__ bf16x8 frag2(const LAS unsigned char* p) { return *(const LAS bf16x8*)p; }
typedef unsigned u32x2 __attribute__((ext_vector_type(2)));
__device__ __forceinline__ int perm_half(int c, int hh) { const int k = 8 * c + 4 * hh; return (k < 16) ? 16 * (k >> 2) : 16 * ((k - 16) >> 2) + 8; }
__device__ __forceinline__ void scan_bh(const ScanArgs& A, LAS unsigned char* lds, int bh) {
    int tx = threadIdx.x; asm volatile("" : "+v"(tx));
    const int wave = __builtin_amdgcn_readfirstlane(tx >> 6), lane = tx & 63, n = lane & 15, g = lane >> 4, q4 = n >> 2, p4 = n & 3;
    const int b = bh >> 3, h = bh & 7, e0 = 16 * wave;
    const int sr = tx >> 3, sc = tx & 7;
    (void)sr; (void)sc;
    u32x4 pfA[9], pfB[9];
    auto issue = [&](u32x4 (&pf)[9], int nc_) { const int nc = nc_ < 127 ? nc_ : 127;
        const size_t t0 = (size_t)b * 8192 + nc * 64; const int cid = bh * 128 + nc;
#pragma unroll
        for (int i = 0; i < 2; ++i) { const int p = tx + 512 * i, r = p >> 4, c = p & 15;
            pf[i] = *(const u32x4*)(A.W + ((size_t)cid * 64 + r) * 128 + c * 8);
            pf[2 + i] = *(const u32x4*)(A.QKVN + (t0 + r) * 3072 + h * 128 + c * 8);
            pf[4 + i] = *(const u32x4*)(A.QKVN + (t0 + r) * 3072 + 1024 + h * 128 + c * 8);
            pf[6 + i] = *(const u32x4*)(A.QKVN + (t0 + r) * 3072 + 2048 + h * 128 + c * 8); }
        pf[8] = *(const u32x4*)(A.ATT + (size_t)cid * 4096 + tx * 8);
    };
    auto commit = [&](const u32x4 (&pf)[9]) {
#pragma unroll
        for (int i = 0; i < 2; ++i) { const int p = tx + 512 * i, r = p >> 4, c = p & 15, kg = c >> 2, cc = c & 3;
            LAS unsigned char* wq = lds + r * PR + kg * 64;
            *(LAS u32x2*)(wq + S_W + perm_half(cc, 0)) = (u32x2){pf[i].x, pf[i].y}; *(LAS u32x2*)(wq + S_W + perm_half(cc, 1)) = (u32x2){pf[i].z, pf[i].w};
            *(LAS u32x2*)(wq + S_QD + perm_half(cc, 0)) = (u32x2){pf[2 + i].x, pf[2 + i].y}; *(LAS u32x2*)(wq + S_QD + perm_half(cc, 1)) = (u32x2){pf[2 + i].z, pf[2 + i].w};
            *(LAS u32x4*)(lds + S_KD + r * PR + c * 16) = pf[4 + i]; *(LAS u32x4*)(lds + S_U + r * PR + c * 16) = pf[6 + i]; }
        { const int r = tx >> 3, c = tx & 7, kg = c >> 2, cc = c & 3; LAS unsigned char* wa = lds + S_ATT + r * PA + kg * 64;
          *(LAS u32x2*)(wa + perm_half(cc, 0)) = (u32x2){pf[8].x, pf[8].y}; *(LAS u32x2*)(wa + perm_half(cc, 1)) = (u32x2){pf[8].z, pf[8].w}; }
    };
    const float gl_lo = A.GL[bh * 128 + lane], gl_hi = A.GL[bh * 128 + 64 + lane];
    f32x4 S[8];
#pragma unroll
    for (int d = 0; d < 8; ++d) S[d] = (f32x4){0.f, 0.f, 0.f, 0.f};
    auto compute = [&](int nc) {
        const float gl = __builtin_bit_cast(float, (nc < 64) ? __builtin_amdgcn_readlane(__builtin_bit_cast(int, gl_lo), nc & 63) : __builtin_amdgcn_readlane(__builtin_bit_cast(int, gl_hi), nc & 63));
        const size_t t0 = (size_t)b * 8192 + nc * 64;
        bf16x8 sp[4];
#pragma unroll
        for (int s = 0; s < 4; ++s) { u32x4 w; w.x = pk2bf(S[2 * s][0], S[2 * s][1]); w.y = pk2bf(S[2 * s][2], S[2 * s][3]); w.z = pk2bf(S[2 * s + 1][0], S[2 * s + 1][1]); w.w = pk2bf(S[2 * s + 1][2], S[2 * s + 1][3]);
            sp[s] = __builtin_bit_cast(bf16x8, w); }
        f32x4 vn[4];
#pragma unroll
        for (int mt = 0; mt < 4; ++mt) {
            const s16x4 u4 = vtr(lds + S_U + (16 * mt + 4 * g + q4) * PR + (e0 + 4 * p4) * 2);
            f32x4 acc; acc[0] = __builtin_bit_cast(float, ((unsigned)(unsigned short)u4[0] << 16) ^ 0x80000000u); acc[1] = __builtin_bit_cast(float, ((unsigned)(unsigned short)u4[1] << 16) ^ 0x80000000u);
            acc[2] = __builtin_bit_cast(float, ((unsigned)(unsigned short)u4[2] << 16) ^ 0x80000000u); acc[3] = __builtin_bit_cast(float, ((unsigned)(unsigned short)u4[3] << 16) ^ 0x80000000u);
            const LAS unsigned char* wr = lds + S_W + (16 * mt + n) * PR + 16 * g;
#pragma unroll
            for (int s = 0; s < 4; ++s) acc = __builtin_amdgcn_mfma_f32_16x16x32_bf16(frag2(wr + 64 * s), sp[s], acc, 0, 0, 0);
            vn[mt] = acc;
        }
        bf16x8 vp[2];
#pragma unroll
        for (int s = 0; s < 2; ++s) { u32x4 w; w.x = pk2bf(vn[2 * s][0], vn[2 * s][1]); w.y = pk2bf(vn[2 * s][2], vn[2 * s][3]); w.z = pk2bf(vn[2 * s + 1][0], vn[2 * s + 1][1]); w.w = pk2bf(vn[2 * s + 1][2], vn[2 * s + 1][3]);
            w.x ^= 0x80008000u; w.y ^= 0x80008000u; w.z ^= 0x80008000u; w.w ^= 0x80008000u; vp[s] = __builtin_bit_cast(bf16x8, w); }
#pragma unroll
        for (int mt = 0; mt < 4; ++mt) {
            f32x4 acc = {0.f, 0.f, 0.f, 0.f};
            const LAS unsigned char* qr = lds + S_QD + (16 * mt + n) * PR + 16 * g; const LAS unsigned char* ar = lds + S_ATT + (16 * mt + n) * PA + 16 * g;
#pragma unroll
            for (int s = 0; s < 4; ++s) acc = __builtin_amdgcn_mfma_f32_16x16x32_bf16(frag2(qr + 64 * s), sp[s], acc, 0, 0, 0);
#pragma unroll
            for (int s = 0; s < 2; ++s) acc = __builtin_amdgcn_mfma_f32_16x16x32_bf16(frag2(ar + 64 * s), vp[s], acc, 0, 0, 0);
#pragma unroll
            for (int r = 0; r < 4; ++r) *(LAS bf16_t*)(lds + S_OBUF + (16 * mt + 4 * g + r) * PR + (e0 + n) * 2) = f2bfd(acc[r]);
        }
#pragma unroll
        for (int d = 0; d < 8; ++d) {
            f32x4 acc = S[d] * gl;
#pragma unroll
            for (int s = 0; s < 2; ++s) { const LAS unsigned char* kp = lds + S_KD + (32 * s + 4 * g + q4) * PR + (16 * d + 4 * p4) * 2;
                const s16x4 k0 = vtr(kp), k1 = vtr(kp + 16 * PR); const bf16x8 af = {k0[0], k0[1], k0[2], k0[3], k1[0], k1[1], k1[2], k1[3]};
                acc = __builtin_amdgcn_mfma_f32_16x16x32_bf16(af, vp[s], acc, 0, 0, 0); }
            S[d] = acc;
        }
    };
    auto flush = [&](int nc) {
        const int row = tx >> 3, c = tx & 7; const size_t t0 = (size_t)b * 8192 + nc * 64;
        const u32x4 v0 = *(const LAS u32x4*)(lds + S_OBUF + row * PR + c * 16), v1 = *(const LAS u32x4*)(lds + S_OBUF + row * PR + (c + 8) * 16);
        float f[16]; float ss = 0.f;
#pragma unroll
        for (int i = 0; i < 4; ++i) { const unsigned a = v0[i], d = v1[i]; f[2 * i] = bflo(a); f[2 * i + 1] = bfhi(a); f[8 + 2 * i] = bflo(d); f[8 + 2 * i + 1] = bfhi(d); }
#pragma unroll
        for (int i = 0; i < 16; ++i) ss += f[i] * f[i];
        DPP_ADDF(ss, 0xB1); DPP_ADDF(ss, 0x4E); DPP_ADDF(ss, 0x141);
        const float rs = 1.f / sqrtf(ss * (1.f / 128.f) + 1e-6f);
        const f32x4 w0 = *(const f32x4*)(A.onw + 8 * c), w1 = *(const f32x4*)(A.onw + 8 * c + 4), w2 = *(const f32x4*)(A.onw + 64 + 8 * c), w3 = *(const f32x4*)(A.onw + 64 + 8 * c + 4);
        u32x4 r0, r1;
        r0.x = pk2bf(f[0] * rs * w0[0], f[1] * rs * w0[1]); r0.y = pk2bf(f[2] * rs * w0[2], f[3] * rs * w0[3]); r0.z = pk2bf(f[4] * rs * w1[0], f[5] * rs * w1[1]); r0.w = pk2bf(f[6] * rs * w1[2], f[7] * rs * w1[3]);
        r1.x = pk2bf(f[8] * rs * w2[0], f[9] * rs * w2[1]); r1.y = pk2bf(f[10] * rs * w2[2], f[11] * rs * w2[3]); r1.z = pk2bf(f[12] * rs * w3[0], f[13] * rs * w3[1]); r1.w = pk2bf(f[14] * rs * w3[2], f[15] * rs * w3[3]);
        bf16_t* op = A.O + (t0 + row) * 1024 + h * 128; *(u32x4*)(op + c * 8) = r0; *(u32x4*)(op + (c + 8) * 8) = r1; };
    issue(pfA, 0); issue(pfB, 1); commit(pfA); __syncthreads();
#define LBAR() asm volatile("s_waitcnt lgkmcnt(0)\n\ts_barrier" ::: "memory")
    for (int nc = 0; nc < 128; nc += 2) {
        issue(pfA, nc + 2); compute(nc);
        LBAR(); flush(nc); commit(pfB); LBAR();
        issue(pfB, nc + 3); compute(nc + 1);
        LBAR(); flush(nc + 1); commit(pfA); LBAR();
    }
#undef LBAR
    __syncthreads();
}
__device__ __forceinline__ void scan_phase(const ScanArgs& A, LAS unsigned char* lds, int bx, int G) { for (int bh = bx; bh < 16; bh += G) scan_bh(A, lds, bh); }
}
namespace peer {
typedef __bf16 bf16x2_t __attribute__((ext_vector_type(2)));
__device__ __forceinline__ float dppf(float v, const int ctrl_unused) { return v; }
#define DPP_ADD(v, CTRL, RMASK) v += __builtin_bit_cast(float, __builtin_amdgcn_update_dpp(0, __builtin_bit_cast(int, v), CTRL, RMASK, 0xF, false))
__device__ __forceinline__ float wave_sum_u(float v) {
    DPP_ADD(v, 0xB1, 0xF); DPP_ADD(v, 0x4E, 0xF); DPP_ADD(v, 0x141, 0xF); DPP_ADD(v, 0x140, 0xF);
    DPP_ADD(v, 0x142, 0xA); DPP_ADD(v, 0x143, 0xC);
    return __builtin_bit_cast(float, __builtin_amdgcn_readlane(__builtin_bit_cast(int, v), 63));
}
__device__ __forceinline__ float dot2bf(unsigned a, unsigned b, float c) { return __builtin_amdgcn_fdot2_f32_bf16(__builtin_bit_cast(bf16x2_t, a), __builtin_bit_cast(bf16x2_t, b), c, false); }
__device__ __forceinline__ float dot16(const u32x4& a0, const u32x4& a1, const u32x4& h0, const u32x4& h1) {
    float s = 0.f;
#pragma unroll
    for (int i = 0; i < 4; ++i) { const unsigned x0 = a0[i], y0 = h0[i], x1 = a1[i], y1 = h1[i]; s = dot2bf(x0, y0, s); s = dot2bf(x1, y1, s); }
    return s;
}
__device__ __forceinline__ void axpy16(float (&acc)[16], float a, const u32x4& v0, const u32x4& v1) {
#pragma unroll
    for (int i = 0; i < 4; ++i) { acc[2 * i] = fmaf(a, __builtin_bit_cast(float, v0[i] << 16), acc[2 * i]); acc[2 * i + 1] = fmaf(a, __builtin_bit_cast(float, v0[i] & 0xffff0000u), acc[2 * i + 1]);
        acc[8 + 2 * i] = fmaf(a, __builtin_bit_cast(float, v1[i] << 16), acc[8 + 2 * i]); acc[8 + 2 * i + 1] = fmaf(a, __builtin_bit_cast(float, v1[i] & 0xffff0000u), acc[8 + 2 * i + 1]); }
}
constexpr float SU_ = 512.f, SV_ = 64.f;
__device__ __forceinline__ unsigned pk4fp8(f32x4 v, float s) { int p = __builtin_amdgcn_cvt_pk_fp8_f32(v[0] * s, v[1] * s, 0, false); p = __builtin_amdgcn_cvt_pk_fp8_f32(v[2] * s, v[3] * s, p, true); return (unsigned)p; }
__device__ __forceinline__ void convert_tables(const float* u, const float* v, unsigned char* ub, unsigned char* vb, int gt, int NGT) {
    for (int i = gt; i < 16384 * 1024 / 16; i += NGT) {
        const f32x4* us = (const f32x4*)u + 4 * (size_t)i; const f32x4* vs = (const f32x4*)v + 4 * (size_t)i;
        u32x4 o; o.x = pk4fp8(us[0], SU_); o.y = pk4fp8(us[1], SU_); o.z = pk4fp8(us[2], SU_); o.w = pk4fp8(us[3], SU_); ((u32x4*)ub)[i] = o;
        o.x = pk4fp8(vs[0], SV_); o.y = pk4fp8(vs[1], SV_); o.z = pk4fp8(vs[2], SV_); o.w = pk4fp8(vs[3], SV_); ((u32x4*)vb)[i] = o; }
}
struct PeerArgs { const unsigned char* Ub; const unsigned char* Vb; const bf16_t* H2; const float* X1; const float* MOD; const float* S; const float* fnw; float* out; };
__device__ __forceinline__ void route_token(const float* Srow, int lane, int& e_lo, int& e_hi, float& g_lo, float& g_hi);
__device__ __forceinline__ void expert_token(const PeerArgs& A, int t, int lane) {
    const int b = t >> 13;
    const u32x4 h0 = *(const u32x4*)(A.H2 + (size_t)t * 1024 + 16 * lane), h1 = *(const u32x4*)(A.H2 + (size_t)t * 1024 + 16 * lane + 8);
    int e_lo, e_hi; float g_lo, g_hi; route_token(A.S + (size_t)(t & 8191) * 2048, lane, e_lo, e_hi, g_lo, g_hi);
    f32x2h_t acc2[8], hf2[8];
#pragma unroll
    for (int i = 0; i < 4; ++i) { const unsigned a = h0[i], b2 = h1[i]; hf2[i] = (f32x2h_t){__builtin_bit_cast(float, a << 16), __builtin_bit_cast(float, a & 0xffff0000u)};
        hf2[4 + i] = (f32x2h_t){__builtin_bit_cast(float, b2 << 16), __builtin_bit_cast(float, b2 & 0xffff0000u)}; }
#pragma unroll
    for (int i = 0; i < 8; ++i) acc2[i] = (f32x2h_t){0.f, 0.f};
    for (int s0 = 0; s0 < 128; s0 += 8) {
        int e[8]; float gt[8]; u32x4 uu[8], vv[8];
#pragma unroll
        for (int q = 0; q < 8; ++q) { const int s = s0 + q;
            e[q] = (s0 < 64) ? __builtin_amdgcn_readlane(e_lo, s & 63) : __builtin_amdgcn_readlane(e_hi, s & 63);
            gt[q] = __builtin_bit_cast(float, (s0 < 64) ? __builtin_amdgcn_readlane(__builtin_bit_cast(int, g_lo), s & 63) : __builtin_amdgcn_readlane(__builtin_bit_cast(int, g_hi), s & 63));
            uu[q] = *(const u32x4*)(A.Ub + (size_t)e[q] * 1024 + 16 * lane); vv[q] = *(const u32x4*)(A.Vb + (size_t)e[q] * 1024 + 16 * lane); }
        float d[8];
#pragma unroll
        for (int q = 0; q < 8; ++q) { f32x2h_t s2 = {0.f, 0.f};
#pragma unroll
            for (int i = 0; i < 4; ++i) { const int w = (int)uu[q][i]; const f32x2h_t lo = __builtin_amdgcn_cvt_pk_f32_fp8(w, false), hi = __builtin_amdgcn_cvt_pk_f32_fp8(w, true);
                s2 = __builtin_elementwise_fma(lo, hf2[2 * i], s2); s2 = __builtin_elementwise_fma(hi, hf2[2 * i + 1], s2); }
            d[q] = s2[0] + s2[1]; }
#pragma unroll
        for (int q = 0; q < 8; ++q) d[q] = wave_sum_u(d[q]) * (1.f / SU_);
#pragma unroll
        for (int q = 0; q < 8; ++q) { const float a = 0.5f * d[q] * (1.f + erff(d[q] * 0.70710678118654752f)) * gt[q] * (1.f / SV_); const f32x2h_t a2 = {a, a};
#pragma unroll
            for (int i = 0; i < 4; ++i) { const int w = (int)vv[q][i]; const f32x2h_t lo = __builtin_amdgcn_cvt_pk_f32_fp8(w, false), hi = __builtin_amdgcn_cvt_pk_f32_fp8(w, true);
                acc2[2 * i] = __builtin_elementwise_fma(a2, lo, acc2[2 * i]); acc2[2 * i + 1] = __builtin_elementwise_fma(a2, hi, acc2[2 * i + 1]); } }
    }
    float acc[16];
#pragma unroll
    for (int i = 0; i < 8; ++i) { acc[2 * i] = acc2[i][0]; acc[2 * i + 1] = acc2[i][1]; }
    const float* xr = A.X1 + (size_t)t * 1024 + 16 * lane; const float* g2 = A.MOD + (size_t)b * 6144 + 5120 + 16 * lane; const float* fw = A.fnw + 16 * lane;
    float x2[16]; float ss = 0.f;
#pragma unroll
    for (int i = 0; i < 4; ++i) { const f32x4 xv = *(const f32x4*)(xr + 4 * i), gv = *(const f32x4*)(g2 + 4 * i);
#pragma unroll
        for (int k = 0; k < 4; ++k) { const float y = xv[k] + gv[k] * acc[4 * i + k]; x2[4 * i + k] = y; ss += y * y; } }
    ss = wave_sum_u(ss);
    const float rstd = 1.f / sqrtf(ss * (1.f / 1024.f) + 1e-6f);
    float* orow = A.out + (size_t)t * 1024 + 16 * lane;
#pragma unroll
    for (int i = 0; i < 4; ++i) { const f32x4 wv = *(const f32x4*)(fw + 4 * i); f32x4 o; o[0] = x2[4 * i] * rstd * wv[0]; o[1] = x2[4 * i + 1] * rstd * wv[1]; o[2] = x2[4 * i + 2] * rstd * wv[2]; o[3] = x2[4 * i + 3] * rstd * wv[3];
        *(f32x4*)(orow + 4 * i) = o; }
}
__device__ __forceinline__ void expert_phase(const PeerArgs& A, int half, int bx, int G) {
    int tx = threadIdx.x; asm volatile("" : "+v"(tx));
    const int wave = __builtin_amdgcn_readfirstlane(tx >> 6), lane = tx & 63;
    for (int t = wave * G + bx; t < 8192; t += 8 * G) expert_token(A, half * 8192 + t, lane);
}
}
namespace peer {
__device__ __forceinline__ unsigned sortable(float f) { const unsigned u = __builtin_bit_cast(unsigned, f); return (u & 0x80000000u) ? ~u : (u | 0x80000000u); }
#define DPP_UMAX(v, CTRL) { const unsigned t_ = (unsigned)__builtin_amdgcn_update_dpp(0, (int)(v), CTRL, 0xF, 0xF, false); v = (v) > t_ ? (v) : t_; }
#define DPP_FMAX(v, CTRL) { const float t_ = __builtin_bit_cast(float, __builtin_amdgcn_update_dpp(0, __builtin_bit_cast(int, v), CTRL, 0xF, 0xF, false)); v = fmaxf(v, t_); }
#define CE_(a, b) { const unsigned hi_ = (a) > (b) ? (a) : (b), lo_ = (a) > (b) ? (b) : (a); a = hi_; b = lo_; }
__device__ __forceinline__ void route_token(const float* Srow, int lane, int& e_lo, int& e_hi, float& g_lo, float& g_hi) {
    const int r = lane >> 4, i = lane & 15;
    int ic, jc; { const int c = lane; ic = (c < 16) ? 0 : (c < 24) ? 1 : (c < 29) ? 2 : (c < 33) ? 3 : (c < 36) ? 4 : (c < 38) ? 5 : (c < 40) ? 6 : (c < 42) ? 7 : (c - 34);
        const int st = (ic == 0) ? 0 : (ic == 1) ? 16 : (ic == 2) ? 24 : (ic == 3) ? 29 : (ic == 4) ? 33 : (ic == 5) ? 36 : (ic == 6) ? 38 : (ic == 7) ? 40 : (c); jc = c - st; if (ic > 15) { ic = 15; jc = 0; } }
    const int flat = ic * 16 + jc; const bool cvalid = lane < 50;
    e_lo = 0; e_hi = 0; g_lo = 0.f; g_hi = 0.f;
#pragma unroll 1
    for (int k = 0; k < 4; ++k) {
        const float* lp = Srow + (4 * k + r) * 128;
        const f32x4 va = *(const f32x4*)(lp + 8 * i), vb = *(const f32x4*)(lp + 8 * i + 4);
        unsigned k0 = (sortable(va[0]) & 0xFFFFFF80u) | (unsigned)(127 - (8 * i + 0)), k1 = (sortable(va[1]) & 0xFFFFFF80u) | (unsigned)(127 - (8 * i + 1)),
                 k2 = (sortable(va[2]) & 0xFFFFFF80u) | (unsigned)(127 - (8 * i + 2)), k3 = (sortable(va[3]) & 0xFFFFFF80u) | (unsigned)(127 - (8 * i + 3)),
                 k4 = (sortable(vb[0]) & 0xFFFFFF80u) | (unsigned)(127 - (8 * i + 4)), k5 = (sortable(vb[1]) & 0xFFFFFF80u) | (unsigned)(127 - (8 * i + 5)),
                 k6 = (sortable(vb[2]) & 0xFFFFFF80u) | (unsigned)(127 - (8 * i + 6)), k7 = (sortable(vb[3]) & 0xFFFFFF80u) | (unsigned)(127 - (8 * i + 7));
        CE_(k0, k1) CE_(k2, k3) CE_(k4, k5) CE_(k6, k7)  CE_(k0, k2) CE_(k1, k3) CE_(k4, k6) CE_(k5, k7)  CE_(k1, k2) CE_(k5, k6)
        CE_(k0, k4) CE_(k1, k5) CE_(k2, k6) CE_(k3, k7)  CE_(k2, k4) CE_(k3, k5)  CE_(k1, k2) CE_(k3, k4) CE_(k5, k6)
        unsigned sel = 0u;
#pragma unroll
        for (int it = 0; it < 16; ++it) { unsigned M = k0; DPP_UMAX(M, 0x128) DPP_UMAX(M, 0x124) DPP_UMAX(M, 0x122) DPP_UMAX(M, 0x121)
            sel = (i == it) ? M : sel; const bool own = (k0 == M);
            k0 = own ? k1 : k0; k1 = own ? k2 : k1; k2 = own ? k3 : k2; k3 = own ? k4 : k3; k4 = own ? k5 : k4; k5 = own ? k6 : k5; k6 = own ? k7 : k6; k7 = own ? 0u : k7; }
        const int sidx = 127 - (int)(sel & 127u); const float sval = lp[sidx];
#pragma unroll
        for (int hh = 0; hh < 2; ++hh) {
            const int h = 2 * k + hh, l0 = 32 * hh, l1 = 32 * hh + 16;
            const float ca = __shfl(sval, l0 + ic), cb = __shfl(sval, l1 + jc); const float cs = ca + cb;
            unsigned key = cvalid ? ((sortable(cs) & 0xFFFFFF00u) | (unsigned)(255 - flat)) : 0u; unsigned top = 0u;
#pragma unroll
            for (int it = 0; it < 16; ++it) { unsigned M = key; DPP_UMAX(M, 0x128) DPP_UMAX(M, 0x124) DPP_UMAX(M, 0x122) DPP_UMAX(M, 0x121)
                const unsigned m0 = (unsigned)__builtin_amdgcn_readlane((int)M, 0), m1 = (unsigned)__builtin_amdgcn_readlane((int)M, 16), m2 = (unsigned)__builtin_amdgcn_readlane((int)M, 32), m3 = (unsigned)__builtin_amdgcn_readlane((int)M, 48);
                const unsigned ma = m0 > m1 ? m0 : m1, mb = m2 > m3 ? m2 : m3, mm = ma > mb ? ma : mb;
                top = (lane == it) ? mm : top; key = (key == mm) ? 0u : key; }
            const int fl = 255 - (int)(top & 255u), ti = fl >> 4, tj = fl & 15;
            const float tv = __shfl(sval, l0 + ti) + __shfl(sval, l1 + tj);
            const int ex = __shfl(sidx, l0 + ti) * 128 + __shfl(sidx, l1 + tj);
            float mx = tv; DPP_FMAX(mx, 0x128) DPP_FMAX(mx, 0x124) DPP_FMAX(mx, 0x122) DPP_FMAX(mx, 0x121)
            float p = __expf(tv - mx), ps = p; DPP_ADD(ps, 0x128, 0xF); DPP_ADD(ps, 0x124, 0xF); DPP_ADD(ps, 0x122, 0xF); DPP_ADD(ps, 0x121, 0xF);
            const float gate = p / ps;
            const int ex_m = __shfl(ex, i); const float g_m = __shfl(gate, i);
            if (r == (h & 3)) { if (h < 4) { e_lo = ex_m; g_lo = g_m; } else { e_hi = ex_m; g_hi = g_m; } }
        }
    }
}
}
namespace ew {
using peer::wave_sum_u;
__device__ __forceinline__ void mod_phase(const float* c, const float* w_ada, const float* b_ada, float* MOD, LAS unsigned char* lds, int bx, int G) {
    int tx = threadIdx.x; asm volatile("" : "+v"(tx));
    LAS float* red = (LAS float*)lds;
    for (int it = bx; it < 192; it += G) {
        const int col = tx & 31, kg = tx >> 5, j = it * 32 + col; float a0 = 0.f, a1 = 0.f, b0 = 0.f, b1 = 0.f;
#pragma unroll 4
        for (int k = kg * 64; k < kg * 64 + 64; k += 2) { const float w0 = w_ada[(size_t)k * 6144 + j], w1 = w_ada[(size_t)(k + 1) * 6144 + j]; const float c00 = c[k], c01 = c[k + 1], c10 = c[1024 + k], c11 = c[1024 + k + 1];
            a0 = fmaf(c00 / (1.f + __expf(-c00)), w0, a0); b0 = fmaf(c01 / (1.f + __expf(-c01)), w1, b0); a1 = fmaf(c10 / (1.f + __expf(-c10)), w0, a1); b1 = fmaf(c11 / (1.f + __expf(-c11)), w1, b1); }
        red[(kg * 2 + 0) * 32 + col] = a0 + b0; red[(kg * 2 + 1) * 32 + col] = a1 + b1;
        __syncthreads();
        if (tx < 64) { const int bb = tx >> 5; float s = b_ada[j];
#pragma unroll
            for (int q = 0; q < 16; ++q) s += red[(q * 2 + bb) * 32 + col];
            MOD[(size_t)bb * 6144 + j] = s; }
        __syncthreads();
    }
}
__device__ __forceinline__ void modnorm_row(const f32x4 (&v)[4], const float* nw, const float* MOD, int which, bf16_t* H, int t, int lane) {
    const int b = t >> 13; const float* sh = MOD + (size_t)b * 6144 + (which ? 3072 : 0) + 16 * lane; const float* sc = sh + 1024; const float* wr = nw + 16 * lane;
    float ss = 0.f;
#pragma unroll
    for (int i = 0; i < 4; ++i) ss += v[i][0] * v[i][0] + v[i][1] * v[i][1] + v[i][2] * v[i][2] + v[i][3] * v[i][3];
    ss = wave_sum_u(ss); const float rstd = 1.f / sqrtf(ss * (1.f / 1024.f) + 1e-6f);
    float y[16];
#pragma unroll
    for (int i = 0; i < 4; ++i) { const f32x4 w = *(const f32x4*)(wr + 4 * i), s1 = *(const f32x4*)(sc + 4 * i), s0 = *(const f32x4*)(sh + 4 * i);
#pragma unroll
        for (int k = 0; k < 4; ++k) y[4 * i + k] = v[i][k] * rstd * w[k] * (1.f + s1[k]) + s0[k]; }
    u32x4 o0, o1; o0.x = pk2bf(y[0], y[1]); o0.y = pk2bf(y[2], y[3]); o0.z = pk2bf(y[4], y[5]); o0.w = pk2bf(y[6], y[7]); o1.x = pk2bf(y[8], y[9]); o1.y = pk2bf(y[10], y[11]); o1.z = pk2bf(y[12], y[13]); o1.w = pk2bf(y[14], y[15]);
    *(u32x4*)(H + (size_t)t * 1024 + 16 * lane) = o0; *(u32x4*)(H + (size_t)t * 1024 + 16 * lane + 8) = o1;
}
__device__ __forceinline__ void modnorm_phase(const float* X, const float* nw, const float* MOD, int which, bf16_t* H, int gw, int NGW, int lane) {
    for (int t = gw; t < 16384; t += 4 * NGW) {
        f32x4 v[4][4];
#pragma unroll
        for (int u = 0; u < 4; ++u) { const int tu = t + u * NGW; if (tu < 16384) {
#pragma unroll
            for (int i = 0; i < 4; ++i) v[u][i] = *(const f32x4*)(X + (size_t)tu * 1024 + 16 * lane + 4 * i); } }
#pragma unroll
        for (int u = 0; u < 4; ++u) { const int tu = t + u * NGW; if (tu < 16384) modnorm_row(v[u], nw, MOD, which, H, tu, lane); }
    }
}
struct SmallArgs { const bf16_t* RAW; const float *qw, *kvw, *kiw, *a_log, *dt_bias; bf16_t *QLATN, *CKVN, *KIDXN; float *BETA, *G, *WIDX; };
__device__ __forceinline__ void small_phase(const SmallArgs& A, int gw, int NGW, int lane) {
    for (int t = gw; t < 16384; t += NGW) {
        const bf16_t* r = A.RAW + (size_t)t * 768;
        const uint2 qp = *(const uint2*)(r + 4 * lane), kp = *(const uint2*)(r + 256 + 4 * lane);
        const float q0 = __builtin_bit_cast(float, qp.x << 16), q1 = __builtin_bit_cast(float, qp.x & 0xffff0000u), q2 = __builtin_bit_cast(float, qp.y << 16), q3 = __builtin_bit_cast(float, qp.y & 0xffff0000u);
        const float k0 = __builtin_bit_cast(float, kp.x << 16), k1 = __builtin_bit_cast(float, kp.x & 0xffff0000u), k2 = __builtin_bit_cast(float, kp.y << 16), k3 = __builtin_bit_cast(float, kp.y & 0xffff0000u);
        const float ki = bf2f(r[512 + lane]);
        const float sq = wave_sum_u(q0 * q0 + q1 * q1 + q2 * q2 + q3 * q3), skv = wave_sum_u(k0 * k0 + k1 * k1 + k2 * k2 + k3 * k3), ski = wave_sum_u(ki * ki);
        const float rq = 1.f / sqrtf(sq * (1.f / 256.f) + 1e-6f), rkv = 1.f / sqrtf(skv * (1.f / 256.f) + 1e-6f), rki = 1.f / sqrtf(ski * (1.f / 64.f) + 1e-6f);
        const f32x4 wq = *(const f32x4*)(A.qw + 4 * lane), wkv = *(const f32x4*)(A.kvw + 4 * lane);
        *(uint2*)(A.QLATN + (size_t)t * 256 + 4 * lane) = make_uint2(pk2bf(q0 * rq * wq[0], q1 * rq * wq[1]), pk2bf(q2 * rq * wq[2], q3 * rq * wq[3]));
        *(uint2*)(A.CKVN + (size_t)t * 256 + 4 * lane) = make_uint2(pk2bf(k0 * rkv * wkv[0], k1 * rkv * wkv[1]), pk2bf(k2 * rkv * wkv[2], k3 * rkv * wkv[3]));
        A.KIDXN[(size_t)t * 64 + lane] = f2bfd(ki * rki * A.kiw[lane]);
        if (lane < 8) { const float be = bf2f(r[576 + lane]), de = bf2f(r[584 + lane]), wi = bf2f(r[592 + lane]);
            A.BETA[(size_t)t * 8 + lane] = 1.f / (1.f + __expf(-be));
            const float xs = de + A.dt_bias[lane]; A.G[(size_t)t * 8 + lane] = -__expf(A.a_log[lane]) * (xs > 20.f ? xs : log1pf(__expf(xs)));
            A.WIDX[(size_t)t * 8 + lane] = wi * 0.04419417382415922f; }
    }
}
__device__ __forceinline__ void ogate_phase(const bf16_t* O, const bf16_t* Z, const float* ow, bf16_t* OG, int gw, int NGW, int lane) {
    for (int t = gw; t < 16384; t += NGW) {
        const u32x4 o0 = *(const u32x4*)(O + (size_t)t * 1024 + 16 * lane), o1 = *(const u32x4*)(O + (size_t)t * 1024 + 16 * lane + 8);
        const u32x4 z0 = *(const u32x4*)(Z + (size_t)t * 1024 + 16 * lane), z1 = *(const u32x4*)(Z + (size_t)t * 1024 + 16 * lane + 8);
        float ov[16], zv[16]; float ss = 0.f;
#pragma unroll
        for (int i = 0; i < 4; ++i) { const unsigned a = o0[i], b = o1[i], c = z0[i], d = z1[i];
            ov[2 * i] = __builtin_bit_cast(float, a << 16); ov[2 * i + 1] = __builtin_bit_cast(float, a & 0xffff0000u); ov[8 + 2 * i] = __builtin_bit_cast(float, b << 16); ov[8 + 2 * i + 1] = __builtin_bit_cast(float, b & 0xffff0000u);
            zv[2 * i] = __builtin_bit_cast(float, c << 16); zv[2 * i + 1] = __builtin_bit_cast(float, c & 0xffff0000u); zv[8 + 2 * i] = __builtin_bit_cast(float, d << 16); zv[8 + 2 * i + 1] = __builtin_bit_cast(float, d & 0xffff0000u); }
#pragma unroll
        for (int i = 0; i < 16; ++i) ss += ov[i] * ov[i];
        DPP_ADD(ss, 0xB1, 0xF); DPP_ADD(ss, 0x4E, 0xF); DPP_ADD(ss, 0x141, 0xF);
        const float rs = 1.f / sqrtf(ss * (1.f / 128.f) + 1e-6f); const float* w = ow + 16 * (lane & 7);
        float y[16];
#pragma unroll
        for (int i = 0; i < 16; ++i) y[i] = ov[i] * rs * w[i] * (zv[i] / (1.f + __expf(-zv[i])));
        u32x4 r0, r1; r0.x = pk2bf(y[0], y[1]); r0.y = pk2bf(y[2], y[3]); r0.z = pk2bf(y[4], y[5]); r0.w = pk2bf(y[6], y[7]); r1.x = pk2bf(y[8], y[9]); r1.y = pk2bf(y[10], y[11]); r1.z = pk2bf(y[12], y[13]); r1.w = pk2bf(y[14], y[15]);
        *(u32x4*)(OG + (size_t)t * 1024 + 16 * lane) = r0; *(u32x4*)(OG + (size_t)t * 1024 + 16 * lane + 8) = r1;
    }
}
}
constexpr int NTHR = 512;
constexpr int LDS_BYTES = 155648;
constexpr size_t CTL_ZERO_BYTES = 32768;
struct MArgs { NP P; NP P2; OP Q; unsigned* ctl; };

typedef const __attribute__((address_space(4))) MArgs* KAP;
typedef const __attribute__((address_space(4))) unsigned long long* KW;
#define KA(ka) KAP ka = (KAP)__builtin_amdgcn_kernarg_segment_ptr(); asm volatile("" : "+s"(ka))
template <class TT, class SS> __device__ __forceinline__ void ka_copy(TT& dst, SS src) { static_assert(sizeof(TT) % 8 == 0, "8-byte words");
    void** d = (void**)&dst; KW s = (KW)src;
#pragma unroll
    for (int i = 0; i < (int)(sizeof(TT) / 8); ++i) d[i] = (void*)(__attribute__((address_space(1))) void*)s[i]; }
#define LOADP(P, ka) NP P; ka_copy(P, &ka->P)
#define LOADQ(Q, ka) OP Q; ka_copy(Q, &ka->Q)
__global__ void __launch_bounds__(NTHR, 2) mega(MArgs a_unused) {
    typedef CfgFull C; typedef WsMap<C> W;
    extern __shared__ __attribute__((aligned(16))) unsigned char lds_raw[];
    LAS unsigned char* lds = (LAS unsigned char*)lds_raw;
    volatile LAS unsigned* MISC = (volatile LAS unsigned*)(lds + LDS_BYTES - 256);
    if (threadIdx.x < 64) MISC[threadIdx.x] = 0u;
    __syncthreads();
    XcdBarrier bar; { KA(ka); bar = xcd_barrier_post((unsigned*)(__attribute__((address_space(1))) unsigned*)(unsigned long long)ka->ctl, MISC + 8); }
    const int G = gridDim.x, NTall = G * NTHR, bx = blockIdx.x;
#define TIDS() int tx_ = threadIdx.x; asm volatile("" : "+v"(tx_)); const int wave = __builtin_amdgcn_readfirstlane(tx_ >> 6), lane = tx_ & 63; \
        const int tid = (wave * G + bx) * 64 + lane;
#define NAIVE_(WHICH, st) do { KA(ka_); NP PP_; ka_copy(PP_, &ka_->WHICH); TIDS(); const long n_ = stage_items<C>(st); const int words_ = stage_scr_words<C>(st); \
        int nt_ = NTall; if (words_) { const long cap_ = (long)(W::SCR_BYTES / (4 * (size_t)words_)); if (cap_ < nt_) nt_ = (int)cap_; } \
        if (tid < nt_) for (long it_ = tid; it_ < n_; it_ += nt_) run_item<C>(PP_, st, it_, tid, nt_); } while (0)
#define NAIVE(st) NAIVE_(P, st)
#define BAR() xcd_barrier(bar)
    { KA(ka); LOADP(P, ka); ew::mod_phase(P.c, P.w_ada, P.b_ada, P.MOD, lds, bx, G); }
    { KA(ka); LOADP(P, ka); LOADQ(Q, ka); TIDS(); (void)tid; p0_weights(P, Q, lds, bx * 8 + wave, G * 8, bx * NTHR + tx_, NTall, wave, lane); }
    BAR();
    { KA(ka); LOADP(P, ka); TIDS(); (void)tid; ew::modnorm_phase(P.x, P.norm1_w, P.MOD, 0, P.H1, bx * 8 + wave, G * 8, lane); }
    { KA(ka); LOADQ(Q, ka); const int c0 = bx < 40 ? bx : -1; WSched S0{0, c0, Q.wuk, Q.wuq, Q.wbT, Q.wuv, Q.skb, Q.pwq}; EpiG<FWeights> E{FWeights{Q.WcombT, Q.WcatT, Q.WsT}};
      pg8::gemm_phase<EpiG<FWeights>, WSched, false, true>(lds, pg8::Gemm{1024, 1024, 128}, S0, E);
      const int c1 = (bx >= 40 && bx < 72) ? bx - 40 : -1; WSched S1{1, c1, Q.wuk, Q.wuq, Q.wbT, Q.wuv, Q.skb, Q.pwq};
      pg8::gemm_phase<EpiG<FWeights>, WSched, false, true>(lds, pg8::Gemm{256, 2048, 256}, S1, E); }
    BAR();
    { KA(ka); LOADP(P, ka); LOADQ(Q, ka); GridSched S; S.init(64, 15, G, bx, P.H1, (size_t)256 * 1024 * 2, Q.WinT, (size_t)256 * 1024 * 2); EpiG<FInprojA> E{FInprojA{P.QKVP, Q.RAWB}};
      pg8::gemm_phase<EpiG<FInprojA>, GridSched, true, true>(lds, pg8::Gemm{1024, 1024, 1024}, S, E); }
    BAR();
    { KA(ka); LOADP(P, ka); LOADQ(Q, ka); TIDS(); (void)tid; ew::SmallArgs SA{Q.RAWB, P.q_norm_w, P.kv_norm_w, P.idx_k_norm_w, P.dn_a_log, P.dn_dt_bias, P.QLATN, P.CKVN, P.KIDXN, P.BETA, P.G, P.WIDX}; ew::small_phase(SA, bx * 8 + wave, G * 8, lane); }
    { KA(ka); LOADP(P, ka); TIDS(); (void)tid; dnet::conv_phase(P.QKVP, P.QKVN, P.dn_conv_w, bx * 8 + wave, G * 8, lane); }
    BAR();
    { KA(ka); LOADP(P, ka); dnet::PrepArgs PA{P.QKVN, P.BETA, P.G, P.W, P.ATT, P.GL}; dnet::prep_phase(PA, lds, bx, G); }
    { KA(ka); LOADP(P, ka); LOADQ(Q, ka); GridSched S; S.init(64, 8, G, bx, P.QLATN, (size_t)256 * 256 * 2, Q.WcombT, (size_t)256 * 256 * 2); EpiG<FStoreBf16> E{FStoreBf16{Q.QA0, 2048, Q.QA1, sattn::QSPLIT / 256}};
      pg8::gemm_phase<EpiG<FStoreBf16>, GridSched, false, true>(lds, pg8::Gemm{256, 256, 256}, S, E); }
    BAR();
    { KA(ka); LOADP(P, ka); dnet::ScanArgs SA{P.QKVN, P.W, P.ATT, P.GL, P.O, P.dn_onorm_w}; dnet::scan_phase(SA, lds, bx, G); }
    { KA(ka); LOADP(P, ka); LOADQ(Q, ka); dsa::DArgs DA{idxk::IdxArgs{P.QLATN, P.KIDXN, P.WIDX, Q.WiqT, nullptr}, sattn::AArgs{P.CKVN, Q.QA0, Q.QA1}, Q.qword};
      dsa::dsa_queue(DA, lds, MISC + 16); }
    BAR();
    { KA(ka); LOADP(P, ka); LOADQ(Q, ka); GridSched S; S.init(64, 12, G, bx, P.H1, (size_t)256 * 1024 * 2, Q.WinT + (size_t)3840 * 1024, (size_t)256 * 1024 * 2); EpiG<FInprojB> E{FInprojB{P.Z, P.GA, P.GB, P.O}};
      pg8::gemm_phase<EpiG<FInprojB>, GridSched, true, true>(lds, pg8::Gemm{1024, 1024, 1024}, S, E); }
    BAR();
    { KA(ka); LOADP(P, ka); LOADQ(Q, ka); GridSched S; S.init(64, 4, G, bx, P.Z, (size_t)256 * 1024 * 2, Q.WcatT, (size_t)256 * 3072 * 2); EpiG<FMerge<0>> E{FMerge<0>{P.GA, P.M}};
      pg8::gemm_phase<EpiG<FMerge<0>>, GridSched, false, true>(lds, pg8::Gemm{1024, 3072, 1024}, S, E); }
    { KA(ka); LOADP(P, ka); LOADQ(Q, ka); GridSched S; S.init(64, 4, G, bx, Q.QA0, (size_t)256 * 2048 * 2, Q.WcatT + 1024, (size_t)256 * 3072 * 2); S.A2 = (const char*)Q.QA1; S.splitA = sattn::QSPLIT / 256; EpiG<FMerge<1>> E{FMerge<1>{P.GB, P.M}};
      pg8::gemm_phase<EpiG<FMerge<1>>, GridSched, false, true>(lds, pg8::Gemm{2048, 3072, 2048}, S, E); }
    BAR();
    { KA(ka); LOADP(P, ka); LOADQ(Q, ka); GridSched S; S.init(64, 4, G, bx, P.M, (size_t)256 * 1024 * 2, Q.WoT, (size_t)256 * 1024 * 2); EpiG<FWo> E{FWo{P.MOD, P.x, P.X1}};
      pg8::gemm_phase<EpiG<FWo>, GridSched, false, true>(lds, pg8::Gemm{1024, 1024, 1024}, S, E); }
    BAR();
    { KA(ka); LOADP(P, ka); LOADQ(Q, ka); TIDS(); (void)tid; ew::modnorm_phase(P.X1, P.norm2_w, P.MOD, 1, P.H2, bx * 8 + wave, G * 8, lane);
      peer::convert_tables(P.peer_u, P.peer_v, Q.Ub, Q.Vb, bx * NTHR + tx_, NTall); }
    BAR();
#pragma unroll 1
    for (int half = 0; half < 2; ++half) {
        { KA(ka); LOADP(P, ka); LOADQ(Q, ka); GridSched S; S.init(32, 8, G, bx, P.H2 + (size_t)half * 8192 * 1024, (size_t)256 * 1024 * 2, Q.WsT, (size_t)256 * 1024 * 2); EpiG<FStoreF32> E{FStoreF32{Q.S, 2048}};
          pg8::gemm_phase<EpiG<FStoreF32>, GridSched, true, true>(lds, pg8::Gemm{1024, 1024, 1024}, S, E); }
        BAR();
        { KA(ka); LOADP(P, ka); LOADQ(Q, ka); peer::PeerArgs EA{Q.Ub, Q.Vb, P.H2, P.X1, P.MOD, Q.S, P.final_norm_w, P.out}; peer::expert_phase(EA, half, bx, G); }
        if (half == 0) BAR();
    }
#undef NAIVE
#undef NAIVE_
#undef BAR
}
extern "C" void kernel_launch(void* const* d_in, const int* in_sizes, int n_in, void* d_out, int out_size, void* d_ws, size_t ws_size, hipStream_t stream) {
    typedef CfgFull C; typedef WsMap<C> W;
    static int grid = 0;
    if (grid == 0) {
        if (n_in != 26 || ws_size < X_END) { fprintf(stderr, "kernel_launch: need 26 inputs and %zu bytes of workspace, got %d / %zu\n", (size_t)X_END, n_in, ws_size); grid = -1; return; }
        int dev = 0, cus = 0, per_cu = 0;
        if (hipGetDevice(&dev) != hipSuccess || hipDeviceGetAttribute(&cus, hipDeviceAttributeMultiprocessorCount, dev) != hipSuccess) { grid = -1; return; }
        if (hipFuncSetAttribute((const void*)mega, hipFuncAttributeMaxDynamicSharedMemorySize, LDS_BYTES) != hipSuccess) { fprintf(stderr, "kernel_launch: hipFuncSetAttribute failed\n"); grid = -1; return; }
        if (hipOccupancyMaxActiveBlocksPerMultiprocessor(&per_cu, (const void*)mega, NTHR, LDS_BYTES) != hipSuccess || per_cu < 1) { fprintf(stderr, "kernel_launch: occupancy query says %d\n", per_cu); }
        (void)hipGetLastError();
        grid = cus;
    }
    if (grid < 0) return;
    hipMemsetAsync(d_ws, 0, CTL_ZERO_BYTES, stream);
    MArgs a{}; np_setup<C>(a.P, d_in, d_out, d_ws);
    char* ws = (char*)d_ws;
    a.Q.WinT = (bf16_t*)(ws + X_WINT); a.Q.WcatT = (bf16_t*)(ws + X_WCAT); a.Q.WoT = (bf16_t*)(ws + X_WOT); a.Q.WsT = (bf16_t*)(ws + X_WST); a.Q.WcombT = (bf16_t*)(ws + X_WCOMB); a.Q.WiqT = (bf16_t*)(ws + X_WIQT);
    a.Q.wuk = (bf16_t*)(ws + X_WUK); a.Q.wuq = (bf16_t*)(ws + X_WUQ); a.Q.wbT = (bf16_t*)(ws + X_WBT); a.Q.wuv = (bf16_t*)(ws + X_WUV); a.Q.skb = (bf16_t*)(ws + X_SKB); a.Q.pwq = (bf16_t*)(ws + X_PWQ);
    a.Q.S = (float*)(ws + W::A0 + (size_t)64 * 1048576);
    a.Q.Ub = (unsigned char*)(ws + W::A0); a.Q.Vb = (unsigned char*)(ws + W::A0 + (size_t)16 * 1048576);
    a.Q.EXPI2 = (int*)(ws + X_EXPI); a.Q.GATE2 = (float*)(ws + X_GATE);
    a.P.ATT = (bf16_t*)(ws + W::A0); a.P.W = (bf16_t*)(ws + W::A0 + (size_t)16 * 1048576);
    a.Q.QA0 = (bf16_t*)(ws + W::A0 + (size_t)48 * 1048576); a.Q.QA1 = (bf16_t*)(ws + W::A3); a.Q.qword = (unsigned*)d_ws + 6144;
    a.P.Z = (bf16_t*)(ws + W::A1); a.P.GA = (bf16_t*)(ws + W::A1 + (size_t)32 * 1048576); a.P.GB = (bf16_t*)(ws + W::A1 + (size_t)64 * 1048576);
    a.Q.RAWB = (bf16_t*)((char*)d_out + (size_t)32 * 1048576);
    a.P2 = a.P; a.P2.EXPI = a.Q.EXPI2; a.P2.GATE = a.Q.GATE2; a.P2.SCRP = (float*)((char*)d_out + W::d_SCR); a.P2.S = a.Q.S; a.ctl = (unsigned*)d_ws;
    hipLaunchKernelGGL(mega, dim3(grid), dim3(NTHR), LDS_BYTES, stream, a);
}
```

```cpp
#include <hip/hip_runtime.h>
#include <cstdio>
#include <cstdint>
#define HD __host__ __device__ __forceinline__
#ifndef HD
#define HD
#endif

typedef unsigned short bf16_t;
HD float bf2f(bf16_t v) { unsigned u = ((unsigned)v) << 16; float f; __builtin_memcpy(&f, &u, 4); return f; }
HD bf16_t f2bf(float f) { unsigned u; __builtin_memcpy(&u, &f, 4); u = (u + 0x7fffu + ((u >> 16) & 1u)) >> 16; return (bf16_t)u; }
HD float siluf(float x) { return x / (1.f + expf(-x)); }
HD float sigmf(float x) { return 1.f / (1.f + expf(-x)); }
HD float softplusf(float x) { return x > 20.f ? x : log1pf(expf(x)); }
HD float geluf(float x) { return 0.5f * x * (1.f + erff(x * 0.70710678118654752f)); }

struct CfgFull {
    static constexpr int D = 1024, B = 2, L = 8192;
    static constexpr int DNH = 8, DK = 128, DV = 128, CONV = 4, CH = 64;
    static constexpr int MH = 8, MDH = 128, MDV = 128, QL = 256, KVL = 256;
    static constexpr int IH = 8, ID = 64, TOPK_MAX = 256;
    static constexpr int PK = 128, PH = 8, PDQ = 256, PTK = 16;
};
struct CfgSmall {
    static constexpr int D = 64, B = 2, L = 512;
    static constexpr int DNH = 2, DK = 16, DV = 16, CONV = 4, CH = 64;
    static constexpr int MH = 2, MDH = 16, MDV = 16, QL = 32, KVL = 32;
    static constexpr int IH = 4, ID = 16, TOPK_MAX = 64;
    static constexpr int PK = 16, PH = 2, PDQ = 32, PTK = 4;
};
template <class C> struct Dims {
    static constexpr int T = C::B * C::L, HK = C::DNH * C::DK, HV = C::DNH * C::DV, QKVC = 2 * HK + HV;
    static constexpr int NCH = C::L / C::CH, NCHUNKS = C::B * C::DNH * NCH;
    static constexpr int TOPK = (C::TOPK_MAX < C::L / 4) ? C::TOPK_MAX : C::L / 4;
    static constexpr int PE = C::PK * C::PK, SLOTS = C::PH * C::PTK, PD2 = C::PDQ / 2;
    static constexpr int OFF_Q = 0, OFF_K = HK, OFF_V = 2 * HK, OFF_Z = 2 * HK + HV, OFF_B = OFF_Z + HV, OFF_A = OFF_B + C::DNH,
                         OFF_QL = OFF_A + C::DNH, OFF_CKV = OFF_QL + C::QL, OFF_KI = OFF_CKV + C::KVL, OFF_WI = OFF_KI + C::ID,
                         OFF_GA = OFF_WI + C::IH, OFF_GB = OFF_GA + C::D, IN_COLS = OFF_GB + C::D;
    static constexpr float EPS = 1e-6f;
};

struct NP {
    const float *x, *c, *w_ada, *b_ada, *norm1_w, *w_in, *dn_conv_w, *dn_a_log, *dn_dt_bias, *dn_onorm_w, *q_norm_w, *kv_norm_w, *idx_k_norm_w,
        *w_uq, *w_iq, *w_uk, *w_uv, *w_a_out, *w_b_out, *w_o, *norm2_w, *peer_w_q, *peer_sub_keys, *peer_u, *peer_v, *final_norm_w;
    float* out;
    float* MOD; bf16_t* H1; bf16_t* QKVP; bf16_t* QKVN; bf16_t* Z; bf16_t* GA; bf16_t* GB;
    float *BETA, *G, *GC, *GL, *QLATR, *CKVR, *KIDXR, *WIDX; bf16_t *QLATN, *CKVN, *KIDXN;
    float* AMAT; bf16_t* ATT; bf16_t* W; bf16_t* O; bf16_t* OG;
    float *QF, *QIDX; bf16_t* QABS; int* IDX; bf16_t* OLAT; bf16_t* OATT; bf16_t* M; float* X1; bf16_t* H2;
    float* PQ; int* EXPI; float* GATE; float* ACT; float* S; float* RAW;
    float* SCRP;
};
#define SCR(w) P.SCRP[(size_t)(w) * NT + tid]

template <class C> struct WsMap {
    typedef Dims<C> Dm;
    static constexpr size_t al(size_t x) { return (x + 255) & ~(size_t)255; }
    static constexpr size_t mx(size_t a, size_t b) { return a > b ? a : b; }
    static constexpr size_t SZ_QKV = al((size_t)Dm::T * Dm::QKVC * 2);
    static constexpr size_t S1a = al(mx((size_t)Dm::T * C::MH * C::KVL * 2, (size_t)Dm::T * C::D * 4));
    static constexpr size_t S1b = al(mx(mx((size_t)Dm::T * Dm::TOPK * 4, (size_t)Dm::T * C::MH * C::MDV * 2), (size_t)Dm::T * C::D * 2));
    static constexpr size_t RAW = al((size_t)Dm::T * C::QL * 4) + al((size_t)Dm::T * C::KVL * 4) + al((size_t)Dm::T * C::ID * 4);
    static constexpr size_t SZ_A1 = mx(mx(SZ_QKV, RAW), S1a + S1b);
    static constexpr size_t SZ_AAW = al((size_t)Dm::NCHUNKS * C::CH * C::CH * 4) + al((size_t)Dm::NCHUNKS * C::CH * C::CH * 2) + al((size_t)Dm::NCHUNKS * C::CH * C::DK * 2);
    static constexpr size_t SZ_QQ = al((size_t)Dm::T * C::MH * C::MDH * 4) + al((size_t)Dm::T * C::IH * C::ID * 4);
    static constexpr size_t SZ_ZGG = al((size_t)Dm::T * Dm::HV * 2) + 2 * al((size_t)Dm::T * C::D * 2);
    static constexpr size_t SZ_A0 = mx(mx(SZ_QKV, SZ_AAW), mx(SZ_QQ, SZ_ZGG));
    static constexpr size_t A1 = 1 << 20, A0 = A1 + SZ_A1, A2 = A0 + SZ_A0;
    static constexpr size_t o_MOD = 65536, o_BETA = A2, o_G = o_BETA + al((size_t)Dm::T * C::DNH * 4), o_GC = o_G + al((size_t)Dm::T * C::DNH * 4),
        o_GL = o_GC + al((size_t)Dm::T * C::DNH * 4), o_WIDX = o_GL + al((size_t)Dm::NCHUNKS * 4), o_QLATN = o_WIDX + al((size_t)Dm::T * C::IH * 4),
        o_CKVN = o_QLATN + al((size_t)Dm::T * C::QL * 2), o_KIDXN = o_CKVN + al((size_t)Dm::T * C::KVL * 2), A3 = o_KIDXN + al((size_t)Dm::T * C::ID * 2);
    static constexpr size_t SCR_BYTES = 16u << 20;
    static constexpr size_t o_PQ = A0;
    static constexpr size_t END = mx(A3 + SCR_BYTES, o_PQ + al((size_t)Dm::T * C::PH * C::PDQ * 4));
    static_assert(o_MOD + (size_t)C::B * 6 * C::D * 4 <= A1, "MOD in the first MiB");
    static constexpr size_t o_QLATR = A1, o_CKVR = o_QLATR + al((size_t)Dm::T * C::QL * 4), o_KIDXR = o_CKVR + al((size_t)Dm::T * C::KVL * 4);
    static constexpr size_t o_AMAT = A0, o_ATT = o_AMAT + al((size_t)Dm::NCHUNKS * C::CH * C::CH * 4), o_W = o_ATT + al((size_t)Dm::NCHUNKS * C::CH * C::CH * 2);
    static constexpr size_t o_QF = A0, o_QIDX = o_QF + al((size_t)Dm::T * C::MH * C::MDH * 4);
    static constexpr size_t o_QABS = A1, o_IDX = A1 + S1a;
    static constexpr size_t o_Z = A0, o_GA = o_Z + al((size_t)Dm::T * Dm::HV * 2), o_GB = o_GA + al((size_t)Dm::T * C::D * 2);
    static constexpr size_t o_OATT = o_IDX, o_X1 = A1, o_H2 = o_IDX;
    static constexpr size_t d_H1 = 0, d_O = al((size_t)Dm::T * C::D * 2), d_OG = 0, d_M = d_O;
    static constexpr size_t d_EXPI = 0, d_GATE = al((size_t)Dm::T * Dm::SLOTS * 4), d_ACT = 2 * d_GATE, d_SCR = (size_t)Dm::T * C::D * 2;
    static_assert(d_O + (size_t)Dm::T * Dm::HV * 2 <= (size_t)Dm::T * C::D * 4 && d_ACT + (size_t)Dm::T * Dm::SLOTS * 4 <= d_SCR, "d_out scratch");
};

template <class C> inline void np_setup(NP& P, void* const* d_in, void* d_out, void* d_ws) {
    typedef WsMap<C> W;
    const float** f = (const float**)&P.x;
    for (int i = 0; i < 26; ++i) f[i] = (const float*)d_in[i];
    char* ws = (char*)d_ws; char* dob = (char*)d_out;
    P.out = (float*)d_out;
    P.MOD = (float*)(ws + W::o_MOD); P.H1 = (bf16_t*)(dob + W::d_H1); P.QKVP = (bf16_t*)(ws + W::A0); P.QKVN = (bf16_t*)(ws + W::A1);
    P.Z = (bf16_t*)(ws + W::o_Z); P.GA = (bf16_t*)(ws + W::o_GA); P.GB = (bf16_t*)(ws + W::o_GB);
    P.BETA = (float*)(ws + W::o_BETA); P.G = (float*)(ws + W::o_G); P.GC = (float*)(ws + W::o_GC); P.GL = (float*)(ws + W::o_GL);
    P.QLATR = (float*)(ws + W::o_QLATR); P.CKVR = (float*)(ws + W::o_CKVR); P.KIDXR = (float*)(ws + W::o_KIDXR); P.WIDX = (float*)(ws + W::o_WIDX);
    P.QLATN = (bf16_t*)(ws + W::o_QLATN); P.CKVN = (bf16_t*)(ws + W::o_CKVN); P.KIDXN = (bf16_t*)(ws + W::o_KIDXN);
    P.AMAT = (float*)(ws + W::o_AMAT); P.ATT = (bf16_t*)(ws + W::o_ATT); P.W = (bf16_t*)(ws + W::o_W); P.O = (bf16_t*)(dob + W::d_O); P.OG = (bf16_t*)(dob + W::d_OG);
    P.QF = (float*)(ws + W::o_QF); P.QIDX = (float*)(ws + W::o_QIDX); P.QABS = (bf16_t*)(ws + W::o_QABS); P.IDX = (int*)(ws + W::o_IDX); P.OLAT = P.QABS;
    P.OATT = (bf16_t*)(ws + W::o_OATT); P.M = (bf16_t*)(dob + W::d_M); P.X1 = (float*)(ws + W::o_X1); P.H2 = (bf16_t*)(ws + W::o_H2);
    P.PQ = (float*)(ws + W::o_PQ); P.EXPI = (int*)(dob + W::d_EXPI); P.GATE = (float*)(dob + W::d_GATE); P.ACT = (float*)(dob + W::d_ACT);
    P.SCRP = (float*)(ws + W::A3); P.S = nullptr; P.RAW = (float*)(ws + W::A1);
}

enum { ST_MOD = 0, ST_H1, ST_INPROJ_A, ST_DSANORM, ST_CONV, ST_GC, ST_AMAT, ST_SOLVE, ST_SCALE, ST_SCAN, ST_Q, ST_QABS, ST_INDEX, ST_ATTN,
       ST_INPROJ_B, ST_QIDX, ST_SMALL, ST_OGATE, ST_OATT, ST_MERGE, ST_WO, ST_H2, ST_PEERQ, ST_ROUTE, ST_PACT, ST_POUT, ST_FINAL, ST_COUNT };

template <class C> HD void n_mod(const NP& P, int item) {
    const int D = C::D; const int b = item / (6 * D), j = item % (6 * D);
    float acc = P.b_ada[j];
    for (int i = 0; i < D; ++i) acc += siluf(P.c[b * D + i]) * P.w_ada[(size_t)i * 6 * D + j];
    P.MOD[item] = acc;
}
template <class C> HD void n_h1(const NP& P, int t) {
    const int D = C::D; const int b = t / C::L; const float* xr = P.x + (size_t)t * D;
    float ss = 0.f; for (int i = 0; i < D; ++i) ss += xr[i] * xr[i];
    const float rstd = 1.f / sqrtf(ss / D + Dims<C>::EPS);
    const float* sh = P.MOD + (size_t)b * 6 * D; const float* sc = sh + D;
    for (int i = 0; i < D; ++i) P.H1[(size_t)t * D + i] = f2bf(xr[i] * rstd * P.norm1_w[i] * (1.f + sc[i]) + sh[i]);
}
template <class C> HD void inproj_store(const NP& P, int t, int n, float v) {
    typedef Dims<C> Dm;
    if (n < Dm::OFF_Z) P.QKVP[(size_t)t * Dm::QKVC + n] = f2bf(v);
    else if (n < Dm::OFF_B) P.Z[(size_t)t * Dm::HV + (n - Dm::OFF_Z)] = f2bf(v);
    else if (n < Dm::OFF_A) P.BETA[(size_t)t * C::DNH + (n - Dm::OFF_B)] = sigmf(v);
    else if (n < Dm::OFF_QL) { const int h = n - Dm::OFF_A; P.G[(size_t)t * C::DNH + h] = -expf(P.dn_a_log[h]) * softplusf(v + P.dn_dt_bias[h]); }
    else if (n < Dm::OFF_CKV) P.QLATR[(size_t)t * C::QL + (n - Dm::OFF_QL)] = v;
    else if (n < Dm::OFF_KI) P.CKVR[(size_t)t * C::KVL + (n - Dm::OFF_CKV)] = v;
    else if (n < Dm::OFF_WI) P.KIDXR[(size_t)t * C::ID + (n - Dm::OFF_KI)] = v;
    else if (n < Dm::OFF_GA) P.WIDX[(size_t)t * C::IH + (n - Dm::OFF_WI)] = v * (1.f / sqrtf((float)C::IH) / sqrtf((float)C::ID));
    else if (n < Dm::OFF_GB) P.GA[(size_t)t * C::D + (n - Dm::OFF_GA)] = f2bf(v);
    else P.GB[(size_t)t * C::D + (n - Dm::OFF_GB)] = f2bf(v);
}
template <class C> HD void n_inproj(const NP& P, int item, int c0, int c1) {
    typedef Dims<C> Dm; const int ng = (c1 - c0) / 4; const int t = item / ng, n = c0 + 4 * (item % ng);
    float a0 = 0, a1 = 0, a2 = 0, a3 = 0; const bf16_t* hr = P.H1 + (size_t)t * C::D;
    for (int k = 0; k < C::D; ++k) { const float h = bf2f(hr[k]); const float* w = P.w_in + (size_t)k * Dm::IN_COLS + n; a0 += h * w[0]; a1 += h * w[1]; a2 += h * w[2]; a3 += h * w[3]; }
    inproj_store<C>(P, t, n, a0); inproj_store<C>(P, t, n + 1, a1); inproj_store<C>(P, t, n + 2, a2); inproj_store<C>(P, t, n + 3, a3);
}
template <class C> HD void n_dsanorm(const NP& P, int t) {
    typedef Dims<C> Dm;
    { const float* r = P.QLATR + (size_t)t * C::QL; float ss = 0; for (int i = 0; i < C::QL; ++i) ss += r[i] * r[i]; const float rs = 1.f / sqrtf(ss / C::QL + Dm::EPS);
      for (int i = 0; i < C::QL; ++i) P.QLATN[(size_t)t * C::QL + i] = f2bf(r[i] * rs * P.q_norm_w[i]); }
    { const float* r = P.CKVR + (size_t)t * C::KVL; float ss = 0; for (int i = 0; i < C::KVL; ++i) ss += r[i] * r[i]; const float rs = 1.f / sqrtf(ss / C::KVL + Dm::EPS);
      for (int i = 0; i < C::KVL; ++i) P.CKVN[(size_t)t * C::KVL + i] = f2bf(r[i] * rs * P.kv_norm_w[i]); }
    { const float* r = P.KIDXR + (size_t)t * C::ID; float ss = 0; for (int i = 0; i < C::ID; ++i) ss += r[i] * r[i]; const float rs = 1.f / sqrtf(ss / C::ID + Dm::EPS);
      for (int i = 0; i < C::ID; ++i) P.KIDXN[(size_t)t * C::ID + i] = f2bf(r[i] * rs * P.idx_k_norm_w[i]); }
}

template <class C> HD void n_small(const NP& P, int t) {
    typedef Dims<C> Dm; const float* r = P.RAW + (size_t)t * 768;
    { float ss = 0; for (int i = 0; i < C::QL; ++i) ss += r[i] * r[i]; const float rs = 1.f / sqrtf(ss / C::QL + Dm::EPS);
      for (int i = 0; i < C::QL; ++i) P.QLATN[(size_t)t * C::QL + i] = f2bf(r[i] * rs * P.q_norm_w[i]); }
    { const float* q = r + 256; float ss = 0; for (int i = 0; i < C::KVL; ++i) ss += q[i] * q[i]; const float rs = 1.f / sqrtf(ss / C::KVL + Dm::EPS);
      for (int i = 0; i < C::KVL; ++i) P.CKVN[(size_t)t * C::KVL + i] = f2bf(q[i] * rs * P.kv_norm_w[i]); }
    { const float* q = r + 512; float ss = 0; for (int i = 0; i < C::ID; ++i) ss += q[i] * q[i]; const float rs = 1.f / sqrtf(ss / C::ID + Dm::EPS);
      for (int i = 0; i < C::ID; ++i) P.KIDXN[(size_t)t * C::ID + i] = f2bf(q[i] * rs * P.idx_k_norm_w[i]); }
    for (int h = 0; h < C::DNH; ++h) { P.BETA[(size_t)t * C::DNH + h] = sigmf(r[576 + h]); P.G[(size_t)t * C::DNH + h] = -expf(P.dn_a_log[h]) * softplusf(r[584 + h] + P.dn_dt_bias[h]); }
    for (int h = 0; h < C::IH; ++h) P.WIDX[(size_t)t * C::IH + h] = r[592 + h] * (1.f / sqrtf((float)C::IH) / sqrtf((float)C::ID));
}
template <class C> HD float conv_at(const NP& P, int t, int ch) {
    typedef Dims<C> Dm; const int l = t % C::L; float acc = 0.f;
    for (int i = 0; i < C::CONV; ++i) { const int ll = l - (C::CONV - 1) + i; if (ll >= 0) acc += bf2f(P.QKVP[(size_t)(t - (C::CONV - 1) + i) * Dm::QKVC + ch]) * P.dn_conv_w[(size_t)i * Dm::QKVC + ch]; }
    return siluf(acc);
}
template <class C> HD void n_conv(const NP& P, int item) {
    typedef Dims<C> Dm; const int which = item % 3, h = (item / 3) % C::DNH, t = item / (3 * C::DNH);
    const int dim = (which == 2) ? C::DV : C::DK; const int ch0 = (which == 0 ? 0 : which == 1 ? Dm::HK : 2 * Dm::HK) + h * dim;
    float rs = 1.f;
    if (which < 2) { float ss = 0.f; for (int d = 0; d < dim; ++d) { const float v = conv_at<C>(P, t, ch0 + d); ss += v * v; } rs = 1.f / sqrtf(ss + Dm::EPS); }
    for (int d = 0; d < dim; ++d) P.QKVN[(size_t)t * Dm::QKVC + ch0 + d] = f2bf(conv_at<C>(P, t, ch0 + d) * rs);
}
template <class C> HD void n_gc(const NP& P, int item) {
    typedef Dims<C> Dm; const int n = item % Dm::NCH, h = (item / Dm::NCH) % C::DNH, b = item / (Dm::NCH * C::DNH);
    float s = 0.f; for (int i = 0; i < C::CH; ++i) { const size_t t = (size_t)b * C::L + n * C::CH + i; s += P.G[t * C::DNH + h]; P.GC[t * C::DNH + h] = s; }
    P.GL[item] = expf(s);
}
template <class C> HD void n_amat(const NP& P, int item) {
    typedef Dims<C> Dm; const int j = item % C::CH, i = (item / C::CH) % C::CH, cid = item / (C::CH * C::CH);
    const int n = cid % Dm::NCH, h = (cid / Dm::NCH) % C::DNH, b = cid / (Dm::NCH * C::DNH);
    const size_t ti = (size_t)b * C::L + n * C::CH + i, tj = (size_t)b * C::L + n * C::CH + j;
    float a = 0.f, at = 0.f;
    if (j <= i) {
        const bf16_t* ki = P.QKVN + ti * Dm::QKVC + Dm::HK + h * C::DK; const bf16_t* kj = P.QKVN + tj * Dm::QKVC + Dm::HK + h * C::DK; const bf16_t* qi = P.QKVN + ti * Dm::QKVC + h * C::DK;
        float kk = 0.f, qk = 0.f; for (int d = 0; d < C::DK; ++d) { const float kjd = bf2f(kj[d]); kk += bf2f(ki[d]) * kjd; qk += bf2f(qi[d]) * kjd; }
        const float dec = expf(P.GC[ti * C::DNH + h] - P.GC[tj * C::DNH + h]);
        if (j < i) a = P.BETA[ti * C::DNH + h] * kk * dec;
        at = qk * (1.f / sqrtf((float)C::DK)) * dec;
    }
    P.AMAT[(size_t)cid * C::CH * C::CH + i * C::CH + j] = a;
    P.ATT[(size_t)cid * C::CH * C::CH + i * C::CH + j] = f2bf(at);
}
template <class C> HD void n_solve(const NP& P, int item, int tid, int NT) {
    typedef Dims<C> Dm; const int NC = C::DV + C::DK; const int col = item % NC, cid = item / NC;
    const int n = cid % Dm::NCH, h = (cid / Dm::NCH) % C::DNH, b = cid / (Dm::NCH * C::DNH);
    const float* A = P.AMAT + (size_t)cid * C::CH * C::CH;
    for (int i = 0; i < C::CH; ++i) {
        const size_t t = (size_t)b * C::L + n * C::CH + i; const float beta = P.BETA[t * C::DNH + h];
        float r;
        if (col < C::DV) r = bf2f(P.QKVN[t * Dm::QKVC + 2 * Dm::HK + h * C::DV + col]) * beta;
        else r = bf2f(P.QKVN[t * Dm::QKVC + Dm::HK + h * C::DK + (col - C::DV)]) * beta * expf(P.GC[t * C::DNH + h]);
        for (int j = 0; j < i; ++j) r -= A[i * C::CH + j] * SCR(j);
        SCR(i) = r;
    }
    for (int i = 0; i < C::CH; ++i) {
        const size_t t = (size_t)b * C::L + n * C::CH + i;
        if (col < C::DV) P.QKVN[t * Dm::QKVC + 2 * Dm::HK + h * C::DV + col] = f2bf(SCR(i));
        else P.W[((size_t)cid * C::CH + i) * C::DK + (col - C::DV)] = f2bf(SCR(i));
    }
}
template <class C> HD void n_scale(const NP& P, int item) {
    typedef Dims<C> Dm; const int h = item % C::DNH; const size_t t = item / C::DNH; const int l = (int)(t % C::L), b = (int)(t / C::L), n = l / C::CH;
    const float gc = P.GC[t * C::DNH + h]; const size_t tl = (size_t)b * C::L + n * C::CH + C::CH - 1; const float gl = P.GC[tl * C::DNH + h];
    const float fq = expf(gc) * (1.f / sqrtf((float)C::DK)), fk = expf(gl - gc);
    bf16_t* q = P.QKVN + t * Dm::QKVC + h * C::DK; bf16_t* k = P.QKVN + t * Dm::QKVC + Dm::HK + h * C::DK;
    for (int d = 0; d < C::DK; ++d) { q[d] = f2bf(bf2f(q[d]) * fq); k[d] = f2bf(bf2f(k[d]) * fk); }
}
template <class C> HD void n_scan(const NP& P, int item, int tid, int NT) {
    typedef Dims<C> Dm; const int e = item % C::DV, h = (item / C::DV) % C::DNH, b = item / (C::DV * C::DNH);
    for (int d = 0; d < C::DK; ++d) SCR(d) = 0.f;
    for (int n = 0; n < Dm::NCH; ++n) {
        const int cid = (b * C::DNH + h) * Dm::NCH + n; const size_t t0 = (size_t)b * C::L + n * C::CH;
        const bf16_t* Wc = P.W + (size_t)cid * C::CH * C::DK; const bf16_t* At = P.ATT + (size_t)cid * C::CH * C::CH;
        for (int r = 0; r < C::CH; ++r) { float acc = bf2f(P.QKVN[(t0 + r) * Dm::QKVC + 2 * Dm::HK + h * C::DV + e]);
            for (int d = 0; d < C::DK; ++d) acc -= bf2f(Wc[r * C::DK + d]) * SCR(d);
            SCR(C::DK + r) = acc; }
        for (int r = 0; r < C::CH; ++r) { float o = 0.f; const bf16_t* qd = P.QKVN + (t0 + r) * Dm::QKVC + h * C::DK;
            for (int d = 0; d < C::DK; ++d) o += bf2f(qd[d]) * SCR(d);
            for (int s = 0; s <= r; ++s) o += bf2f(At[r * C::CH + s]) * SCR(C::DK + s);
            P.O[(t0 + r) * Dm::HV + h * C::DV + e] = f2bf(o); }
        const float gl = P.GL[cid];
        for (int d = 0; d < C::DK; ++d) { float acc = SCR(d) * gl;
            for (int r = 0; r < C::CH; ++r) acc += bf2f(P.QKVN[(t0 + r) * Dm::QKVC + Dm::HK + h * C::DK + d]) * SCR(C::DK + r);
            SCR(d) = acc; }
    }
}
template <class C> HD void n_ogate(const NP& P, int item) {
    typedef Dims<C> Dm; const int h = item % C::DNH; const size_t t = item / C::DNH; const bf16_t* o = P.O + t * Dm::HV + h * C::DV;
    float ss = 0.f; for (int d = 0; d < C::DV; ++d) { const float v = bf2f(o[d]); ss += v * v; } const float rs = 1.f / sqrtf(ss / C::DV + Dm::EPS);
    for (int d = 0; d < C::DV; ++d) P.OG[t * Dm::HV + h * C::DV + d] = f2bf(bf2f(o[d]) * rs * P.dn_onorm_w[d] * siluf(bf2f(P.Z[t * Dm::HV + h * C::DV + d])));
}
template <class C> HD void n_q(const NP& P, int item) {
    const int NJ = C::MH * C::MDH + C::IH * C::ID; const int j = item % NJ; const size_t t = item / NJ; const bf16_t* ql = P.QLATN + t * C::QL;
    float acc = 0.f;
    if (j < C::MH * C::MDH) { for (int k = 0; k < C::QL; ++k) acc += bf2f(ql[k]) * P.w_uq[(size_t)k * C::MH * C::MDH + j]; P.QF[t * C::MH * C::MDH + j] = acc; }
    else { const int jj = j - C::MH * C::MDH; for (int k = 0; k < C::QL; ++k) acc += bf2f(ql[k]) * P.w_iq[(size_t)k * C::IH * C::ID + jj]; P.QIDX[t * C::IH * C::ID + jj] = acc; }
}
template <class C> HD void n_qabs(const NP& P, int item) {
    const int c = item % C::KVL, h = (item / C::KVL) % C::MH; const size_t t = item / (C::KVL * C::MH);
    float acc = 0.f; for (int d = 0; d < C::MDH; ++d) acc += P.QF[t * C::MH * C::MDH + h * C::MDH + d] * P.w_uk[((size_t)c * C::MH + h) * C::MDH + d];
    P.QABS[(t * C::MH + h) * C::KVL + c] = f2bf(acc * (1.f / sqrtf((float)C::MDH)));
}
template <class C> HD void n_index(const NP& P, int t, int tid, int NT) {
    typedef Dims<C> Dm; const int K = Dm::TOPK; const int l = t % C::L, b = t / C::L; int cnt = 0;
    const float* qi = P.QIDX + (size_t)t * C::IH * C::ID; const float* wi = P.WIDX + (size_t)t * C::IH;
#define HV_(i) SCR(i)
#define HI_(i) SCR(K + (i))
#define WORSE(v1, i1, v2, i2) ((v1) < (v2) || ((v1) == (v2) && (i1) > (i2)))
    for (int s = 0; s <= l; ++s) {
        const bf16_t* kr = P.KIDXN + ((size_t)b * C::L + s) * C::ID; float sc = 0.f;
        for (int h = 0; h < C::IH; ++h) { float dot = 0.f; for (int d = 0; d < C::ID; ++d) dot += qi[h * C::ID + d] * bf2f(kr[d]); sc += wi[h] * (dot > 0.f ? dot : 0.f); }
        const float fs = (float)s;
        if (cnt < K) {
            int i = cnt++; HV_(i) = sc; HI_(i) = fs;
            while (i > 0) { const int p = (i - 1) >> 1; const float pv = HV_(p), pi = HI_(p), cv = HV_(i), ci = HI_(i);
                if (WORSE(cv, ci, pv, pi)) { HV_(p) = cv; HI_(p) = ci; HV_(i) = pv; HI_(i) = pi; i = p; } else break; }
        } else if (HV_(0) < sc) {
            int i = 0; HV_(0) = sc; HI_(0) = fs;
            for (;;) { const int a = 2 * i + 1, c2 = a + 1; int w = i; float wv = HV_(i), wx = HI_(i);
                if (a < K) { const float av = HV_(a), ai = HI_(a); if (WORSE(av, ai, wv, wx)) { w = a; wv = av; wx = ai; } }
                if (c2 < K) { const float bv = HV_(c2), bi = HI_(c2); if (WORSE(bv, bi, wv, wx)) { w = c2; wv = bv; wx = bi; } }
                if (w == i) break; const float tv = HV_(i), ti = HI_(i); HV_(i) = wv; HI_(i) = wx; HV_(w) = tv; HI_(w) = ti; i = w; }
        }
    }
    for (int k = 0; k < K; ++k) P.IDX[(size_t)t * K + k] = (k < cnt) ? (int)HI_(k) : -1;
#undef HV_
#undef HI_
#undef WORSE
}
template <class C> HD void n_attn(const NP& P, int item, int tid, int NT) {
    typedef Dims<C> Dm; const int K = Dm::TOPK; const int h = item % C::MH; const size_t t = item / C::MH; const int b = (int)(t / C::L);
    const int* idx = P.IDX + t * K; bf16_t* qa = P.QABS + (t * C::MH + h) * C::KVL;
    int nv = 0; float m = -3.0e38f;
    for (int k = 0; k < K; ++k) { const int s = idx[k]; if (s < 0) break; ++nv;
        const bf16_t* kv = P.CKVN + ((size_t)b * C::L + s) * C::KVL; float lg = 0.f; for (int c = 0; c < C::KVL; ++c) lg += bf2f(qa[c]) * bf2f(kv[c]);
        SCR(k) = lg; m = lg > m ? lg : m; }
    float sum = 0.f; for (int k = 0; k < nv; ++k) { const float p = expf(SCR(k) - m); SCR(k) = p; sum += p; }
    const float inv = 1.f / sum;
    for (int c = 0; c < C::KVL; ++c) { float acc = 0.f; for (int k = 0; k < nv; ++k) acc += SCR(k) * bf2f(P.CKVN[((size_t)b * C::L + idx[k]) * C::KVL + c]);
        SCR(K + c) = acc * inv; }
    for (int c = 0; c < C::KVL; ++c) qa[c] = f2bf(SCR(K + c));
}
template <class C> HD void n_oatt(const NP& P, int item) {
    const int d = item % C::MDV, h = (item / C::MDV) % C::MH; const size_t t = item / (C::MDV * C::MH);
    float acc = 0.f; for (int c = 0; c < C::KVL; ++c) acc += bf2f(P.OLAT[(t * C::MH + h) * C::KVL + c]) * P.w_uv[((size_t)c * C::MH + h) * C::MDV + d];
    P.OATT[t * C::MH * C::MDV + h * C::MDV + d] = f2bf(acc);
}
template <class C> HD void n_merge(const NP& P, int item) {
    typedef Dims<C> Dm; const int n = item % C::D; const size_t t = item / C::D;
    float ya = 0.f, yb = 0.f;
    for (int k = 0; k < Dm::HV; ++k) ya += bf2f(P.OG[t * Dm::HV + k]) * P.w_a_out[(size_t)k * C::D + n];
    for (int k = 0; k < C::MH * C::MDV; ++k) yb += bf2f(P.OATT[t * C::MH * C::MDV + k]) * P.w_b_out[(size_t)k * C::D + n];
    P.M[t * C::D + n] = f2bf(sigmf(bf2f(P.GA[t * C::D + n])) * ya + sigmf(bf2f(P.GB[t * C::D + n])) * yb);
}
template <class C> HD void n_wo(const NP& P, int item) {
    const int n = item % C::D; const size_t t = item / C::D; const int b = (int)(t / C::L);
    float acc = 0.f; for (int k = 0; k < C::D; ++k) acc += bf2f(P.M[t * C::D + k]) * P.w_o[(size_t)k * C::D + n];
    P.X1[t * C::D + n] = P.x[t * C::D + n] + P.MOD[(size_t)b * 6 * C::D + 2 * C::D + n] * acc;
}
template <class C> HD void n_h2(const NP& P, int t) {
    const int D = C::D; const int b = t / C::L; const float* xr = P.X1 + (size_t)t * D;
    float ss = 0.f; for (int i = 0; i < D; ++i) ss += xr[i] * xr[i];
    const float rstd = 1.f / sqrtf(ss / D + Dims<C>::EPS);
    const float* sh = P.MOD + (size_t)b * 6 * D + 3 * D; const float* sc = sh + D;
    for (int i = 0; i < D; ++i) P.H2[(size_t)t * D + i] = f2bf(xr[i] * rstd * P.norm2_w[i] * (1.f + sc[i]) + sh[i]);
}
template <class C> HD void n_peerq(const NP& P, int item) {
    const int NJ = C::PH * C::PDQ; const int j = item % NJ; const size_t t = item / NJ;
    float acc = 0.f; for (int k = 0; k < C::D; ++k) acc += bf2f(P.H2[t * C::D + k]) * P.peer_w_q[(size_t)k * NJ + j];
    P.PQ[t * NJ + j] = acc;
}
template <class C> HD void n_route(const NP& P, int item, int tid, int NT) {
    typedef Dims<C> Dm; const int PK = C::PK, TK = C::PTK; const int h = item % C::PH; const size_t t = item / C::PH;
    const int oS = 0, oSV = 2 * PK, oSI = oSV + 2 * TK, oC = oSI + 2 * TK;
    for (int p = 0; p < 2; ++p) for (int n = 0; n < PK; ++n) {
        float acc = 0.f;
        if (P.S) acc = P.S[t * (size_t)(C::PH * 2 * PK) + (h * 2 + p) * PK + n];
        else { const float* q = P.PQ + t * C::PH * C::PDQ + (h * 2 + p) * Dm::PD2; const float* key = P.peer_sub_keys + (((size_t)h * 2 + p) * PK + n) * Dm::PD2;
            for (int d = 0; d < Dm::PD2; ++d) acc += q[d] * key[d]; }
        SCR(oS + p * PK + n) = acc; }
    for (int p = 0; p < 2; ++p) for (int k = 0; k < TK; ++k) { int bi = 0; float bv = -3.0e38f;
        for (int n = 0; n < PK; ++n) { const float v = SCR(oS + p * PK + n); if (v > bv) { bv = v; bi = n; } }
        SCR(oSV + p * TK + k) = bv; SCR(oSI + p * TK + k) = (float)bi; SCR(oS + p * PK + bi) = -3.0e38f; }
    for (int i = 0; i < TK; ++i) for (int j = 0; j < TK; ++j) SCR(oC + i * TK + j) = SCR(oSV + i) + SCR(oSV + TK + j);
    float tv[C::PTK]; int te[C::PTK]; float mx = -3.0e38f;
#pragma unroll
    for (int k = 0; k < TK; ++k) { int bi = 0; float bv = -3.0e38f;
        for (int n = 0; n < TK * TK; ++n) { const float v = SCR(oC + n); if (v > bv) { bv = v; bi = n; } }
        SCR(oC + bi) = -3.0e38f; tv[k] = bv; te[k] = (int)SCR(oSI + bi / TK) * PK + (int)SCR(oSI + TK + bi % TK); mx = bv > mx ? bv : mx; }
    float sum = 0.f;
#pragma unroll
    for (int k = 0; k < TK; ++k) { tv[k] = expf(tv[k] - mx); sum += tv[k]; }
#pragma unroll
    for (int k = 0; k < TK; ++k) { P.EXPI[t * Dm::SLOTS + h * TK + k] = te[k]; P.GATE[t * Dm::SLOTS + h * TK + k] = tv[k] / sum; }
}
template <class C> HD void n_pact(const NP& P, int item) {
    typedef Dims<C> Dm; const int sl = item % Dm::SLOTS; const size_t t = item / Dm::SLOTS; const int e = P.EXPI[t * Dm::SLOTS + sl];
    const float* u = P.peer_u + (size_t)e * C::D; float acc = 0.f; for (int d = 0; d < C::D; ++d) acc += u[d] * bf2f(P.H2[t * C::D + d]);
    P.ACT[t * Dm::SLOTS + sl] = geluf(acc) * P.GATE[t * Dm::SLOTS + sl];
}
template <class C> HD void n_pout(const NP& P, int item) {
    typedef Dims<C> Dm; const int d = item % C::D; const size_t t = item / C::D; const int b = (int)(t / C::L);
    float acc = 0.f; for (int s = 0; s < Dm::SLOTS; ++s) acc += P.ACT[t * Dm::SLOTS + s] * P.peer_v[(size_t)P.EXPI[t * Dm::SLOTS + s] * C::D + d];
    P.X1[t * C::D + d] += P.MOD[(size_t)b * 6 * C::D + 5 * C::D + d] * acc;
}
template <class C> HD void n_final(const NP& P, int t) {
    const int D = C::D; const float* xr = P.X1 + (size_t)t * D; float ss = 0.f; for (int i = 0; i < D; ++i) ss += xr[i] * xr[i];
    const float rstd = 1.f / sqrtf(ss / D + Dims<C>::EPS);
    for (int i = 0; i < D; ++i) P.out[(size_t)t * D + i] = xr[i] * rstd * P.final_norm_w[i];
}

template <class C> HD long stage_items(int st) {
    typedef Dims<C> Dm; const long T = Dm::T;
    switch (st) {
        case ST_MOD: return (long)C::B * 6 * C::D; case ST_H1: return T;
        case ST_INPROJ_A: return T * ((Dm::OFF_GA - 0) / 4) - T * (Dm::HV / 4);
        case ST_DSANORM: return T; case ST_CONV: return T * C::DNH * 3; case ST_GC: return Dm::NCHUNKS; case ST_AMAT: return (long)Dm::NCHUNKS * C::CH * C::CH;
        case ST_SOLVE: return (long)Dm::NCHUNKS * (C::DV + C::DK); case ST_SCALE: return T * C::DNH; case ST_SCAN: return (long)C::B * C::DNH * C::DV;
        case ST_Q: return T * (C::MH * C::MDH + C::IH * C::ID); case ST_QIDX: return T * (C::IH * C::ID); case ST_SMALL: return T; case ST_QABS: return T * C::MH * C::KVL; case ST_INDEX: return T; case ST_ATTN: return T * C::MH;
        case ST_INPROJ_B: return T * ((Dm::HV + 2 * C::D) / 4); case ST_OGATE: return T * C::DNH; case ST_OATT: return T * C::MH * C::MDV; case ST_MERGE: return T * C::D;
        case ST_WO: return T * C::D; case ST_H2: return T; case ST_PEERQ: return T * C::PH * C::PDQ; case ST_ROUTE: return T * C::PH; case ST_PACT: return T * Dm::SLOTS;
        case ST_POUT: return T * C::D; case ST_FINAL: return T;
    }
    return 0;
}
template <class C> HD int stage_scr_words(int st) {
    typedef Dims<C> Dm;
    switch (st) { case ST_SOLVE: return C::CH; case ST_SCAN: return C::DK + C::CH; case ST_INDEX: return 2 * Dm::TOPK; case ST_ATTN: return Dm::TOPK + C::KVL;
        case ST_ROUTE: return 2 * C::PK + 4 * C::PTK + C::PTK * C::PTK; }
    return 0;
}
template <class C> HD void run_item(const NP& P, int st, long item, int tid, int NT) {
    typedef Dims<C> Dm;
    switch (st) {
        case ST_MOD: n_mod<C>(P, (int)item); break; case ST_H1: n_h1<C>(P, (int)item); break;
        case ST_INPROJ_A: { const int ngA = Dm::OFF_Z / 4, ngB = (Dm::OFF_GA - Dm::OFF_B) / 4, ng = ngA + ngB; const int t = (int)(item / ng), g = (int)(item % ng);
            if (g < ngA) n_inproj<C>(P, t * ngA + g, 0, Dm::OFF_Z); else n_inproj<C>(P, t * ngB + (g - ngA), Dm::OFF_B, Dm::OFF_GA); } break;
        case ST_DSANORM: n_dsanorm<C>(P, (int)item); break; case ST_CONV: n_conv<C>(P, (int)item); break; case ST_GC: n_gc<C>(P, (int)item); break;
        case ST_AMAT: n_amat<C>(P, (int)item); break; case ST_SOLVE: n_solve<C>(P, (int)item, tid, NT); break; case ST_SCALE: n_scale<C>(P, (int)item); break;
        case ST_SCAN: n_scan<C>(P, (int)item, tid, NT); break; case ST_Q: n_q<C>(P, (int)item); break; case ST_QIDX: { const int NI = C::IH * C::ID, NJ = C::MH * C::MDH + NI; n_q<C>(P, (int)((item / NI) * NJ + C::MH * C::MDH + item % NI)); } break; case ST_QABS: n_qabs<C>(P, (int)item); break; case ST_SMALL: n_small<C>(P, (int)item); break;
        case ST_INDEX: n_index<C>(P, (int)item, tid, NT); break; case ST_ATTN: n_attn<C>(P, (int)item, tid, NT); break;
        case ST_INPROJ_B: { const int ngA = Dm::HV / 4, ngB = 2 * C::D / 4, ng = ngA + ngB; const int t = (int)(item / ng), g = (int)(item % ng);
            if (g < ngA) n_inproj<C>(P, t * ngA + g, Dm::OFF_Z, Dm::OFF_B); else n_inproj<C>(P, t * ngB + (g - ngA), Dm::OFF_GA, Dm::IN_COLS); } break;
        case ST_OGATE: n_ogate<C>(P, (int)item); break; case ST_OATT: n_oatt<C>(P, (int)item); break; case ST_MERGE: n_merge<C>(P, (int)item); break;
        case ST_WO: n_wo<C>(P, (int)item); break; case ST_H2: n_h2<C>(P, (int)item); break; case ST_PEERQ: n_peerq<C>(P, (int)item); break;
        case ST_ROUTE: n_route<C>(P, (int)item, tid, NT); break; case ST_PACT: n_pact<C>(P, (int)item); break; case ST_POUT: n_pout<C>(P, (int)item); break;
        case ST_FINAL: n_final<C>(P, (int)item); break;
    }
}
#define GAS __attribute__((address_space(1)))
#define LAS __attribute__((address_space(3)))
#define XB_TMO      128
#define XB_XCNT(j)  (256  + 64 * (j))
#define XB_XSUB(j)  (1280 + 64 * (j))
#define XB_XGEN(j)  (2304 + 64 * (j))
#define XB_TOP      3328
#define XB_TOPGEN   3392
#define XCD_BAR_WORDS 3456
#ifndef XB_SPIN_CAP
#define XB_SPIN_CAP (1u << 26)
#endif
__device__ __forceinline__ unsigned xb_ld(unsigned* p)              { return __hip_atomic_load(p, __ATOMIC_RELAXED, __HIP_MEMORY_SCOPE_AGENT); }
__device__ __forceinline__ unsigned xb_add(unsigned* p, unsigned v) { return __hip_atomic_fetch_add(p, v, __ATOMIC_RELAXED, __HIP_MEMORY_SCOPE_AGENT); }
__device__ __forceinline__ unsigned xb_xcc_id() { return (unsigned)__builtin_amdgcn_s_getreg((3 << 11) | 20) & 0xFu; }
#define XB_SPIN(cond, bar) do { unsigned _sp = 0; while (cond) { __builtin_amdgcn_s_sleep(1); \
    if ((++_sp & 255u) == 0u) { if (xb_ld(&(bar)[XB_TMO])) break; if (_sp > XB_SPIN_CAP) { atomicAdd(&(bar)[XB_TMO], 1u); break; } } } } while (0)
struct XcdBarrier { unsigned* bar; unsigned x; volatile LAS unsigned* st; };
__device__ __forceinline__ XcdBarrier xcd_barrier_post(unsigned* bar, volatile LAS unsigned* st) {
    XcdBarrier b; b.bar = bar; b.x = xb_xcc_id(); b.st = st;
    if (threadIdx.x == 0) (void)xb_add(&bar[XB_XCNT(b.x)], 1u);
    return b;
}
__device__ __forceinline__ void xcd_barrier_complete(unsigned* bar, unsigned x, unsigned& nloc, unsigned& nx) {
    const unsigned G = gridDim.x * gridDim.y * gridDim.z;
    unsigned sum, cnt, mine, sp = 0u;
    for (;;) {
        sum = 0u; cnt = 0u; mine = 0u;
#pragma unroll
        for (unsigned j = 0; j < 16; ++j) { const unsigned c = xb_ld(&bar[XB_XCNT(j)]); sum += c; cnt += (c > 0u) ? 1u : 0u; mine = (j == x) ? c : mine; }
        if (sum == G) break;
        __builtin_amdgcn_s_sleep(1);
        if ((++sp & 255u) == 0u) { if (xb_ld(&bar[XB_TMO])) break; if (sp > XB_SPIN_CAP) { atomicAdd(&bar[XB_TMO], 1u); break; } }
    }
    nloc = mine > 0u ? mine : 1u; nx = cnt > 0u ? cnt : 1u;
}
__device__ __forceinline__ void xcd_barrier(const XcdBarrier& b) {
    asm volatile("s_waitcnt vmcnt(0)" ::: "memory");
    __syncthreads();
    if (threadIdx.x == 0) {
        unsigned* bar = b.bar;
        __builtin_amdgcn_s_waitcnt(0);
        unsigned nloc = b.st[0], nx = b.st[1];
        if (nloc == 0u) { xcd_barrier_complete(bar, b.x, nloc, nx); b.st[0] = nloc; b.st[1] = nx; }
        const unsigned old = xb_add(&bar[XB_XSUB(b.x)], 1u);
        const unsigned gen = old / nloc;
        if (old + 1u == (gen + 1u) * nloc) {
            __builtin_amdgcn_fence(__ATOMIC_RELEASE, "agent");
            asm volatile("s_waitcnt vmcnt(0)" ::: "memory");
            const unsigned og = xb_add(&bar[XB_TOP], 1u);
            const unsigned tg = og / nx;
            if (og + 1u == (tg + 1u) * nx) xb_add(&bar[XB_TOPGEN], 1u);
            else XB_SPIN(xb_ld(&bar[XB_TOPGEN]) == tg, bar);
            __builtin_amdgcn_fence(__ATOMIC_ACQUIRE, "agent");
            xb_add(&bar[XB_XGEN(b.x)], 1u);
            asm volatile("s_waitcnt vmcnt(0)" ::: "memory");
        } else {
            XB_SPIN(xb_ld(&bar[XB_XGEN(b.x)]) == gen, bar);
            __builtin_amdgcn_fence(__ATOMIC_ACQUIRE, "agent");
            asm volatile("s_waitcnt vmcnt(0)" ::: "memory");
        }
    }
    __syncthreads();
}
namespace pg8 {
#define PG8_LAS __attribute__((address_space(3)))
typedef unsigned short bf16_t;
typedef short bf16x8 __attribute__((ext_vector_type(8)));
typedef float f32x4 __attribute__((ext_vector_type(4)));
typedef unsigned u32x4 __attribute__((ext_vector_type(4)));
constexpr int BM = 256, BK = 64, HALF = 128, HTB = HALF * BK * 2  , STAGE_BYTES = 8 * HTB, NXCD = 8, WGM = 8;

__host__ __device__ __forceinline__ int lds_byte(int r, int c) { const int st = (r >> 4) * 2 + (c >> 5), rr = r & 15, cc = c & 31, ob = rr * 64 + cc * 2; return st * 1024 + (ob ^ (((ob >> 9) & 1) << 5)); }
__host__ __device__ __forceinline__ void stage_rc(int b, int& R, int& C) { const int st = b / 1024, sb = b % 1024, swz = sb ^ (((sb >> 9) & 1) << 5); R = (st >> 1) * 16 + swz / 64; C = (st & 1) * 32 + (swz % 64) / 2; }
__host__ __device__ __forceinline__ int perm32(int rho) { const int n = rho >> 4, i = rho & 15; return 8 * (i >> 2) + 4 * n + (i & 3); }
__device__ __forceinline__ unsigned cvt_pk_bf16(float lo, float hi) { unsigned r; asm volatile("v_cvt_pk_bf16_f32 %0, %1, %2" : "=v"(r) : "v"(lo), "v"(hi)); return r; }
struct Unit { int pm, pn; const char* a; const char* b; };
struct Gemm { int lda, ldb, K; };
template <class Epi, class Sched, bool ALIGN_EPI = false, bool SP2 = false>
__device__ __forceinline__ void gemm_phase(PG8_LAS unsigned char* lds, const Gemm g, const Sched& S, const Epi& E) {
    int tid = threadIdx.x; asm volatile("" : "+v"(tid));
    const int wid = __builtin_amdgcn_readfirstlane(tid >> 6), lane = tid & 63, wr = wid >> 2, wc = wid & 3, fr = lane & 15, fq = lane >> 4;
    const int K = g.K, nt = K / BK;
    unsigned voffA[2], voffB[2];
#pragma unroll
    for (int i = 0; i < 2; ++i) { int R, C; stage_rc(tid * 16 + i * 8192, R, C); const int Rb = Epi::PERM ? ((R & ~31) + perm32(R & 31)) : R;
        voffA[i] = (unsigned)(R * g.lda + C) * 2u; voffB[i] = (unsigned)(Rb * g.ldb + C) * 2u; }
    const size_t kstep = (size_t)(BK * 2);
    const size_t hstepA = (size_t)HALF * g.lda * 2, hstepB = (size_t)HALF * g.ldb * 2;
    const unsigned ldsw = (unsigned)wid * 1024u;
    const int aoff = lds_byte(wr * 64 + fr, fq * 8), boff = lds_byte(wc * 32 + fr, fq * 8);
#define PG8_SA(b, h) (((b) * 2 + (h)) * HTB)
#define PG8_SB(b, h) ((4 + (b) * 2 + (h)) * HTB)
#define PG8_STAGE(bufoff, gbase, voff) do { _Pragma("unroll") for (int _i = 0; _i < 2; ++_i) \
        __builtin_amdgcn_global_load_lds((const unsigned*)((const char*)(gbase) + (voff)[_i]), (PG8_LAS unsigned*)(lds + (bufoff) + ldsw + _i * 8192), 16, 0, 0); } while (0)
#define PG8_LDA(dst, b, h) do { _Pragma("unroll") for (int m = 0; m < 4; ++m) _Pragma("unroll") for (int k = 0; k < 2; ++k) dst[m][k] = *(const PG8_LAS bf16x8*)(lds + PG8_SA(b, h) + aoff + m * 2048 + k * 1024); } while (0)
#define PG8_LDB(dst, b, h) do { _Pragma("unroll") for (int n = 0; n < 2; ++n) _Pragma("unroll") for (int k = 0; k < 2; ++k) dst[n][k] = *(const PG8_LAS bf16x8*)(lds + PG8_SB(b, h) + boff + n * 2048 + k * 1024); } while (0)
#define PG8_MMA(ai, bj, At, Bt) do { __builtin_amdgcn_s_setprio(1); _Pragma("unroll") for (int m = 0; m < 4; ++m) _Pragma("unroll") for (int n = 0; n < 2; ++n) _Pragma("unroll") for (int k = 0; k < 2; ++k) \
        acc[ai][bj][m][n] = __builtin_amdgcn_mfma_f32_16x16x32_bf16(Bt[n][k], At[m][k], acc[ai][bj][m][n], 0, 0, 0); __builtin_amdgcn_s_setprio(0); } while (0)
#define PG8_WAIT_V(n) asm volatile("s_waitcnt vmcnt(" #n ")" ::: "memory")
#define PG8_WAIT_L(n) asm volatile("s_waitcnt lgkmcnt(" #n ")" ::: "memory")
#define PG8_BAR __builtin_amdgcn_s_barrier()
#define PG8_SCHED __builtin_amdgcn_sched_barrier(0)
    Unit cur, nxt; int ui = 0;
    if (!S.next(0, cur)) return;
    f32x4 acc[2][2][4][2];
#pragma unroll
    for (int a = 0; a < 2; ++a)
#pragma unroll
        for (int b = 0; b < 2; ++b)
#pragma unroll
            for (int m = 0; m < 4; ++m)
#pragma unroll
                for (int n = 0; n < 2; ++n) acc[a][b][m][n] = (f32x4){0.f, 0.f, 0.f, 0.f};
    bf16x8 At[4][2], B0[2][2], B1[2][2];
    const char* cA = cur.a; const char* cB = cur.b;
    S.a_ready(cur);
    if constexpr (SP2) {
        PG8_STAGE(PG8_SB(0, 0), cB, voffB); PG8_STAGE(PG8_SB(0, 1), cB + hstepB, voffB); PG8_STAGE(PG8_SA(0, 0), cA, voffA); PG8_STAGE(PG8_SA(0, 1), cA + hstepA, voffA);
        if (wr == 1) PG8_BAR;
        PG8_WAIT_V(2); PG8_BAR;
        PG8_STAGE(PG8_SB(1, 0), cB + kstep, voffB); PG8_STAGE(PG8_SA(1, 0), cA + kstep, voffA); PG8_STAGE(PG8_SB(1, 1), cB + hstepB + kstep, voffB);
        PG8_WAIT_V(6); PG8_BAR;
    } else {
        PG8_STAGE(PG8_SB(0, 0), cB, voffB); PG8_STAGE(PG8_SA(0, 0), cA, voffA); PG8_STAGE(PG8_SB(0, 1), cB + hstepB, voffB); PG8_STAGE(PG8_SA(0, 1), cA + hstepA, voffA);
        if (wr == 1) PG8_BAR;
        PG8_WAIT_V(4); PG8_BAR;
        PG8_STAGE(PG8_SB(1, 0), cB + kstep, voffB); PG8_STAGE(PG8_SA(1, 0), cA + kstep, voffA); PG8_STAGE(PG8_SB(1, 1), cB + hstepB + kstep, voffB);
        PG8_WAIT_V(6); PG8_BAR;
    }
    for (;;) {
        const bool has_next = S.next(ui + 1, nxt);
        const char* nA = has_next ? nxt.a : cA; const char* nB = has_next ? nxt.b : cB;
        for (int t = 0; t < nt; t += 2) {
            const bool last = (t == nt - 2);
            const char* a1 = cA + (size_t)(t + 1) * kstep;
            const char* a2 = last ? nA : cA + (size_t)(t + 2) * kstep; const char* b2 = last ? nB : cB + (size_t)(t + 2) * kstep;
            const char* a3 = a2 + kstep; const char* b3 = b2 + kstep;
            if (last && has_next) S.a_ready(nxt);
            if constexpr (SP2) {
            PG8_LDB(B0, 0, 0); PG8_LDB(B1, 0, 1); PG8_SCHED; PG8_LDA(At, 0, 0); PG8_STAGE(PG8_SA(1, 1), a1 + hstepA, voffA);
            PG8_WAIT_V(8); PG8_WAIT_L(0); PG8_BAR; PG8_MMA(0, 0, At, B0); PG8_MMA(0, 1, At, B1); PG8_BAR; PG8_SCHED;
            PG8_LDA(At, 0, 1); PG8_STAGE(PG8_SB(0, 0), b2, voffB); PG8_STAGE(PG8_SB(0, 1), b2 + hstepB, voffB); PG8_STAGE(PG8_SA(0, 0), a2, voffA);
            PG8_WAIT_V(8); PG8_WAIT_L(0); PG8_BAR; PG8_MMA(1, 0, At, B0); PG8_MMA(1, 1, At, B1); PG8_BAR; PG8_SCHED;
            PG8_LDB(B0, 1, 0); PG8_LDB(B1, 1, 1); PG8_SCHED; PG8_LDA(At, 1, 0); PG8_STAGE(PG8_SA(0, 1), a2 + hstepA, voffA);
            PG8_WAIT_V(8); PG8_WAIT_L(0); PG8_BAR; PG8_MMA(0, 0, At, B0); PG8_MMA(0, 1, At, B1); PG8_BAR; PG8_SCHED;
            PG8_LDA(At, 1, 1); PG8_STAGE(PG8_SB(1, 0), b3, voffB); PG8_STAGE(PG8_SB(1, 1), b3 + hstepB, voffB); PG8_STAGE(PG8_SA(1, 0), a3, voffA);
            PG8_WAIT_V(8); PG8_WAIT_L(0); PG8_BAR; PG8_MMA(1, 0, At, B0); PG8_MMA(1, 1, At, B1); PG8_BAR; PG8_SCHED;
            } else {
            PG8_LDB(B0, 0, 0); PG8_SCHED; PG8_LDA(At, 0, 0); PG8_STAGE(PG8_SA(1, 1), a1 + hstepA, voffA);
            PG8_WAIT_L(8); PG8_BAR; PG8_WAIT_L(0); PG8_MMA(0, 0, At, B0); PG8_BAR; PG8_SCHED;
            PG8_LDB(B1, 0, 1); PG8_STAGE(PG8_SB(0, 0), b2, voffB);
            PG8_BAR; PG8_WAIT_L(0); PG8_MMA(0, 1, At, B1); PG8_BAR;
            PG8_LDA(At, 0, 1); PG8_STAGE(PG8_SA(0, 0), a2, voffA);
            PG8_BAR; PG8_WAIT_L(0); PG8_MMA(1, 0, At, B0); PG8_BAR; PG8_SCHED;
            PG8_STAGE(PG8_SB(0, 1), b2 + hstepB, voffB);
            PG8_WAIT_V(6); PG8_BAR; PG8_MMA(1, 1, At, B1); PG8_BAR;
            PG8_LDB(B0, 1, 0); PG8_SCHED; PG8_LDA(At, 1, 0); PG8_STAGE(PG8_SA(0, 1), a2 + hstepA, voffA);
            PG8_WAIT_L(8); PG8_BAR; PG8_WAIT_L(0); PG8_MMA(0, 0, At, B0); PG8_BAR; PG8_SCHED;
            PG8_LDB(B1, 1, 1); PG8_STAGE(PG8_SB(1, 0), b3, voffB);
            PG8_BAR; PG8_WAIT_L(0); PG8_MMA(0, 1, At, B1); PG8_BAR;
            PG8_LDA(At, 1, 1); PG8_STAGE(PG8_SA(1, 0), a3, voffA);
            PG8_BAR; PG8_WAIT_L(0); PG8_MMA(1, 0, At, B0); PG8_BAR; PG8_SCHED;
            PG8_STAGE(PG8_SB(1, 1), b3 + hstepB, voffB);
            PG8_WAIT_V(6); PG8_BAR; PG8_MMA(1, 1, At, B1); PG8_BAR;
            }
        }
        if constexpr (ALIGN_EPI) { if (wr == 0) PG8_BAR; }
        if constexpr (!Epi::AFTER_DRAIN) { E(acc, cur, wr, wc, fr, fq); S.done(cur); }
        if (!has_next) break;
#pragma unroll
        for (int a = 0; a < 2; ++a)
#pragma unroll
            for (int b = 0; b < 2; ++b)
#pragma unroll
                for (int m = 0; m < 4; ++m)
#pragma unroll
                    for (int n = 0; n < 2; ++n) acc[a][b][m][n] = (f32x4){0.f, 0.f, 0.f, 0.f};
        cur = nxt; cA = nA; cB = nB; ++ui;
        if constexpr (ALIGN_EPI) { if (wr == 1) PG8_BAR; }
    }
    PG8_WAIT_V(0);
    if constexpr (!ALIGN_EPI) { if (wr == 0) PG8_BAR; }
    PG8_BAR;
    if constexpr (Epi::AFTER_DRAIN) { E.fused(acc, cur, wr, wc, fr, fq, lds, wid, lane); S.done(cur); }
#undef PG8_SA
#undef PG8_SB
#undef PG8_STAGE
#undef PG8_LDA
#undef PG8_LDB
#undef PG8_MMA
#undef PG8_WAIT_V
#undef PG8_WAIT_L
#undef PG8_BAR
#undef PG8_SCHED
}
}
typedef float f32x4 __attribute__((ext_vector_type(4)));
typedef unsigned u32x4 __attribute__((ext_vector_type(4)));
constexpr int T_ = 16384, D_ = 1024, NIN_ = 6912;
constexpr size_t MiB_ = 1u << 20;
constexpr size_t X_BASE = 230 * MiB_;
constexpr size_t X_WINT = X_BASE, X_WCAT = X_WINT + (size_t)NIN_ * 1024 * 2, X_WOT = X_WCAT + (size_t)1024 * 3072 * 2, X_WST = X_WOT + (size_t)1024 * 1024 * 2,
                 X_WCOMB = X_WST + (size_t)2048 * 1024 * 2, X_WIQT = X_WCOMB + (size_t)2048 * 256 * 2, X_END = X_WIQT + (size_t)512 * 256 * 2;
constexpr size_t X_EXPI = X_WINT, X_GATE = X_EXPI + (size_t)16384 * 128 * 4;
static_assert(X_GATE + (size_t)16384 * 128 * 4 <= X_WOT, "routing results fit over WinT | WcatT");
constexpr size_t X_WUK = WsMap<CfgFull>::A0, X_WUQ = X_WUK + (size_t)256 * 1024 * 2, X_WBT = X_WUQ + (size_t)256 * 1024 * 2,
                 X_WUV = X_WBT + (size_t)1024 * 1024 * 2, X_SKB = X_WUV + (size_t)256 * 1024 * 2, X_PWQ = X_SKB + (size_t)2048 * 256 * 2, X_TMP_END = X_PWQ + (size_t)1024 * 2048 * 2;
static_assert(WsMap<CfgFull>::END <= X_BASE && X_END <= 260 * MiB_ && X_TMP_END <= WsMap<CfgFull>::A2, "extra workspace map (d_ws >= 266.9 MiB = the sum of the inputs)");
struct OP {
    bf16_t *WinT, *WcatT, *WoT, *WsT, *WcombT, *WiqT, *wuk, *wuq, *wbT, *wuv, *skb, *pwq; float* S; bf16_t* RAWB; unsigned char *Ub, *Vb; int* EXPI2; float* GATE2; bf16_t *QA0, *QA1; unsigned* qword;
};
typedef __bf16 bf16x2h_t __attribute__((ext_vector_type(2)));
typedef float f32x2h_t __attribute__((ext_vector_type(2)));
__device__ __forceinline__ unsigned pk2bf(float lo, float hi) { const f32x2h_t v = {lo, hi}; return __builtin_bit_cast(unsigned, __builtin_convertvector(v, bf16x2h_t)); }
__device__ __forceinline__ bf16_t f2bfd(float f) { return (bf16_t)(pk2bf(f, 0.f) & 0xffffu); }

__device__ __forceinline__ int inproj_src(int n) {
    if (n < 3072) return n;
    if (n < 3328) return 4112 + (n - 3072);
    if (n < 3584) return 4368 + (n - 3328);
    if (n < 3648) return 4624 + (n - 3584);
    if (n < 3656) return 4096 + (n - 3648);
    if (n < 3664) return 4104 + (n - 3656);
    if (n < 3672) return 4688 + (n - 3664);
    if (n < 3840) return -1;
    if (n < 4864) return 3072 + (n - 3840);
    if (n < 5888) return 4696 + (n - 4864);
    return 5720 + (n - 5888);
}
template <int MAP> __device__ __forceinline__ void transpose_item(const float* W, int ldn, bf16_t* WT, int ldk, int n0, int k0, LAS float* scr, int lane) {
    const int j = lane & 31; int sc = n0 + j; if (MAP == 1) sc = inproj_src(n0 + j);
#pragma unroll 8
    for (int i = 0; i < 32; ++i) { const int kk = 2 * i + (lane >> 5); scr[kk * 33 + j] = (sc >= 0) ? W[(size_t)(k0 + kk) * ldn + sc] : 0.f; }
    asm volatile("s_waitcnt lgkmcnt(0)" ::: "memory");
    const int c = lane & 7;
#pragma unroll
    for (int q = 0; q < 4; ++q) { const int n = (lane >> 3) + 8 * q; const LAS float* s = scr + (8 * c) * 33 + n;
        u32x4 o; o.x = pk2bf(s[0 * 33], s[1 * 33]); o.y = pk2bf(s[2 * 33], s[3 * 33]); o.z = pk2bf(s[4 * 33], s[5 * 33]); o.w = pk2bf(s[6 * 33], s[7 * 33]);
        *(u32x4*)(WT + (size_t)(n0 + n) * ldk + k0 + 8 * c) = o; }
    asm volatile("s_waitcnt lgkmcnt(0)" ::: "memory");
}
__device__ __forceinline__ void p0_weights(const NP& P, const OP& Q, LAS unsigned char* lds, int gw, int NGW, int gt, int NGT, int wave, int lane) {
    LAS float* scr = (LAS float*)(lds + wave * 16384);
    constexpr int I_IN = (NIN_ / 32) * 16, I_SQ = 32 * 16;
    constexpr int I_IQ = 16 * 4;
    for (int it = gw; it < I_IN + 3 * I_SQ + I_IQ; it += NGW) {
        int r = it;
        if (r < I_IN) { transpose_item<1>(P.w_in, 6744, Q.WinT, 1024, (r / 16) * 32, (r % 16) * 64, scr, lane); continue; } r -= I_IN;
        if (r < I_SQ) { transpose_item<0>(P.w_a_out, 1024, Q.WcatT, 3072, (r / 16) * 32, (r % 16) * 64, scr, lane); continue; } r -= I_SQ;
        if (r < I_SQ) { transpose_item<0>(P.w_o, 1024, Q.WoT, 1024, (r / 16) * 32, (r % 16) * 64, scr, lane); continue; } r -= I_SQ;
        if (r < I_SQ) { transpose_item<0>(P.w_b_out, 1024, Q.wbT, 1024, (r / 16) * 32, (r % 16) * 64, scr, lane); continue; } r -= I_SQ;
        transpose_item<0>(P.w_iq, 512, Q.WiqT, 256, (r / 4) * 32, (r % 4) * 64, scr, lane);
    }
    for (int i = gt; i < 256 * 1024 / 4; i += NGT) { const f32x4 a = ((const f32x4*)P.w_uk)[i], b = ((const f32x4*)P.w_uq)[i], c = ((const f32x4*)P.w_uv)[i];
        ((uint2*)Q.wuk)[i] = make_uint2(pk2bf(a.x, a.y), pk2bf(a.z, a.w)); ((uint2*)Q.wuq)[i] = make_uint2(pk2bf(b.x, b.y), pk2bf(b.z, b.w)); ((uint2*)Q.wuv)[i] = make_uint2(pk2bf(c.x, c.y), pk2bf(c.z, c.w)); }
    for (int i = gt; i < 1024 * 2048 / 4; i += NGT) { const f32x4 a = ((const f32x4*)P.peer_w_q)[i]; ((uint2*)Q.pwq)[i] = make_uint2(pk2bf(a.x, a.y), pk2bf(a.z, a.w)); }
    for (int i = gt; i < 2048 * 256 / 4; i += NGT) { const int row = i / 64, c4 = (i % 64) * 4, g = row >> 7; uint2 o = make_uint2(0u, 0u);
        if ((c4 >> 7) == (g & 1)) { const f32x4 a = *(const f32x4*)(P.peer_sub_keys + (size_t)row * 128 + (c4 & 127)); o = make_uint2(pk2bf(a.x, a.y), pk2bf(a.z, a.w)); }
        ((uint2*)Q.skb)[i] = o; }
}
struct GridSched {
    int nM, nN, nwg, G, c; const char* A; const char* B; size_t sA, sB;
    const char* A2 = nullptr; int splitA = 1 << 30;
    __device__ void init(int nM_, int nN_, int G_, int c_, const void* A_, size_t sA_, const void* B_, size_t sB_) { nM = nM_; nN = nN_; nwg = nM * nN; G = G_; c = c_; A = (const char*)A_; B = (const char*)B_; sA = sA_; sB = sB_; }
    __device__ bool next(int i, pg8::Unit& u) const {
        const long L = (long)i * G + c; if (L >= nwg) return false;
        int wgid = (int)L; { const int q = nwg / 8, r = nwg % 8, xcd = wgid % 8, off = wgid / 8; wgid = (xcd < r ? xcd * (q + 1) : r * (q + 1) + (xcd - r) * q) + off; }
        const int nig = 8 * nN, gid = wgid / nig, fm = gid * 8, gsz = (nM - fm) < 8 ? (nM - fm) : 8;
        u.pm = fm + ((wgid % nig) % gsz); u.pn = (wgid % nig) / gsz; u.a = (u.pm < splitA) ? A + (size_t)u.pm * sA : A2 + (size_t)(u.pm - splitA) * sA; u.b = B + (size_t)u.pn * sB; return true;
    }
    __device__ __forceinline__ void a_ready(const pg8::Unit&) const {}
    __device__ __forceinline__ void done(const pg8::Unit&) const {}
};
struct WSched {
    int kind, c; const bf16_t *wuk, *wuq, *wbT, *wuv, *skb, *pwq;
    __device__ bool next(int i, pg8::Unit& u) const {
        if (i > 0 || c < 0) return false;
        if (kind == 0) {
            if (c < 8) { u.pm = c; u.pn = 100; u.a = (const char*)(wuk + c * 128); u.b = (const char*)(wuq + c * 128); return true; }
            if (c < 40) { const int h = (c - 8) >> 2, mt = (c - 8) & 3; u.pm = mt; u.pn = 200 + h; u.a = (const char*)(wbT + (size_t)mt * 256 * 1024 + h * 128); u.b = (const char*)(wuv + h * 128); return true; }
            return false;
        }
        if (c < 32) { const int pm = c >> 2, nt = c & 3; u.pm = pm; u.pn = nt; u.a = (const char*)(skb + (size_t)pm * 256 * 256); u.b = (const char*)(pwq + (size_t)nt * 256 * 2048 + pm * 256); return true; }
        return false;
    }
    __device__ __forceinline__ void a_ready(const pg8::Unit&) const {}
    __device__ __forceinline__ void done(const pg8::Unit&) const {}
};
template <class F> struct EpiG {
    static constexpr bool PERM = true, AFTER_DRAIN = false; F f;
    __device__ __forceinline__ void operator()(const f32x4 (&acc)[2][2][4][2], const pg8::Unit& u, int wr, int wc, int fr, int fq) const {
#pragma unroll
        for (int ai = 0; ai < 2; ++ai)
#pragma unroll
            for (int m = 0; m < 4; ++m)
#pragma unroll
                for (int bj = 0; bj < 2; ++bj) f.st(u, ai * 128 + wr * 64 + m * 16 + fr, bj * 128 + wc * 32 + 8 * fq, acc[ai][bj][m][0], acc[ai][bj][m][1]);
    }
};
__device__ __forceinline__ u32x4 pack8(f32x4 v0, f32x4 v1) { u32x4 w; w.x = pk2bf(v0[0], v0[1]); w.y = pk2bf(v0[2], v0[3]); w.z = pk2bf(v1[0], v1[1]); w.w = pk2bf(v1[2], v1[3]); return w; }
struct FWeights {
    bf16_t *WcombT, *WcatT, *WsT;
    __device__ __forceinline__ void st(const pg8::Unit& u, int row, int col, f32x4 v0, f32x4 v1) const {
        bf16_t* p; float sc = 1.f;
        if (u.pn == 100) { p = WcombT + (size_t)(u.pm * 256 + row) * 256 + col; sc = 0.08838834764831845f; }
        else if (u.pn >= 200) { p = WcatT + (size_t)(u.pm * 256 + row) * 3072 + 1024 + (u.pn - 200) * 256 + col; }
        else { p = WsT + (size_t)(u.pm * 256 + row) * 1024 + u.pn * 256 + col; }
        *(u32x4*)p = pack8(v0 * sc, v1 * sc);
    }
};
struct FInprojA {
    bf16_t* QKVP; bf16_t* RAW;
    __device__ __forceinline__ void st(const pg8::Unit& u, int row, int col, f32x4 v0, f32x4 v1) const {
        const size_t t = (size_t)u.pm * 256 + row;
        if (u.pn < 12) { *(u32x4*)(QKVP + t * 3072 + u.pn * 256 + col) = pack8(v0, v1); }
        else { *(u32x4*)(RAW + t * 768 + (u.pn - 12) * 256 + col) = pack8(v0, v1); }
    }
};
__device__ __forceinline__ f32x4 bf4(uint2 w) { f32x4 r; r[0] = bf2f((bf16_t)(w.x & 0xffff)); r[1] = bf2f((bf16_t)(w.x >> 16)); r[2] = bf2f((bf16_t)(w.y & 0xffff)); r[3] = bf2f((bf16_t)(w.y >> 16)); return r; }
struct FInprojB {
    bf16_t *Z, *GA, *GB; const bf16_t* ON;
    __device__ __forceinline__ void st(const pg8::Unit& u, int row, int col, f32x4 v0, f32x4 v1) const {
        const size_t t = (size_t)u.pm * 256 + row; const int which = u.pn >> 2, c = (u.pn & 3) * 256 + col;
        bf16_t* dst = Z + (size_t)which * ((size_t)16384 * 1024) + t * 1024 + c;
        if (which == 0) { const u32x4 on = *(const u32x4*)(ON + t * 1024 + c);
            f32x4 a0 = bf4(make_uint2(on.x, on.y)), a1 = bf4(make_uint2(on.z, on.w));
#pragma unroll
            for (int k = 0; k < 4; ++k) { a0[k] *= v0[k] / (1.f + __expf(-v0[k])); a1[k] *= v1[k] / (1.f + __expf(-v1[k])); }
            *(u32x4*)dst = pack8(a0, a1); }
        else *(u32x4*)dst = pack8(v0, v1);
    }
};
struct FStoreBf16 { bf16_t* O; int ldc; bf16_t* O2; int split;
    __device__ __forceinline__ void st(const pg8::Unit& u, int row, int col, f32x4 v0, f32x4 v1) const { bf16_t* base = (u.pm < split) ? O + (size_t)(u.pm * 256) * ldc : O2 + (size_t)((u.pm - split) * 256) * ldc;
        *(u32x4*)(base + (size_t)row * ldc + u.pn * 256 + col) = pack8(v0, v1); } };
struct FStoreF32 { float* O; int ldc;
    __device__ __forceinline__ void st(const pg8::Unit& u, int row, int col, f32x4 v0, f32x4 v1) const { float* p = O + (size_t)(u.pm * 256 + row) * ldc + u.pn * 256 + col; *(f32x4*)p = v0; *(f32x4*)(p + 4) = v1; } };
__device__ __forceinline__ f32x4 sig4(f32x4 v) { return (f32x4){sigmf(v[0]), sigmf(v[1]), sigmf(v[2]), sigmf(v[3])}; }
template <int SECOND> struct FMerge {
    const bf16_t* Gt; bf16_t* M;
    __device__ __forceinline__ void st(const pg8::Unit& u, int row, int col, f32x4 v0, f32x4 v1) const {
        const size_t o = (size_t)(u.pm * 256 + row) * 1024 + u.pn * 256 + col; const u32x4 g = *(const u32x4*)(Gt + o);
        f32x4 r0 = sig4(bf4(make_uint2(g.x, g.y))) * v0, r1 = sig4(bf4(make_uint2(g.z, g.w))) * v1;
        if (SECOND) { const u32x4 m = *(const u32x4*)(M + o); r0 += bf4(make_uint2(m.x, m.y)); r1 += bf4(make_uint2(m.z, m.w)); }
        *(u32x4*)(M + o) = pack8(r0, r1);
    }
};
struct FWo {
    const float* MOD; const float* x; float* X1;
    __device__ __forceinline__ void st(const pg8::Unit& u, int row, int col, f32x4 v0, f32x4 v1) const {
        const size_t t = (size_t)u.pm * 256 + row; const int c = u.pn * 256 + col; const int b = (int)(t >> 13);
        const float* gt = MOD + (size_t)b * 6144 + 2048 + c; const float* xr = x + t * 1024 + c; float* o = X1 + t * 1024 + c;
        *(f32x4*)o = *(const f32x4*)xr + *(const f32x4*)gt * v0; *(f32x4*)(o + 4) = *(const f32x4*)(xr + 4) + *(const f32x4*)(gt + 4) * v1;
    }
};
namespace idxk {
typedef short bf16x8 __attribute__((ext_vector_type(8)));
constexpr int NQ = 16, CAP = 768, CAPS = 772, THRESH = 512, KSEL = 256, L_ = 8192;
constexpr int L_VAL = 0, L_IDX = NQ * CAPS * 4, L_QF = 2 * NQ * CAPS * 4, L_HIST = L_QF + 16 * 64 * 16, L_CNT = L_HIST + 8 * 1024, L_TAU = L_CNT + 64, L_FLAG = L_TAU + 64, L_END = L_FLAG + 64, L_SIDX = 131072;
static_assert(L_END <= 131072, "indexer LDS map");
__device__ __forceinline__ unsigned sortable(float f) { const unsigned u = __builtin_bit_cast(unsigned, f); return (u & 0x80000000u) ? ~u : (u | 0x80000000u); }
__device__ __forceinline__ unsigned lanemask_lt_lo() { return __builtin_amdgcn_mbcnt_lo(~0u, 0u); }
__device__ __forceinline__ int mbcnt64(unsigned long long m) { return (int)__builtin_amdgcn_mbcnt_hi((unsigned)(m >> 32), __builtin_amdgcn_mbcnt_lo((unsigned)m, 0u)); }

#define DPPX_(v, CTRL) __builtin_amdgcn_update_dpp(0, (int)(v), CTRL, 0xF, 0xF, false)
__device__ __forceinline__ unsigned wave_and(unsigned v) { v &= (unsigned)DPPX_(v, 0xB1); v &= (unsigned)DPPX_(v, 0x4E); v &= (unsigned)DPPX_(v, 0x141); v &= (unsigned)DPPX_(v, 0x140);
    const unsigned a = (unsigned)__builtin_amdgcn_readlane((int)v, 0), b = (unsigned)__builtin_amdgcn_readlane((int)v, 16), c = (unsigned)__builtin_amdgcn_readlane((int)v, 32), d = (unsigned)__builtin_amdgcn_readlane((int)v, 48); return a & b & c & d; }
__device__ __forceinline__ unsigned wave_or(unsigned v) { v |= (unsigned)DPPX_(v, 0xB1); v |= (unsigned)DPPX_(v, 0x4E); v |= (unsigned)DPPX_(v, 0x141); v |= (unsigned)DPPX_(v, 0x140);
    const unsigned a = (unsigned)__builtin_amdgcn_readlane((int)v, 0), b = (unsigned)__builtin_amdgcn_readlane((int)v, 16), c = (unsigned)__builtin_amdgcn_readlane((int)v, 32), d = (unsigned)__builtin_amdgcn_readlane((int)v, 48); return a | b | c | d; }
__device__ __forceinline__ float wave_fmin(float v) {
#define FM_(CTRL) v = fminf(v, __builtin_bit_cast(float, DPPX_(__builtin_bit_cast(int, v), CTRL)))
    FM_(0xB1); FM_(0x4E); FM_(0x141); FM_(0x140);
#undef FM_
    const float a = __builtin_bit_cast(float, __builtin_amdgcn_readlane(__builtin_bit_cast(int, v), 0)), b = __builtin_bit_cast(float, __builtin_amdgcn_readlane(__builtin_bit_cast(int, v), 16)),
                c = __builtin_bit_cast(float, __builtin_amdgcn_readlane(__builtin_bit_cast(int, v), 32)), d = __builtin_bit_cast(float, __builtin_amdgcn_readlane(__builtin_bit_cast(int, v), 48));
    return fminf(fminf(a, b), fminf(c, d)); }
__device__ __forceinline__ float compact_query(LAS float* val, LAS unsigned* idx, LAS unsigned* hist, int cnt, int lane) {
    float v[12]; unsigned ix[12]; unsigned long long key[12];
    unsigned a_hi = ~0u, a_lo = ~0u, o_hi = 0u, o_lo = 0u;
#pragma unroll
    for (int r = 0; r < 12; ++r) { const int e = r * 64 + lane; v[r] = 0.f; ix[r] = 0u; key[r] = 0ull;
        if (e < cnt) { v[r] = val[e]; ix[r] = idx[e]; key[r] = ((unsigned long long)sortable(v[r]) << 13) | (unsigned long long)(8191u - ix[r]);
            a_hi &= (unsigned)(key[r] >> 32); a_lo &= (unsigned)key[r]; o_hi |= (unsigned)(key[r] >> 32); o_lo |= (unsigned)key[r]; } }
    const unsigned long long kand = ((unsigned long long)wave_and(a_hi) << 32) | wave_and(a_lo), kor = ((unsigned long long)wave_or(o_hi) << 32) | wave_or(o_lo);
    const unsigned long long diff = kand ^ kor;
    int fixed = 64 - (int)__builtin_clzll(diff);
    unsigned long long prefix = (fixed < 64) ? ((kor >> fixed) << fixed) : 0ull;
    int need = KSEL; bool done = false;
    while (!done) {
        const int shift = (fixed >= 8) ? fixed - 8 : 0; const unsigned mask = (1u << (fixed - shift)) - 1u;
        hist[lane * 4 + 0] = 0u; hist[lane * 4 + 1] = 0u; hist[lane * 4 + 2] = 0u; hist[lane * 4 + 3] = 0u;
        asm volatile("s_waitcnt lgkmcnt(0)" ::: "memory");
#pragma unroll
        for (int r = 0; r < 12; ++r) { const int e = r * 64 + lane;
            if (e < cnt && ((fixed >= 64) || ((key[r] >> fixed) == (prefix >> fixed)))) atomicAdd((unsigned*)&hist[(unsigned)(key[r] >> shift) & mask], 1u); }
        asm volatile("s_waitcnt lgkmcnt(0)" ::: "memory");
        const unsigned c0 = hist[lane * 4 + 0], c1 = hist[lane * 4 + 1], c2 = hist[lane * 4 + 2], c3 = hist[lane * 4 + 3];
        const unsigned loc = c0 + c1 + c2 + c3; unsigned suf = loc;
        suf += (unsigned)__builtin_amdgcn_update_dpp(0, (int)suf, 0x101, 0xF, 0xF, true); suf += (unsigned)__builtin_amdgcn_update_dpp(0, (int)suf, 0x102, 0xF, 0xF, true);
        suf += (unsigned)__builtin_amdgcn_update_dpp(0, (int)suf, 0x104, 0xF, 0xF, true); suf += (unsigned)__builtin_amdgcn_update_dpp(0, (int)suf, 0x108, 0xF, 0xF, true);
        { const unsigned t1 = (unsigned)__builtin_amdgcn_readlane((int)suf, 16), t2 = (unsigned)__builtin_amdgcn_readlane((int)suf, 32), t3 = (unsigned)__builtin_amdgcn_readlane((int)suf, 48);
          const int rw = lane >> 4; suf += (rw == 0) ? (t1 + t2 + t3) : (rw == 1) ? (t2 + t3) : (rw == 2) ? t3 : 0u; }
        unsigned cum = suf - loc; int fb = -1, fneed = 0, fcnt = 0;
        if (cum < (unsigned)need && (unsigned)need <= cum + c3) { fb = lane * 4 + 3; fneed = need - (int)cum; fcnt = (int)c3; } cum += c3;
        if (cum < (unsigned)need && (unsigned)need <= cum + c2) { fb = lane * 4 + 2; fneed = need - (int)cum; fcnt = (int)c2; } cum += c2;
        if (cum < (unsigned)need && (unsigned)need <= cum + c1) { fb = lane * 4 + 1; fneed = need - (int)cum; fcnt = (int)c1; } cum += c1;
        if (cum < (unsigned)need && (unsigned)need <= cum + c0) { fb = lane * 4 + 0; fneed = need - (int)cum; fcnt = (int)c0; }
        const unsigned long long bm = __ballot(fb >= 0); const int src = bm ? (int)__builtin_ctzll(bm) : 0;
        const int bin = __builtin_amdgcn_readlane(fb, src), nneed = __builtin_amdgcn_readlane(fneed, src), ncnt = __builtin_amdgcn_readlane(fcnt, src);
        prefix |= (unsigned long long)(unsigned)bin << shift; need = nneed; fixed = shift;
        if (ncnt == nneed || shift == 0) done = true;
    }
    int base = 0; float mn = 3.0e38f;
#pragma unroll
    for (int r = 0; r < 12; ++r) { const int e = r * 64 + lane; const bool keep = (e < cnt) && ((key[r] >> fixed) >= (prefix >> fixed));
        const unsigned long long m = __ballot(keep); const int pos = base + mbcnt64(m);
        if (keep) { val[pos] = v[r]; idx[pos] = ix[r]; mn = fminf(mn, v[r]); } base += (int)__builtin_popcountll(m); }
    return wave_fmin(mn);
}

struct IdxArgs { const bf16_t* QLATN; const bf16_t* KIDXN; const float* WIDX; const bf16_t* WiqT; int* IDX; };

__device__ __forceinline__ void index_task(const IdxArgs& A, LAS unsigned char* lds, int b, int q0) {
    int tx = threadIdx.x; asm volatile("" : "+v"(tx));
    const int wave = __builtin_amdgcn_readfirstlane(tx >> 6), lane = tx & 63, n = lane & 15, g = lane >> 4;
    LAS float* VAL = (LAS float*)(lds + L_VAL); LAS unsigned* IDXB = (LAS unsigned*)(lds + L_IDX); LAS unsigned* HIST = (LAS unsigned*)(lds + L_HIST) + wave * 256;
    LAS unsigned* CNT = (LAS unsigned*)(lds + L_CNT); LAS float* TAU = (LAS float*)(lds + L_TAU); LAS unsigned* FLAG = (LAS unsigned*)(lds + L_FLAG);
    const size_t trow = (size_t)b * L_ + q0;
    if (tx < NQ) { CNT[tx] = 0u; TAU[tx] = -__builtin_inff(); } if (tx < 3) FLAG[tx] = 0u;
    {
        bf16x8 qb[8];
#pragma unroll
        for (int kk = 0; kk < 8; ++kk) qb[kk] = *(const bf16x8*)(A.QLATN + (trow + n) * 256 + kk * 32 + 8 * g);
#pragma unroll
        for (int s = 0; s < 2; ++s) {
            f32x4 x1 = {0.f, 0.f, 0.f, 0.f}, x2 = {0.f, 0.f, 0.f, 0.f};
            const int r = n, d1 = 32 * s + 8 * (r >> 2) + (r & 3), d2 = d1 + 4;
            const bf16_t* w1 = A.WiqT + (size_t)(wave * 64 + d1) * 256 + 8 * g; const bf16_t* w2 = A.WiqT + (size_t)(wave * 64 + d2) * 256 + 8 * g;
#pragma unroll
            for (int kk = 0; kk < 8; ++kk) { const bf16x8 a1 = *(const bf16x8*)(w1 + kk * 32), a2 = *(const bf16x8*)(w2 + kk * 32);
                x1 = __builtin_amdgcn_mfma_f32_16x16x32_bf16(a1, qb[kk], x1, 0, 0, 0); x2 = __builtin_amdgcn_mfma_f32_16x16x32_bf16(a2, qb[kk], x2, 0, 0, 0); }
            u32x4 fr; fr.x = pk2bf(x1[0], x1[1]); fr.y = pk2bf(x1[2], x1[3]); fr.z = pk2bf(x2[0], x2[1]); fr.w = pk2bf(x2[2], x2[3]);
            *(LAS u32x4*)(lds + L_QF + ((wave * 2 + s) * 64 + lane) * 16) = fr;
        }
    }
    __syncthreads();
    bf16x8 qf[8][2];
#pragma unroll
    for (int h = 0; h < 8; ++h)
#pragma unroll
        for (int s = 0; s < 2; ++s) qf[h][s] = *(const LAS bf16x8*)(lds + L_QF + ((h * 2 + s) * 64 + lane) * 16);
    float wq[8];
    { const f32x4 w0 = *(const f32x4*)(A.WIDX + (trow + n) * 8), w1 = *(const f32x4*)(A.WIDX + (trow + n) * 8 + 4);
      wq[0] = w0[0]; wq[1] = w0[1]; wq[2] = w0[2]; wq[3] = w0[3]; wq[4] = w1[0]; wq[5] = w1[1]; wq[6] = w1[2]; wq[7] = w1[3]; }
    const int qpos = q0 + n, kmax = q0 + 15;
    const int nst = (kmax >> 8) + 1;
    const bf16_t* kbase = A.KIDXN + (size_t)b * L_ * 64;
    bf16x8 ka[2][2];
#pragma unroll
    for (int blk = 0; blk < 2; ++blk) { const int kb = 32 * wave + 16 * blk; if (kb <= kmax) { const bf16_t* kr = kbase + (size_t)(kb + n) * 64 + 8 * g; ka[blk][0] = *(const bf16x8*)kr; ka[blk][1] = *(const bf16x8*)(kr + 32); } }
    for (int j = 0, jf = 0; j < nst; ++j, jf = (jf == 2) ? 0 : jf + 1) {
        const float tau = TAU[n];
        bf16x8 kc[2][2];
#pragma unroll
        for (int blk = 0; blk < 2; ++blk) { kc[blk][0] = ka[blk][0]; kc[blk][1] = ka[blk][1];
            const int kbn = 256 * (j + 1) + 32 * wave + 16 * blk; if (kbn <= kmax) { const bf16_t* kr = kbase + (size_t)(kbn + n) * 64 + 8 * g; ka[blk][0] = *(const bf16x8*)kr; ka[blk][1] = *(const bf16x8*)(kr + 32); } }
#pragma unroll
        for (int blk = 0; blk < 2; ++blk) {
            const int kb = 256 * j + 32 * wave + 16 * blk;
            if (kb <= kmax) {
                const bf16x8 a0 = kc[blk][0], a1 = kc[blk][1];
                float sc[4] = {0.f, 0.f, 0.f, 0.f};
                f32x4 acc[8];
#pragma unroll
                for (int h = 0; h < 8; ++h) acc[h] = __builtin_amdgcn_mfma_f32_16x16x32_bf16(a0, qf[h][0], (f32x4){0.f, 0.f, 0.f, 0.f}, 0, 0, 0);
#pragma unroll
                for (int h = 0; h < 8; ++h) acc[h] = __builtin_amdgcn_mfma_f32_16x16x32_bf16(a1, qf[h][1], acc[h], 0, 0, 0);
                __builtin_amdgcn_sched_barrier(0);
#pragma unroll
                for (int h = 0; h < 8; ++h) {
#pragma unroll
                    for (int i = 0; i < 4; ++i) sc[i] = fmaf(wq[h], fmaxf(acc[h][i], 0.f), sc[i]); }
                bool ps[4]; int np = 0;
#pragma unroll
                for (int i = 0; i < 4; ++i) { const int key = kb + 4 * g + i; ps[i] = (key <= qpos) && (sc[i] > tau); np += ps[i] ? 1 : 0; }
                if (np) {
                    unsigned pos = __hip_atomic_fetch_add((unsigned*)&CNT[n], (unsigned)np, __ATOMIC_RELAXED, __HIP_MEMORY_SCOPE_WORKGROUP);
                    if (pos + np > THRESH) FLAG[jf] = 1u;
#pragma unroll
                    for (int i = 0; i < 4; ++i) if (ps[i]) { VAL[n * CAPS + pos] = sc[i]; IDXB[n * CAPS + pos] = (unsigned)(kb + 4 * g + i); ++pos; }
                }
            }
        }
        asm volatile("s_waitcnt lgkmcnt(0)\n\ts_barrier" ::: "memory");
        if (tx == 0) FLAG[jf == 0 ? 2 : jf - 1] = 0u;
        if (FLAG[jf]) {
#pragma unroll
            for (int qq = 0; qq < 2; ++qq) { const int q = wave * 2 + qq; const int c = (int)CNT[q];
                if (c > 384) { const float t = compact_query(VAL + q * CAPS, IDXB + q * CAPS, HIST, c, lane); if (lane == 0) { TAU[q] = t; CNT[q] = KSEL; } } }
            __syncthreads();
        }
    }
#pragma unroll
    for (int qq = 0; qq < 2; ++qq) { const int q = wave * 2 + qq; int c = (int)CNT[q];
        if (c > KSEL) { (void)compact_query(VAL + q * CAPS, IDXB + q * CAPS, HIST, c, lane); c = KSEL; }
        asm volatile("s_waitcnt lgkmcnt(0)" ::: "memory");
        HIST[lane * 4 + 0] = 0u; HIST[lane * 4 + 1] = 0u; HIST[lane * 4 + 2] = 0u; HIST[lane * 4 + 3] = 0u;
        asm volatile("s_waitcnt lgkmcnt(0)" ::: "memory");
        for (int e = lane; e < c; e += 64) { const unsigned k = IDXB[q * CAPS + e]; atomicOr((unsigned*)&HIST[k >> 5], 1u << (k & 31u)); }
        asm volatile("s_waitcnt lgkmcnt(0)" ::: "memory");
        unsigned wd[4]; int pc = 0;
#pragma unroll
        for (int i = 0; i < 4; ++i) { wd[i] = HIST[lane * 4 + i]; pc += (int)__builtin_popcount(wd[i]); }
        int incl = pc;
#pragma unroll
        for (int o = 1; o < 64; o <<= 1) { const int t = __shfl_up(incl, o); if (lane >= o) incl += t; }
        LAS int* out = (LAS int*)(lds + L_SIDX) + q * KSEL; int pos = incl - pc;
#pragma unroll
        for (int i = 0; i < 4; ++i) { unsigned w = wd[i]; while (w) { const int bit = __builtin_ctz(w); w &= w - 1u; out[pos++] = (lane * 4 + i) * 32 + bit; } }
#pragma unroll
        for (int e = lane; e < KSEL; e += 64) if (e >= c) out[e] = -1; }
    __syncthreads();
}
__device__ __forceinline__ void index_phase(const IdxArgs& A, LAS unsigned char* lds, int bx, int G) {
    if (G == 256) { for (int k = 0; k < 4; ++k) { const int b = k >> 1, qt = (k & 1) ? 511 - bx : bx; index_task(A, lds, b, qt * 16); } }
    else { for (int id = bx; id < 1024; id += G) index_task(A, lds, id >> 9, (id & 511) * 16); }
}
}
namespace sattn {
typedef short bf16x8 __attribute__((ext_vector_type(8)));
typedef short s16x4 __attribute__((ext_vector_type(4)));
typedef unsigned u32x2_t __attribute__((ext_vector_type(2)));
typedef __attribute__((ext_vector_type(4))) short v4i16_t;
__device__ __forceinline__ s16x4 vtr(LAS unsigned char* p) { return __builtin_bit_cast(s16x4, __builtin_amdgcn_ds_read_tr16_b64_v4i16((LAS v4i16_t*)p)); }
constexpr int QSPLIT = 12288;
__device__ __forceinline__ void dma16(const void* gsrc, unsigned lds_dst) { unsigned keep; asm volatile("s_mov_b32 %0, m0\n\ts_mov_b32 m0, %2\n\ts_nop 0\n\tglobal_load_lds_dwordx4 %1, off\n\ts_mov_b32 m0, %0" : "=&s"(keep) : "v"(gsrc), "s"(lds_dst) : "memory"); }
struct AArgs { const bf16_t* CKVN; bf16_t* Q0; bf16_t* Q1; };

__device__ __forceinline__ void attn_query(const AArgs& A, LAS unsigned char* tile, int t, int lane, const LAS int* sidx) {
    const int n = lane & 15, g = lane >> 4, b = t >> 13, l = t & 8191;
    const int nv = (l + 1 < 256) ? l + 1 : 256;
    const bf16_t* ckv = A.CKVN + (size_t)b * 8192 * 256;
    bf16_t* qrow = (t < QSPLIT) ? A.Q0 + (size_t)t * 2048 : A.Q1 + (size_t)(t - QSPLIT) * 2048;
    bf16x8 qf[8];
#pragma unroll
    for (int s = 0; s < 8; ++s) { qf[s] = (bf16x8){0, 0, 0, 0, 0, 0, 0, 0}; if (n < 8) qf[s] = *(const bf16x8*)(qrow + n * 256 + 32 * s + 8 * g); }
    f32x4 o[16];
#pragma unroll
    for (int c = 0; c < 16; ++c) o[c] = (f32x4){0.f, 0.f, 0.f, 0.f};
    float mrun = -3.0e38f, lsum = 0.f;
    const int nblk = (nv + 15) >> 4;
    asm volatile("s_waitcnt vmcnt(0) lgkmcnt(0)" ::: "memory");
#pragma unroll
    for (int s = 0; s < 8; ++s) asm volatile("" : "+v"(qf[s]));
#define ATT_ISSUE(J) do { const int k_ = (J) * 16 + n; int my_ = (k_ < nv) ? sidx[k_] : 0; if (my_ < 0) my_ = 0; const unsigned dst_ = tbase + ((J) & 1) * 8192u; \
        _Pragma("unroll") for (int i = 0; i < 8; ++i) { const int r = 2 * i + (lane >> 5); const int row = __shfl(my_, r); \
            const bf16_t* src = ckv + (size_t)row * 256 + (((lane & 31) ^ r) << 3); \
            dma16(src, dst_ + i * 1024u); } } while (0)
    const unsigned tbase = (unsigned)__builtin_amdgcn_readfirstlane((int)(unsigned)(size_t)tile);
    ATT_ISSUE(0);
    for (int j = 0; j < nblk; ++j) {
        LAS unsigned char* buf = tile + (j & 1) * 8192;
        if (j + 1 < nblk) { ATT_ISSUE(j + 1); asm volatile("s_waitcnt vmcnt(8)" ::: "memory"); }
        else asm volatile("s_waitcnt vmcnt(0)" ::: "memory");
        __builtin_amdgcn_sched_barrier(0);
        f32x4 s0 = {0.f, 0.f, 0.f, 0.f};
#pragma unroll
        for (int s = 0; s < 8; ++s) s0 = __builtin_amdgcn_mfma_f32_16x16x32_bf16(*(const LAS bf16x8*)(buf + n * 512 + (((4 * s + g) ^ n) << 4)), qf[s], s0, 0, 0, 0);
        const int k0 = j * 16 + 4 * g;
        float bm = -3.0e38f;
#pragma unroll
        for (int i = 0; i < 4; ++i) { if (k0 + i >= nv) s0[i] = -3.0e38f; bm = fmaxf(bm, s0[i]); }
        bm = fmaxf(bm, __shfl_xor(bm, 16)); bm = fmaxf(bm, __shfl_xor(bm, 32));
        const float mnew = fmaxf(mrun, bm), alpha = __expf(mrun - mnew); const bool grow = mnew > mrun; mrun = mnew;
        float p[4]; float ps = 0.f;
#pragma unroll
        for (int i = 0; i < 4; ++i) { p[i] = (k0 + i < nv) ? __expf(s0[i] - mnew) : 0.f; ps += p[i]; }
        lsum = lsum * alpha + ps;
        const s16x4 pf = __builtin_bit_cast(s16x4, (u32x2_t){pk2bf(p[0], p[1]), pk2bf(p[2], p[3])});
        if (__any(grow)) {
#pragma unroll
            for (int c = 0; c < 16; ++c) o[c] = o[c] * alpha;
        }
        const int q4 = (lane & 15) >> 2, p4 = lane & 3, r0 = 4 * g + q4;
#pragma unroll
        for (int c = 0; c < 16; ++c) { const int ch = 2 * c + (p4 >> 1);
            const s16x4 af = vtr(buf + r0 * 512 + ((ch ^ r0) << 4) + ((p4 & 1) << 3));
            o[c] = __builtin_amdgcn_mfma_f32_16x16x16bf16_1k(af, pf, o[c], 0, 0, 0); }
        asm volatile("s_waitcnt lgkmcnt(0)" ::: "memory");
    }
#undef ATT_ISSUE
    lsum += __shfl_xor(lsum, 16); lsum += __shfl_xor(lsum, 32);
    const float inv = 1.f / lsum;
    if (n < 8) {
#pragma unroll
        for (int c = 0; c < 16; ++c) { const f32x4 v = o[c] * inv; *(uint2*)(qrow + n * 256 + 16 * c + 4 * g) = make_uint2(pk2bf(v[0], v[1]), pk2bf(v[2], v[3])); }
    }
}
}
namespace dsa {
struct DArgs { idxk::IdxArgs I; sattn::AArgs A; unsigned* qword; };
__device__ __forceinline__ void dsa_task(const DArgs& D, LAS unsigned char* lds, int b, int q0) {
    idxk::index_task(D.I, lds, b, q0);
    int tx = threadIdx.x; asm volatile("" : "+v"(tx));
    const int wave = __builtin_amdgcn_readfirstlane(tx >> 6), lane = tx & 63;
#pragma unroll 1
    for (int qq = 0; qq < 2; ++qq) { const int q = 2 * wave + qq;
        sattn::attn_query(D.A, lds + wave * 16384, b * 8192 + q0 + q, lane, (const LAS int*)(lds + idxk::L_SIDX) + q * 256); }
    asm volatile("s_waitcnt vmcnt(0) lgkmcnt(0)" ::: "memory");
    __syncthreads();
}
__device__ __forceinline__ void dsa_queue(const DArgs& D, LAS unsigned char* lds, volatile LAS unsigned* slot) {
    for (;;) {
        if (threadIdx.x == 0) *slot = __hip_atomic_fetch_add(D.qword, 1u, __ATOMIC_RELAXED, __HIP_MEMORY_SCOPE_AGENT);
        __syncthreads();
        const unsigned id = *slot;
        __syncthreads();
        if (id >= 1024u) break;
        dsa_task(D, lds, (int)(id & 1u), (511 - (int)(id >> 1)) * 16);
    }
}
}
namespace dnet {
typedef short bf16x8 __attribute__((ext_vector_type(8)));
typedef unsigned u32x2_t __attribute__((ext_vector_type(2)));
typedef __attribute__((ext_vector_type(4))) short v4i16p_t;
__device__ __forceinline__ float bflo(unsigned w) { return __builtin_bit_cast(float, w << 16); }
__device__ __forceinline__ float bfhi(unsigned w) { return __builtin_bit_cast(float, w & 0xffff0000u); }
#define DPP_ADDF(v, CTRL) v += __builtin_bit_cast(float, __builtin_amdgcn_update_dpp(0, __builtin_bit_cast(int, v), CTRL, 0xF, 0xF, false))
__device__ __forceinline__ void conv_phase(const bf16_t* QKVP, bf16_t* QKVN, const float* convw, int gw, int NGW, int lane) {
    for (int it = gw; it < 1024 * 6; it += NGW) {
        const int slab = it % 6, tb = it / 6, t0 = tb * 16, ch = slab * 512 + lane * 8;
        float w[4][8];
#pragma unroll
        for (int i = 0; i < 4; ++i) { const f32x4 a = *(const f32x4*)(convw + (size_t)i * 3072 + ch), b = *(const f32x4*)(convw + (size_t)i * 3072 + ch + 4);
            w[i][0] = a[0]; w[i][1] = a[1]; w[i][2] = a[2]; w[i][3] = a[3]; w[i][4] = b[0]; w[i][5] = b[1]; w[i][6] = b[2]; w[i][7] = b[3]; }
        u32x4 r0 = {0u, 0u, 0u, 0u}, r1 = r0, r2 = r0;
        if ((t0 & 8191) != 0) { r0 = *(const u32x4*)(QKVP + (size_t)(t0 - 3) * 3072 + ch); r1 = *(const u32x4*)(QKVP + (size_t)(t0 - 2) * 3072 + ch); r2 = *(const u32x4*)(QKVP + (size_t)(t0 - 1) * 3072 + ch); }
        u32x4 rows[16];
#pragma unroll
        for (int tt = 0; tt < 16; ++tt) rows[tt] = *(const u32x4*)(QKVP + (size_t)(t0 + tt) * 3072 + ch);
#pragma unroll
        for (int tt = 0; tt < 16; ++tt) {
            const u32x4 r3 = rows[tt];
            float y[8];
#pragma unroll
            for (int e = 0; e < 4; ++e) {
                const float a0 = bflo(r0[e]) * w[0][2 * e] + bflo(r1[e]) * w[1][2 * e] + bflo(r2[e]) * w[2][2 * e] + bflo(r3[e]) * w[3][2 * e];
                const float a1 = bfhi(r0[e]) * w[0][2 * e + 1] + bfhi(r1[e]) * w[1][2 * e + 1] + bfhi(r2[e]) * w[2][2 * e + 1] + bfhi(r3[e]) * w[3][2 * e + 1];
                y[2 * e] = a0 / (1.f + __expf(-a0)); y[2 * e + 1] = a1 / (1.f + __expf(-a1)); }
            if (slab < 4) {
                float ss = 0.f;
#pragma unroll
                for (int e = 0; e < 8; ++e) ss += y[e] * y[e];
                DPP_ADDF(ss, 0xB1); DPP_ADDF(ss, 0x4E); DPP_ADDF(ss, 0x141); DPP_ADDF(ss, 0x140);
                const float rs = 1.f / sqrtf(ss + 1e-6f);
#pragma unroll
                for (int e = 0; e < 8; ++e) y[e] *= rs;
            }
            u32x4 o; o.x = pk2bf(y[0], y[1]); o.y = pk2bf(y[2], y[3]); o.z = pk2bf(y[4], y[5]); o.w = pk2bf(y[6], y[7]);
            *(u32x4*)(QKVN + (size_t)(t0 + tt) * 3072 + ch) = o;
            r0 = r1; r1 = r2; r2 = r3;
        }
    }
}
constexpr int PR = 272, L_QN = 0, L_KN = 64 * PR, L_V = 2 * 64 * PR, L_A = 3 * 64 * PR, L_SM = 4 * 64 * PR, L_TI = L_SM + 5 * 256, L_PEND = L_TI + 4 * 16 * 16 * 2;
struct PrepArgs { bf16_t* QKVN; const float* BETA; const float* G; bf16_t* W; bf16_t* ATT; float* GL; };
__device__ __forceinline__ float dpp_swap1(float v) { return __builtin_bit_cast(float, __builtin_amdgcn_update_dpp(0, __builtin_bit_cast(int, v), 0xB1, 0xF, 0xF, false)); }
__device__ __forceinline__ void prep_chunk(const PrepArgs& A, LAS unsigned char* lds, int cid) {
    int tx = threadIdx.x; asm volatile("" : "+v"(tx));
    const int wave = __builtin_amdgcn_readfirstlane(tx >> 6), lane = tx & 63, n = lane & 15, g = lane >> 4;
    const int nc = cid & 127, h = (cid >> 7) & 7, b = cid >> 10; const size_t t0 = (size_t)b * 8192 + nc * 64;
    LAS float* SM = (LAS float*)(lds + L_SM);
    for (int i = tx; i < 3 * 64 * 16; i += 512) { const int which = i / 1024, r = (i >> 4) & 63, c16 = i & 15;
        const u32x4 v = *(const u32x4*)(A.QKVN + (t0 + r) * 3072 + which * 1024 + h * 128 + c16 * 8);
        *(LAS u32x4*)(lds + which * 64 * PR + r * PR + c16 * 16) = v; }
    if (wave == 0) {
        float gg = A.G[(t0 + lane) * 8 + h]; const float be = A.BETA[(t0 + lane) * 8 + h];
#pragma unroll
        for (int o = 1; o < 64; o <<= 1) { const float t = __shfl_up(gg, o); if (lane >= o) gg += t; }
        const float gl = __shfl(gg, 63);
        SM[lane] = be; SM[64 + lane] = gg; SM[128 + lane] = __expf(gg); SM[192 + lane] = __expf(gl - gg);
        if (lane == 0) A.GL[cid] = __expf(gl);
    }
    __syncthreads();
#pragma unroll
    for (int q = 0; q < 4; ++q) {
        const int tl = wave * 4 + q, isq = tl >> 4, mi = (tl >> 2) & 3, nj = tl & 3;
        if (nj > mi) continue;
        f32x4 acc = {0.f, 0.f, 0.f, 0.f};
        const LAS unsigned char* ar = lds + (isq ? L_QN : L_KN) + (16 * mi + n) * PR + 16 * g; const LAS unsigned char* br = lds + L_KN + (16 * nj + n) * PR + 16 * g;
#pragma unroll
        for (int s = 0; s < 4; ++s) acc = __builtin_amdgcn_mfma_f32_16x16x32_bf16(*(const LAS bf16x8*)(ar + 64 * s), *(const LAS bf16x8*)(br + 64 * s), acc, 0, 0, 0);
        const int j = 16 * nj + n; const float gcj = SM[64 + j];
#pragma unroll
        for (int r = 0; r < 4; ++r) { const int i = 16 * mi + 4 * g + r; const float dec = __expf(fminf(SM[64 + i] - gcj, 0.f));
            if (isq) A.ATT[(size_t)cid * 4096 + i * 64 + j] = f2bfd((j <= i) ? acc[r] * 0.08838834764831845f * dec : 0.f);
            else *(LAS float*)(lds + L_A + i * PR + j * 4) = (j < i) ? SM[i] * acc[r] * dec : 0.f; }
    }
    for (int i = tx; i < 64 * 64; i += 512) { const int r = i >> 6, c = i & 63; if ((c >> 4) > (r >> 4)) { *(LAS float*)(lds + L_A + r * PR + c * 4) = 0.f; A.ATT[(size_t)cid * 4096 + r * 64 + c] = 0; } }
    __syncthreads();
    if (wave < 4 && lane < 16) {
        float tcol[16];
#pragma unroll
        for (int i = 0; i < 16; ++i) { float s = (i == lane) ? 1.f : 0.f;
#pragma unroll
            for (int j = 0; j < i; ++j) s = fmaf(-*(const LAS float*)(lds + L_A + (16 * wave + i) * PR + (16 * wave + j) * 4), tcol[j], s);
            tcol[i] = s; }
#pragma unroll
        for (int i = 0; i < 16; ++i) *(LAS bf16_t*)(lds + L_TI + ((wave * 16 + i) * 16 + lane) * 2) = f2bfd(tcol[i] - ((i == lane) ? 1.f : 0.f));
    }
    __syncthreads();
    {
        const int q4 = n >> 2, p4 = n & 3;
#pragma unroll 1
        for (int tt = 0; tt < 2; ++tt) {
            const int col0 = 32 * wave + 16 * tt; const bool isw = col0 >= 128;
            const LAS unsigned char* srcm = lds + (isw ? L_KN + (col0 - 128) * 2 : L_V + col0 * 2);
            typedef short s16x4_t __attribute__((ext_vector_type(4)));
            s16x4_t xb[4];
#pragma unroll
            for (int bb = 0; bb < 4; ++bb) {
                const s16x4_t r4 = __builtin_bit_cast(s16x4_t, __builtin_amdgcn_ds_read_tr16_b64_v4i16((LAS v4i16p_t*)(srcm + (16 * bb + 4 * g + q4) * PR + 8 * p4)));
                f32x4 acc;
#pragma unroll
                for (int r = 0; r < 4; ++r) { const int i = 16 * bb + 4 * g + r; float sc = SM[i]; if (isw) sc *= SM[128 + i]; acc[r] = __builtin_bit_cast(float, (unsigned)(unsigned short)r4[r] << 16) * sc; }
#pragma unroll
                for (int bp = 0; bp < bb; ++bp) { const f32x4 av = *(const LAS f32x4*)(lds + L_A + (16 * bb + n) * PR + (16 * bp + 4 * g) * 4);
                    u32x2_t w; w.x = pk2bf(-av[0], -av[1]); w.y = pk2bf(-av[2], -av[3]);
                    acc = __builtin_amdgcn_mfma_f32_16x16x16bf16_1k(__builtin_bit_cast(s16x4_t, w), xb[bp], acc, 0, 0, 0); }
                { u32x2_t w; w.x = pk2bf(acc[0], acc[1]); w.y = pk2bf(acc[2], acc[3]);
                  const s16x4_t ti = *(const LAS s16x4_t*)(lds + L_TI + ((bb * 16 + n) * 16 + 4 * g) * 2);
                  acc = __builtin_amdgcn_mfma_f32_16x16x16bf16_1k(ti, __builtin_bit_cast(s16x4_t, w), acc, 0, 0, 0); }
                { u32x2_t w; w.x = pk2bf(acc[0], acc[1]); w.y = pk2bf(acc[2], acc[3]); xb[bb] = __builtin_bit_cast(s16x4_t, w); }
                if (!isw) {
#pragma unroll
                    for (int r = 0; r < 4; ++r) A.QKVN[(t0 + 16 * bb + 4 * g + r) * 3072 + 2048 + h * 128 + col0 + n] = f2bfd(acc[r]);
                } else {
#pragma unroll
                    for (int r = 0; r < 4; ++r) A.W[((size_t)cid * 64 + 16 * bb + 4 * g + r) * 128 + (col0 - 128) + n] = f2bfd(acc[r]);
                }
            }
        }
    }
    for (int i = tx; i < 2 * 64 * 16; i += 512) { const int which = i >> 10, r = (i >> 4) & 63, c16 = i & 15;
        const u32x4 v = *(const LAS u32x4*)(lds + which * 64 * PR + r * PR + c16 * 16); const float f = which ? SM[192 + r] : SM[128 + r] * 0.08838834764831845f;
        u32x4 o; o.x = pk2bf(bflo(v.x) * f, bfhi(v.x) * f); o.y = pk2bf(bflo(v.y) * f, bfhi(v.y) * f); o.z = pk2bf(bflo(v.z) * f, bfhi(v.z) * f); o.w = pk2bf(bflo(v.w) * f, bfhi(v.w) * f);
        *(u32x4*)(A.QKVN + (t0 + r) * 3072 + which * 1024 + h * 128 + c16 * 8) = o; }
    __syncthreads();
}
__device__ __forceinline__ void prep_phase(const PrepArgs& A, LAS unsigned char* lds, int bx, int G) { for (int cid = bx; cid < 2048; cid += G) prep_chunk(A, lds, cid); }
}
namespace dnet {
typedef short s16x4 __attribute__((ext_vector_type(4)));
typedef __attribute__((ext_vector_type(4))) short v4i16_t;
__device__ __forceinline__ s16x4 vtr(const LAS unsigned char* p) { return __builtin_bit_cast(s16x4, __builtin_amdgcn_ds_read_tr16_b64_v4i16((LAS v4i16_t*)p)); }
constexpr int PA = 144, S_W = 0, S_QD = 64 * PR, S_KD = 2 * 64 * PR, S_U = 3 * 64 * PR, S_ATT = 4 * 64 * PR, S_OBUF = S_ATT + 64 * PA, S_END = S_OBUF + 64 * PR;
static_assert(S_END <= 131072, "scan LDS map");
struct ScanArgs { const bf16_t* QKVN; const bf16_t* W; const bf16_t* ATT; const float* GL; bf16_t* O; const float* onw; };
__device__ __forceinline__ bf16x8 frag2(const LAS unsigned char* p) { return *(const LAS bf16x8*)p; }
typedef unsigned u32x2 __attribute__((ext_vector_type(2)));
__device__ __forceinline__ int perm_half(int c, int hh) { const int k = 8 * c + 4 * hh; return (k < 16) ? 16 * (k >> 2) : 16 * ((k - 16) >> 2) + 8; }
__device__ __forceinline__ void scan_bh(const ScanArgs& A, LAS unsigned char* lds, int bh) {
    int tx = threadIdx.x; asm volatile("" : "+v"(tx));
    const int wave = __builtin_amdgcn_readfirstlane(tx >> 6), lane = tx & 63, n = lane & 15, g = lane >> 4, q4 = n >> 2, p4 = n & 3;
    const int b = bh >> 3, h = bh & 7, e0 = 16 * wave;
    const int sr = tx >> 3, sc = tx & 7;
    (void)sr; (void)sc;
    u32x4 pfA[9], pfB[9];
    auto issue = [&](u32x4 (&pf)[9], int nc_) { const int nc = nc_ < 127 ? nc_ : 127;
        const size_t t0 = (size_t)b * 8192 + nc * 64; const int cid = bh * 128 + nc;
#pragma unroll
        for (int i = 0; i < 2; ++i) { const int p = tx + 512 * i, r = p >> 4, c = p & 15;
            pf[i] = *(const u32x4*)(A.W + ((size_t)cid * 64 + r) * 128 + c * 8);
            pf[2 + i] = *(const u32x4*)(A.QKVN + (t0 + r) * 3072 + h * 128 + c * 8);
            pf[4 + i] = *(const u32x4*)(A.QKVN + (t0 + r) * 3072 + 1024 + h * 128 + c * 8);
            pf[6 + i] = *(const u32x4*)(A.QKVN + (t0 + r) * 3072 + 2048 + h * 128 + c * 8); }
        pf[8] = *(const u32x4*)(A.ATT + (size_t)cid * 4096 + tx * 8);
    };
    auto commit = [&](const u32x4 (&pf)[9]) {
#pragma unroll
        for (int i = 0; i < 2; ++i) { const int p = tx + 512 * i, r = p >> 4, c = p & 15, kg = c >> 2, cc = c & 3;
            LAS unsigned char* wq = lds + r * PR + kg * 64;
            *(LAS u32x2*)(wq + S_W + perm_half(cc, 0)) = (u32x2){pf[i].x, pf[i].y}; *(LAS u32x2*)(wq + S_W + perm_half(cc, 1)) = (u32x2){pf[i].z, pf[i].w};
            *(LAS u32x2*)(wq + S_QD + perm_half(cc, 0)) = (u32x2){pf[2 + i].x, pf[2 + i].y}; *(LAS u32x2*)(wq + S_QD + perm_half(cc, 1)) = (u32x2){pf[2 + i].z, pf[2 + i].w};
            *(LAS u32x4*)(lds + S_KD + r * PR + c * 16) = pf[4 + i]; *(LAS u32x4*)(lds + S_U + r * PR + c * 16) = pf[6 + i]; }
        { const int r = tx >> 3, c = tx & 7, kg = c >> 2, cc = c & 3; LAS unsigned char* wa = lds + S_ATT + r * PA + kg * 64;
          *(LAS u32x2*)(wa + perm_half(cc, 0)) = (u32x2){pf[8].x, pf[8].y}; *(LAS u32x2*)(wa + perm_half(cc, 1)) = (u32x2){pf[8].z, pf[8].w}; }
    };
    const float gl_lo = A.GL[bh * 128 + lane], gl_hi = A.GL[bh * 128 + 64 + lane];
    f32x4 S[8];
#pragma unroll
    for (int d = 0; d < 8; ++d) S[d] = (f32x4){0.f, 0.f, 0.f, 0.f};
    auto compute = [&](int nc) {
        const float gl = __builtin_bit_cast(float, (nc < 64) ? __builtin_amdgcn_readlane(__builtin_bit_cast(int, gl_lo), nc & 63) : __builtin_amdgcn_readlane(__builtin_bit_cast(int, gl_hi), nc & 63));
        const size_t t0 = (size_t)b * 8192 + nc * 64;
        bf16x8 sp[4];
#pragma unroll
        for (int s = 0; s < 4; ++s) { u32x4 w; w.x = pk2bf(S[2 * s][0], S[2 * s][1]); w.y = pk2bf(S[2 * s][2], S[2 * s][3]); w.z = pk2bf(S[2 * s + 1][0], S[2 * s + 1][1]); w.w = pk2bf(S[2 * s + 1][2], S[2 * s + 1][3]);
            sp[s] = __builtin_bit_cast(bf16x8, w); }
        f32x4 vn[4];
#pragma unroll
        for (int mt = 0; mt < 4; ++mt) {
            const s16x4 u4 = vtr(lds + S_U + (16 * mt + 4 * g + q4) * PR + (e0 + 4 * p4) * 2);
            f32x4 acc; acc[0] = __builtin_bit_cast(float, ((unsigned)(unsigned short)u4[0] << 16) ^ 0x80000000u); acc[1] = __builtin_bit_cast(float, ((unsigned)(unsigned short)u4[1] << 16) ^ 0x80000000u);
            acc[2] = __builtin_bit_cast(float, ((unsigned)(unsigned short)u4[2] << 16) ^ 0x80000000u); acc[3] = __builtin_bit_cast(float, ((unsigned)(unsigned short)u4[3] << 16) ^ 0x80000000u);
            const LAS unsigned char* wr = lds + S_W + (16 * mt + n) * PR + 16 * g;
#pragma unroll
            for (int s = 0; s < 4; ++s) acc = __builtin_amdgcn_mfma_f32_16x16x32_bf16(frag2(wr + 64 * s), sp[s], acc, 0, 0, 0);
            vn[mt] = acc;
        }
        bf16x8 vp[2];
#pragma unroll
        for (int s = 0; s < 2; ++s) { u32x4 w; w.x = pk2bf(vn[2 * s][0], vn[2 * s][1]); w.y = pk2bf(vn[2 * s][2], vn[2 * s][3]); w.z = pk2bf(vn[2 * s + 1][0], vn[2 * s + 1][1]); w.w = pk2bf(vn[2 * s + 1][2], vn[2 * s + 1][3]);
            w.x ^= 0x80008000u; w.y ^= 0x80008000u; w.z ^= 0x80008000u; w.w ^= 0x80008000u; vp[s] = __builtin_bit_cast(bf16x8, w); }
#pragma unroll
        for (int mt = 0; mt < 4; ++mt) {
            f32x4 acc = {0.f, 0.f, 0.f, 0.f};
            const LAS unsigned char* qr = lds + S_QD + (16 * mt + n) * PR + 16 * g; const LAS unsigned char* ar = lds + S_ATT + (16 * mt + n) * PA + 16 * g;
#pragma unroll
            for (int s = 0; s < 4; ++s) acc = __builtin_amdgcn_mfma_f32_16x16x32_bf16(frag2(qr + 64 * s), sp[s], acc, 0, 0, 0);
#pragma unroll
            for (int s = 0; s < 2; ++s) acc = __builtin_amdgcn_mfma_f32_16x16x32_bf16(frag2(ar + 64 * s), vp[s], acc, 0, 0, 0);
#pragma unroll
            for (int r = 0; r < 4; ++r) *(LAS bf16_t*)(lds + S_OBUF + (16 * mt + 4 * g + r) * PR + (e0 + n) * 2) = f2bfd(acc[r]);
        }
#pragma unroll
        for (int d = 0; d < 8; ++d) {
            f32x4 acc = S[d] * gl;
#pragma unroll
            for (int s = 0; s < 2; ++s) { const LAS unsigned char* kp = lds + S_KD + (32 * s + 4 * g + q4) * PR + (16 * d + 4 * p4) * 2;
                const s16x4 k0 = vtr(kp), k1 = vtr(kp + 16 * PR); const bf16x8 af = {k0[0], k0[1], k0[2], k0[3], k1[0], k1[1], k1[2], k1[3]};
                acc = __builtin_amdgcn_mfma_f32_16x16x32_bf16(af, vp[s], acc, 0, 0, 0); }
            S[d] = acc;
        }
    };
    auto flush = [&](int nc) {
        const int row = tx >> 3, c = tx & 7; const size_t t0 = (size_t)b * 8192 + nc * 64;
        const u32x4 v0 = *(const LAS u32x4*)(lds + S_OBUF + row * PR + c * 16), v1 = *(const LAS u32x4*)(lds + S_OBUF + row * PR + (c + 8) * 16);
        float f[16]; float ss = 0.f;
#pragma unroll
        for (int i = 0; i < 4; ++i) { const unsigned a = v0[i], d = v1[i]; f[2 * i] = bflo(a); f[2 * i + 1] = bfhi(a); f[8 + 2 * i] = bflo(d); f[8 + 2 * i + 1] = bfhi(d); }
#pragma unroll
        for (int i = 0; i < 16; ++i) ss += f[i] * f[i];
        DPP_ADDF(ss, 0xB1); DPP_ADDF(ss, 0x4E); DPP_ADDF(ss, 0x141);
        const float rs = 1.f / sqrtf(ss * (1.f / 128.f) + 1e-6f);
        const f32x4 w0 = *(const f32x4*)(A.onw + 8 * c), w1 = *(const f32x4*)(A.onw + 8 * c + 4), w2 = *(const f32x4*)(A.onw + 64 + 8 * c), w3 = *(const f32x4*)(A.onw + 64 + 8 * c + 4);
        u32x4 r0, r1;
        r0.x = pk2bf(f[0] * rs * w0[0], f[1] * rs * w0[1]); r0.y = pk2bf(f[2] * rs * w0[2], f[3] * rs * w0[3]); r0.z = pk2bf(f[4] * rs * w1[0], f[5] * rs * w1[1]); r0.w = pk2bf(f[6] * rs * w1[2], f[7] * rs * w1[3]);
        r1.x = pk2bf(f[8] * rs * w2[0], f[9] * rs * w2[1]); r1.y = pk2bf(f[10] * rs * w2[2], f[11] * rs * w2[3]); r1.z = pk2bf(f[12] * rs * w3[0], f[13] * rs * w3[1]); r1.w = pk2bf(f[14] * rs * w3[2], f[15] * rs * w3[3]);
        bf16_t* op = A.O + (t0 + row) * 1024 + h * 128; *(u32x4*)(op + c * 8) = r0; *(u32x4*)(op + (c + 8) * 8) = r1; };
    issue(pfA, 0); issue(pfB, 1); commit(pfA); __syncthreads();
#define LBAR() asm volatile("s_waitcnt lgkmcnt(0)\n\ts_barrier" ::: "memory")
    for (int nc = 0; nc < 128; nc += 2) {
        issue(pfA, nc + 2); compute(nc);
        LBAR(); flush(nc); commit(pfB); LBAR();
        issue(pfB, nc + 3); compute(nc + 1);
        LBAR(); flush(nc + 1); commit(pfA); LBAR();
    }
#undef LBAR
    __syncthreads();
}
__device__ __forceinline__ void scan_phase(const ScanArgs& A, LAS unsigned char* lds, int bx, int G) { for (int bh = bx; bh < 16; bh += G) scan_bh(A, lds, bh); }
}
namespace peer {
typedef __bf16 bf16x2_t __attribute__((ext_vector_type(2)));
__device__ __forceinline__ float dppf(float v, const int ctrl_unused) { return v; }
#define DPP_ADD(v, CTRL, RMASK) v += __builtin_bit_cast(float, __builtin_amdgcn_update_dpp(0, __builtin_bit_cast(int, v), CTRL, RMASK, 0xF, false))
__device__ __forceinline__ float wave_sum_u(float v) {
    DPP_ADD(v, 0xB1, 0xF); DPP_ADD(v, 0x4E, 0xF); DPP_ADD(v, 0x141, 0xF); DPP_ADD(v, 0x140, 0xF);
    DPP_ADD(v, 0x142, 0xA); DPP_ADD(v, 0x143, 0xC);
    return __builtin_bit_cast(float, __builtin_amdgcn_readlane(__builtin_bit_cast(int, v), 63));
}
__device__ __forceinline__ float dot2bf(unsigned a, unsigned b, float c) { return __builtin_amdgcn_fdot2_f32_bf16(__builtin_bit_cast(bf16x2_t, a), __builtin_bit_cast(bf16x2_t, b), c, false); }
__device__ __forceinline__ float dot16(const u32x4& a0, const u32x4& a1, const u32x4& h0, const u32x4& h1) {
    float s = 0.f;
#pragma unroll
    for (int i = 0; i < 4; ++i) { const unsigned x0 = a0[i], y0 = h0[i], x1 = a1[i], y1 = h1[i]; s = dot2bf(x0, y0, s); s = dot2bf(x1, y1, s); }
    return s;
}
__device__ __forceinline__ void axpy16(float (&acc)[16], float a, const u32x4& v0, const u32x4& v1) {
#pragma unroll
    for (int i = 0; i < 4; ++i) { acc[2 * i] = fmaf(a, __builtin_bit_cast(float, v0[i] << 16), acc[2 * i]); acc[2 * i + 1] = fmaf(a, __builtin_bit_cast(float, v0[i] & 0xffff0000u), acc[2 * i + 1]);
        acc[8 + 2 * i] = fmaf(a, __builtin_bit_cast(float, v1[i] << 16), acc[8 + 2 * i]); acc[8 + 2 * i + 1] = fmaf(a, __builtin_bit_cast(float, v1[i] & 0xffff0000u), acc[8 + 2 * i + 1]); }
}
constexpr float SU_ = 512.f, SV_ = 64.f;
__device__ __forceinline__ unsigned pk4fp8(f32x4 v, float s) { int p = __builtin_amdgcn_cvt_pk_fp8_f32(v[0] * s, v[1] * s, 0, false); p = __builtin_amdgcn_cvt_pk_fp8_f32(v[2] * s, v[3] * s, p, true); return (unsigned)p; }
__device__ __forceinline__ void convert_tables(const float* u, const float* v, unsigned char* ub, unsigned char* vb, int gt, int NGT) {
    for (int i = gt; i < 16384 * 1024 / 16; i += NGT) {
        const f32x4* us = (const f32x4*)u + 4 * (size_t)i; const f32x4* vs = (const f32x4*)v + 4 * (size_t)i;
        u32x4 o; o.x = pk4fp8(us[0], SU_); o.y = pk4fp8(us[1], SU_); o.z = pk4fp8(us[2], SU_); o.w = pk4fp8(us[3], SU_); ((u32x4*)ub)[i] = o;
        o.x = pk4fp8(vs[0], SV_); o.y = pk4fp8(vs[1], SV_); o.z = pk4fp8(vs[2], SV_); o.w = pk4fp8(vs[3], SV_); ((u32x4*)vb)[i] = o; }
}
struct PeerArgs { const unsigned char* Ub; const unsigned char* Vb; const bf16_t* H2; const float* X1; const float* MOD; const float* S; const float* fnw; float* out; };
__device__ __forceinline__ void route_token(const float* Srow, int lane, int& e_lo, int& e_hi, float& g_lo, float& g_hi);
constexpr float SH_ = 16.f;
typedef float f32x4m_t __attribute__((ext_vector_type(4)));
__device__ __forceinline__ long pk64(unsigned lo, unsigned hi) { return (long)(((unsigned long long)hi << 32) | (unsigned long long)lo); }
__device__ __forceinline__ float clamp8(float x) { return __builtin_amdgcn_fmed3f(x, -448.f, 448.f); }
__device__ __forceinline__ void expert_token(const PeerArgs& A, int t, int lane, LAS unsigned char* hl) {
    const int b = t >> 13, r16 = lane & 15, g = lane >> 4;
    const u32x4 h0 = *(const u32x4*)(A.H2 + (size_t)t * 1024 + 16 * lane), h1 = *(const u32x4*)(A.H2 + (size_t)t * 1024 + 16 * lane + 8);
    int e_lo, e_hi; float g_lo, g_hi; route_token(A.S + (size_t)(t & 8191) * 2048, lane, e_lo, e_hi, g_lo, g_hi);
    { u32x4 hq;
#pragma unroll
        for (int i = 0; i < 4; ++i) { const unsigned a = (i < 2) ? h0[2 * i] : h1[2 * i - 4], c = (i < 2) ? h0[2 * i + 1] : h1[2 * i - 3];
            int p = __builtin_amdgcn_cvt_pk_fp8_f32(clamp8(__builtin_bit_cast(float, a << 16) * SH_), clamp8(__builtin_bit_cast(float, a & 0xffff0000u) * SH_), 0, false);
            p = __builtin_amdgcn_cvt_pk_fp8_f32(clamp8(__builtin_bit_cast(float, c << 16) * SH_), clamp8(__builtin_bit_cast(float, c & 0xffff0000u) * SH_), p, true); hq[i] = (unsigned)p; }
        *(LAS u32x4*)(hl + 16 * lane) = hq; }
    u32x4 hb[16];
#pragma unroll
    for (int s = 0; s < 16; ++s) hb[s] = *(const LAS u32x4*)(hl + 64 * s + 16 * g);
    u32x4 ua[16];
    { const int er = __builtin_amdgcn_ds_bpermute(4 * r16, e_lo); const unsigned char* up = A.Ub + (size_t)er * 1024 + 16 * g;
#pragma unroll
        for (int s = 0; s < 16; ++s) ua[s] = *(const u32x4*)(up + 64 * s); }
    f32x4m_t D[8];
#pragma unroll
    for (int G = 0; G < 8; ++G) {
        const unsigned char* upn = A.Ub;
        if (G < 7) { const int er = __builtin_amdgcn_ds_bpermute(4 * ((((G + 1) & 3) * 16) + r16), (G + 1 < 4) ? e_lo : e_hi); upn = A.Ub + (size_t)er * 1024 + 16 * g; }
        f32x4m_t d0 = {0.f, 0.f, 0.f, 0.f}, d1 = {0.f, 0.f, 0.f, 0.f};
#pragma unroll
        for (int s = 0; s < 16; ++s) {
            d0 = __builtin_amdgcn_mfma_f32_16x16x32_fp8_fp8(pk64(ua[s].x, ua[s].y), pk64(hb[s].x, hb[s].y), d0, 0, 0, 0);
            d1 = __builtin_amdgcn_mfma_f32_16x16x32_fp8_fp8(pk64(ua[s].z, ua[s].w), pk64(hb[s].z, hb[s].w), d1, 0, 0, 0);
            if (G < 7) ua[s] = *(const u32x4*)(upn + 64 * s); }
        D[G] = d0 + d1;
    }
    const unsigned char* vb = A.Vb + 16 * lane;
    u32x4 vv[16];
#pragma unroll
    for (int j = 0; j < 16; ++j) { const int ej = __builtin_amdgcn_readlane(e_lo, j); vv[j] = *(const u32x4*)(vb + (size_t)ej * 1024); }
    const int Gs = r16 & 7;
    float a[4];
#pragma unroll
    for (int r = 0; r < 4; ++r) { float x = D[0][r];
#pragma unroll
        for (int G = 1; G < 8; ++G) x = (Gs == G) ? D[G][r] : x;
        const int src = 4 * (((Gs & 3) * 16) + 4 * g + r);
        const float gl = __builtin_bit_cast(float, __builtin_amdgcn_ds_bpermute(src, __builtin_bit_cast(int, g_lo))), gh = __builtin_bit_cast(float, __builtin_amdgcn_ds_bpermute(src, __builtin_bit_cast(int, g_hi)));
        x *= 1.f / (SU_ * SH_); a[r] = 0.5f * x * (1.f + erff(x * 0.70710678118654752f)) * ((Gs < 4) ? gl : gh) * (1.f / SV_); }
    f32x2h_t acc2[8];
#pragma unroll
    for (int i = 0; i < 8; ++i) acc2[i] = (f32x2h_t){0.f, 0.f};
#define PEER_ROW_(j, G_) { const float aj = __builtin_bit_cast(float, __builtin_amdgcn_readlane(__builtin_bit_cast(int, a[(j) & 3]), 16 * ((j) >> 2) + (G_))); const f32x2h_t a2 = {aj, aj}; \
        _Pragma("unroll") for (int i = 0; i < 4; ++i) { const int w = (int)vv[j][i]; const f32x2h_t lo2 = __builtin_amdgcn_cvt_pk_f32_fp8(w, false), hi2 = __builtin_amdgcn_cvt_pk_f32_fp8(w, true); \
            acc2[2 * i] = __builtin_elementwise_fma(a2, lo2, acc2[2 * i]); acc2[2 * i + 1] = __builtin_elementwise_fma(a2, hi2, acc2[2 * i + 1]); } }
#pragma unroll 1
    for (int G = 0; G < 7; ++G) {
        const int exn = (G + 1 < 4) ? e_lo : e_hi; const int sbn = ((G + 1) & 3) * 16;
#pragma unroll
        for (int j = 0; j < 16; ++j) { PEER_ROW_(j, G) const int ej = __builtin_amdgcn_readlane(exn, sbn + j); vv[j] = *(const u32x4*)(vb + (size_t)ej * 1024); }
    }
#pragma unroll
    for (int j = 0; j < 16; ++j) PEER_ROW_(j, 7)
#undef PEER_ROW_
    float acc[16];
#pragma unroll
    for (int i = 0; i < 8; ++i) { acc[2 * i] = acc2[i][0]; acc[2 * i + 1] = acc2[i][1]; }
    const float* xr = A.X1 + (size_t)t * 1024 + 16 * lane; const float* g2 = A.MOD + (size_t)b * 6144 + 5120 + 16 * lane; const float* fw = A.fnw + 16 * lane;
    float x2[16]; float ss = 0.f;
#pragma unroll
    for (int i = 0; i < 4; ++i) { const f32x4 xv = *(const f32x4*)(xr + 4 * i), gv = *(const f32x4*)(g2 + 4 * i);
#pragma unroll
        for (int k = 0; k < 4; ++k) { const float y = xv[k] + gv[k] * acc[4 * i + k]; x2[4 * i + k] = y; ss += y * y; } }
    ss = wave_sum_u(ss);
    const float rstd = 1.f / sqrtf(ss * (1.f / 1024.f) + 1e-6f);
    float* orow = A.out + (size_t)t * 1024 + 16 * lane;
#pragma unroll
    for (int i = 0; i < 4; ++i) { const f32x4 wv = *(const f32x4*)(fw + 4 * i); f32x4 o; o[0] = x2[4 * i] * rstd * wv[0]; o[1] = x2[4 * i + 1] * rstd * wv[1]; o[2] = x2[4 * i + 2] * rstd * wv[2]; o[3] = x2[4 * i + 3] * rstd * wv[3];
        *(f32x4*)(orow + 4 * i) = o; }
}
__device__ __forceinline__ void expert_phase(const PeerArgs& A, int half, int bx, int G, LAS unsigned char* lds) {
    int tx = threadIdx.x; asm volatile("" : "+v"(tx));
    const int wave = __builtin_amdgcn_readfirstlane(tx >> 6), lane = tx & 63;
    for (int t = wave * G + bx; t < 8192; t += 8 * G) expert_token(A, half * 8192 + t, lane, lds + wave * 1024);
}
}
namespace peer {
__device__ __forceinline__ unsigned sortable(float f) { const unsigned u = __builtin_bit_cast(unsigned, f); return (u & 0x80000000u) ? ~u : (u | 0x80000000u); }
#define DPP_UMAX(v, CTRL) { const unsigned t_ = (unsigned)__builtin_amdgcn_update_dpp(0, (int)(v), CTRL, 0xF, 0xF, false); v = (v) > t_ ? (v) : t_; }
#define DPP_FMAX(v, CTRL) { const float t_ = __builtin_bit_cast(float, __builtin_amdgcn_update_dpp(0, __builtin_bit_cast(int, v), CTRL, 0xF, 0xF, false)); v = fmaxf(v, t_); }
#define CE_(a, b) { const unsigned hi_ = (a) > (b) ? (a) : (b), lo_ = (a) > (b) ? (b) : (a); a = hi_; b = lo_; }
__device__ __forceinline__ void route_token(const float* Srow, int lane, int& e_lo, int& e_hi, float& g_lo, float& g_hi) {
    const int r = lane >> 4, i = lane & 15;
    int ic, jc; { const int c = lane; ic = (c < 16) ? 0 : (c < 24) ? 1 : (c < 29) ? 2 : (c < 33) ? 3 : (c < 36) ? 4 : (c < 38) ? 5 : (c < 40) ? 6 : (c < 42) ? 7 : (c - 34);
        const int st = (ic == 0) ? 0 : (ic == 1) ? 16 : (ic == 2) ? 24 : (ic == 3) ? 29 : (ic == 4) ? 33 : (ic == 5) ? 36 : (ic == 6) ? 38 : (ic == 7) ? 40 : (c); jc = c - st; if (ic > 15) { ic = 15; jc = 0; } }
    const int flat = ic * 16 + jc; const bool cvalid = lane < 50;
    e_lo = 0; e_hi = 0; g_lo = 0.f; g_hi = 0.f;
#pragma unroll 1
    for (int k = 0; k < 4; ++k) {
        const float* lp = Srow + (4 * k + r) * 128;
        const f32x4 va = *(const f32x4*)(lp + 8 * i), vb = *(const f32x4*)(lp + 8 * i + 4);
        unsigned k0 = (sortable(va[0]) & 0xFFFFFF80u) | (unsigned)(127 - (8 * i + 0)), k1 = (sortable(va[1]) & 0xFFFFFF80u) | (unsigned)(127 - (8 * i + 1)),
                 k2 = (sortable(va[2]) & 0xFFFFFF80u) | (unsigned)(127 - (8 * i + 2)), k3 = (sortable(va[3]) & 0xFFFFFF80u) | (unsigned)(127 - (8 * i + 3)),
                 k4 = (sortable(vb[0]) & 0xFFFFFF80u) | (unsigned)(127 - (8 * i + 4)), k5 = (sortable(vb[1]) & 0xFFFFFF80u) | (unsigned)(127 - (8 * i + 5)),
                 k6 = (sortable(vb[2]) & 0xFFFFFF80u) | (unsigned)(127 - (8 * i + 6)), k7 = (sortable(vb[3]) & 0xFFFFFF80u) | (unsigned)(127 - (8 * i + 7));
        CE_(k0, k1) CE_(k2, k3) CE_(k4, k5) CE_(k6, k7)  CE_(k0, k2) CE_(k1, k3) CE_(k4, k6) CE_(k5, k7)  CE_(k1, k2) CE_(k5, k6)
        CE_(k0, k4) CE_(k1, k5) CE_(k2, k6) CE_(k3, k7)  CE_(k2, k4) CE_(k3, k5)  CE_(k1, k2) CE_(k3, k4) CE_(k5, k6)
        unsigned sel = 0u;
#pragma unroll
        for (int it = 0; it < 16; ++it) { unsigned M = k0; DPP_UMAX(M, 0x128) DPP_UMAX(M, 0x124) DPP_UMAX(M, 0x122) DPP_UMAX(M, 0x121)
            sel = (i == it) ? M : sel; const bool own = (k0 == M);
            k0 = own ? k1 : k0; k1 = own ? k2 : k1; k2 = own ? k3 : k2; k3 = own ? k4 : k3; k4 = own ? k5 : k4; k5 = own ? k6 : k5; k6 = own ? k7 : k6; k7 = own ? 0u : k7; }
        const int sidx = 127 - (int)(sel & 127u); const float sval = lp[sidx];
#pragma unroll
        for (int hh = 0; hh < 2; ++hh) {
            const int h = 2 * k + hh, l0 = 32 * hh, l1 = 32 * hh + 16;
            const float ca = __shfl(sval, l0 + ic), cb = __shfl(sval, l1 + jc); const float cs = ca + cb;
            unsigned key = cvalid ? ((sortable(cs) & 0xFFFFFF00u) | (unsigned)(255 - flat)) : 0u; unsigned top = 0u;
#pragma unroll
            for (int it = 0; it < 16; ++it) { unsigned M = key; DPP_UMAX(M, 0x128) DPP_UMAX(M, 0x124) DPP_UMAX(M, 0x122) DPP_UMAX(M, 0x121)
                const unsigned m0 = (unsigned)__builtin_amdgcn_readlane((int)M, 0), m1 = (unsigned)__builtin_amdgcn_readlane((int)M, 16), m2 = (unsigned)__builtin_amdgcn_readlane((int)M, 32), m3 = (unsigned)__builtin_amdgcn_readlane((int)M, 48);
                const unsigned ma = m0 > m1 ? m0 : m1, mb = m2 > m3 ? m2 : m3, mm = ma > mb ? ma : mb;
                top = (lane == it) ? mm : top; key = (key == mm) ? 0u : key; }
            const int fl = 255 - (int)(top & 255u), ti = fl >> 4, tj = fl & 15;
            const float tv = __shfl(sval, l0 + ti) + __shfl(sval, l1 + tj);
            const int ex = __shfl(sidx, l0 + ti) * 128 + __shfl(sidx, l1 + tj);
            float mx = tv; DPP_FMAX(mx, 0x128) DPP_FMAX(mx, 0x124) DPP_FMAX(mx, 0x122) DPP_FMAX(mx, 0x121)
            float p = __expf(tv - mx), ps = p; DPP_ADD(ps, 0x128, 0xF); DPP_ADD(ps, 0x124, 0xF); DPP_ADD(ps, 0x122, 0xF); DPP_ADD(ps, 0x121, 0xF);
            const float gate = p / ps;
            const int ex_m = __shfl(ex, i); const float g_m = __shfl(gate, i);
            if (r == (h & 3)) { if (h < 4) { e_lo = ex_m; g_lo = g_m; } else { e_hi = ex_m; g_hi = g_m; } }
        }
    }
}
}
namespace ew {
using peer::wave_sum_u;
__device__ __forceinline__ void mod_phase(const float* c, const float* w_ada, const float* b_ada, float* MOD, LAS unsigned char* lds, int bx, int G) {
    int tx = threadIdx.x; asm volatile("" : "+v"(tx));
    LAS float* red = (LAS float*)lds;
    for (int it = bx; it < 192; it += G) {
        const int col = tx & 31, kg = tx >> 5, j = it * 32 + col; float a0 = 0.f, a1 = 0.f, b0 = 0.f, b1 = 0.f;
#pragma unroll 4
        for (int k = kg * 64; k < kg * 64 + 64; k += 2) { const float w0 = w_ada[(size_t)k * 6144 + j], w1 = w_ada[(size_t)(k + 1) * 6144 + j]; const float c00 = c[k], c01 = c[k + 1], c10 = c[1024 + k], c11 = c[1024 + k + 1];
            a0 = fmaf(c00 / (1.f + __expf(-c00)), w0, a0); b0 = fmaf(c01 / (1.f + __expf(-c01)), w1, b0); a1 = fmaf(c10 / (1.f + __expf(-c10)), w0, a1); b1 = fmaf(c11 / (1.f + __expf(-c11)), w1, b1); }
        red[(kg * 2 + 0) * 32 + col] = a0 + b0; red[(kg * 2 + 1) * 32 + col] = a1 + b1;
        __syncthreads();
        if (tx < 64) { const int bb = tx >> 5; float s = b_ada[j];
#pragma unroll
            for (int q = 0; q < 16; ++q) s += red[(q * 2 + bb) * 32 + col];
            MOD[(size_t)bb * 6144 + j] = s; }
        __syncthreads();
    }
}
__device__ __forceinline__ void modnorm_row(const f32x4 (&v)[4], const float* nw, const float* MOD, int which, bf16_t* H, int t, int lane) {
    const int b = t >> 13; const float* sh = MOD + (size_t)b * 6144 + (which ? 3072 : 0) + 16 * lane; const float* sc = sh + 1024; const float* wr = nw + 16 * lane;
    float ss = 0.f;
#pragma unroll
    for (int i = 0; i < 4; ++i) ss += v[i][0] * v[i][0] + v[i][1] * v[i][1] + v[i][2] * v[i][2] + v[i][3] * v[i][3];
    ss = wave_sum_u(ss); const float rstd = 1.f / sqrtf(ss * (1.f / 1024.f) + 1e-6f);
    float y[16];
#pragma unroll
    for (int i = 0; i < 4; ++i) { const f32x4 w = *(const f32x4*)(wr + 4 * i), s1 = *(const f32x4*)(sc + 4 * i), s0 = *(const f32x4*)(sh + 4 * i);
#pragma unroll
        for (int k = 0; k < 4; ++k) y[4 * i + k] = v[i][k] * rstd * w[k] * (1.f + s1[k]) + s0[k]; }
    u32x4 o0, o1; o0.x = pk2bf(y[0], y[1]); o0.y = pk2bf(y[2], y[3]); o0.z = pk2bf(y[4], y[5]); o0.w = pk2bf(y[6], y[7]); o1.x = pk2bf(y[8], y[9]); o1.y = pk2bf(y[10], y[11]); o1.z = pk2bf(y[12], y[13]); o1.w = pk2bf(y[14], y[15]);
    *(u32x4*)(H + (size_t)t * 1024 + 16 * lane) = o0; *(u32x4*)(H + (size_t)t * 1024 + 16 * lane + 8) = o1;
}
__device__ __forceinline__ void modnorm_phase(const float* X, const float* nw, const float* MOD, int which, bf16_t* H, int gw, int NGW, int lane) {
    for (int t = gw; t < 16384; t += 4 * NGW) {
        f32x4 v[4][4];
#pragma unroll
        for (int u = 0; u < 4; ++u) { const int tu = t + u * NGW; if (tu < 16384) {
#pragma unroll
            for (int i = 0; i < 4; ++i) v[u][i] = *(const f32x4*)(X + (size_t)tu * 1024 + 16 * lane + 4 * i); } }
#pragma unroll
        for (int u = 0; u < 4; ++u) { const int tu = t + u * NGW; if (tu < 16384) modnorm_row(v[u], nw, MOD, which, H, tu, lane); }
    }
}
struct SmallArgs { const bf16_t* RAW; const float *qw, *kvw, *kiw, *a_log, *dt_bias; bf16_t *QLATN, *CKVN, *KIDXN; float *BETA, *G, *WIDX; };
__device__ __forceinline__ void small_phase(const SmallArgs& A, int gw, int NGW, int lane) {
    for (int t = gw; t < 16384; t += NGW) {
        const bf16_t* r = A.RAW + (size_t)t * 768;
        const uint2 qp = *(const uint2*)(r + 4 * lane), kp = *(const uint2*)(r + 256 + 4 * lane);
        const float q0 = __builtin_bit_cast(float, qp.x << 16), q1 = __builtin_bit_cast(float, qp.x & 0xffff0000u), q2 = __builtin_bit_cast(float, qp.y << 16), q3 = __builtin_bit_cast(float, qp.y & 0xffff0000u);
        const float k0 = __builtin_bit_cast(float, kp.x << 16), k1 = __builtin_bit_cast(float, kp.x & 0xffff0000u), k2 = __builtin_bit_cast(float, kp.y << 16), k3 = __builtin_bit_cast(float, kp.y & 0xffff0000u);
        const float ki = bf2f(r[512 + lane]);
        const float sq = wave_sum_u(q0 * q0 + q1 * q1 + q2 * q2 + q3 * q3), skv = wave_sum_u(k0 * k0 + k1 * k1 + k2 * k2 + k3 * k3), ski = wave_sum_u(ki * ki);
        const float rq = 1.f / sqrtf(sq * (1.f / 256.f) + 1e-6f), rkv = 1.f / sqrtf(skv * (1.f / 256.f) + 1e-6f), rki = 1.f / sqrtf(ski * (1.f / 64.f) + 1e-6f);
        const f32x4 wq = *(const f32x4*)(A.qw + 4 * lane), wkv = *(const f32x4*)(A.kvw + 4 * lane);
        *(uint2*)(A.QLATN + (size_t)t * 256 + 4 * lane) = make_uint2(pk2bf(q0 * rq * wq[0], q1 * rq * wq[1]), pk2bf(q2 * rq * wq[2], q3 * rq * wq[3]));
        *(uint2*)(A.CKVN + (size_t)t * 256 + 4 * lane) = make_uint2(pk2bf(k0 * rkv * wkv[0], k1 * rkv * wkv[1]), pk2bf(k2 * rkv * wkv[2], k3 * rkv * wkv[3]));
        A.KIDXN[(size_t)t * 64 + lane] = f2bfd(ki * rki * A.kiw[lane]);
        if (lane < 8) { const float be = bf2f(r[576 + lane]), de = bf2f(r[584 + lane]), wi = bf2f(r[592 + lane]);
            A.BETA[(size_t)t * 8 + lane] = 1.f / (1.f + __expf(-be));
            const float xs = de + A.dt_bias[lane]; A.G[(size_t)t * 8 + lane] = -__expf(A.a_log[lane]) * (xs > 20.f ? xs : log1pf(__expf(xs)));
            A.WIDX[(size_t)t * 8 + lane] = wi * 0.04419417382415922f; }
    }
}
__device__ __forceinline__ void ogate_phase(const bf16_t* O, const bf16_t* Z, const float* ow, bf16_t* OG, int gw, int NGW, int lane) {
    for (int t = gw; t < 16384; t += NGW) {
        const u32x4 o0 = *(const u32x4*)(O + (size_t)t * 1024 + 16 * lane), o1 = *(const u32x4*)(O + (size_t)t * 1024 + 16 * lane + 8);
        const u32x4 z0 = *(const u32x4*)(Z + (size_t)t * 1024 + 16 * lane), z1 = *(const u32x4*)(Z + (size_t)t * 1024 + 16 * lane + 8);
        float ov[16], zv[16]; float ss = 0.f;
#pragma unroll
        for (int i = 0; i < 4; ++i) { const unsigned a = o0[i], b = o1[i], c = z0[i], d = z1[i];
            ov[2 * i] = __builtin_bit_cast(float, a << 16); ov[2 * i + 1] = __builtin_bit_cast(float, a & 0xffff0000u); ov[8 + 2 * i] = __builtin_bit_cast(float, b << 16); ov[8 + 2 * i + 1] = __builtin_bit_cast(float, b & 0xffff0000u);
            zv[2 * i] = __builtin_bit_cast(float, c << 16); zv[2 * i + 1] = __builtin_bit_cast(float, c & 0xffff0000u); zv[8 + 2 * i] = __builtin_bit_cast(float, d << 16); zv[8 + 2 * i + 1] = __builtin_bit_cast(float, d & 0xffff0000u); }
#pragma unroll
        for (int i = 0; i < 16; ++i) ss += ov[i] * ov[i];
        DPP_ADD(ss, 0xB1, 0xF); DPP_ADD(ss, 0x4E, 0xF); DPP_ADD(ss, 0x141, 0xF);
        const float rs = 1.f / sqrtf(ss * (1.f / 128.f) + 1e-6f); const float* w = ow + 16 * (lane & 7);
        float y[16];
#pragma unroll
        for (int i = 0; i < 16; ++i) y[i] = ov[i] * rs * w[i] * (zv[i] / (1.f + __expf(-zv[i])));
        u32x4 r0, r1; r0.x = pk2bf(y[0], y[1]); r0.y = pk2bf(y[2], y[3]); r0.z = pk2bf(y[4], y[5]); r0.w = pk2bf(y[6], y[7]); r1.x = pk2bf(y[8], y[9]); r1.y = pk2bf(y[10], y[11]); r1.z = pk2bf(y[12], y[13]); r1.w = pk2bf(y[14], y[15]);
        *(u32x4*)(OG + (size_t)t * 1024 + 16 * lane) = r0; *(u32x4*)(OG + (size_t)t * 1024 + 16 * lane + 8) = r1;
    }
}
}
constexpr int NTHR = 512;
constexpr int LDS_BYTES = 155648;
constexpr size_t CTL_ZERO_BYTES = 32768;
struct MArgs { NP P; NP P2; OP Q; unsigned* ctl; };

typedef const __attribute__((address_space(4))) MArgs* KAP;
typedef const __attribute__((address_space(4))) unsigned long long* KW;
#define KA(ka) KAP ka = (KAP)__builtin_amdgcn_kernarg_segment_ptr(); asm volatile("" : "+s"(ka))
template <class TT, class SS> __device__ __forceinline__ void ka_copy(TT& dst, SS src) { static_assert(sizeof(TT) % 8 == 0, "8-byte words");
    void** d = (void**)&dst; KW s = (KW)src;
#pragma unroll
    for (int i = 0; i < (int)(sizeof(TT) / 8); ++i) d[i] = (void*)(__attribute__((address_space(1))) void*)s[i]; }
#define LOADP(P, ka) NP P; ka_copy(P, &ka->P)
#define LOADQ(Q, ka) OP Q; ka_copy(Q, &ka->Q)
__global__ void __launch_bounds__(NTHR, 2) mega(MArgs a_unused) {
    typedef CfgFull C; typedef WsMap<C> W;
    extern __shared__ __attribute__((aligned(16))) unsigned char lds_raw[];
    LAS unsigned char* lds = (LAS unsigned char*)lds_raw;
    volatile LAS unsigned* MISC = (volatile LAS unsigned*)(lds + LDS_BYTES - 256);
    if (threadIdx.x < 64) MISC[threadIdx.x] = 0u;
    __syncthreads();
    XcdBarrier bar; { KA(ka); bar = xcd_barrier_post((unsigned*)(__attribute__((address_space(1))) unsigned*)(unsigned long long)ka->ctl, MISC + 8); }
    const int G = gridDim.x, NTall = G * NTHR, bx = blockIdx.x;
#define TIDS() int tx_ = threadIdx.x; asm volatile("" : "+v"(tx_)); const int wave = __builtin_amdgcn_readfirstlane(tx_ >> 6), lane = tx_ & 63; \
        const int tid = (wave * G + bx) * 64 + lane;
#define NAIVE_(WHICH, st) do { KA(ka_); NP PP_; ka_copy(PP_, &ka_->WHICH); TIDS(); const long n_ = stage_items<C>(st); const int words_ = stage_scr_words<C>(st); \
        int nt_ = NTall; if (words_) { const long cap_ = (long)(W::SCR_BYTES / (4 * (size_t)words_)); if (cap_ < nt_) nt_ = (int)cap_; } \
        if (tid < nt_) for (long it_ = tid; it_ < n_; it_ += nt_) run_item<C>(PP_, st, it_, tid, nt_); } while (0)
#define NAIVE(st) NAIVE_(P, st)
#define BAR() xcd_barrier(bar)
    { KA(ka); LOADP(P, ka); ew::mod_phase(P.c, P.w_ada, P.b_ada, P.MOD, lds, bx, G); }
    { KA(ka); LOADP(P, ka); LOADQ(Q, ka); TIDS(); (void)tid; p0_weights(P, Q, lds, bx * 8 + wave, G * 8, bx * NTHR + tx_, NTall, wave, lane); }
    BAR();
    { KA(ka); LOADP(P, ka); TIDS(); (void)tid; ew::modnorm_phase(P.x, P.norm1_w, P.MOD, 0, P.H1, bx * 8 + wave, G * 8, lane); }
    { KA(ka); LOADQ(Q, ka); const int c0 = bx < 40 ? bx : -1; WSched S0{0, c0, Q.wuk, Q.wuq, Q.wbT, Q.wuv, Q.skb, Q.pwq}; EpiG<FWeights> E{FWeights{Q.WcombT, Q.WcatT, Q.WsT}};
      pg8::gemm_phase<EpiG<FWeights>, WSched, false, true>(lds, pg8::Gemm{1024, 1024, 128}, S0, E);
      const int c1 = (bx >= 40 && bx < 72) ? bx - 40 : -1; WSched S1{1, c1, Q.wuk, Q.wuq, Q.wbT, Q.wuv, Q.skb, Q.pwq};
      pg8::gemm_phase<EpiG<FWeights>, WSched, false, true>(lds, pg8::Gemm{256, 2048, 256}, S1, E); }
    BAR();
    { KA(ka); LOADP(P, ka); LOADQ(Q, ka); GridSched S; S.init(64, 15, G, bx, P.H1, (size_t)256 * 1024 * 2, Q.WinT, (size_t)256 * 1024 * 2); EpiG<FInprojA> E{FInprojA{P.QKVP, Q.RAWB}};
      pg8::gemm_phase<EpiG<FInprojA>, GridSched, true, true>(lds, pg8::Gemm{1024, 1024, 1024}, S, E); }
    BAR();
    { KA(ka); LOADP(P, ka); LOADQ(Q, ka); TIDS(); (void)tid; ew::SmallArgs SA{Q.RAWB, P.q_norm_w, P.kv_norm_w, P.idx_k_norm_w, P.dn_a_log, P.dn_dt_bias, P.QLATN, P.CKVN, P.KIDXN, P.BETA, P.G, P.WIDX}; ew::small_phase(SA, bx * 8 + wave, G * 8, lane); }
    { KA(ka); LOADP(P, ka); TIDS(); (void)tid; dnet::conv_phase(P.QKVP, P.QKVN, P.dn_conv_w, bx * 8 + wave, G * 8, lane); }
    BAR();
    { KA(ka); LOADP(P, ka); dnet::PrepArgs PA{P.QKVN, P.BETA, P.G, P.W, P.ATT, P.GL}; dnet::prep_phase(PA, lds, bx, G); }
    { KA(ka); LOADP(P, ka); LOADQ(Q, ka); GridSched S; S.init(64, 8, G, bx, P.QLATN, (size_t)256 * 256 * 2, Q.WcombT, (size_t)256 * 256 * 2); EpiG<FStoreBf16> E{FStoreBf16{Q.QA0, 2048, Q.QA1, sattn::QSPLIT / 256}};
      pg8::gemm_phase<EpiG<FStoreBf16>, GridSched, false, true>(lds, pg8::Gemm{256, 256, 256}, S, E); }
    BAR();
    { KA(ka); LOADP(P, ka); dnet::ScanArgs SA{P.QKVN, P.W, P.ATT, P.GL, P.O, P.dn_onorm_w}; dnet::scan_phase(SA, lds, bx, G); }
    { KA(ka); LOADP(P, ka); LOADQ(Q, ka); dsa::DArgs DA{idxk::IdxArgs{P.QLATN, P.KIDXN, P.WIDX, Q.WiqT, nullptr}, sattn::AArgs{P.CKVN, Q.QA0, Q.QA1}, Q.qword};
      dsa::dsa_queue(DA, lds, MISC + 16); }
    BAR();
    { KA(ka); LOADP(P, ka); LOADQ(Q, ka); GridSched S; S.init(64, 12, G, bx, P.H1, (size_t)256 * 1024 * 2, Q.WinT + (size_t)3840 * 1024, (size_t)256 * 1024 * 2); EpiG<FInprojB> E{FInprojB{P.Z, P.GA, P.GB, P.O}};
      pg8::gemm_phase<EpiG<FInprojB>, GridSched, true, true>(lds, pg8::Gemm{1024, 1024, 1024}, S, E); }
    BAR();
    { KA(ka); LOADP(P, ka); LOADQ(Q, ka); GridSched S; S.init(64, 4, G, bx, P.Z, (size_t)256 * 1024 * 2, Q.WcatT, (size_t)256 * 3072 * 2); EpiG<FMerge<0>> E{FMerge<0>{P.GA, P.M}};
      pg8::gemm_phase<EpiG<FMerge<0>>, GridSched, false, true>(lds, pg8::Gemm{1024, 3072, 1024}, S, E); }
    { KA(ka); LOADP(P, ka); LOADQ(Q, ka); GridSched S; S.init(64, 4, G, bx, Q.QA0, (size_t)256 * 2048 * 2, Q.WcatT + 1024, (size_t)256 * 3072 * 2); S.A2 = (const char*)Q.QA1; S.splitA = sattn::QSPLIT / 256; EpiG<FMerge<1>> E{FMerge<1>{P.GB, P.M}};
      pg8::gemm_phase<EpiG<FMerge<1>>, GridSched, false, true>(lds, pg8::Gemm{2048, 3072, 2048}, S, E); }
    BAR();
    { KA(ka); LOADP(P, ka); LOADQ(Q, ka); GridSched S; S.init(64, 4, G, bx, P.M, (size_t)256 * 1024 * 2, Q.WoT, (size_t)256 * 1024 * 2); EpiG<FWo> E{FWo{P.MOD, P.x, P.X1}};
      pg8::gemm_phase<EpiG<FWo>, GridSched, false, true>(lds, pg8::Gemm{1024, 1024, 1024}, S, E); }
    BAR();
    { KA(ka); LOADP(P, ka); LOADQ(Q, ka); TIDS(); (void)tid; ew::modnorm_phase(P.X1, P.norm2_w, P.MOD, 1, P.H2, bx * 8 + wave, G * 8, lane);
      peer::convert_tables(P.peer_u, P.peer_v, Q.Ub, Q.Vb, bx * NTHR + tx_, NTall); }
    BAR();
#pragma unroll 1
    for (int half = 0; half < 2; ++half) {
        { KA(ka); LOADP(P, ka); LOADQ(Q, ka); GridSched S; S.init(32, 8, G, bx, P.H2 + (size_t)half * 8192 * 1024, (size_t)256 * 1024 * 2, Q.WsT, (size_t)256 * 1024 * 2); EpiG<FStoreF32> E{FStoreF32{Q.S, 2048}};
          pg8::gemm_phase<EpiG<FStoreF32>, GridSched, true, true>(lds, pg8::Gemm{1024, 1024, 1024}, S, E); }
        BAR();
        { KA(ka); LOADP(P, ka); LOADQ(Q, ka); peer::PeerArgs EA{Q.Ub, Q.Vb, P.H2, P.X1, P.MOD, Q.S, P.final_norm_w, P.out}; peer::expert_phase(EA, half, bx, G, lds); }
        if (half == 0) BAR();
    }
#undef NAIVE
#undef NAIVE_
#undef BAR
}
extern "C" void kernel_launch(void* const* d_in, const int* in_sizes, int n_in, void* d_out, int out_size, void* d_ws, size_t ws_size, hipStream_t stream) {
    typedef CfgFull C; typedef WsMap<C> W;
    static int grid = 0;
    if (grid == 0) {
        if (n_in != 26 || ws_size < X_END) { fprintf(stderr, "kernel_launch: need 26 inputs and %zu bytes of workspace, got %d / %zu\n", (size_t)X_END, n_in, ws_size); grid = -1; return; }
        int dev = 0, cus = 0, per_cu = 0;
        if (hipGetDevice(&dev) != hipSuccess || hipDeviceGetAttribute(&cus, hipDeviceAttributeMultiprocessorCount, dev) != hipSuccess) { grid = -1; return; }
        if (hipFuncSetAttribute((const void*)mega, hipFuncAttributeMaxDynamicSharedMemorySize, LDS_BYTES) != hipSuccess) { fprintf(stderr, "kernel_launch: hipFuncSetAttribute failed\n"); grid = -1; return; }
        if (hipOccupancyMaxActiveBlocksPerMultiprocessor(&per_cu, (const void*)mega, NTHR, LDS_BYTES) != hipSuccess || per_cu < 1) { fprintf(stderr, "kernel_launch: occupancy query says %d\n", per_cu); }
        (void)hipGetLastError();
        grid = cus;
    }
    if (grid < 0) return;
    hipMemsetAsync(d_ws, 0, CTL_ZERO_BYTES, stream);
    MArgs a{}; np_setup<C>(a.P, d_in, d_out, d_ws);
    char* ws = (char*)d_ws;
    a.Q.WinT = (bf16_t*)(ws + X_WINT); a.Q.WcatT = (bf16_t*)(ws + X_WCAT); a.Q.WoT = (bf16_t*)(ws + X_WOT); a.Q.WsT = (bf16_t*)(ws + X_WST); a.Q.WcombT = (bf16_t*)(ws + X_WCOMB); a.Q.WiqT = (bf16_t*)(ws + X_WIQT);
    a.Q.wuk = (bf16_t*)(ws + X_WUK); a.Q.wuq = (bf16_t*)(ws + X_WUQ); a.Q.wbT = (bf16_t*)(ws + X_WBT); a.Q.wuv = (bf16_t*)(ws + X_WUV); a.Q.skb = (bf16_t*)(ws + X_SKB); a.Q.pwq = (bf16_t*)(ws + X_PWQ);
    a.Q.S = (float*)(ws + W::A0 + (size_t)64 * 1048576);
    a.Q.Ub = (unsigned char*)(ws + W::A0); a.Q.Vb = (unsigned char*)(ws + W::A0 + (size_t)16 * 1048576);
    a.Q.EXPI2 = (int*)(ws + X_EXPI); a.Q.GATE2 = (float*)(ws + X_GATE);
    a.P.ATT = (bf16_t*)(ws + W::A0); a.P.W = (bf16_t*)(ws + W::A0 + (size_t)16 * 1048576);
    a.Q.QA0 = (bf16_t*)(ws + W::A0 + (size_t)48 * 1048576); a.Q.QA1 = (bf16_t*)(ws + W::A3); a.Q.qword = (unsigned*)d_ws + 6144;
    a.P.Z = (bf16_t*)(ws + W::A1); a.P.GA = (bf16_t*)(ws + W::A1 + (size_t)32 * 1048576); a.P.GB = (bf16_t*)(ws + W::A1 + (size_t)64 * 1048576);
    a.Q.RAWB = (bf16_t*)((char*)d_out + (size_t)32 * 1048576);
    a.P2 = a.P; a.P2.EXPI = a.Q.EXPI2; a.P2.GATE = a.Q.GATE2; a.P2.SCRP = (float*)((char*)d_out + W::d_SCR); a.P2.S = a.Q.S; a.ctl = (unsigned*)d_ws;
    hipLaunchKernelGGL(mega, dim3(grid), dim3(NTHR), LDS_BYTES, stream, a);
}
```

```cpp
#include <hip/hip_runtime.h>
#include <cstdio>
#include <cstdint>
#define HD __host__ __device__ __forceinline__
#ifndef HD
#define HD
#endif

typedef unsigned short bf16_t;
HD float bf2f(bf16_t v) { unsigned u = ((unsigned)v) << 16; float f; __builtin_memcpy(&f, &u, 4); return f; }
HD bf16_t f2bf(float f) { unsigned u; __builtin_memcpy(&u, &f, 4); u = (u + 0x7fffu + ((u >> 16) & 1u)) >> 16; return (bf16_t)u; }
HD float siluf(float x) { return x / (1.f + expf(-x)); }
HD float sigmf(float x) { return 1.f / (1.f + expf(-x)); }
HD float softplusf(float x) { return x > 20.f ? x : log1pf(expf(x)); }
HD float geluf(float x) { return 0.5f * x * (1.f + erff(x * 0.70710678118654752f)); }

struct CfgFull {
    static constexpr int D = 1024, B = 2, L = 8192;
    static constexpr int DNH = 8, DK = 128, DV = 128, CONV = 4, CH = 64;
    static constexpr int MH = 8, MDH = 128, MDV = 128, QL = 256, KVL = 256;
    static constexpr int IH = 8, ID = 64, TOPK_MAX = 256;
    static constexpr int PK = 128, PH = 8, PDQ = 256, PTK = 16;
};
struct CfgSmall {
    static constexpr int D = 64, B = 2, L = 512;
    static constexpr int DNH = 2, DK = 16, DV = 16, CONV = 4, CH = 64;
    static constexpr int MH = 2, MDH = 16, MDV = 16, QL = 32, KVL = 32;
    static constexpr int IH = 4, ID = 16, TOPK_MAX = 64;
    static constexpr int PK = 16, PH = 2, PDQ = 32, PTK = 4;
};
template <class C> struct Dims {
    static constexpr int T = C::B * C::L, HK = C::DNH * C::DK, HV = C::DNH * C::DV, QKVC = 2 * HK + HV;
    static constexpr int NCH = C::L / C::CH, NCHUNKS = C::B * C::DNH * NCH;
    static constexpr int TOPK = (C::TOPK_MAX < C::L / 4) ? C::TOPK_MAX : C::L / 4;
    static constexpr int PE = C::PK * C::PK, SLOTS = C::PH * C::PTK, PD2 = C::PDQ / 2;
    static constexpr int OFF_Q = 0, OFF_K = HK, OFF_V = 2 * HK, OFF_Z = 2 * HK + HV, OFF_B = OFF_Z + HV, OFF_A = OFF_B + C::DNH,
                         OFF_QL = OFF_A + C::DNH, OFF_CKV = OFF_QL + C::QL, OFF_KI = OFF_CKV + C::KVL, OFF_WI = OFF_KI + C::ID,
                         OFF_GA = OFF_WI + C::IH, OFF_GB = OFF_GA + C::D, IN_COLS = OFF_GB + C::D;
    static constexpr float EPS = 1e-6f;
};

struct NP {
    const float *x, *c, *w_ada, *b_ada, *norm1_w, *w_in, *dn_conv_w, *dn_a_log, *dn_dt_bias, *dn_onorm_w, *q_norm_w, *kv_norm_w, *idx_k_norm_w,
        *w_uq, *w_iq, *w_uk, *w_uv, *w_a_out, *w_b_out, *w_o, *norm2_w, *peer_w_q, *peer_sub_keys, *peer_u, *peer_v, *final_norm_w;
    float* out;
    float* MOD; bf16_t* H1; bf16_t* QKVP; bf16_t* QKVN; bf16_t* Z; bf16_t* GA; bf16_t* GB;
    float *BETA, *G, *GC, *GL, *QLATR, *CKVR, *KIDXR, *WIDX; bf16_t *QLATN, *CKVN, *KIDXN;
    float* AMAT; bf16_t* ATT; bf16_t* W; bf16_t* O; bf16_t* OG;
    float *QF, *QIDX; bf16_t* QABS; int* IDX; bf16_t* OLAT; bf16_t* OATT; bf16_t* M; float* X1; bf16_t* H2;
    float* PQ; int* EXPI; float* GATE; float* ACT; float* S; float* RAW;
    float* SCRP;
};
#define SCR(w) P.SCRP[(size_t)(w) * NT + tid]

template <class C> struct WsMap {
    typedef Dims<C> Dm;
    static constexpr size_t al(size_t x) { return (x + 255) & ~(size_t)255; }
    static constexpr size_t mx(size_t a, size_t b) { return a > b ? a : b; }
    static constexpr size_t SZ_QKV = al((size_t)Dm::T * Dm::QKVC * 2);
    static constexpr size_t S1a = al(mx((size_t)Dm::T * C::MH * C::KVL * 2, (size_t)Dm::T * C::D * 4));
    static constexpr size_t S1b = al(mx(mx((size_t)Dm::T * Dm::TOPK * 4, (size_t)Dm::T * C::MH * C::MDV * 2), (size_t)Dm::T * C::D * 2));
    static constexpr size_t RAW = al((size_t)Dm::T * C::QL * 4) + al((size_t)Dm::T * C::KVL * 4) + al((size_t)Dm::T * C::ID * 4);
    static constexpr size_t SZ_A1 = mx(mx(SZ_QKV, RAW), S1a + S1b);
    static constexpr size_t SZ_AAW = al((size_t)Dm::NCHUNKS * C::CH * C::CH * 4) + al((size_t)Dm::NCHUNKS * C::CH * C::CH * 2) + al((size_t)Dm::NCHUNKS * C::CH * C::DK * 2);
    static constexpr size_t SZ_QQ = al((size_t)Dm::T * C::MH * C::MDH * 4) + al((size_t)Dm::T * C::IH * C::ID * 4);
    static constexpr size_t SZ_ZGG = al((size_t)Dm::T * Dm::HV * 2) + 2 * al((size_t)Dm::T * C::D * 2);
    static constexpr size_t SZ_A0 = mx(mx(SZ_QKV, SZ_AAW), mx(SZ_QQ, SZ_ZGG));
    static constexpr size_t A1 = 1 << 20, A0 = A1 + SZ_A1, A2 = A0 + SZ_A0;
    static constexpr size_t o_MOD = 65536, o_BETA = A2, o_G = o_BETA + al((size_t)Dm::T * C::DNH * 4), o_GC = o_G + al((size_t)Dm::T * C::DNH * 4),
        o_GL = o_GC + al((size_t)Dm::T * C::DNH * 4), o_WIDX = o_GL + al((size_t)Dm::NCHUNKS * 4), o_QLATN = o_WIDX + al((size_t)Dm::T * C::IH * 4),
        o_CKVN = o_QLATN + al((size_t)Dm::T * C::QL * 2), o_KIDXN = o_CKVN + al((size_t)Dm::T * C::KVL * 2), A3 = o_KIDXN + al((size_t)Dm::T * C::ID * 2);
    static constexpr size_t SCR_BYTES = 16u << 20;
    static constexpr size_t o_PQ = A0;
    static constexpr size_t END = mx(A3 + SCR_BYTES, o_PQ + al((size_t)Dm::T * C::PH * C::PDQ * 4));
    static_assert(o_MOD + (size_t)C::B * 6 * C::D * 4 <= A1, "MOD in the first MiB");
    static constexpr size_t o_QLATR = A1, o_CKVR = o_QLATR + al((size_t)Dm::T * C::QL * 4), o_KIDXR = o_CKVR + al((size_t)Dm::T * C::KVL * 4);
    static constexpr size_t o_AMAT = A0, o_ATT = o_AMAT + al((size_t)Dm::NCHUNKS * C::CH * C::CH * 4), o_W = o_ATT + al((size_t)Dm::NCHUNKS * C::CH * C::CH * 2);
    static constexpr size_t o_QF = A0, o_QIDX = o_QF + al((size_t)Dm::T * C::MH * C::MDH * 4);
    static constexpr size_t o_QABS = A1, o_IDX = A1 + S1a;
    static constexpr size_t o_Z = A0, o_GA = o_Z + al((size_t)Dm::T * Dm::HV * 2), o_GB = o_GA + al((size_t)Dm::T * C::D * 2);
    static constexpr size_t o_OATT = o_IDX, o_X1 = A1, o_H2 = o_IDX;
    static constexpr size_t d_H1 = 0, d_O = al((size_t)Dm::T * C::D * 2), d_OG = 0, d_M = d_O;
    static constexpr size_t d_EXPI = 0, d_GATE = al((size_t)Dm::T * Dm::SLOTS * 4), d_ACT = 2 * d_GATE, d_SCR = (size_t)Dm::T * C::D * 2;
    static_assert(d_O + (size_t)Dm::T * Dm::HV * 2 <= (size_t)Dm::T * C::D * 4 && d_ACT + (size_t)Dm::T * Dm::SLOTS * 4 <= d_SCR, "d_out scratch");
};

template <class C> inline void np_setup(NP& P, void* const* d_in, void* d_out, void* d_ws) {
    typedef WsMap<C> W;
    const float** f = (const float**)&P.x;
    for (int i = 0; i < 26; ++i) f[i] = (const float*)d_in[i];
    char* ws = (char*)d_ws; char* dob = (char*)d_out;
    P.out = (float*)d_out;
    P.MOD = (float*)(ws + W::o_MOD); P.H1 = (bf16_t*)(dob + W::d_H1); P.QKVP = (bf16_t*)(ws + W::A0); P.QKVN = (bf16_t*)(ws + W::A1);
    P.Z = (bf16_t*)(ws + W::o_Z); P.GA = (bf16_t*)(ws + W::o_GA); P.GB = (bf16_t*)(ws + W::o_GB);
    P.BETA = (float*)(ws + W::o_BETA); P.G = (float*)(ws + W::o_G); P.GC = (float*)(ws + W::o_GC); P.GL = (float*)(ws + W::o_GL);
    P.QLATR = (float*)(ws + W::o_QLATR); P.CKVR = (float*)(ws + W::o_CKVR); P.KIDXR = (float*)(ws + W::o_KIDXR); P.WIDX = (float*)(ws + W::o_WIDX);
    P.QLATN = (bf16_t*)(ws + W::o_QLATN); P.CKVN = (bf16_t*)(ws + W::o_CKVN); P.KIDXN = (bf16_t*)(ws + W::o_KIDXN);
    P.AMAT = (float*)(ws + W::o_AMAT); P.ATT = (bf16_t*)(ws + W::o_ATT); P.W = (bf16_t*)(ws + W::o_W); P.O = (bf16_t*)(dob + W::d_O); P.OG = (bf16_t*)(dob + W::d_OG);
    P.QF = (float*)(ws + W::o_QF); P.QIDX = (float*)(ws + W::o_QIDX); P.QABS = (bf16_t*)(ws + W::o_QABS); P.IDX = (int*)(ws + W::o_IDX); P.OLAT = P.QABS;
    P.OATT = (bf16_t*)(ws + W::o_OATT); P.M = (bf16_t*)(dob + W::d_M); P.X1 = (float*)(ws + W::o_X1); P.H2 = (bf16_t*)(ws + W::o_H2);
    P.PQ = (float*)(ws + W::o_PQ); P.EXPI = (int*)(dob + W::d_EXPI); P.GATE = (float*)(dob + W::d_GATE); P.ACT = (float*)(dob + W::d_ACT);
    P.SCRP = (float*)(ws + W::A3); P.S = nullptr; P.RAW = (float*)(ws + W::A1);
}

enum { ST_MOD = 0, ST_H1, ST_INPROJ_A, ST_DSANORM, ST_CONV, ST_GC, ST_AMAT, ST_SOLVE, ST_SCALE, ST_SCAN, ST_Q, ST_QABS, ST_INDEX, ST_ATTN,
       ST_INPROJ_B, ST_QIDX, ST_SMALL, ST_OGATE, ST_OATT, ST_MERGE, ST_WO, ST_H2, ST_PEERQ, ST_ROUTE, ST_PACT, ST_POUT, ST_FINAL, ST_COUNT };

template <class C> HD void n_mod(const NP& P, int item) {
    const int D = C::D; const int b = item / (6 * D), j = item % (6 * D);
    float acc = P.b_ada[j];
    for (int i = 0; i < D; ++i) acc += siluf(P.c[b * D + i]) * P.w_ada[(size_t)i * 6 * D + j];
    P.MOD[item] = acc;
}
template <class C> HD void n_h1(const NP& P, int t) {
    const int D = C::D; const int b = t / C::L; const float* xr = P.x + (size_t)t * D;
    float ss = 0.f; for (int i = 0; i < D; ++i) ss += xr[i] * xr[i];
    const float rstd = 1.f / sqrtf(ss / D + Dims<C>::EPS);
    const float* sh = P.MOD + (size_t)b * 6 * D; const float* sc = sh + D;
    for (int i = 0; i < D; ++i) P.H1[(size_t)t * D + i] = f2bf(xr[i] * rstd * P.norm1_w[i] * (1.f + sc[i]) + sh[i]);
}
template <class C> HD void inproj_store(const NP& P, int t, int n, float v) {
    typedef Dims<C> Dm;
    if (n < Dm::OFF_Z) P.QKVP[(size_t)t * Dm::QKVC + n] = f2bf(v);
    else if (n < Dm::OFF_B) P.Z[(size_t)t * Dm::HV + (n - Dm::OFF_Z)] = f2bf(v);
    else if (n < Dm::OFF_A) P.BETA[(size_t)t * C::DNH + (n - Dm::OFF_B)] = sigmf(v);
    else if (n < Dm::OFF_QL) { const int h = n - Dm::OFF_A; P.G[(size_t)t * C::DNH + h] = -expf(P.dn_a_log[h]) * softplusf(v + P.dn_dt_bias[h]); }
    else if (n < Dm::OFF_CKV) P.QLATR[(size_t)t * C::QL + (n - Dm::OFF_QL)] = v;
    else if (n < Dm::OFF_KI) P.CKVR[(size_t)t * C::KVL + (n - Dm::OFF_CKV)] = v;
    else if (n < Dm::OFF_WI) P.KIDXR[(size_t)t * C::ID + (n - Dm::OFF_KI)] = v;
    else if (n < Dm::OFF_GA) P.WIDX[(size_t)t * C::IH + (n - Dm::OFF_WI)] = v * (1.f / sqrtf((float)C::IH) / sqrtf((float)C::ID));
    else if (n < Dm::OFF_GB) P.GA[(size_t)t * C::D + (n - Dm::OFF_GA)] = f2bf(v);
    else P.GB[(size_t)t * C::D + (n - Dm::OFF_GB)] = f2bf(v);
}
template <class C> HD void n_inproj(const NP& P, int item, int c0, int c1) {
    typedef Dims<C> Dm; const int ng = (c1 - c0) / 4; const int t = item / ng, n = c0 + 4 * (item % ng);
    float a0 = 0, a1 = 0, a2 = 0, a3 = 0; const bf16_t* hr = P.H1 + (size_t)t * C::D;
    for (int k = 0; k < C::D; ++k) { const float h = bf2f(hr[k]); const float* w = P.w_in + (size_t)k * Dm::IN_COLS + n; a0 += h * w[0]; a1 += h * w[1]; a2 += h * w[2]; a3 += h * w[3]; }
    inproj_store<C>(P, t, n, a0); inproj_store<C>(P, t, n + 1, a1); inproj_store<C>(P, t, n + 2, a2); inproj_store<C>(P, t, n + 3, a3);
}
template <class C> HD void n_dsanorm(const NP& P, int t) {
    typedef Dims<C> Dm;
    { const float* r = P.QLATR + (size_t)t * C::QL; float ss = 0; for (int i = 0; i < C::QL; ++i) ss += r[i] * r[i]; const float rs = 1.f / sqrtf(ss / C::QL + Dm::EPS);
      for (int i = 0; i < C::QL; ++i) P.QLATN[(size_t)t * C::QL + i] = f2bf(r[i] * rs * P.q_norm_w[i]); }
    { const float* r = P.CKVR + (size_t)t * C::KVL; float ss = 0; for (int i = 0; i < C::KVL; ++i) ss += r[i] * r[i]; const float rs = 1.f / sqrtf(ss / C::KVL + Dm::EPS);
      for (int i = 0; i < C::KVL; ++i) P.CKVN[(size_t)t * C::KVL + i] = f2bf(r[i] * rs * P.kv_norm_w[i]); }
    { const float* r = P.KIDXR + (size_t)t * C::ID; float ss = 0; for (int i = 0; i < C::ID; ++i) ss += r[i] * r[i]; const float rs = 1.f / sqrtf(ss / C::ID + Dm::EPS);
      for (int i = 0; i < C::ID; ++i) P.KIDXN[(size_t)t * C::ID + i] = f2bf(r[i] * rs * P.idx_k_norm_w[i]); }
}

template <class C> HD void n_small(const NP& P, int t) {
    typedef Dims<C> Dm; const float* r = P.RAW + (size_t)t * 768;
    { float ss = 0; for (int i = 0; i < C::QL; ++i) ss += r[i] * r[i]; const float rs = 1.f / sqrtf(ss / C::QL + Dm::EPS);
      for (int i = 0; i < C::QL; ++i) P.QLATN[(size_t)t * C::QL + i] = f2bf(r[i] * rs * P.q_norm_w[i]); }
    { const float* q = r + 256; float ss = 0; for (int i = 0; i < C::KVL; ++i) ss += q[i] * q[i]; const float rs = 1.f / sqrtf(ss / C::KVL + Dm::EPS);
      for (int i = 0; i < C::KVL; ++i) P.CKVN[(size_t)t * C::KVL + i] = f2bf(q[i] * rs * P.kv_norm_w[i]); }
    { const float* q = r + 512; float ss = 0; for (int i = 0; i < C::ID; ++i) ss += q[i] * q[i]; const float rs = 1.f / sqrtf(ss / C::ID + Dm::EPS);
      for (int i = 0; i < C::ID; ++i) P.KIDXN[(size_t)t * C::ID + i] = f2bf(q[i] * rs * P.idx_k_norm_w[i]); }
    for (int h = 0; h < C::DNH; ++h) { P.BETA[(size_t)t * C::DNH + h] = sigmf(r[576 + h]); P.G[(size_t)t * C::DNH + h] = -expf(P.dn_a_log[h]) * softplusf(r[584 + h] + P.dn_dt_bias[h]); }
    for (int h = 0; h < C::IH; ++h) P.WIDX[(size_t)t * C::IH + h] = r[592 + h] * (1.f / sqrtf((float)C::IH) / sqrtf((float)C::ID));
}
template <class C> HD float conv_at(const NP& P, int t, int ch) {
    typedef Dims<C> Dm; const int l = t % C::L; float acc = 0.f;
    for (int i = 0; i < C::CONV; ++i) { const int ll = l - (C::CONV - 1) + i; if (ll >= 0) acc += bf2f(P.QKVP[(size_t)(t - (C::CONV - 1) + i) * Dm::QKVC + ch]) * P.dn_conv_w[(size_t)i * Dm::QKVC + ch]; }
    return siluf(acc);
}
template <class C> HD void n_conv(const NP& P, int item) {
    typedef Dims<C> Dm; const int which = item % 3, h = (item / 3) % C::DNH, t = item / (3 * C::DNH);
    const int dim = (which == 2) ? C::DV : C::DK; const int ch0 = (which == 0 ? 0 : which == 1 ? Dm::HK : 2 * Dm::HK) + h * dim;
    float rs = 1.f;
    if (which < 2) { float ss = 0.f; for (int d = 0; d < dim; ++d) { const float v = conv_at<C>(P, t, ch0 + d); ss += v * v; } rs = 1.f / sqrtf(ss + Dm::EPS); }
    for (int d = 0; d < dim; ++d) P.QKVN[(size_t)t * Dm::QKVC + ch0 + d] = f2bf(conv_at<C>(P, t, ch0 + d) * rs);
}
template <class C> HD void n_gc(const NP& P, int item) {
    typedef Dims<C> Dm; const int n = item % Dm::NCH, h = (item / Dm::NCH) % C::DNH, b = item / (Dm::NCH * C::DNH);
    float s = 0.f; for (int i = 0; i < C::CH; ++i) { const size_t t = (size_t)b * C::L + n * C::CH + i; s += P.G[t * C::DNH + h]; P.GC[t * C::DNH + h] = s; }
    P.GL[item] = expf(s);
}
template <class C> HD void n_amat(const NP& P, int item) {
    typedef Dims<C> Dm; const int j = item % C::CH, i = (item / C::CH) % C::CH, cid = item / (C::CH * C::CH);
    const int n = cid % Dm::NCH, h = (cid / Dm::NCH) % C::DNH, b = cid / (Dm::NCH * C::DNH);
    const size_t ti = (size_t)b * C::L + n * C::CH + i, tj = (size_t)b * C::L + n * C::CH + j;
    float a = 0.f, at = 0.f;
    if (j <= i) {
        const bf16_t* ki = P.QKVN + ti * Dm::QKVC + Dm::HK + h * C::DK; const bf16_t* kj = P.QKVN + tj * Dm::QKVC + Dm::HK + h * C::DK; const bf16_t* qi = P.QKVN + ti * Dm::QKVC + h * C::DK;
        float kk = 0.f, qk = 0.f; for (int d = 0; d < C::DK; ++d) { const float kjd = bf2f(kj[d]); kk += bf2f(ki[d]) * kjd; qk += bf2f(qi[d]) * kjd; }
        const float dec = expf(P.GC[ti * C::DNH + h] - P.GC[tj * C::DNH + h]);
        if (j < i) a = P.BETA[ti * C::DNH + h] * kk * dec;
        at = qk * (1.f / sqrtf((float)C::DK)) * dec;
    }
    P.AMAT[(size_t)cid * C::CH * C::CH + i * C::CH + j] = a;
    P.ATT[(size_t)cid * C::CH * C::CH + i * C::CH + j] = f2bf(at);
}
template <class C> HD void n_solve(const NP& P, int item, int tid, int NT) {
    typedef Dims<C> Dm; const int NC = C::DV + C::DK; const int col = item % NC, cid = item / NC;
    const int n = cid % Dm::NCH, h = (cid / Dm::NCH) % C::DNH, b = cid / (Dm::NCH * C::DNH);
    const float* A = P.AMAT + (size_t)cid * C::CH * C::CH;
    for (int i = 0; i < C::CH; ++i) {
        const size_t t = (size_t)b * C::L + n * C::CH + i; const float beta = P.BETA[t * C::DNH + h];
        float r;
        if (col < C::DV) r = bf2f(P.QKVN[t * Dm::QKVC + 2 * Dm::HK + h * C::DV + col]) * beta;
        else r = bf2f(P.QKVN[t * Dm::QKVC + Dm::HK + h * C::DK + (col - C::DV)]) * beta * expf(P.GC[t * C::DNH + h]);
        for (int j = 0; j < i; ++j) r -= A[i * C::CH + j] * SCR(j);
        SCR(i) = r;
    }
    for (int i = 0; i < C::CH; ++i) {
        const size_t t = (size_t)b * C::L + n * C::CH + i;
        if (col < C::DV) P.QKVN[t * Dm::QKVC + 2 * Dm::HK + h * C::DV + col] = f2bf(SCR(i));
        else P.W[((size_t)cid * C::CH + i) * C::DK + (col - C::DV)] = f2bf(SCR(i));
    }
}
template <class C> HD void n_scale(const NP& P, int item) {
    typedef Dims<C> Dm; const int h = item % C::DNH; const size_t t = item / C::DNH; const int l = (int)(t % C::L), b = (int)(t / C::L), n = l / C::CH;
    const float gc = P.GC[t * C::DNH + h]; const size_t tl = (size_t)b * C::L + n * C::CH + C::CH - 1; const float gl = P.GC[tl * C::DNH + h];
    const float fq = expf(gc) * (1.f / sqrtf((float)C::DK)), fk = expf(gl - gc);
    bf16_t* q = P.QKVN + t * Dm::QKVC + h * C::DK; bf16_t* k = P.QKVN + t * Dm::QKVC + Dm::HK + h * C::DK;
    for (int d = 0; d < C::DK; ++d) { q[d] = f2bf(bf2f(q[d]) * fq); k[d] = f2bf(bf2f(k[d]) * fk); }
}
template <class C> HD void n_scan(const NP& P, int item, int tid, int NT) {
    typedef Dims<C> Dm; const int e = item % C::DV, h = (item / C::DV) % C::DNH, b = item / (C::DV * C::DNH);
    for (int d = 0; d < C::DK; ++d) SCR(d) = 0.f;
    for (int n = 0; n < Dm::NCH; ++n) {
        const int cid = (b * C::DNH + h) * Dm::NCH + n; const size_t t0 = (size_t)b * C::L + n * C::CH;
        const bf16_t* Wc = P.W + (size_t)cid * C::CH * C::DK; const bf16_t* At = P.ATT + (size_t)cid * C::CH * C::CH;
        for (int r = 0; r < C::CH; ++r) { float acc = bf2f(P.QKVN[(t0 + r) * Dm::QKVC + 2 * Dm::HK + h * C::DV + e]);
            for (int d = 0; d < C::DK; ++d) acc -= bf2f(Wc[r * C::DK + d]) * SCR(d);
            SCR(C::DK + r) = acc; }
        for (int r = 0; r < C::CH; ++r) { float o = 0.f; const bf16_t* qd = P.QKVN + (t0 + r) * Dm::QKVC + h * C::DK;
            for (int d = 0; d < C::DK; ++d) o += bf2f(qd[d]) * SCR(d);
            for (int s = 0; s <= r; ++s) o += bf2f(At[r * C::CH + s]) * SCR(C::DK + s);
            P.O[(t0 + r) * Dm::HV + h * C::DV + e] = f2bf(o); }
        const float gl = P.GL[cid];
        for (int d = 0; d < C::DK; ++d) { float acc = SCR(d) * gl;
            for (int r = 0; r < C::CH; ++r) acc += bf2f(P.QKVN[(t0 + r) * Dm::QKVC + Dm::HK + h * C::DK + d]) * SCR(C::DK + r);
            SCR(d) = acc; }
    }
}
template <class C> HD void n_ogate(const NP& P, int item) {
    typedef Dims<C> Dm; const int h = item % C::DNH; const size_t t = item / C::DNH; const bf16_t* o = P.O + t * Dm::HV + h * C::DV;
    float ss = 0.f; for (int d = 0; d < C::DV; ++d) { const float v = bf2f(o[d]); ss += v * v; } const float rs = 1.f / sqrtf(ss / C::DV + Dm::EPS);
    for (int d = 0; d < C::DV; ++d) P.OG[t * Dm::HV + h * C::DV + d] = f2bf(bf2f(o[d]) * rs * P.dn_onorm_w[d] * siluf(bf2f(P.Z[t * Dm::HV + h * C::DV + d])));
}
template <class C> HD void n_q(const NP& P, int item) {
    const int NJ = C::MH * C::MDH + C::IH * C::ID; const int j = item % NJ; const size_t t = item / NJ; const bf16_t* ql = P.QLATN + t * C::QL;
    float acc = 0.f;
    if (j < C::MH * C::MDH) { for (int k = 0; k < C::QL; ++k) acc += bf2f(ql[k]) * P.w_uq[(size_t)k * C::MH * C::MDH + j]; P.QF[t * C::MH * C::MDH + j] = acc; }
    else { const int jj = j - C::MH * C::MDH; for (int k = 0; k < C::QL; ++k) acc += bf2f(ql[k]) * P.w_iq[(size_t)k * C::IH * C::ID + jj]; P.QIDX[t * C::IH * C::ID + jj] = acc; }
}
template <class C> HD void n_qabs(const NP& P, int item) {
    const int c = item % C::KVL, h = (item / C::KVL) % C::MH; const size_t t = item / (C::KVL * C::MH);
    float acc = 0.f; for (int d = 0; d < C::MDH; ++d) acc += P.QF[t * C::MH * C::MDH + h * C::MDH + d] * P.w_uk[((size_t)c * C::MH + h) * C::MDH + d];
    P.QABS[(t * C::MH + h) * C::KVL + c] = f2bf(acc * (1.f / sqrtf((float)C::MDH)));
}
template <class C> HD void n_index(const NP& P, int t, int tid, int NT) {
    typedef Dims<C> Dm; const int K = Dm::TOPK; const int l = t % C::L, b = t / C::L; int cnt = 0;
    const float* qi = P.QIDX + (size_t)t * C::IH * C::ID; const float* wi = P.WIDX + (size_t)t * C::IH;
#define HV_(i) SCR(i)
#define HI_(i) SCR(K + (i))
#define WORSE(v1, i1, v2, i2) ((v1) < (v2) || ((v1) == (v2) && (i1) > (i2)))
    for (int s = 0; s <= l; ++s) {
        const bf16_t* kr = P.KIDXN + ((size_t)b * C::L + s) * C::ID; float sc = 0.f;
        for (int h = 0; h < C::IH; ++h) { float dot = 0.f; for (int d = 0; d < C::ID; ++d) dot += qi[h * C::ID + d] * bf2f(kr[d]); sc += wi[h] * (dot > 0.f ? dot : 0.f); }
        const float fs = (float)s;
        if (cnt < K) {
            int i = cnt++; HV_(i) = sc; HI_(i) = fs;
            while (i > 0) { const int p = (i - 1) >> 1; const float pv = HV_(p), pi = HI_(p), cv = HV_(i), ci = HI_(i);
                if (WORSE(cv, ci, pv, pi)) { HV_(p) = cv; HI_(p) = ci; HV_(i) = pv; HI_(i) = pi; i = p; } else break; }
        } else if (HV_(0) < sc) {
            int i = 0; HV_(0) = sc; HI_(0) = fs;
            for (;;) { const int a = 2 * i + 1, c2 = a + 1; int w = i; float wv = HV_(i), wx = HI_(i);
                if (a < K) { const float av = HV_(a), ai = HI_(a); if (WORSE(av, ai, wv, wx)) { w = a; wv = av; wx = ai; } }
                if (c2 < K) { const float bv = HV_(c2), bi = HI_(c2); if (WORSE(bv, bi, wv, wx)) { w = c2; wv = bv; wx = bi; } }
                if (w == i) break; const float tv = HV_(i), ti = HI_(i); HV_(i) = wv; HI_(i) = wx; HV_(w) = tv; HI_(w) = ti; i = w; }
        }
    }
    for (int k = 0; k < K; ++k) P.IDX[(size_t)t * K + k] = (k < cnt) ? (int)HI_(k) : -1;
#undef HV_
#undef HI_
#undef WORSE
}
template <class C> HD void n_attn(const NP& P, int item, int tid, int NT) {
    typedef Dims<C> Dm; const int K = Dm::TOPK; const int h = item % C::MH; const size_t t = item / C::MH; const int b = (int)(t / C::L);
    const int* idx = P.IDX + t * K; bf16_t* qa = P.QABS + (t * C::MH + h) * C::KVL;
    int nv = 0; float m = -3.0e38f;
    for (int k = 0; k < K; ++k) { const int s = idx[k]; if (s < 0) break; ++nv;
        const bf16_t* kv = P.CKVN + ((size_t)b * C::L + s) * C::KVL; float lg = 0.f; for (int c = 0; c < C::KVL; ++c) lg += bf2f(qa[c]) * bf2f(kv[c]);
        SCR(k) = lg; m = lg > m ? lg : m; }
    float sum = 0.f; for (int k = 0; k < nv; ++k) { const float p = expf(SCR(k) - m); SCR(k) = p; sum += p; }
    const float inv = 1.f / sum;
    for (int c = 0; c < C::KVL; ++c) { float acc = 0.f; for (int k = 0; k < nv; ++k) acc += SCR(k) * bf2f(P.CKVN[((size_t)b * C::L + idx[k]) * C::KVL + c]);
        SCR(K + c) = acc * inv; }
    for (int c = 0; c < C::KVL; ++c) qa[c] = f2bf(SCR(K + c));
}
template <class C> HD void n_oatt(const NP& P, int item) {
    const int d = item % C::MDV, h = (item / C::MDV) % C::MH; const size_t t = item / (C::MDV * C::MH);
    float acc = 0.f; for (int c = 0; c < C::KVL; ++c) acc += bf2f(P.OLAT[(t * C::MH + h) * C::KVL + c]) * P.w_uv[((size_t)c * C::MH + h) * C::MDV + d];
    P.OATT[t * C::MH * C::MDV + h * C::MDV + d] = f2bf(acc);
}
template <class C> HD void n_merge(const NP& P, int item) {
    typedef Dims<C> Dm; const int n = item % C::D; const size_t t = item / C::D;
    float ya = 0.f, yb = 0.f;
    for (int k = 0; k < Dm::HV; ++k) ya += bf2f(P.OG[t * Dm::HV + k]) * P.w_a_out[(size_t)k * C::D + n];
    for (int k = 0; k < C::MH * C::MDV; ++k) yb += bf2f(P.OATT[t * C::MH * C::MDV + k]) * P.w_b_out[(size_t)k * C::D + n];
    P.M[t * C::D + n] = f2bf(sigmf(bf2f(P.GA[t * C::D + n])) * ya + sigmf(bf2f(P.GB[t * C::D + n])) * yb);
}
template <class C> HD void n_wo(const NP& P, int item) {
    const int n = item % C::D; const size_t t = item / C::D; const int b = (int)(t / C::L);
    float acc = 0.f; for (int k = 0; k < C::D; ++k) acc += bf2f(P.M[t * C::D + k]) * P.w_o[(size_t)k * C::D + n];
    P.X1[t * C::D + n] = P.x[t * C::D + n] + P.MOD[(size_t)b * 6 * C::D + 2 * C::D + n] * acc;
}
template <class C> HD void n_h2(const NP& P, int t) {
    const int D = C::D; const int b = t / C::L; const float* xr = P.X1 + (size_t)t * D;
    float ss = 0.f; for (int i = 0; i < D; ++i) ss += xr[i] * xr[i];
    const float rstd = 1.f / sqrtf(ss / D + Dims<C>::EPS);
    const float* sh = P.MOD + (size_t)b * 6 * D + 3 * D; const float* sc = sh + D;
    for (int i = 0; i < D; ++i) P.H2[(size_t)t * D + i] = f2bf(xr[i] * rstd * P.norm2_w[i] * (1.f + sc[i]) + sh[i]);
}
template <class C> HD void n_peerq(const NP& P, int item) {
    const int NJ = C::PH * C::PDQ; const int j = item % NJ; const size_t t = item / NJ;
    float acc = 0.f; for (int k = 0; k < C::D; ++k) acc += bf2f(P.H2[t * C::D + k]) * P.peer_w_q[(size_t)k * NJ + j];
    P.PQ[t * NJ + j] = acc;
}
template <class C> HD void n_route(const NP& P, int item, int tid, int NT) {
    typedef Dims<C> Dm; const int PK = C::PK, TK = C::PTK; const int h = item % C::PH; const size_t t = item / C::PH;
    const int oS = 0, oSV = 2 * PK, oSI = oSV + 2 * TK, oC = oSI + 2 * TK;
    for (int p = 0; p < 2; ++p) for (int n = 0; n < PK; ++n) {
        float acc = 0.f;
        if (P.S) acc = P.S[t * (size_t)(C::PH * 2 * PK) + (h * 2 + p) * PK + n];
        else { const float* q = P.PQ + t * C::PH * C::PDQ + (h * 2 + p) * Dm::PD2; const float* key = P.peer_sub_keys + (((size_t)h * 2 + p) * PK + n) * Dm::PD2;
            for (int d = 0; d < Dm::PD2; ++d) acc += q[d] * key[d]; }
        SCR(oS + p * PK + n) = acc; }
    for (int p = 0; p < 2; ++p) for (int k = 0; k < TK; ++k) { int bi = 0; float bv = -3.0e38f;
        for (int n = 0; n < PK; ++n) { const float v = SCR(oS + p * PK + n); if (v > bv) { bv = v; bi = n; } }
        SCR(oSV + p * TK + k) = bv; SCR(oSI + p * TK + k) = (float)bi; SCR(oS + p * PK + bi) = -3.0e38f; }
    for (int i = 0; i < TK; ++i) for (int j = 0; j < TK; ++j) SCR(oC + i * TK + j) = SCR(oSV + i) + SCR(oSV + TK + j);
    float tv[C::PTK]; int te[C::PTK]; float mx = -3.0e38f;
#pragma unroll
    for (int k = 0; k < TK; ++k) { int bi = 0; float bv = -3.0e38f;
        for (int n = 0; n < TK * TK; ++n) { const float v = SCR(oC + n); if (v > bv) { bv = v; bi = n; } }
        SCR(oC + bi) = -3.0e38f; tv[k] = bv; te[k] = (int)SCR(oSI + bi / TK) * PK + (int)SCR(oSI + TK + bi % TK); mx = bv > mx ? bv : mx; }
    float sum = 0.f;
#pragma unroll
    for (int k = 0; k < TK; ++k) { tv[k] = expf(tv[k] - mx); sum += tv[k]; }
#pragma unroll
    for (int k = 0; k < TK; ++k) { P.EXPI[t * Dm::SLOTS + h * TK + k] = te[k]; P.GATE[t * Dm::SLOTS + h * TK + k] = tv[k] / sum; }
}
template <class C> HD void n_pact(const NP& P, int item) {
    typedef Dims<C> Dm; const int sl = item % Dm::SLOTS; const size_t t = item / Dm::SLOTS; const int e = P.EXPI[t * Dm::SLOTS + sl];
    const float* u = P.peer_u + (size_t)e * C::D; float acc = 0.f; for (int d = 0; d < C::D; ++d) acc += u[d] * bf2f(P.H2[t * C::D + d]);
    P.ACT[t * Dm::SLOTS + sl] = geluf(acc) * P.GATE[t * Dm::SLOTS + sl];
}
template <class C> HD void n_pout(const NP& P, int item) {
    typedef Dims<C> Dm; const int d = item % C::D; const size_t t = item / C::D; const int b = (int)(t / C::L);
    float acc = 0.f; for (int s = 0; s < Dm::SLOTS; ++s) acc += P.ACT[t * Dm::SLOTS + s] * P.peer_v[(size_t)P.EXPI[t * Dm::SLOTS + s] * C::D + d];
    P.X1[t * C::D + d] += P.MOD[(size_t)b * 6 * C::D + 5 * C::D + d] * acc;
}
template <class C> HD void n_final(const NP& P, int t) {
    const int D = C::D; const float* xr = P.X1 + (size_t)t * D; float ss = 0.f; for (int i = 0; i < D; ++i) ss += xr[i] * xr[i];
    const float rstd = 1.f / sqrtf(ss / D + Dims<C>::EPS);
    for (int i = 0; i < D; ++i) P.out[(size_t)t * D + i] = xr[i] * rstd * P.final_norm_w[i];
}

template <class C> HD long stage_items(int st) {
    typedef Dims<C> Dm; const long T = Dm::T;
    switch (st) {
        case ST_MOD: return (long)C::B * 6 * C::D; case ST_H1: return T;
        case ST_INPROJ_A: return T * ((Dm::OFF_GA - 0) / 4) - T * (Dm::HV / 4);
        case ST_DSANORM: return T; case ST_CONV: return T * C::DNH * 3; case ST_GC: return Dm::NCHUNKS; case ST_AMAT: return (long)Dm::NCHUNKS * C::CH * C::CH;
        case ST_SOLVE: return (long)Dm::NCHUNKS * (C::DV + C::DK); case ST_SCALE: return T * C::DNH; case ST_SCAN: return (long)C::B * C::DNH * C::DV;
        case ST_Q: return T * (C::MH * C::MDH + C::IH * C::ID); case ST_QIDX: return T * (C::IH * C::ID); case ST_SMALL: return T; case ST_QABS: return T * C::MH * C::KVL; case ST_INDEX: return T; case ST_ATTN: return T * C::MH;
        case ST_INPROJ_B: return T * ((Dm::HV + 2 * C::D) / 4); case ST_OGATE: return T * C::DNH; case ST_OATT: return T * C::MH * C::MDV; case ST_MERGE: return T * C::D;
        case ST_WO: return T * C::D; case ST_H2: return T; case ST_PEERQ: return T * C::PH * C::PDQ; case ST_ROUTE: return T * C::PH; case ST_PACT: return T * Dm::SLOTS;
        case ST_POUT: return T * C::D; case ST_FINAL: return T;
    }
    return 0;
}
template <class C> HD int stage_scr_words(int st) {
    typedef Dims<C> Dm;
    switch (st) { case ST_SOLVE: return C::CH; case ST_SCAN: return C::DK + C::CH; case ST_INDEX: return 2 * Dm::TOPK; case ST_ATTN: return Dm::TOPK + C::KVL;
        case ST_ROUTE: return 2 * C::PK + 4 * C::PTK + C::PTK * C::PTK; }
    return 0;
}
template <class C> HD void run_item(const NP& P, int st, long item, int tid, int NT) {
    typedef Dims<C> Dm;
    switch (st) {
        case ST_MOD: n_mod<C>(P, (int)item); break; case ST_H1: n_h1<C>(P, (int)item); break;
        case ST_INPROJ_A: { const int ngA = Dm::OFF_Z / 4, ngB = (Dm::OFF_GA - Dm::OFF_B) / 4, ng = ngA + ngB; const int t = (int)(item / ng), g = (int)(item % ng);
            if (g < ngA) n_inproj<C>(P, t * ngA + g, 0, Dm::OFF_Z); else n_inproj<C>(P, t * ngB + (g - ngA), Dm::OFF_B, Dm::OFF_GA); } break;
        case ST_DSANORM: n_dsanorm<C>(P, (int)item); break; case ST_CONV: n_conv<C>(P, (int)item); break; case ST_GC: n_gc<C>(P, (int)item); break;
        case ST_AMAT: n_amat<C>(P, (int)item); break; case ST_SOLVE: n_solve<C>(P, (int)item, tid, NT); break; case ST_SCALE: n_scale<C>(P, (int)item); break;
        case ST_SCAN: n_scan<C>(P, (int)item, tid, NT); break; case ST_Q: n_q<C>(P, (int)item); break; case ST_QIDX: { const int NI = C::IH * C::ID, NJ = C::MH * C::MDH + NI; n_q<C>(P, (int)((item / NI) * NJ + C::MH * C::MDH + item % NI)); } break; case ST_QABS: n_qabs<C>(P, (int)item); break; case ST_SMALL: n_small<C>(P, (int)item); break;
        case ST_INDEX: n_index<C>(P, (int)item, tid, NT); break; case ST_ATTN: n_attn<C>(P, (int)item, tid, NT); break;
        case ST_INPROJ_B: { const int ngA = Dm::HV / 4, ngB = 2 * C::D / 4, ng = ngA + ngB; const int t = (int)(item / ng), g = (int)(item % ng);
            if (g < ngA) n_inproj<C>(P, t * ngA + g, Dm::OFF_Z, Dm::OFF_B); else n_inproj<C>(P, t * ngB + (g - ngA), Dm::OFF_GA, Dm::IN_COLS); } break;
        case ST_OGATE: n_ogate<C>(P, (int)item); break; case ST_OATT: n_oatt<C>(P, (int)item); break; case ST_MERGE: n_merge<C>(P, (int)item); break;
        case ST_WO: n_wo<C>(P, (int)item); break; case ST_H2: n_h2<C>(P, (int)item); break; case ST_PEERQ: n_peerq<C>(P, (int)item); break;
        case ST_ROUTE: n_route<C>(P, (int)item, tid, NT); break; case ST_PACT: n_pact<C>(P, (int)item); break; case ST_POUT: n_pout<C>(P, (int)item); break;
        case ST_FINAL: n_final<C>(P, (int)item); break;
    }
}
#define GAS __attribute__((address_space(1)))
#define LAS __attribute__((address_space(3)))
#define XB_TMO      128
#define XB_XCNT(j)  (256  + 64 * (j))
#define XB_XSUB(j)  (1280 + 64 * (j))
#define XB_XGEN(j)  (2304 + 64 * (j))
#define XB_TOP      3328
#define XB_TOPGEN   3392
#define XCD_BAR_WORDS 3456
#ifndef XB_SPIN_CAP
#define XB_SPIN_CAP (1u << 26)
#endif
__device__ __forceinline__ unsigned xb_ld(unsigned* p)              { return __hip_atomic_load(p, __ATOMIC_RELAXED, __HIP_MEMORY_SCOPE_AGENT); }
__device__ __forceinline__ unsigned xb_add(unsigned* p, unsigned v) { return __hip_atomic_fetch_add(p, v, __ATOMIC_RELAXED, __HIP_MEMORY_SCOPE_AGENT); }
__device__ __forceinline__ unsigned xb_xcc_id() { return (unsigned)__builtin_amdgcn_s_getreg((3 << 11) | 20) & 0xFu; }
#define XB_SPIN(cond, bar) do { unsigned _sp = 0; while (cond) { __builtin_amdgcn_s_sleep(1); \
    if ((++_sp & 255u) == 0u) { if (xb_ld(&(bar)[XB_TMO])) break; if (_sp > XB_SPIN_CAP) { atomicAdd(&(bar)[XB_TMO], 1u); break; } } } } while (0)
struct XcdBarrier { unsigned* bar; unsigned x; volatile LAS unsigned* st; };
__device__ __forceinline__ XcdBarrier xcd_barrier_post(unsigned* bar, volatile LAS unsigned* st) {
    XcdBarrier b; b.bar = bar; b.x = xb_xcc_id(); b.st = st;
    if (threadIdx.x == 0) (void)xb_add(&bar[XB_XCNT(b.x)], 1u);
    return b;
}
__device__ __forceinline__ void xcd_barrier_complete(unsigned* bar, unsigned x, unsigned& nloc, unsigned& nx) {
    const unsigned G = gridDim.x * gridDim.y * gridDim.z;
    unsigned sum, cnt, mine, sp = 0u;
    for (;;) {
        sum = 0u; cnt = 0u; mine = 0u;
#pragma unroll
        for (unsigned j = 0; j < 16; ++j) { const unsigned c = xb_ld(&bar[XB_XCNT(j)]); sum += c; cnt += (c > 0u) ? 1u : 0u; mine = (j == x) ? c : mine; }
        if (sum == G) break;
        __builtin_amdgcn_s_sleep(1);
        if ((++sp & 255u) == 0u) { if (xb_ld(&bar[XB_TMO])) break; if (sp > XB_SPIN_CAP) { atomicAdd(&bar[XB_TMO], 1u); break; } }
    }
    nloc = mine > 0u ? mine : 1u; nx = cnt > 0u ? cnt : 1u;
}
__device__ __forceinline__ void xcd_barrier(const XcdBarrier& b) {
    asm volatile("s_waitcnt vmcnt(0)" ::: "memory");
    __syncthreads();
    if (threadIdx.x == 0) {
        unsigned* bar = b.bar;
        __builtin_amdgcn_s_waitcnt(0);
        unsigned nloc = b.st[0], nx = b.st[1];
        if (nloc == 0u) { xcd_barrier_complete(bar, b.x, nloc, nx); b.st[0] = nloc; b.st[1] = nx; }
        const unsigned old = xb_add(&bar[XB_XSUB(b.x)], 1u);
        const unsigned gen = old / nloc;
        if (old + 1u == (gen + 1u) * nloc) {
            __builtin_amdgcn_fence(__ATOMIC_RELEASE, "agent");
            asm volatile("s_waitcnt vmcnt(0)" ::: "memory");
            const unsigned og = xb_add(&bar[XB_TOP], 1u);
            const unsigned tg = og / nx;
            if (og + 1u == (tg + 1u) * nx) xb_add(&bar[XB_TOPGEN], 1u);
            else XB_SPIN(xb_ld(&bar[XB_TOPGEN]) == tg, bar);
            __builtin_amdgcn_fence(__ATOMIC_ACQUIRE, "agent");
            xb_add(&bar[XB_XGEN(b.x)], 1u);
            asm volatile("s_waitcnt vmcnt(0)" ::: "memory");
        } else {
            XB_SPIN(xb_ld(&bar[XB_XGEN(b.x)]) == gen, bar);
            __builtin_amdgcn_fence(__ATOMIC_ACQUIRE, "agent");
            asm volatile("s_waitcnt vmcnt(0)" ::: "memory");
        }
    }
    __syncthreads();
}
namespace pg8 {
#define PG8_LAS __attribute__((address_space(3)))
typedef unsigned short bf16_t;
typedef short bf16x8 __attribute__((ext_vector_type(8)));
typedef float f32x4 __attribute__((ext_vector_type(4)));
typedef unsigned u32x4 __attribute__((ext_vector_type(4)));
constexpr int BM = 256, BK = 64, HALF = 128, HTB = HALF * BK * 2  , STAGE_BYTES = 8 * HTB, NXCD = 8, WGM = 8;

__host__ __device__ __forceinline__ int lds_byte(int r, int c) { const int st = (r >> 4) * 2 + (c >> 5), rr = r & 15, cc = c & 31, ob = rr * 64 + cc * 2; return st * 1024 + (ob ^ (((ob >> 9) & 1) << 5)); }
__host__ __device__ __forceinline__ void stage_rc(int b, int& R, int& C) { const int st = b / 1024, sb = b % 1024, swz = sb ^ (((sb >> 9) & 1) << 5); R = (st >> 1) * 16 + swz / 64; C = (st & 1) * 32 + (swz % 64) / 2; }
__host__ __device__ __forceinline__ int perm32(int rho) { const int n = rho >> 4, i = rho & 15; return 8 * (i >> 2) + 4 * n + (i & 3); }
__device__ __forceinline__ unsigned cvt_pk_bf16(float lo, float hi) { unsigned r; asm volatile("v_cvt_pk_bf16_f32 %0, %1, %2" : "=v"(r) : "v"(lo), "v"(hi)); return r; }
struct Unit { int pm, pn; const char* a; const char* b; };
struct Gemm { int lda, ldb, K; };
template <class Epi, class Sched, bool ALIGN_EPI = false, bool SP2 = false>
__device__ __forceinline__ void gemm_phase(PG8_LAS unsigned char* lds, const Gemm g, const Sched& S, const Epi& E) {
    int tid = threadIdx.x; asm volatile("" : "+v"(tid));
    const int wid = __builtin_amdgcn_readfirstlane(tid >> 6), lane = tid & 63, wr = wid >> 2, wc = wid & 3, fr = lane & 15, fq = lane >> 4;
    const int K = g.K, nt = K / BK;
    unsigned voffA[2], voffB[2];
#pragma unroll
    for (int i = 0; i < 2; ++i) { int R, C; stage_rc(tid * 16 + i * 8192, R, C); const int Rb = Epi::PERM ? ((R & ~31) + perm32(R & 31)) : R;
        voffA[i] = (unsigned)(R * g.lda + C) * 2u; voffB[i] = (unsigned)(Rb * g.ldb + C) * 2u; }
    const size_t kstep = (size_t)(BK * 2);
    const size_t hstepA = (size_t)HALF * g.lda * 2, hstepB = (size_t)HALF * g.ldb * 2;
    const unsigned ldsw = (unsigned)wid * 1024u;
    const int aoff = lds_byte(wr * 64 + fr, fq * 8), boff = lds_byte(wc * 32 + fr, fq * 8);
#define PG8_SA(b, h) (((b) * 2 + (h)) * HTB)
#define PG8_SB(b, h) ((4 + (b) * 2 + (h)) * HTB)
#define PG8_STAGE(bufoff, gbase, voff) do { _Pragma("unroll") for (int _i = 0; _i < 2; ++_i) \
        __builtin_amdgcn_global_load_lds((const unsigned*)((const char*)(gbase) + (voff)[_i]), (PG8_LAS unsigned*)(lds + (bufoff) + ldsw + _i * 8192), 16, 0, 0); } while (0)
#define PG8_LDA(dst, b, h) do { _Pragma("unroll") for (int m = 0; m < 4; ++m) _Pragma("unroll") for (int k = 0; k < 2; ++k) dst[m][k] = *(const PG8_LAS bf16x8*)(lds + PG8_SA(b, h) + aoff + m * 2048 + k * 1024); } while (0)
#define PG8_LDB(dst, b, h) do { _Pragma("unroll") for (int n = 0; n < 2; ++n) _Pragma("unroll") for (int k = 0; k < 2; ++k) dst[n][k] = *(const PG8_LAS bf16x8*)(lds + PG8_SB(b, h) + boff + n * 2048 + k * 1024); } while (0)
#define PG8_MMA(ai, bj, At, Bt) do { __builtin_amdgcn_s_setprio(1); _Pragma("unroll") for (int m = 0; m < 4; ++m) _Pragma("unroll") for (int n = 0; n < 2; ++n) _Pragma("unroll") for (int k = 0; k < 2; ++k) \
        acc[ai][bj][m][n] = __builtin_amdgcn_mfma_f32_16x16x32_bf16(Bt[n][k], At[m][k], acc[ai][bj][m][n], 0, 0, 0); __builtin_amdgcn_s_setprio(0); } while (0)
#define PG8_WAIT_V(n) asm volatile("s_waitcnt vmcnt(" #n ")" ::: "memory")
#define PG8_WAIT_L(n) asm volatile("s_waitcnt lgkmcnt(" #n ")" ::: "memory")
#define PG8_BAR __builtin_amdgcn_s_barrier()
#define PG8_SCHED __builtin_amdgcn_sched_barrier(0)
    Unit cur, nxt; int ui = 0;
    if (!S.next(0, cur)) return;
    f32x4 acc[2][2][4][2];
#pragma unroll
    for (int a = 0; a < 2; ++a)
#pragma unroll
        for (int b = 0; b < 2; ++b)
#pragma unroll
            for (int m = 0; m < 4; ++m)
#pragma unroll
                for (int n = 0; n < 2; ++n) acc[a][b][m][n] = (f32x4){0.f, 0.f, 0.f, 0.f};
    bf16x8 At[4][2], B0[2][2], B1[2][2];
    const char* cA = cur.a; const char* cB = cur.b;
    S.a_ready(cur);
    if constexpr (SP2) {
        PG8_STAGE(PG8_SB(0, 0), cB, voffB); PG8_STAGE(PG8_SB(0, 1), cB + hstepB, voffB); PG8_STAGE(PG8_SA(0, 0), cA, voffA); PG8_STAGE(PG8_SA(0, 1), cA + hstepA, voffA);
        if (wr == 1) PG8_BAR;
        PG8_WAIT_V(2); PG8_BAR;
        PG8_STAGE(PG8_SB(1, 0), cB + kstep, voffB); PG8_STAGE(PG8_SA(1, 0), cA + kstep, voffA); PG8_STAGE(PG8_SB(1, 1), cB + hstepB + kstep, voffB);
        PG8_WAIT_V(6); PG8_BAR;
    } else {
        PG8_STAGE(PG8_SB(0, 0), cB, voffB); PG8_STAGE(PG8_SA(0, 0), cA, voffA); PG8_STAGE(PG8_SB(0, 1), cB + hstepB, voffB); PG8_STAGE(PG8_SA(0, 1), cA + hstepA, voffA);
        if (wr == 1) PG8_BAR;
        PG8_WAIT_V(4); PG8_BAR;
        PG8_STAGE(PG8_SB(1, 0), cB + kstep, voffB); PG8_STAGE(PG8_SA(1, 0), cA + kstep, voffA); PG8_STAGE(PG8_SB(1, 1), cB + hstepB + kstep, voffB);
        PG8_WAIT_V(6); PG8_BAR;
    }
    for (;;) {
        const bool has_next = S.next(ui + 1, nxt);
        const char* nA = has_next ? nxt.a : cA; const char* nB = has_next ? nxt.b : cB;
        for (int t = 0; t < nt; t += 2) {
            const bool last = (t == nt - 2);
            const char* a1 = cA + (size_t)(t + 1) * kstep;
            const char* a2 = last ? nA : cA + (size_t)(t + 2) * kstep; const char* b2 = last ? nB : cB + (size_t)(t + 2) * kstep;
            const char* a3 = a2 + kstep; const char* b3 = b2 + kstep;
            if (last && has_next) S.a_ready(nxt);
            if constexpr (SP2) {
            PG8_LDB(B0, 0, 0); PG8_LDB(B1, 0, 1); PG8_SCHED; PG8_LDA(At, 0, 0); PG8_STAGE(PG8_SA(1, 1), a1 + hstepA, voffA);
            PG8_WAIT_V(8); PG8_WAIT_L(0); PG8_BAR; PG8_MMA(0, 0, At, B0); PG8_MMA(0, 1, At, B1); PG8_BAR; PG8_SCHED;
            PG8_LDA(At, 0, 1); PG8_STAGE(PG8_SB(0, 0), b2, voffB); PG8_STAGE(PG8_SB(0, 1), b2 + hstepB, voffB); PG8_STAGE(PG8_SA(0, 0), a2, voffA);
            PG8_WAIT_V(8); PG8_WAIT_L(0); PG8_BAR; PG8_MMA(1, 0, At, B0); PG8_MMA(1, 1, At, B1); PG8_BAR; PG8_SCHED;
            PG8_LDB(B0, 1, 0); PG8_LDB(B1, 1, 1); PG8_SCHED; PG8_LDA(At, 1, 0); PG8_STAGE(PG8_SA(0, 1), a2 + hstepA, voffA);
            PG8_WAIT_V(8); PG8_WAIT_L(0); PG8_BAR; PG8_MMA(0, 0, At, B0); PG8_MMA(0, 1, At, B1); PG8_BAR; PG8_SCHED;
            PG8_LDA(At, 1, 1); PG8_STAGE(PG8_SB(1, 0), b3, voffB); PG8_STAGE(PG8_SB(1, 1), b3 + hstepB, voffB); PG8_STAGE(PG8_SA(1, 0), a3, voffA);
            PG8_WAIT_V(8); PG8_WAIT_L(0); PG8_BAR; PG8_MMA(1, 0, At, B0); PG8_MMA(1, 1, At, B1); PG8_BAR; PG8_SCHED;
            } else {
            PG8_LDB(B0, 0, 0); PG8_SCHED; PG8_LDA(At, 0, 0); PG8_STAGE(PG8_SA(1, 1), a1 + hstepA, voffA);
            PG8_WAIT_L(8); PG8_BAR; PG8_WAIT_L(0); PG8_MMA(0, 0, At, B0); PG8_BAR; PG8_SCHED;
            PG8_LDB(B1, 0, 1); PG8_STAGE(PG8_SB(0, 0), b2, voffB);
            PG8_BAR; PG8_WAIT_L(0); PG8_MMA(0, 1, At, B1); PG8_BAR;
            PG8_LDA(At, 0, 1); PG8_STAGE(PG8_SA(0, 0), a2, voffA);
            PG8_BAR; PG8_WAIT_L(0); PG8_MMA(1, 0, At, B0); PG8_BAR; PG8_SCHED;
            PG8_STAGE(PG8_SB(0, 1), b2 + hstepB, voffB);
            PG8_WAIT_V(6); PG8_BAR; PG8_MMA(1, 1, At, B1); PG8_BAR;
            PG8_LDB(B0, 1, 0); PG8_SCHED; PG8_LDA(At, 1, 0); PG8_STAGE(PG8_SA(0, 1), a2 + hstepA, voffA);
            PG8_WAIT_L(8); PG8_BAR; PG8_WAIT_L(0); PG8_MMA(0, 0, At, B0); PG8_BAR; PG8_SCHED;
            PG8_LDB(B1, 1, 1); PG8_STAGE(PG8_SB(1, 0), b3, voffB);
            PG8_BAR; PG8_WAIT_L(0); PG8_MMA(0, 1, At, B1); PG8_BAR;
            PG8_LDA(At, 1, 1); PG8_STAGE(PG8_SA(1, 0), a3, voffA);
            PG8_BAR; PG8_WAIT_L(0); PG8_MMA(1, 0, At, B0); PG8_BAR; PG8_SCHED;
            PG8_STAGE(PG8_SB(1, 1), b3 + hstepB, voffB);
            PG8_WAIT_V(6); PG8_BAR; PG8_MMA(1, 1, At, B1); PG8_BAR;
            }
        }
        if constexpr (ALIGN_EPI) { if (wr == 0) PG8_BAR; }
        if constexpr (!Epi::AFTER_DRAIN) { E(acc, cur, wr, wc, fr, fq); S.done(cur); }
        if (!has_next) break;
#pragma unroll
        for (int a = 0; a < 2; ++a)
#pragma unroll
            for (int b = 0; b < 2; ++b)
#pragma unroll
                for (int m = 0; m < 4; ++m)
#pragma unroll
                    for (int n = 0; n < 2; ++n) acc[a][b][m][n] = (f32x4){0.f, 0.f, 0.f, 0.f};
        cur = nxt; cA = nA; cB = nB; ++ui;
        if constexpr (ALIGN_EPI) { if (wr == 1) PG8_BAR; }
    }
    PG8_WAIT_V(0);
    if constexpr (!ALIGN_EPI) { if (wr == 0) PG8_BAR; }
    PG8_BAR;
    if constexpr (Epi::AFTER_DRAIN) { E.fused(acc, cur, wr, wc, fr, fq, lds, wid, lane); S.done(cur); }
#undef PG8_SA
#undef PG8_SB
#undef PG8_STAGE
#undef PG8_LDA
#undef PG8_LDB
#undef PG8_MMA
#undef PG8_WAIT_V
#undef PG8_WAIT_L
#undef PG8_BAR
#undef PG8_SCHED
}
}
typedef float f32x4 __attribute__((ext_vector_type(4)));
typedef unsigned u32x4 __attribute__((ext_vector_type(4)));
constexpr int T_ = 16384, D_ = 1024, NIN_ = 6912;
constexpr size_t MiB_ = 1u << 20;
constexpr size_t X_BASE = 230 * MiB_;
constexpr size_t X_WINT = X_BASE, X_WCAT = X_WINT + (size_t)NIN_ * 1024 * 2, X_WOT = X_WCAT + (size_t)1024 * 3072 * 2, X_WST = X_WOT + (size_t)1024 * 1024 * 2,
                 X_WCOMB = X_WST + (size_t)2048 * 1024 * 2, X_WIQT = X_WCOMB + (size_t)2048 * 256 * 2, X_END = X_WIQT + (size_t)512 * 256 * 2;
constexpr size_t X_EXPI = X_WINT, X_GATE = X_EXPI + (size_t)16384 * 128 * 4;
static_assert(X_GATE + (size_t)16384 * 128 * 4 <= X_WOT, "routing results fit over WinT | WcatT");
constexpr size_t X_WUK = WsMap<CfgFull>::A0, X_WUQ = X_WUK + (size_t)256 * 1024 * 2, X_WBT = X_WUQ + (size_t)256 * 1024 * 2,
                 X_WUV = X_WBT + (size_t)1024 * 1024 * 2, X_SKB = X_WUV + (size_t)256 * 1024 * 2, X_PWQ = X_SKB + (size_t)2048 * 256 * 2, X_TMP_END = X_PWQ + (size_t)1024 * 2048 * 2;
static_assert(WsMap<CfgFull>::END <= X_BASE && X_END <= 260 * MiB_ && X_TMP_END <= WsMap<CfgFull>::A2, "extra workspace map (d_ws >= 266.9 MiB = the sum of the inputs)");
struct OP {
    bf16_t *WinT, *WcatT, *WoT, *WsT, *WcombT, *WiqT, *wuk, *wuq, *wbT, *wuv, *skb, *pwq; float* S; bf16_t* RAWB; unsigned char *Ub, *Vb; int* EXPI2; float* GATE2; bf16_t *QA0, *QA1; unsigned* qword;
};
typedef __bf16 bf16x2h_t __attribute__((ext_vector_type(2)));
typedef float f32x2h_t __attribute__((ext_vector_type(2)));
__device__ __forceinline__ unsigned pk2bf(float lo, float hi) { const f32x2h_t v = {lo, hi}; return __builtin_bit_cast(unsigned, __builtin_convertvector(v, bf16x2h_t)); }
__device__ __forceinline__ bf16_t f2bfd(float f) { return (bf16_t)(pk2bf(f, 0.f) & 0xffffu); }

__device__ __forceinline__ int inproj_src(int n) {
    if (n < 3072) return n;
    if (n < 3328) return 4112 + (n - 3072);
    if (n < 3584) return 4368 + (n - 3328);
    if (n < 3648) return 4624 + (n - 3584);
    if (n < 3656) return 4096 + (n - 3648);
    if (n < 3664) return 4104 + (n - 3656);
    if (n < 3672) return 4688 + (n - 3664);
    if (n < 3840) return -1;
    if (n < 4864) return 3072 + (n - 3840);
    if (n < 5888) return 4696 + (n - 4864);
    return 5720 + (n - 5888);
}
template <int MAP> __device__ __forceinline__ void transpose_item(const float* W, int ldn, bf16_t* WT, int ldk, int n0, int k0, LAS float* scr, int lane) {
    const int j = lane & 31; int sc = n0 + j; if (MAP == 1) sc = inproj_src(n0 + j);
#pragma unroll 8
    for (int i = 0; i < 32; ++i) { const int kk = 2 * i + (lane >> 5); scr[kk * 33 + j] = (sc >= 0) ? W[(size_t)(k0 + kk) * ldn + sc] : 0.f; }
    asm volatile("s_waitcnt lgkmcnt(0)" ::: "memory");
    const int c = lane & 7;
#pragma unroll
    for (int q = 0; q < 4; ++q) { const int n = (lane >> 3) + 8 * q; const LAS float* s = scr + (8 * c) * 33 + n;
        u32x4 o; o.x = pk2bf(s[0 * 33], s[1 * 33]); o.y = pk2bf(s[2 * 33], s[3 * 33]); o.z = pk2bf(s[4 * 33], s[5 * 33]); o.w = pk2bf(s[6 * 33], s[7 * 33]);
        *(u32x4*)(WT + (size_t)(n0 + n) * ldk + k0 + 8 * c) = o; }
    asm volatile("s_waitcnt lgkmcnt(0)" ::: "memory");
}
__device__ __forceinline__ void p0_weights(const NP& P, const OP& Q, LAS unsigned char* lds, int gw, int NGW, int gt, int NGT, int wave, int lane) {
    LAS float* scr = (LAS float*)(lds + wave * 16384);
    constexpr int I_IN = (NIN_ / 32) * 16, I_SQ = 32 * 16;
    constexpr int I_IQ = 16 * 4;
    for (int it = gw; it < I_IN + 3 * I_SQ + I_IQ; it += NGW) {
        int r = it;
        if (r < I_IN) { transpose_item<1>(P.w_in, 6744, Q.WinT, 1024, (r / 16) * 32, (r % 16) * 64, scr, lane); continue; } r -= I_IN;
        if (r < I_SQ) { transpose_item<0>(P.w_a_out, 1024, Q.WcatT, 3072, (r / 16) * 32, (r % 16) * 64, scr, lane); continue; } r -= I_SQ;
        if (r < I_SQ) { transpose_item<0>(P.w_o, 1024, Q.WoT, 1024, (r / 16) * 32, (r % 16) * 64, scr, lane); continue; } r -= I_SQ;
        if (r < I_SQ) { transpose_item<0>(P.w_b_out, 1024, Q.wbT, 1024, (r / 16) * 32, (r % 16) * 64, scr, lane); continue; } r -= I_SQ;
        transpose_item<0>(P.w_iq, 512, Q.WiqT, 256, (r / 4) * 32, (r % 4) * 64, scr, lane);
    }
    for (int i = gt; i < 256 * 1024 / 4; i += NGT) { const f32x4 a = ((const f32x4*)P.w_uk)[i], b = ((const f32x4*)P.w_uq)[i], c = ((const f32x4*)P.w_uv)[i];
        ((uint2*)Q.wuk)[i] = make_uint2(pk2bf(a.x, a.y), pk2bf(a.z, a.w)); ((uint2*)Q.wuq)[i] = make_uint2(pk2bf(b.x, b.y), pk2bf(b.z, b.w)); ((uint2*)Q.wuv)[i] = make_uint2(pk2bf(c.x, c.y), pk2bf(c.z, c.w)); }
    for (int i = gt; i < 1024 * 2048 / 4; i += NGT) { const f32x4 a = ((const f32x4*)P.peer_w_q)[i]; ((uint2*)Q.pwq)[i] = make_uint2(pk2bf(a.x, a.y), pk2bf(a.z, a.w)); }
    for (int i = gt; i < 2048 * 256 / 4; i += NGT) { const int row = i / 64, c4 = (i % 64) * 4, g = row >> 7; uint2 o = make_uint2(0u, 0u);
        if ((c4 >> 7) == (g & 1)) { const f32x4 a = *(const f32x4*)(P.peer_sub_keys + (size_t)row * 128 + (c4 & 127)); o = make_uint2(pk2bf(a.x, a.y), pk2bf(a.z, a.w)); }
        ((uint2*)Q.skb)[i] = o; }
}
struct GridSched {
    int nM, nN, nwg, G, c; const char* A; const char* B; size_t sA, sB;
    const char* A2 = nullptr; int splitA = 1 << 30;
    __device__ void init(int nM_, int nN_, int G_, int c_, const void* A_, size_t sA_, const void* B_, size_t sB_) { nM = nM_; nN = nN_; nwg = nM * nN; G = G_; c = c_; A = (const char*)A_; B = (const char*)B_; sA = sA_; sB = sB_; }
    __device__ bool next(int i, pg8::Unit& u) const {
        const long L = (long)i * G + c; if (L >= nwg) return false;
        int wgid = (int)L; { const int q = nwg / 8, r = nwg % 8, xcd = wgid % 8, off = wgid / 8; wgid = (xcd < r ? xcd * (q + 1) : r * (q + 1) + (xcd - r) * q) + off; }
        const int nig = 8 * nN, gid = wgid / nig, fm = gid * 8, gsz = (nM - fm) < 8 ? (nM - fm) : 8;
        u.pm = fm + ((wgid % nig) % gsz); u.pn = (wgid % nig) / gsz; u.a = (u.pm < splitA) ? A + (size_t)u.pm * sA : A2 + (size_t)(u.pm - splitA) * sA; u.b = B + (size_t)u.pn * sB; return true;
    }
    __device__ __forceinline__ void a_ready(const pg8::Unit&) const {}
    __device__ __forceinline__ void done(const pg8::Unit&) const {}
};
struct WSched {
    int kind, c; const bf16_t *wuk, *wuq, *wbT, *wuv, *skb, *pwq;
    __device__ bool next(int i, pg8::Unit& u) const {
        if (i > 0 || c < 0) return false;
        if (kind == 0) {
            if (c < 8) { u.pm = c; u.pn = 100; u.a = (const char*)(wuk + c * 128); u.b = (const char*)(wuq + c * 128); return true; }
            if (c < 40) { const int h = (c - 8) >> 2, mt = (c - 8) & 3; u.pm = mt; u.pn = 200 + h; u.a = (const char*)(wbT + (size_t)mt * 256 * 1024 + h * 128); u.b = (const char*)(wuv + h * 128); return true; }
            return false;
        }
        if (c < 32) { const int pm = c >> 2, nt = c & 3; u.pm = pm; u.pn = nt; u.a = (const char*)(skb + (size_t)pm * 256 * 256); u.b = (const char*)(pwq + (size_t)nt * 256 * 2048 + pm * 256); return true; }
        return false;
    }
    __device__ __forceinline__ void a_ready(const pg8::Unit&) const {}
    __device__ __forceinline__ void done(const pg8::Unit&) const {}
};
template <class F> struct EpiG {
    static constexpr bool PERM = true, AFTER_DRAIN = false; F f;
    __device__ __forceinline__ void operator()(const f32x4 (&acc)[2][2][4][2], const pg8::Unit& u, int wr, int wc, int fr, int fq) const {
#pragma unroll
        for (int ai = 0; ai < 2; ++ai)
#pragma unroll
            for (int m = 0; m < 4; ++m)
#pragma unroll
                for (int bj = 0; bj < 2; ++bj) f.st(u, ai * 128 + wr * 64 + m * 16 + fr, bj * 128 + wc * 32 + 8 * fq, acc[ai][bj][m][0], acc[ai][bj][m][1]);
    }
};
__device__ __forceinline__ u32x4 pack8(f32x4 v0, f32x4 v1) { u32x4 w; w.x = pk2bf(v0[0], v0[1]); w.y = pk2bf(v0[2], v0[3]); w.z = pk2bf(v1[0], v1[1]); w.w = pk2bf(v1[2], v1[3]); return w; }
struct FWeights {
    bf16_t *WcombT, *WcatT, *WsT;
    __device__ __forceinline__ void st(const pg8::Unit& u, int row, int col, f32x4 v0, f32x4 v1) const {
        bf16_t* p; float sc = 1.f;
        if (u.pn == 100) { p = WcombT + (size_t)(u.pm * 256 + row) * 256 + col; sc = 0.08838834764831845f; }
        else if (u.pn >= 200) { p = WcatT + (size_t)(u.pm * 256 + row) * 3072 + 1024 + (u.pn - 200) * 256 + col; }
        else { p = WsT + (size_t)(u.pm * 256 + row) * 1024 + u.pn * 256 + col; }
        *(u32x4*)p = pack8(v0 * sc, v1 * sc);
    }
};
struct FInprojA {
    bf16_t* QKVP; bf16_t* RAW;
    __device__ __forceinline__ void st(const pg8::Unit& u, int row, int col, f32x4 v0, f32x4 v1) const {
        const size_t t = (size_t)u.pm * 256 + row;
        if (u.pn < 12) { *(u32x4*)(QKVP + t * 3072 + u.pn * 256 + col) = pack8(v0, v1); }
        else { *(u32x4*)(RAW + t * 768 + (u.pn - 12) * 256 + col) = pack8(v0, v1); }
    }
};
__device__ __forceinline__ f32x4 bf4(uint2 w) { f32x4 r; r[0] = bf2f((bf16_t)(w.x & 0xffff)); r[1] = bf2f((bf16_t)(w.x >> 16)); r[2] = bf2f((bf16_t)(w.y & 0xffff)); r[3] = bf2f((bf16_t)(w.y >> 16)); return r; }
struct FInprojB {
    bf16_t *Z, *GA, *GB; const bf16_t* ON;
    __device__ __forceinline__ void st(const pg8::Unit& u, int row, int col, f32x4 v0, f32x4 v1) const {
        const size_t t = (size_t)u.pm * 256 + row; const int which = u.pn >> 2, c = (u.pn & 3) * 256 + col;
        bf16_t* dst = Z + (size_t)which * ((size_t)16384 * 1024) + t * 1024 + c;
        if (which == 0) { const u32x4 on = *(const u32x4*)(ON + t * 1024 + c);
            f32x4 a0 = bf4(make_uint2(on.x, on.y)), a1 = bf4(make_uint2(on.z, on.w));
#pragma unroll
            for (int k = 0; k < 4; ++k) { a0[k] *= v0[k] / (1.f + __expf(-v0[k])); a1[k] *= v1[k] / (1.f + __expf(-v1[k])); }
            *(u32x4*)dst = pack8(a0, a1); }
        else *(u32x4*)dst = pack8(v0, v1);
    }
};
struct FStoreBf16 { bf16_t* O; int ldc; bf16_t* O2; int split;
    __device__ __forceinline__ void st(const pg8::Unit& u, int row, int col, f32x4 v0, f32x4 v1) const { bf16_t* base = (u.pm < split) ? O + (size_t)(u.pm * 256) * ldc : O2 + (size_t)((u.pm - split) * 256) * ldc;
        *(u32x4*)(base + (size_t)row * ldc + u.pn * 256 + col) = pack8(v0, v1); } };
struct FStoreF32 { float* O; int ldc;
    __device__ __forceinline__ void st(const pg8::Unit& u, int row, int col, f32x4 v0, f32x4 v1) const { float* p = O + (size_t)(u.pm * 256 + row) * ldc + u.pn * 256 + col; *(f32x4*)p = v0; *(f32x4*)(p + 4) = v1; } };
__device__ __forceinline__ f32x4 sig4(f32x4 v) { return (f32x4){sigmf(v[0]), sigmf(v[1]), sigmf(v[2]), sigmf(v[3])}; }
template <int SECOND> struct FMerge {
    const bf16_t* Gt; bf16_t* M;
    __device__ __forceinline__ void st(const pg8::Unit& u, int row, int col, f32x4 v0, f32x4 v1) const {
        const size_t o = (size_t)(u.pm * 256 + row) * 1024 + u.pn * 256 + col; const u32x4 g = *(const u32x4*)(Gt + o);
        f32x4 r0 = sig4(bf4(make_uint2(g.x, g.y))) * v0, r1 = sig4(bf4(make_uint2(g.z, g.w))) * v1;
        if (SECOND) { const u32x4 m = *(const u32x4*)(M + o); r0 += bf4(make_uint2(m.x, m.y)); r1 += bf4(make_uint2(m.z, m.w)); }
        *(u32x4*)(M + o) = pack8(r0, r1);
    }
};
struct FWo {
    const float* MOD; const float* x; float* X1;
    __device__ __forceinline__ void st(const pg8::Unit& u, int row, int col, f32x4 v0, f32x4 v1) const {
        const size_t t = (size_t)u.pm * 256 + row; const int c = u.pn * 256 + col; const int b = (int)(t >> 13);
        const float* gt = MOD + (size_t)b * 6144 + 2048 + c; const float* xr = x + t * 1024 + c; float* o = X1 + t * 1024 + c;
        *(f32x4*)o = *(const f32x4*)xr + *(const f32x4*)gt * v0; *(f32x4*)(o + 4) = *(const f32x4*)(xr + 4) + *(const f32x4*)(gt + 4) * v1;
    }
};
namespace idxk {
typedef short bf16x8 __attribute__((ext_vector_type(8)));
constexpr int NQ = 16, CAP = 768, CAPS = 772, THRESH = 512, KSEL = 256, L_ = 8192;
constexpr int L_VAL = 0, L_IDX = NQ * CAPS * 4, L_QF = 2 * NQ * CAPS * 4, L_HIST = L_QF + 16 * 64 * 16, L_CNT = L_HIST + 8 * 1024, L_TAU = L_CNT + 64, L_FLAG = L_TAU + 64, L_END = L_FLAG + 64, L_SIDX = 131072;
static_assert(L_END <= 131072, "indexer LDS map");
__device__ __forceinline__ unsigned sortable(float f) { const unsigned u = __builtin_bit_cast(unsigned, f); return (u & 0x80000000u) ? ~u : (u | 0x80000000u); }
__device__ __forceinline__ unsigned lanemask_lt_lo() { return __builtin_amdgcn_mbcnt_lo(~0u, 0u); }
__device__ __forceinline__ int mbcnt64(unsigned long long m) { return (int)__builtin_amdgcn_mbcnt_hi((unsigned)(m >> 32), __builtin_amdgcn_mbcnt_lo((unsigned)m, 0u)); }

#define DPPX_(v, CTRL) __builtin_amdgcn_update_dpp(0, (int)(v), CTRL, 0xF, 0xF, false)
__device__ __forceinline__ unsigned wave_and(unsigned v) { v &= (unsigned)DPPX_(v, 0xB1); v &= (unsigned)DPPX_(v, 0x4E); v &= (unsigned)DPPX_(v, 0x141); v &= (unsigned)DPPX_(v, 0x140);
    const unsigned a = (unsigned)__builtin_amdgcn_readlane((int)v, 0), b = (unsigned)__builtin_amdgcn_readlane((int)v, 16), c = (unsigned)__builtin_amdgcn_readlane((int)v, 32), d = (unsigned)__builtin_amdgcn_readlane((int)v, 48); return a & b & c & d; }
__device__ __forceinline__ unsigned wave_or(unsigned v) { v |= (unsigned)DPPX_(v, 0xB1); v |= (unsigned)DPPX_(v, 0x4E); v |= (unsigned)DPPX_(v, 0x141); v |= (unsigned)DPPX_(v, 0x140);
    const unsigned a = (unsigned)__builtin_amdgcn_readlane((int)v, 0), b = (unsigned)__builtin_amdgcn_readlane((int)v, 16), c = (unsigned)__builtin_amdgcn_readlane((int)v, 32), d = (unsigned)__builtin_amdgcn_readlane((int)v, 48); return a | b | c | d; }
__device__ __forceinline__ float wave_fmin(float v) {
#define FM_(CTRL) v = fminf(v, __builtin_bit_cast(float, DPPX_(__builtin_bit_cast(int, v), CTRL)))
    FM_(0xB1); FM_(0x4E); FM_(0x141); FM_(0x140);
#undef FM_
    const float a = __builtin_bit_cast(float, __builtin_amdgcn_readlane(__builtin_bit_cast(int, v), 0)), b = __builtin_bit_cast(float, __builtin_amdgcn_readlane(__builtin_bit_cast(int, v), 16)),
                c = __builtin_bit_cast(float, __builtin_amdgcn_readlane(__builtin_bit_cast(int, v), 32)), d = __builtin_bit_cast(float, __builtin_amdgcn_readlane(__builtin_bit_cast(int, v), 48));
    return fminf(fminf(a, b), fminf(c, d)); }
__device__ __forceinline__ float compact_query(LAS float* val, LAS unsigned* idx, LAS unsigned* hist, int cnt, int lane) {
    float v[12]; unsigned ix[12]; unsigned long long key[12];
    unsigned a_hi = ~0u, a_lo = ~0u, o_hi = 0u, o_lo = 0u;
#pragma unroll
    for (int r = 0; r < 12; ++r) { const int e = r * 64 + lane; v[r] = 0.f; ix[r] = 0u; key[r] = 0ull;
        if (e < cnt) { v[r] = val[e]; ix[r] = idx[e]; key[r] = ((unsigned long long)sortable(v[r]) << 13) | (unsigned long long)(8191u - ix[r]);
            a_hi &= (unsigned)(key[r] >> 32); a_lo &= (unsigned)key[r]; o_hi |= (unsigned)(key[r] >> 32); o_lo |= (unsigned)key[r]; } }
    const unsigned long long kand = ((unsigned long long)wave_and(a_hi) << 32) | wave_and(a_lo), kor = ((unsigned long long)wave_or(o_hi) << 32) | wave_or(o_lo);
    const unsigned long long diff = kand ^ kor;
    int fixed = 64 - (int)__builtin_clzll(diff);
    unsigned long long prefix = (fixed < 64) ? ((kor >> fixed) << fixed) : 0ull;
    int need = KSEL; bool done = false;
    while (!done) {
        const int shift = (fixed >= 8) ? fixed - 8 : 0; const unsigned mask = (1u << (fixed - shift)) - 1u;
        hist[lane * 4 + 0] = 0u; hist[lane * 4 + 1] = 0u; hist[lane * 4 + 2] = 0u; hist[lane * 4 + 3] = 0u;
        asm volatile("s_waitcnt lgkmcnt(0)" ::: "memory");
#pragma unroll
        for (int r = 0; r < 12; ++r) { const int e = r * 64 + lane;
            if (e < cnt && ((fixed >= 64) || ((key[r] >> fixed) == (prefix >> fixed)))) atomicAdd((unsigned*)&hist[(unsigned)(key[r] >> shift) & mask], 1u); }
        asm volatile("s_waitcnt lgkmcnt(0)" ::: "memory");
        const unsigned c0 = hist[lane * 4 + 0], c1 = hist[lane * 4 + 1], c2 = hist[lane * 4 + 2], c3 = hist[lane * 4 + 3];
        const unsigned loc = c0 + c1 + c2 + c3; unsigned suf = loc;
        suf += (unsigned)__builtin_amdgcn_update_dpp(0, (int)suf, 0x101, 0xF, 0xF, true); suf += (unsigned)__builtin_amdgcn_update_dpp(0, (int)suf, 0x102, 0xF, 0xF, true);
        suf += (unsigned)__builtin_amdgcn_update_dpp(0, (int)suf, 0x104, 0xF, 0xF, true); suf += (unsigned)__builtin_amdgcn_update_dpp(0, (int)suf, 0x108, 0xF, 0xF, true);
        { const unsigned t1 = (unsigned)__builtin_amdgcn_readlane((int)suf, 16), t2 = (unsigned)__builtin_amdgcn_readlane((int)suf, 32), t3 = (unsigned)__builtin_amdgcn_readlane((int)suf, 48);
          const int rw = lane >> 4; suf += (rw == 0) ? (t1 + t2 + t3) : (rw == 1) ? (t2 + t3) : (rw == 2) ? t3 : 0u; }
        unsigned cum = suf - loc; int fb = -1, fneed = 0, fcnt = 0;
        if (cum < (unsigned)need && (unsigned)need <= cum + c3) { fb = lane * 4 + 3; fneed = need - (int)cum; fcnt = (int)c3; } cum += c3;
        if (cum < (unsigned)need && (unsigned)need <= cum + c2) { fb = lane * 4 + 2; fneed = need - (int)cum; fcnt = (int)c2; } cum += c2;
        if (cum < (unsigned)need && (unsigned)need <= cum + c1) { fb = lane * 4 + 1; fneed = need - (int)cum; fcnt = (int)c1; } cum += c1;
        if (cum < (unsigned)need && (unsigned)need <= cum + c0) { fb = lane * 4 + 0; fneed = need - (int)cum; fcnt = (int)c0; }
        const unsigned long long bm = __ballot(fb >= 0); const int src = bm ? (int)__builtin_ctzll(bm) : 0;
        const int bin = __builtin_amdgcn_readlane(fb, src), nneed = __builtin_amdgcn_readlane(fneed, src), ncnt = __builtin_amdgcn_readlane(fcnt, src);
        prefix |= (unsigned long long)(unsigned)bin << shift; need = nneed; fixed = shift;
        if (ncnt == nneed || shift == 0) done = true;
    }
    int base = 0; float mn = 3.0e38f;
#pragma unroll
    for (int r = 0; r < 12; ++r) { const int e = r * 64 + lane; const bool keep = (e < cnt) && ((key[r] >> fixed) >= (prefix >> fixed));
        const unsigned long long m = __ballot(keep); const int pos = base + mbcnt64(m);
        if (keep) { val[pos] = v[r]; idx[pos] = ix[r]; mn = fminf(mn, v[r]); } base += (int)__builtin_popcountll(m); }
    return wave_fmin(mn);
}

struct IdxArgs { const bf16_t* QLATN; const bf16_t* KIDXN; const float* WIDX; const bf16_t* WiqT; int* IDX; };

__device__ __forceinline__ void index_task(const IdxArgs& A, LAS unsigned char* lds, int b, int q0) {
    int tx = threadIdx.x; asm volatile("" : "+v"(tx));
    const int wave = __builtin_amdgcn_readfirstlane(tx >> 6), lane = tx & 63, n = lane & 15, g = lane >> 4;
    LAS float* VAL = (LAS float*)(lds + L_VAL); LAS unsigned* IDXB = (LAS unsigned*)(lds + L_IDX); LAS unsigned* HIST = (LAS unsigned*)(lds + L_HIST) + wave * 256;
    LAS unsigned* CNT = (LAS unsigned*)(lds + L_CNT); LAS float* TAU = (LAS float*)(lds + L_TAU); LAS unsigned* FLAG = (LAS unsigned*)(lds + L_FLAG);
    const size_t trow = (size_t)b * L_ + q0;
    if (tx < NQ) { CNT[tx] = 0u; TAU[tx] = -__builtin_inff(); } if (tx < 3) FLAG[tx] = 0u;
    {
        bf16x8 qb[8];
#pragma unroll
        for (int kk = 0; kk < 8; ++kk) qb[kk] = *(const bf16x8*)(A.QLATN + (trow + n) * 256 + kk * 32 + 8 * g);
#pragma unroll
        for (int s = 0; s < 2; ++s) {
            f32x4 x1 = {0.f, 0.f, 0.f, 0.f}, x2 = {0.f, 0.f, 0.f, 0.f};
            const int r = n, d1 = 32 * s + 8 * (r >> 2) + (r & 3), d2 = d1 + 4;
            const bf16_t* w1 = A.WiqT + (size_t)(wave * 64 + d1) * 256 + 8 * g; const bf16_t* w2 = A.WiqT + (size_t)(wave * 64 + d2) * 256 + 8 * g;
#pragma unroll
            for (int kk = 0; kk < 8; ++kk) { const bf16x8 a1 = *(const bf16x8*)(w1 + kk * 32), a2 = *(const bf16x8*)(w2 + kk * 32);
                x1 = __builtin_amdgcn_mfma_f32_16x16x32_bf16(a1, qb[kk], x1, 0, 0, 0); x2 = __builtin_amdgcn_mfma_f32_16x16x32_bf16(a2, qb[kk], x2, 0, 0, 0); }
            u32x4 fr; fr.x = pk2bf(x1[0], x1[1]); fr.y = pk2bf(x1[2], x1[3]); fr.z = pk2bf(x2[0], x2[1]); fr.w = pk2bf(x2[2], x2[3]);
            *(LAS u32x4*)(lds + L_QF + ((wave * 2 + s) * 64 + lane) * 16) = fr;
        }
    }
    __syncthreads();
    bf16x8 qf[8][2];
#pragma unroll
    for (int h = 0; h < 8; ++h)
#pragma unroll
        for (int s = 0; s < 2; ++s) qf[h][s] = *(const LAS bf16x8*)(lds + L_QF + ((h * 2 + s) * 64 + lane) * 16);
    float wq[8];
    { const f32x4 w0 = *(const f32x4*)(A.WIDX + (trow + n) * 8), w1 = *(const f32x4*)(A.WIDX + (trow + n) * 8 + 4);
      wq[0] = w0[0]; wq[1] = w0[1]; wq[2] = w0[2]; wq[3] = w0[3]; wq[4] = w1[0]; wq[5] = w1[1]; wq[6] = w1[2]; wq[7] = w1[3]; }
    const int qpos = q0 + n, kmax = q0 + 15;
    const int nst = (kmax >> 8) + 1;
    const bf16_t* kbase = A.KIDXN + (size_t)b * L_ * 64;
    bf16x8 ka[2][2];
#pragma unroll
    for (int blk = 0; blk < 2; ++blk) { const int kb = 32 * wave + 16 * blk; if (kb <= kmax) { const bf16_t* kr = kbase + (size_t)(kb + n) * 64 + 8 * g; ka[blk][0] = *(const bf16x8*)kr; ka[blk][1] = *(const bf16x8*)(kr + 32); } }
    for (int j = 0, jf = 0; j < nst; ++j, jf = (jf == 2) ? 0 : jf + 1) {
        const float tau = TAU[n];
        bf16x8 kc[2][2];
#pragma unroll
        for (int blk = 0; blk < 2; ++blk) { kc[blk][0] = ka[blk][0]; kc[blk][1] = ka[blk][1];
            const int kbn = 256 * (j + 1) + 32 * wave + 16 * blk; if (kbn <= kmax) { const bf16_t* kr = kbase + (size_t)(kbn + n) * 64 + 8 * g; ka[blk][0] = *(const bf16x8*)kr; ka[blk][1] = *(const bf16x8*)(kr + 32); } }
#pragma unroll
        for (int blk = 0; blk < 2; ++blk) {
            const int kb = 256 * j + 32 * wave + 16 * blk;
            if (kb <= kmax) {
                const bf16x8 a0 = kc[blk][0], a1 = kc[blk][1];
                float sc[4] = {0.f, 0.f, 0.f, 0.f};
                f32x4 acc[8];
#pragma unroll
                for (int h = 0; h < 8; ++h) acc[h] = __builtin_amdgcn_mfma_f32_16x16x32_bf16(a0, qf[h][0], (f32x4){0.f, 0.f, 0.f, 0.f}, 0, 0, 0);
#pragma unroll
                for (int h = 0; h < 8; ++h) acc[h] = __builtin_amdgcn_mfma_f32_16x16x32_bf16(a1, qf[h][1], acc[h], 0, 0, 0);
                __builtin_amdgcn_sched_barrier(0);
#pragma unroll
                for (int h = 0; h < 8; ++h) {
#pragma unroll
                    for (int i = 0; i < 4; ++i) sc[i] = fmaf(wq[h], fmaxf(acc[h][i], 0.f), sc[i]); }
                bool ps[4]; int np = 0;
#pragma unroll
                for (int i = 0; i < 4; ++i) { const int key = kb + 4 * g + i; ps[i] = (key <= qpos) && (sc[i] > tau); np += ps[i] ? 1 : 0; }
                if (np) {
                    unsigned pos = __hip_atomic_fetch_add((unsigned*)&CNT[n], (unsigned)np, __ATOMIC_RELAXED, __HIP_MEMORY_SCOPE_WORKGROUP);
                    if (pos + np > THRESH) FLAG[jf] = 1u;
#pragma unroll
                    for (int i = 0; i < 4; ++i) if (ps[i]) { VAL[n * CAPS + pos] = sc[i]; IDXB[n * CAPS + pos] = (unsigned)(kb + 4 * g + i); ++pos; }
                }
            }
        }
        asm volatile("s_waitcnt lgkmcnt(0)\n\ts_barrier" ::: "memory");
        if (tx == 0) FLAG[jf == 0 ? 2 : jf - 1] = 0u;
        if (FLAG[jf]) {
#pragma unroll
            for (int qq = 0; qq < 2; ++qq) { const int q = wave * 2 + qq; const int c = (int)CNT[q];
                if (c > 384) { const float t = compact_query(VAL + q * CAPS, IDXB + q * CAPS, HIST, c, lane); if (lane == 0) { TAU[q] = t; CNT[q] = KSEL; } } }
            __syncthreads();
        }
    }
#pragma unroll
    for (int qq = 0; qq < 2; ++qq) { const int q = wave * 2 + qq; int c = (int)CNT[q];
        if (c > KSEL) { (void)compact_query(VAL + q * CAPS, IDXB + q * CAPS, HIST, c, lane); c = KSEL; }
        asm volatile("s_waitcnt lgkmcnt(0)" ::: "memory");
        HIST[lane * 4 + 0] = 0u; HIST[lane * 4 + 1] = 0u; HIST[lane * 4 + 2] = 0u; HIST[lane * 4 + 3] = 0u;
        asm volatile("s_waitcnt lgkmcnt(0)" ::: "memory");
        for (int e = lane; e < c; e += 64) { const unsigned k = IDXB[q * CAPS + e]; atomicOr((unsigned*)&HIST[k >> 5], 1u << (k & 31u)); }
        asm volatile("s_waitcnt lgkmcnt(0)" ::: "memory");
        unsigned wd[4]; int pc = 0;
#pragma unroll
        for (int i = 0; i < 4; ++i) { wd[i] = HIST[lane * 4 + i]; pc += (int)__builtin_popcount(wd[i]); }
        int incl = pc;
#pragma unroll
        for (int o = 1; o < 64; o <<= 1) { const int t = __shfl_up(incl, o); if (lane >= o) incl += t; }
        LAS int* out = (LAS int*)(lds + L_SIDX) + q * KSEL; int pos = incl - pc;
#pragma unroll
        for (int i = 0; i < 4; ++i) { unsigned w = wd[i]; while (w) { const int bit = __builtin_ctz(w); w &= w - 1u; out[pos++] = (lane * 4 + i) * 32 + bit; } }
#pragma unroll
        for (int e = lane; e < KSEL; e += 64) if (e >= c) out[e] = -1; }
    __syncthreads();
}
__device__ __forceinline__ void index_phase(const IdxArgs& A, LAS unsigned char* lds, int bx, int G) {
    if (G == 256) { for (int k = 0; k < 4; ++k) { const int b = k >> 1, qt = (k & 1) ? 511 - bx : bx; index_task(A, lds, b, qt * 16); } }
    else { for (int id = bx; id < 1024; id += G) index_task(A, lds, id >> 9, (id & 511) * 16); }
}
}
namespace sattn {
typedef short bf16x8 __attribute__((ext_vector_type(8)));
typedef short s16x4 __attribute__((ext_vector_type(4)));
typedef unsigned u32x2_t __attribute__((ext_vector_type(2)));
typedef __attribute__((ext_vector_type(4))) short v4i16_t;
__device__ __forceinline__ s16x4 vtr(LAS unsigned char* p) { return __builtin_bit_cast(s16x4, __builtin_amdgcn_ds_read_tr16_b64_v4i16((LAS v4i16_t*)p)); }
constexpr int QSPLIT = 12288;
__device__ __forceinline__ void dma16(const void* gsrc, unsigned lds_dst) { unsigned keep; asm volatile("s_mov_b32 %0, m0\n\ts_mov_b32 m0, %2\n\ts_nop 0\n\tglobal_load_lds_dwordx4 %1, off\n\ts_mov_b32 m0, %0" : "=&s"(keep) : "v"(gsrc), "s"(lds_dst) : "memory"); }
struct AArgs { const bf16_t* CKVN; bf16_t* Q0; bf16_t* Q1; };

__device__ __forceinline__ void attn_query(const AArgs& A, LAS unsigned char* tile, int t, int lane, const LAS int* sidx) {
    const int n = lane & 15, g = lane >> 4, b = t >> 13, l = t & 8191;
    const int nv = (l + 1 < 256) ? l + 1 : 256;
    const bf16_t* ckv = A.CKVN + (size_t)b * 8192 * 256;
    bf16_t* qrow = (t < QSPLIT) ? A.Q0 + (size_t)t * 2048 : A.Q1 + (size_t)(t - QSPLIT) * 2048;
    bf16x8 qf[8];
#pragma unroll
    for (int s = 0; s < 8; ++s) { qf[s] = (bf16x8){0, 0, 0, 0, 0, 0, 0, 0}; if (n < 8) qf[s] = *(const bf16x8*)(qrow + n * 256 + 32 * s + 8 * g); }
    f32x4 o[16];
#pragma unroll
    for (int c = 0; c < 16; ++c) o[c] = (f32x4){0.f, 0.f, 0.f, 0.f};
    float mrun = -3.0e38f, lsum = 0.f;
    const int nblk = (nv + 15) >> 4;
    asm volatile("s_waitcnt vmcnt(0) lgkmcnt(0)" ::: "memory");
#pragma unroll
    for (int s = 0; s < 8; ++s) asm volatile("" : "+v"(qf[s]));
#define ATT_ISSUE(J) do { const int k_ = (J) * 16 + n; int my_ = (k_ < nv) ? sidx[k_] : 0; if (my_ < 0) my_ = 0; const unsigned dst_ = tbase + ((J) & 1) * 8192u; \
        _Pragma("unroll") for (int i = 0; i < 8; ++i) { const int r = 2 * i + (lane >> 5); const int row = __shfl(my_, r); \
            const bf16_t* src = ckv + (size_t)row * 256 + (((lane & 31) ^ r) << 3); \
            dma16(src, dst_ + i * 1024u); } } while (0)
    const unsigned tbase = (unsigned)__builtin_amdgcn_readfirstlane((int)(unsigned)(size_t)tile);
    ATT_ISSUE(0);
    for (int j = 0; j < nblk; ++j) {
        LAS unsigned char* buf = tile + (j & 1) * 8192;
        if (j + 1 < nblk) { ATT_ISSUE(j + 1); asm volatile("s_waitcnt vmcnt(8)" ::: "memory"); }
        else asm volatile("s_waitcnt vmcnt(0)" ::: "memory");
        __builtin_amdgcn_sched_barrier(0);
        f32x4 s0 = {0.f, 0.f, 0.f, 0.f};
#pragma unroll
        for (int s = 0; s < 8; ++s) s0 = __builtin_amdgcn_mfma_f32_16x16x32_bf16(*(const LAS bf16x8*)(buf + n * 512 + (((4 * s + g) ^ n) << 4)), qf[s], s0, 0, 0, 0);
        const int k0 = j * 16 + 4 * g;
        float bm = -3.0e38f;
#pragma unroll
        for (int i = 0; i < 4; ++i) { if (k0 + i >= nv) s0[i] = -3.0e38f; bm = fmaxf(bm, s0[i]); }
        bm = fmaxf(bm, __shfl_xor(bm, 16)); bm = fmaxf(bm, __shfl_xor(bm, 32));
        const float mnew = fmaxf(mrun, bm), alpha = __expf(mrun - mnew); const bool grow = mnew > mrun; mrun = mnew;
        float p[4]; float ps = 0.f;
#pragma unroll
        for (int i = 0; i < 4; ++i) { p[i] = (k0 + i < nv) ? __expf(s0[i] - mnew) : 0.f; ps += p[i]; }
        lsum = lsum * alpha + ps;
        const s16x4 pf = __builtin_bit_cast(s16x4, (u32x2_t){pk2bf(p[0], p[1]), pk2bf(p[2], p[3])});
        if (__any(grow)) {
#pragma unroll
            for (int c = 0; c < 16; ++c) o[c] = o[c] * alpha;
        }
        const int q4 = (lane & 15) >> 2, p4 = lane & 3, r0 = 4 * g + q4;
#pragma unroll
        for (int c = 0; c < 16; ++c) { const int ch = 2 * c + (p4 >> 1);
            const s16x4 af = vtr(buf + r0 * 512 + ((ch ^ r0) << 4) + ((p4 & 1) << 3));
            o[c] = __builtin_amdgcn_mfma_f32_16x16x16bf16_1k(af, pf, o[c], 0, 0, 0); }
        asm volatile("s_waitcnt lgkmcnt(0)" ::: "memory");
    }
#undef ATT_ISSUE
    lsum += __shfl_xor(lsum, 16); lsum += __shfl_xor(lsum, 32);
    const float inv = 1.f / lsum;
    if (n < 8) {
#pragma unroll
        for (int c = 0; c < 16; ++c) { const f32x4 v = o[c] * inv; *(uint2*)(qrow + n * 256 + 16 * c + 4 * g) = make_uint2(pk2bf(v[0], v[1]), pk2bf(v[2], v[3])); }
    }
}
}
namespace dsa {
struct DArgs { idxk::IdxArgs I; sattn::AArgs A; unsigned* qword; };
__device__ __forceinline__ void dsa_task(const DArgs& D, LAS unsigned char* lds, int b, int q0) {
    idxk::index_task(D.I, lds, b, q0);
    int tx = threadIdx.x; asm volatile("" : "+v"(tx));
    const int wave = __builtin_amdgcn_readfirstlane(tx >> 6), lane = tx & 63;
#pragma unroll 1
    for (int qq = 0; qq < 2; ++qq) { const int q = 2 * wave + qq;
        sattn::attn_query(D.A, lds + wave * 16384, b * 8192 + q0 + q, lane, (const LAS int*)(lds + idxk::L_SIDX) + q * 256); }
    asm volatile("s_waitcnt vmcnt(0) lgkmcnt(0)" ::: "memory");
    __syncthreads();
}
__device__ __forceinline__ void dsa_queue(const DArgs& D, LAS unsigned char* lds, volatile LAS unsigned* slot) {
    for (;;) {
        if (threadIdx.x == 0) *slot = __hip_atomic_fetch_add(D.qword, 1u, __ATOMIC_RELAXED, __HIP_MEMORY_SCOPE_AGENT);
        __syncthreads();
        const unsigned id = *slot;
        __syncthreads();
        if (id >= 1024u) break;
        dsa_task(D, lds, (int)(id & 1u), (511 - (int)(id >> 1)) * 16);
    }
}
}
namespace dnet {
typedef short bf16x8 __attribute__((ext_vector_type(8)));
typedef unsigned u32x2_t __attribute__((ext_vector_type(2)));
typedef __attribute__((ext_vector_type(4))) short v4i16p_t;
__device__ __forceinline__ float bflo(unsigned w) { return __builtin_bit_cast(float, w << 16); }
__device__ __forceinline__ float bfhi(unsigned w) { return __builtin_bit_cast(float, w & 0xffff0000u); }
#define DPP_ADDF(v, CTRL) v += __builtin_bit_cast(float, __builtin_amdgcn_update_dpp(0, __builtin_bit_cast(int, v), CTRL, 0xF, 0xF, false))
__device__ __forceinline__ void conv_phase(const bf16_t* QKVP, bf16_t* QKVN, const float* convw, int gw, int NGW, int lane) {
    for (int it = gw; it < 1024 * 6; it += NGW) {
        const int slab = it % 6, tb = it / 6, t0 = tb * 16, ch = slab * 512 + lane * 8;
        float w[4][8];
#pragma unroll
        for (int i = 0; i < 4; ++i) { const f32x4 a = *(const f32x4*)(convw + (size_t)i * 3072 + ch), b = *(const f32x4*)(convw + (size_t)i * 3072 + ch + 4);
            w[i][0] = a[0]; w[i][1] = a[1]; w[i][2] = a[2]; w[i][3] = a[3]; w[i][4] = b[0]; w[i][5] = b[1]; w[i][6] = b[2]; w[i][7] = b[3]; }
        u32x4 r0 = {0u, 0u, 0u, 0u}, r1 = r0, r2 = r0;
        if ((t0 & 8191) != 0) { r0 = *(const u32x4*)(QKVP + (size_t)(t0 - 3) * 3072 + ch); r1 = *(const u32x4*)(QKVP + (size_t)(t0 - 2) * 3072 + ch); r2 = *(const u32x4*)(QKVP + (size_t)(t0 - 1) * 3072 + ch); }
        u32x4 rows[16];
#pragma unroll
        for (int tt = 0; tt < 16; ++tt) rows[tt] = *(const u32x4*)(QKVP + (size_t)(t0 + tt) * 3072 + ch);
#pragma unroll
        for (int tt = 0; tt < 16; ++tt) {
            const u32x4 r3 = rows[tt];
            float y[8];
#pragma unroll
            for (int e = 0; e < 4; ++e) {
                const float a0 = bflo(r0[e]) * w[0][2 * e] + bflo(r1[e]) * w[1][2 * e] + bflo(r2[e]) * w[2][2 * e] + bflo(r3[e]) * w[3][2 * e];
                const float a1 = bfhi(r0[e]) * w[0][2 * e + 1] + bfhi(r1[e]) * w[1][2 * e + 1] + bfhi(r2[e]) * w[2][2 * e + 1] + bfhi(r3[e]) * w[3][2 * e + 1];
                y[2 * e] = a0 / (1.f + __expf(-a0)); y[2 * e + 1] = a1 / (1.f + __expf(-a1)); }
            if (slab < 4) {
                float ss = 0.f;
#pragma unroll
                for (int e = 0; e < 8; ++e) ss += y[e] * y[e];
                DPP_ADDF(ss, 0xB1); DPP_ADDF(ss, 0x4E); DPP_ADDF(ss, 0x141); DPP_ADDF(ss, 0x140);
                const float rs = 1.f / sqrtf(ss + 1e-6f);
#pragma unroll
                for (int e = 0; e < 8; ++e) y[e] *= rs;
            }
            u32x4 o; o.x = pk2bf(y[0], y[1]); o.y = pk2bf(y[2], y[3]); o.z = pk2bf(y[4], y[5]); o.w = pk2bf(y[6], y[7]);
            *(u32x4*)(QKVN + (size_t)(t0 + tt) * 3072 + ch) = o;
            r0 = r1; r1 = r2; r2 = r3;
        }
    }
}
constexpr int PR = 272, L_QN = 0, L_KN = 64 * PR, L_V = 2 * 64 * PR, L_A = 3 * 64 * PR, L_SM = 4 * 64 * PR, L_TI = L_SM + 5 * 256, L_PEND = L_TI + 4 * 16 * 16 * 2;
struct PrepArgs { bf16_t* QKVN; const float* BETA; const float* G; bf16_t* W; bf16_t* ATT; float* GL; };
__device__ __forceinline__ float dpp_swap1(float v) { return __builtin_bit_cast(float, __builtin_amdgcn_update_dpp(0, __builtin_bit_cast(int, v), 0xB1, 0xF, 0xF, false)); }
__device__ __forceinline__ void prep_chunk(const PrepArgs& A, LAS unsigned char* lds, int cid) {
    int tx = threadIdx.x; asm volatile("" : "+v"(tx));
    const int wave = __builtin_amdgcn_readfirstlane(tx >> 6), lane = tx & 63, n = lane & 15, g = lane >> 4;
    const int nc = cid & 127, h = (cid >> 7) & 7, b = cid >> 10; const size_t t0 = (size_t)b * 8192 + nc * 64;
    LAS float* SM = (LAS float*)(lds + L_SM);
    for (int i = tx; i < 3 * 64 * 16; i += 512) { const int which = i / 1024, r = (i >> 4) & 63, c16 = i & 15;
        const u32x4 v = *(const u32x4*)(A.QKVN + (t0 + r) * 3072 + which * 1024 + h * 128 + c16 * 8);
        *(LAS u32x4*)(lds + which * 64 * PR + r * PR + c16 * 16) = v; }
    if (wave == 0) {
        float gg = A.G[(t0 + lane) * 8 + h]; const float be = A.BETA[(t0 + lane) * 8 + h];
#pragma unroll
        for (int o = 1; o < 64; o <<= 1) { const float t = __shfl_up(gg, o); if (lane >= o) gg += t; }
        const float gl = __shfl(gg, 63);
        SM[lane] = be; SM[64 + lane] = gg; SM[128 + lane] = __expf(gg); SM[192 + lane] = __expf(gl - gg);
        if (lane == 0) A.GL[cid] = __expf(gl);
    }
    __syncthreads();
#pragma unroll
    for (int q = 0; q < 4; ++q) {
        const int tl = wave * 4 + q, isq = tl >> 4, mi = (tl >> 2) & 3, nj = tl & 3;
        if (nj > mi) continue;
        f32x4 acc = {0.f, 0.f, 0.f, 0.f};
        const LAS unsigned char* ar = lds + (isq ? L_QN : L_KN) + (16 * mi + n) * PR + 16 * g; const LAS unsigned char* br = lds + L_KN + (16 * nj + n) * PR + 16 * g;
#pragma unroll
        for (int s = 0; s < 4; ++s) acc = __builtin_amdgcn_mfma_f32_16x16x32_bf16(*(const LAS bf16x8*)(ar + 64 * s), *(const LAS bf16x8*)(br + 64 * s), acc, 0, 0, 0);
        const int j = 16 * nj + n; const float gcj = SM[64 + j];
#pragma unroll
        for (int r = 0; r < 4; ++r) { const int i = 16 * mi + 4 * g + r; const float dec = __expf(fminf(SM[64 + i] - gcj, 0.f));
            if (isq) A.ATT[(size_t)cid * 4096 + i * 64 + j] = f2bfd((j <= i) ? acc[r] * 0.08838834764831845f * dec : 0.f);
            else *(LAS float*)(lds + L_A + i * PR + j * 4) = (j < i) ? SM[i] * acc[r] * dec : 0.f; }
    }
    for (int i = tx; i < 64 * 64; i += 512) { const int r = i >> 6, c = i & 63; if ((c >> 4) > (r >> 4)) { *(LAS float*)(lds + L_A + r * PR + c * 4) = 0.f; A.ATT[(size_t)cid * 4096 + r * 64 + c] = 0; } }
    __syncthreads();
    if (wave < 4 && lane < 16) {
        float tcol[16];
#pragma unroll
        for (int i = 0; i < 16; ++i) { float s = (i == lane) ? 1.f : 0.f;
#pragma unroll
            for (int j = 0; j < i; ++j) s = fmaf(-*(const LAS float*)(lds + L_A + (16 * wave + i) * PR + (16 * wave + j) * 4), tcol[j], s);
            tcol[i] = s; }
#pragma unroll
        for (int i = 0; i < 16; ++i) *(LAS bf16_t*)(lds + L_TI + ((wave * 16 + i) * 16 + lane) * 2) = f2bfd(tcol[i] - ((i == lane) ? 1.f : 0.f));
    }
    __syncthreads();
    {
        const int q4 = n >> 2, p4 = n & 3;
#pragma unroll 1
        for (int tt = 0; tt < 2; ++tt) {
            const int col0 = 32 * wave + 16 * tt; const bool isw = col0 >= 128;
            const LAS unsigned char* srcm = lds + (isw ? L_KN + (col0 - 128) * 2 : L_V + col0 * 2);
            typedef short s16x4_t __attribute__((ext_vector_type(4)));
            s16x4_t xb[4];
#pragma unroll
            for (int bb = 0; bb < 4; ++bb) {
                const s16x4_t r4 = __builtin_bit_cast(s16x4_t, __builtin_amdgcn_ds_read_tr16_b64_v4i16((LAS v4i16p_t*)(srcm + (16 * bb + 4 * g + q4) * PR + 8 * p4)));
                f32x4 acc;
#pragma unroll
                for (int r = 0; r < 4; ++r) { const int i = 16 * bb + 4 * g + r; float sc = SM[i]; if (isw) sc *= SM[128 + i]; acc[r] = __builtin_bit_cast(float, (unsigned)(unsigned short)r4[r] << 16) * sc; }
#pragma unroll
                for (int bp = 0; bp < bb; ++bp) { const f32x4 av = *(const LAS f32x4*)(lds + L_A + (16 * bb + n) * PR + (16 * bp + 4 * g) * 4);
                    u32x2_t w; w.x = pk2bf(-av[0], -av[1]); w.y = pk2bf(-av[2], -av[3]);
                    acc = __builtin_amdgcn_mfma_f32_16x16x16bf16_1k(__builtin_bit_cast(s16x4_t, w), xb[bp], acc, 0, 0, 0); }
                { u32x2_t w; w.x = pk2bf(acc[0], acc[1]); w.y = pk2bf(acc[2], acc[3]);
                  const s16x4_t ti = *(const LAS s16x4_t*)(lds + L_TI + ((bb * 16 + n) * 16 + 4 * g) * 2);
                  acc = __builtin_amdgcn_mfma_f32_16x16x16bf16_1k(ti, __builtin_bit_cast(s16x4_t, w), acc, 0, 0, 0); }
                { u32x2_t w; w.x = pk2bf(acc[0], acc[1]); w.y = pk2bf(acc[2], acc[3]); xb[bb] = __builtin_bit_cast(s16x4_t, w); }
                if (!isw) {
#pragma unroll
                    for (int r = 0; r < 4; ++r) A.QKVN[(t0 + 16 * bb + 4 * g + r) * 3072 + 2048 + h * 128 + col0 + n] = f2bfd(acc[r]);
                } else {
#pragma unroll
                    for (int r = 0; r < 4; ++r) A.W[((size_t)cid * 64 + 16 * bb + 4 * g + r) * 128 + (col0 - 128) + n] = f2bfd(acc[r]);
                }
            }
        }
    }
    for (int i = tx; i < 2 * 64 * 16; i += 512) { const int which = i >> 10, r = (i >> 4) & 63, c16 = i & 15;
        const u32x4 v = *(const LAS u32x4*)(lds + which * 64 * PR + r * PR + c16 * 16); const float f = which ? SM[192 + r] : SM[128 + r] * 0.08838834764831845f;
        u32x4 o; o.x = pk2bf(bflo(v.x) * f, bfhi(v.x) * f); o.y = pk2bf(bflo(v.y) * f, bfhi(v.y) * f); o.z = pk2bf(bflo(v.z) * f, bfhi(v.z) * f); o.w = pk2bf(bflo(v.w) * f, bfhi(v.w) * f);
        *(u32x4*)(A.QKVN + (t0 + r) * 3072 + which * 1024 + h * 128 + c16 * 8) = o; }
    __syncthreads();
}
__device__ __forceinline__ void prep_phase(const PrepArgs& A, LAS unsigned char* lds, int bx, int G) { for (int cid = bx; cid < 2048; cid += G) prep_chunk(A, lds, cid); }
}
namespace dnet {
typedef short s16x4 __attribute__((ext_vector_type(4)));
typedef __attribute__((ext_vector_type(4))) short v4i16_t;
__device__ __forceinline__ s16x4 vtr(const LAS unsigned char* p) { return __builtin_bit_cast(s16x4, __builtin_amdgcn_ds_read_tr16_b64_v4i16((LAS v4i16_t*)p)); }
constexpr int PA = 144, S_W = 0, S_QD = 64 * PR, S_KD = 2 * 64 * PR, S_U = 3 * 64 * PR, S_ATT = 4 * 64 * PR, S_OBUF = S_ATT + 64 * PA, S_END = S_OBUF + 64 * PR;
static_assert(S_END <= 131072, "scan LDS map");
struct ScanArgs { const bf16_t* QKVN; const bf16_t* W; const bf16_t* ATT; const float* GL; bf16_t* O; const float* onw; };
__device__ __forceinline__ bf16x8 frag2(const LAS unsigned char* p) { return *(const LAS bf16x8*)p; }
typedef unsigned u32x2 __attribute__((ext_vector_type(2)));
__device__ __forceinline__ int perm_half(int c, int hh) { const int k = 8 * c + 4 * hh; return (k < 16) ? 16 * (k >> 2) : 16 * ((k - 16) >> 2) + 8; }
__device__ __forceinline__ void scan_bh(const ScanArgs& A, LAS unsigned char* lds, int bh) {
    int tx = threadIdx.x; asm volatile("" : "+v"(tx));
    const int wave = __builtin_amdgcn_readfirstlane(tx >> 6), lane = tx & 63, n = lane & 15, g = lane >> 4, q4 = n >> 2, p4 = n & 3;
    const int b = bh >> 3, h = bh & 7, e0 = 16 * wave;
    const int sr = tx >> 3, sc = tx & 7;
    (void)sr; (void)sc;
    u32x4 pfA[9], pfB[9];
    auto issue = [&](u32x4 (&pf)[9], int nc_) { const int nc = nc_ < 127 ? nc_ : 127;
        const size_t t0 = (size_t)b * 8192 + nc * 64; const int cid = bh * 128 + nc;
#pragma unroll
        for (int i = 0; i < 2; ++i) { const int p = tx + 512 * i, r = p >> 4, c = p & 15;
            pf[i] = *(const u32x4*)(A.W + ((size_t)cid * 64 + r) * 128 + c * 8);
            pf[2 + i] = *(const u32x4*)(A.QKVN + (t0 + r) * 3072 + h * 128 + c * 8);
            pf[4 + i] = *(const u32x4*)(A.QKVN + (t0 + r) * 3072 + 1024 + h * 128 + c * 8);
            pf[6 + i] = *(const u32x4*)(A.QKVN + (t0 + r) * 3072 + 2048 + h * 128 + c * 8); }
        pf[8] = *(const u32x4*)(A.ATT + (size_t)cid * 4096 + tx * 8);
    };
    auto commit = [&](const u32x4 (&pf)[9]) {
#pragma unroll
        for (int i = 0; i < 2; ++i) { const int p = tx + 512 * i, r = p >> 4, c = p & 15, kg = c >> 2, cc = c & 3;
            LAS unsigned char* wq = lds + r * PR + kg * 64;
            *(LAS u32x2*)(wq + S_W + perm_half(cc, 0)) = (u32x2){pf[i].x, pf[i].y}; *(LAS u32x2*)(wq + S_W + perm_half(cc, 1)) = (u32x2){pf[i].z, pf[i].w};
            *(LAS u32x2*)(wq + S_QD + perm_half(cc, 0)) = (u32x2){pf[2 + i].x, pf[2 + i].y}; *(LAS u32x2*)(wq + S_QD + perm_half(cc, 1)) = (u32x2){pf[2 + i].z, pf[2 + i].w};
            *(LAS u32x4*)(lds + S_KD + r * PR + c * 16) = pf[4 + i]; *(LAS u32x4*)(lds + S_U + r * PR + c * 16) = pf[6 + i]; }
        { const int r = tx >> 3, c = tx & 7, kg = c >> 2, cc = c & 3; LAS unsigned char* wa = lds + S_ATT + r * PA + kg * 64;
          *(LAS u32x2*)(wa + perm_half(cc, 0)) = (u32x2){pf[8].x, pf[8].y}; *(LAS u32x2*)(wa + perm_half(cc, 1)) = (u32x2){pf[8].z, pf[8].w}; }
    };
    const float gl_lo = A.GL[bh * 128 + lane], gl_hi = A.GL[bh * 128 + 64 + lane];
    f32x4 S[8];
#pragma unroll
    for (int d = 0; d < 8; ++d) S[d] = (f32x4){0.f, 0.f, 0.f, 0.f};
    auto compute = [&](int nc) {
        const float gl = __builtin_bit_cast(float, (nc < 64) ? __builtin_amdgcn_readlane(__builtin_bit_cast(int, gl_lo), nc & 63) : __builtin_amdgcn_readlane(__builtin_bit_cast(int, gl_hi), nc & 63));
        const size_t t0 = (size_t)b * 8192 + nc * 64;
        bf16x8 sp[4];
#pragma unroll
        for (int s = 0; s < 4; ++s) { u32x4 w; w.x = pk2bf(S[2 * s][0], S[2 * s][1]); w.y = pk2bf(S[2 * s][2], S[2 * s][3]); w.z = pk2bf(S[2 * s + 1][0], S[2 * s + 1][1]); w.w = pk2bf(S[2 * s + 1][2], S[2 * s + 1][3]);
            sp[s] = __builtin_bit_cast(bf16x8, w); }
        f32x4 vn[4];
#pragma unroll
        for (int mt = 0; mt < 4; ++mt) {
            const s16x4 u4 = vtr(lds + S_U + (16 * mt + 4 * g + q4) * PR + (e0 + 4 * p4) * 2);
            f32x4 acc; acc[0] = __builtin_bit_cast(float, ((unsigned)(unsigned short)u4[0] << 16) ^ 0x80000000u); acc[1] = __builtin_bit_cast(float, ((unsigned)(unsigned short)u4[1] << 16) ^ 0x80000000u);
            acc[2] = __builtin_bit_cast(float, ((unsigned)(unsigned short)u4[2] << 16) ^ 0x80000000u); acc[3] = __builtin_bit_cast(float, ((unsigned)(unsigned short)u4[3] << 16) ^ 0x80000000u);
            const LAS unsigned char* wr = lds + S_W + (16 * mt + n) * PR + 16 * g;
#pragma unroll
            for (int s = 0; s < 4; ++s) acc = __builtin_amdgcn_mfma_f32_16x16x32_bf16(frag2(wr + 64 * s), sp[s], acc, 0, 0, 0);
            vn[mt] = acc;
        }
        bf16x8 vp[2];
#pragma unroll
        for (int s = 0; s < 2; ++s) { u32x4 w; w.x = pk2bf(vn[2 * s][0], vn[2 * s][1]); w.y = pk2bf(vn[2 * s][2], vn[2 * s][3]); w.z = pk2bf(vn[2 * s + 1][0], vn[2 * s + 1][1]); w.w = pk2bf(vn[2 * s + 1][2], vn[2 * s + 1][3]);
            w.x ^= 0x80008000u; w.y ^= 0x80008000u; w.z ^= 0x80008000u; w.w ^= 0x80008000u; vp[s] = __builtin_bit_cast(bf16x8, w); }
#pragma unroll
        for (int mt = 0; mt < 4; ++mt) {
            f32x4 acc = {0.f, 0.f, 0.f, 0.f};
            const LAS unsigned char* qr = lds + S_QD + (16 * mt + n) * PR + 16 * g; const LAS unsigned char* ar = lds + S_ATT + (16 * mt + n) * PA + 16 * g;
#pragma unroll
            for (int s = 0; s < 4; ++s) acc = __builtin_amdgcn_mfma_f32_16x16x32_bf16(frag2(qr + 64 * s), sp[s], acc, 0, 0, 0);
#pragma unroll
            for (int s = 0; s < 2; ++s) acc = __builtin_amdgcn_mfma_f32_16x16x32_bf16(frag2(ar + 64 * s), vp[s], acc, 0, 0, 0);
#pragma unroll
            for (int r = 0; r < 4; ++r) *(LAS bf16_t*)(lds + S_OBUF + (16 * mt + 4 * g + r) * PR + (e0 + n) * 2) = f2bfd(acc[r]);
        }
#pragma unroll
        for (int d = 0; d < 8; ++d) {
            f32x4 acc = S[d] * gl;
#pragma unroll
            for (int s = 0; s < 2; ++s) { const LAS unsigned char* kp = lds + S_KD + (32 * s + 4 * g + q4) * PR + (16 * d + 4 * p4) * 2;
                const s16x4 k0 = vtr(kp), k1 = vtr(kp + 16 * PR); const bf16x8 af = {k0[0], k0[1], k0[2], k0[3], k1[0], k1[1], k1[2], k1[3]};
                acc = __builtin_amdgcn_mfma_f32_16x16x32_bf16(af, vp[s], acc, 0, 0, 0); }
            S[d] = acc;
        }
    };
    auto flush = [&](int nc) {
        const int row = tx >> 3, c = tx & 7; const size_t t0 = (size_t)b * 8192 + nc * 64;
        const u32x4 v0 = *(const LAS u32x4*)(lds + S_OBUF + row * PR + c * 16), v1 = *(const LAS u32x4*)(lds + S_OBUF + row * PR + (c + 8) * 16);
        float f[16]; float ss = 0.f;
#pragma unroll
        for (int i = 0; i < 4; ++i) { const unsigned a = v0[i], d = v1[i]; f[2 * i] = bflo(a); f[2 * i + 1] = bfhi(a); f[8 + 2 * i] = bflo(d); f[8 + 2 * i + 1] = bfhi(d); }
#pragma unroll
        for (int i = 0; i < 16; ++i) ss += f[i] * f[i];
        DPP_ADDF(ss, 0xB1); DPP_ADDF(ss, 0x4E); DPP_ADDF(ss, 0x141);
        const float rs = 1.f / sqrtf(ss * (1.f / 128.f) + 1e-6f);
        const f32x4 w0 = *(const f32x4*)(A.onw + 8 * c), w1 = *(const f32x4*)(A.onw + 8 * c + 4), w2 = *(const f32x4*)(A.onw + 64 + 8 * c), w3 = *(const f32x4*)(A.onw + 64 + 8 * c + 4);
        u32x4 r0, r1;
        r0.x = pk2bf(f[0] * rs * w0[0], f[1] * rs * w0[1]); r0.y = pk2bf(f[2] * rs * w0[2], f[3] * rs * w0[3]); r0.z = pk2bf(f[4] * rs * w1[0], f[5] * rs * w1[1]); r0.w = pk2bf(f[6] * rs * w1[2], f[7] * rs * w1[3]);
        r1.x = pk2bf(f[8] * rs * w2[0], f[9] * rs * w2[1]); r1.y = pk2bf(f[10] * rs * w2[2], f[11] * rs * w2[3]); r1.z = pk2bf(f[12] * rs * w3[0], f[13] * rs * w3[1]); r1.w = pk2bf(f[14] * rs * w3[2], f[15] * rs * w3[3]);
        bf16_t* op = A.O + (t0 + row) * 1024 + h * 128; *(u32x4*)(op + c * 8) = r0; *(u32x4*)(op + (c + 8) * 8) = r1; };
    issue(pfA, 0); issue(pfB, 1); commit(pfA); __syncthreads();
#define LBAR() asm volatile("s_waitcnt lgkmcnt(0)\n\ts_barrier" ::: "memory")
    for (int nc = 0; nc < 128; nc += 2) {
        issue(pfA, nc + 2); compute(nc);
        LBAR(); flush(nc); commit(pfB); LBAR();
        issue(pfB, nc + 3); compute(nc + 1);
        LBAR(); flush(nc + 1); commit(pfA); LBAR();
    }
#undef LBAR
    __syncthreads();
}
__device__ __forceinline__ void scan_phase(const ScanArgs& A, LAS unsigned char* lds, int bx, int G) { for (int bh = bx; bh < 16; bh += G) scan_bh(A, lds, bh); }
}
namespace peer {
typedef __bf16 bf16x2_t __attribute__((ext_vector_type(2)));
__device__ __forceinline__ float dppf(float v, const int ctrl_unused) { return v; }
#define DPP_ADD(v, CTRL, RMASK) v += __builtin_bit_cast(float, __builtin_amdgcn_update_dpp(0, __builtin_bit_cast(int, v), CTRL, RMASK, 0xF, false))
__device__ __forceinline__ float wave_sum_u(float v) {
    DPP_ADD(v, 0xB1, 0xF); DPP_ADD(v, 0x4E, 0xF); DPP_ADD(v, 0x141, 0xF); DPP_ADD(v, 0x140, 0xF);
    DPP_ADD(v, 0x142, 0xA); DPP_ADD(v, 0x143, 0xC);
    return __builtin_bit_cast(float, __builtin_amdgcn_readlane(__builtin_bit_cast(int, v), 63));
}
__device__ __forceinline__ float dot2bf(unsigned a, unsigned b, float c) { return __builtin_amdgcn_fdot2_f32_bf16(__builtin_bit_cast(bf16x2_t, a), __builtin_bit_cast(bf16x2_t, b), c, false); }
__device__ __forceinline__ float dot16(const u32x4& a0, const u32x4& a1, const u32x4& h0, const u32x4& h1) {
    float s = 0.f;
#pragma unroll
    for (int i = 0; i < 4; ++i) { const unsigned x0 = a0[i], y0 = h0[i], x1 = a1[i], y1 = h1[i]; s = dot2bf(x0, y0, s); s = dot2bf(x1, y1, s); }
    return s;
}
__device__ __forceinline__ void axpy16(float (&acc)[16], float a, const u32x4& v0, const u32x4& v1) {
#pragma unroll
    for (int i = 0; i < 4; ++i) { acc[2 * i] = fmaf(a, __builtin_bit_cast(float, v0[i] << 16), acc[2 * i]); acc[2 * i + 1] = fmaf(a, __builtin_bit_cast(float, v0[i] & 0xffff0000u), acc[2 * i + 1]);
        acc[8 + 2 * i] = fmaf(a, __builtin_bit_cast(float, v1[i] << 16), acc[8 + 2 * i]); acc[8 + 2 * i + 1] = fmaf(a, __builtin_bit_cast(float, v1[i] & 0xffff0000u), acc[8 + 2 * i + 1]); }
}
constexpr float SU_ = 512.f, SV_ = 64.f;
__device__ __forceinline__ unsigned pk4fp8(f32x4 v, float s) { int p = __builtin_amdgcn_cvt_pk_fp8_f32(v[0] * s, v[1] * s, 0, false); p = __builtin_amdgcn_cvt_pk_fp8_f32(v[2] * s, v[3] * s, p, true); return (unsigned)p; }
__device__ __forceinline__ void convert_tables(const float* u, const float* v, unsigned char* ub, unsigned char* vb, int gt, int NGT) {
    for (int i = gt; i < 16384 * 1024 / 16; i += NGT) {
        const f32x4* us = (const f32x4*)u + 4 * (size_t)i; const f32x4* vs = (const f32x4*)v + 4 * (size_t)i;
        u32x4 o; o.x = pk4fp8(us[0], SU_); o.y = pk4fp8(us[1], SU_); o.z = pk4fp8(us[2], SU_); o.w = pk4fp8(us[3], SU_); ((u32x4*)ub)[i] = o;
        o.x = pk4fp8(vs[0], SV_); o.y = pk4fp8(vs[1], SV_); o.z = pk4fp8(vs[2], SV_); o.w = pk4fp8(vs[3], SV_); ((u32x4*)vb)[i] = o; }
}
struct PeerArgs { const unsigned char* Ub; const unsigned char* Vb; const bf16_t* H2; const float* X1; const float* MOD; const float* S; const float* fnw; float* out; };
__device__ __forceinline__ void score_prefetch(const float* Srow, int lane, f32x4 (&sq)[8]);
__device__ __forceinline__ void route_token(const float* Srow, LAS unsigned char* rl, int lane, int& e_lo, int& e_hi, float& g_lo, float& g_hi);
constexpr float SH_ = 16.f;
typedef float f32x4m_t __attribute__((ext_vector_type(4)));
__device__ __forceinline__ long pk64(unsigned lo, unsigned hi) { return (long)(((unsigned long long)hi << 32) | (unsigned long long)lo); }
__device__ __forceinline__ float clamp8(float x) { return __builtin_amdgcn_fmed3f(x, -448.f, 448.f); }
template <int FAKE = 0> __device__ __forceinline__ void gather_token(const PeerArgs& A, int t, int lane, LAS unsigned char* st, LAS unsigned char* hl, int e_lo, int e_hi, float g_lo, float g_hi) {
    asm volatile("" : "+v"(lane));
    const int b = t >> 13, r16 = lane & 15, g = lane >> 4;
    { const u32x4 h0 = *(const u32x4*)(A.H2 + (size_t)t * 1024 + 16 * lane), h1 = *(const u32x4*)(A.H2 + (size_t)t * 1024 + 16 * lane + 8); u32x4 hq;
#pragma unroll
        for (int i = 0; i < 4; ++i) { const unsigned a = (i < 2) ? h0[2 * i] : h1[2 * i - 4], c = (i < 2) ? h0[2 * i + 1] : h1[2 * i - 3];
            int p = __builtin_amdgcn_cvt_pk_fp8_f32(clamp8(__builtin_bit_cast(float, a << 16) * SH_), clamp8(__builtin_bit_cast(float, a & 0xffff0000u) * SH_), 0, false);
            p = __builtin_amdgcn_cvt_pk_fp8_f32(clamp8(__builtin_bit_cast(float, c << 16) * SH_), clamp8(__builtin_bit_cast(float, c & 0xffff0000u) * SH_), p, true); hq[i] = (unsigned)p; }
        *(LAS u32x4*)(hl + 16 * lane) = hq; }
    if (FAKE == 1) { e_lo &= 1023; e_hi &= 1023; }
    f32x2h_t acc2[8];
#pragma unroll
    for (int i = 0; i < 8; ++i) acc2[i] = (f32x2h_t){0.f, 0.f};
    if (FAKE == 2 || FAKE == 5) { acc2[0] = (f32x2h_t){g_lo + g_hi, (float)(e_lo + e_hi)}; } else {
    u32x4 hb[16];
#pragma unroll
    for (int s = 0; s < 16; ++s) hb[s] = *(const LAS u32x4*)(hl + 64 * s + 16 * g);
    const int Gs = r16 & 7;
    float xd[4] = {0.f, 0.f, 0.f, 0.f};
    if (FAKE == 6) { xd[0] = g_lo; xd[1] = g_hi; xd[2] = hb[3].x; xd[3] = hb[9].y; } else {
    u32x4 ld[16];
#pragma unroll
    for (int j = 0; j < 16; ++j) { const int ej = __builtin_amdgcn_readlane(e_lo, j); ld[j] = *(const u32x4*)(A.Ub + (size_t)ej * 1024 + 16 * lane); }
#pragma unroll 1
    for (int G = 0; G < 8; ++G) {
#pragma unroll
        for (int j = 0; j < 16; ++j) *(LAS u32x4*)(st + j * 1040 + 16 * lane) = ld[j];
        if (G < 7) { const int exn = (G + 1 < 4) ? e_lo : e_hi; const int sbn = ((G + 1) & 3) * 16;
#pragma unroll
            for (int j = 0; j < 16; ++j) { const int ej = __builtin_amdgcn_readlane(exn, sbn + j); ld[j] = *(const u32x4*)(A.Ub + (size_t)ej * 1024 + 16 * lane); } }
        f32x4m_t d0 = {0.f, 0.f, 0.f, 0.f}, d1 = {0.f, 0.f, 0.f, 0.f};
#pragma unroll
        for (int s = 0; s < 16; ++s) { const u32x4 fr = *(const LAS u32x4*)(st + r16 * 1040 + 64 * s + 16 * g);
            d0 = __builtin_amdgcn_mfma_f32_16x16x32_fp8_fp8(pk64(fr.x, fr.y), pk64(hb[s].x, hb[s].y), d0, 0, 0, 0);
            d1 = __builtin_amdgcn_mfma_f32_16x16x32_fp8_fp8(pk64(fr.z, fr.w), pk64(hb[s].z, hb[s].w), d1, 0, 0, 0); }
#pragma unroll
        for (int r = 0; r < 4; ++r) xd[r] = (Gs == G) ? d0[r] + d1[r] : xd[r];
    }
    }
    float a[4];
#pragma unroll
    for (int r = 0; r < 4; ++r) { float x = xd[r];
        const int src = 4 * (((Gs & 3) * 16) + 4 * g + r);
        const float gl = __builtin_bit_cast(float, __builtin_amdgcn_ds_bpermute(src, __builtin_bit_cast(int, g_lo))), gh = __builtin_bit_cast(float, __builtin_amdgcn_ds_bpermute(src, __builtin_bit_cast(int, g_hi)));
        x *= 1.f / (SU_ * SH_); a[r] = 0.5f * x * (1.f + erff(x * 0.70710678118654752f)) * ((Gs < 4) ? gl : gh) * (1.f / SV_); }
    if (FAKE == 7) { acc2[0] = (f32x2h_t){a[0] + a[1], a[2] + a[3]}; } else {
    const unsigned char* vb = A.Vb + 16 * lane;
    u32x4 vv[16];
#pragma unroll
    for (int j = 0; j < 16; ++j) { const int ej = __builtin_amdgcn_readlane(e_lo, j); vv[j] = *(const u32x4*)(vb + (size_t)ej * 1024); }
#define PEER_ROW_(j, G_) { const float aj = __builtin_bit_cast(float, __builtin_amdgcn_readlane(__builtin_bit_cast(int, a[(j) & 3]), 16 * ((j) >> 2) + (G_))); const f32x2h_t a2 = {aj, aj}; \
        _Pragma("unroll") for (int i = 0; i < 4; ++i) { const int w = (int)vv[j][i]; const f32x2h_t lo2 = __builtin_amdgcn_cvt_pk_f32_fp8(w, false), hi2 = __builtin_amdgcn_cvt_pk_f32_fp8(w, true); \
            acc2[2 * i] = __builtin_elementwise_fma(a2, lo2, acc2[2 * i]); acc2[2 * i + 1] = __builtin_elementwise_fma(a2, hi2, acc2[2 * i + 1]); } }
#pragma unroll 1
    for (int G = 0; G < 7; ++G) {
        const int exn = (G + 1 < 4) ? e_lo : e_hi; const int sbn = ((G + 1) & 3) * 16;
#pragma unroll
        for (int j = 0; j < 16; ++j) { PEER_ROW_(j, G) const int ej = __builtin_amdgcn_readlane(exn, sbn + j); vv[j] = *(const u32x4*)(vb + (size_t)ej * 1024); __builtin_amdgcn_sched_barrier(0); }
    }
#pragma unroll
    for (int j = 0; j < 16; ++j) PEER_ROW_(j, 7)
#undef PEER_ROW_
    }
    }
    float acc[16];
#pragma unroll
    for (int i = 0; i < 8; ++i) { acc[2 * i] = acc2[i][0]; acc[2 * i + 1] = acc2[i][1]; }
    const float* xr = A.X1 + (size_t)t * 1024 + 16 * lane; const float* g2 = A.MOD + (size_t)b * 6144 + 5120 + 16 * lane; const float* fw = A.fnw + 16 * lane;
    float x2[16]; float ss = 0.f;
#pragma unroll
    for (int i = 0; i < 4; ++i) { const f32x4 xv = *(const f32x4*)(xr + 4 * i), gv = *(const f32x4*)(g2 + 4 * i);
#pragma unroll
        for (int k = 0; k < 4; ++k) { const float y = xv[k] + gv[k] * acc[4 * i + k]; x2[4 * i + k] = y; ss += y * y; } }
    ss = wave_sum_u(ss);
    const float rstd = 1.f / sqrtf(ss * (1.f / 1024.f) + 1e-6f);
    float* orow = A.out + (size_t)t * 1024 + 16 * lane;
#pragma unroll
    for (int i = 0; i < 4; ++i) { const f32x4 wv = *(const f32x4*)(fw + 4 * i); f32x4 o; o[0] = x2[4 * i] * rstd * wv[0]; o[1] = x2[4 * i + 1] * rstd * wv[1]; o[2] = x2[4 * i + 2] * rstd * wv[2]; o[3] = x2[4 * i + 3] * rstd * wv[3];
        *(f32x4*)(orow + 4 * i) = o; }
}
template <int FAKE = 0> __device__ __forceinline__ void expert_phase(const PeerArgs& A, int half, int bx, int G, LAS unsigned char* lds) {
    int tx = threadIdx.x; asm volatile("" : "+v"(tx));
    const int wave = __builtin_amdgcn_readfirstlane(tx >> 6), lane = tx & 63;
    LAS unsigned char* st = lds + wave * 17664; LAS unsigned char* hl = st + 16640; LAS unsigned char* rl = st;
    const int t0 = wave * G + bx, stride = 8 * G, n = (t0 < 8192) ? (8192 - t0 + stride - 1) / stride : 0;
    const bool skew = (wave & 4) != 0;
    int ea_lo = 0, ea_hi = 0, eb_lo = 0, eb_hi = 0; float ga_lo = 0.f, ga_hi = 0.f, gb_lo = 0.f, gb_hi = 0.f;
#pragma unroll 1
    for (int i = 0; i < 2 * n + 2; ++i) {
        const int isg = skew ? ((i >> 1) & 1) : (i & 1), ti = skew ? (2 * (i >> 2) + (i & 1)) : (i >> 1);
        if (ti >= n) continue;
        const int t = t0 + ti * stride;
        int ln = lane; asm volatile("" : "+v"(ln));
        if (!isg) { int e_lo, e_hi; float g_lo, g_hi;
            if (FAKE == 3 || FAKE >= 5) { e_lo = ((t * 64 + ln) * 40503) & 16383; e_hi = ((t * 64 + ln) * 48271 + 77) & 16383; g_lo = g_hi = 0.0078125f; } else route_token(A.S + (size_t)t * 2048, rl, ln, e_lo, e_hi, g_lo, g_hi);
            if (ti & 1) { eb_lo = e_lo; eb_hi = e_hi; gb_lo = g_lo; gb_hi = g_hi; } else { ea_lo = e_lo; ea_hi = e_hi; ga_lo = g_lo; ga_hi = g_hi; } }
        else { const bool sb = (ti & 1) != 0; gather_token<FAKE>(A, half * 8192 + t, ln, st, hl, sb ? eb_lo : ea_lo, sb ? eb_hi : ea_hi, sb ? gb_lo : ga_lo, sb ? gb_hi : ga_hi); }
    }
}
}
namespace peer {
__device__ __forceinline__ unsigned sortable(float f) { const unsigned u = __builtin_bit_cast(unsigned, f); return (u & 0x80000000u) ? ~u : (u | 0x80000000u); }
#define DPP_UMAX(v, CTRL) { const unsigned t_ = (unsigned)__builtin_amdgcn_update_dpp(0, (int)(v), CTRL, 0xF, 0xF, false); v = (v) > t_ ? (v) : t_; }
#define DPP_FMAX(v, CTRL) { const float t_ = __builtin_bit_cast(float, __builtin_amdgcn_update_dpp(0, __builtin_bit_cast(int, v), CTRL, 0xF, 0xF, false)); v = fmaxf(v, t_); }
#define CE_(a, b) { const unsigned hi_ = (a) > (b) ? (a) : (b), lo_ = (a) > (b) ? (b) : (a); a = hi_; b = lo_; }
__device__ __forceinline__ void score_prefetch(const float* Srow, int lane, f32x4 (&sq)[8]) {
    const int r = lane >> 4, i = lane & 15;
#pragma unroll
    for (int k = 0; k < 4; ++k) { const float* lp = Srow + (4 * k + r) * 128 + 8 * i; sq[2 * k] = *(const f32x4*)lp; sq[2 * k + 1] = *(const f32x4*)(lp + 4); }
}
__device__ __forceinline__ void route_token(const float* Srow, LAS unsigned char* rl, int lane, int& e_lo, int& e_hi, float& g_lo, float& g_hi) {
    const int r = lane >> 4, i = lane & 15;
    int ic, jc; { const int c = lane; ic = (c < 16) ? 0 : (c < 24) ? 1 : (c < 29) ? 2 : (c < 33) ? 3 : (c < 36) ? 4 : (c < 38) ? 5 : (c < 40) ? 6 : (c < 42) ? 7 : (c - 34);
        const int st = (ic == 0) ? 0 : (ic == 1) ? 16 : (ic == 2) ? 24 : (ic == 3) ? 29 : (ic == 4) ? 33 : (ic == 5) ? 36 : (ic == 6) ? 38 : (ic == 7) ? 40 : (c); jc = c - st; if (ic > 15) { ic = 15; jc = 0; } }
    const int flat = ic * 16 + jc; const bool cvalid = lane < 50;
    e_lo = 0; e_hi = 0; g_lo = 0.f; g_hi = 0.f;
#pragma unroll 1
    for (int k = 0; k < 4; ++k) {
        const float* lp = Srow + (4 * k + r) * 128;
        const f32x4 va = *(const f32x4*)(lp + 8 * i), vb = *(const f32x4*)(lp + 8 * i + 4);
        *(LAS f32x4*)(rl + (r * 128 + 8 * i) * 4) = va; *(LAS f32x4*)(rl + (r * 128 + 8 * i) * 4 + 16) = vb;
        unsigned k0 = (sortable(va[0]) & 0xFFFFFF80u) | (unsigned)(127 - (8 * i + 0)), k1 = (sortable(va[1]) & 0xFFFFFF80u) | (unsigned)(127 - (8 * i + 1)),
                 k2 = (sortable(va[2]) & 0xFFFFFF80u) | (unsigned)(127 - (8 * i + 2)), k3 = (sortable(va[3]) & 0xFFFFFF80u) | (unsigned)(127 - (8 * i + 3)),
                 k4 = (sortable(vb[0]) & 0xFFFFFF80u) | (unsigned)(127 - (8 * i + 4)), k5 = (sortable(vb[1]) & 0xFFFFFF80u) | (unsigned)(127 - (8 * i + 5)),
                 k6 = (sortable(vb[2]) & 0xFFFFFF80u) | (unsigned)(127 - (8 * i + 6)), k7 = (sortable(vb[3]) & 0xFFFFFF80u) | (unsigned)(127 - (8 * i + 7));
        CE_(k0, k1) CE_(k2, k3) CE_(k4, k5) CE_(k6, k7)  CE_(k0, k2) CE_(k1, k3) CE_(k4, k6) CE_(k5, k7)  CE_(k1, k2) CE_(k5, k6)
        CE_(k0, k4) CE_(k1, k5) CE_(k2, k6) CE_(k3, k7)  CE_(k2, k4) CE_(k3, k5)  CE_(k1, k2) CE_(k3, k4) CE_(k5, k6)
        unsigned sel = 0u;
#pragma unroll
        for (int it = 0; it < 16; ++it) { unsigned M = k0; DPP_UMAX(M, 0x128) DPP_UMAX(M, 0x124) DPP_UMAX(M, 0x122) DPP_UMAX(M, 0x121)
            sel = (i == it) ? M : sel; const bool own = (k0 == M);
            k0 = own ? k1 : k0; k1 = own ? k2 : k1; k2 = own ? k3 : k2; k3 = own ? k4 : k3; k4 = own ? k5 : k4; k5 = own ? k6 : k5; k6 = own ? k7 : k6; k7 = own ? 0u : k7; }
        const int sidx = 127 - (int)(sel & 127u); const float sval = *(const LAS float*)(rl + (r * 128 + sidx) * 4);
#pragma unroll
        for (int hh = 0; hh < 2; ++hh) {
            const int h = 2 * k + hh, l0 = 32 * hh, l1 = 32 * hh + 16;
            const float ca = __shfl(sval, l0 + ic), cb = __shfl(sval, l1 + jc); const float cs = ca + cb;
            unsigned key = cvalid ? ((sortable(cs) & 0xFFFFFF00u) | (unsigned)(255 - flat)) : 0u; unsigned top = 0u;
#pragma unroll
            for (int it = 0; it < 16; ++it) { unsigned M = key; DPP_UMAX(M, 0x128) DPP_UMAX(M, 0x124) DPP_UMAX(M, 0x122) DPP_UMAX(M, 0x121)
                const unsigned m0 = (unsigned)__builtin_amdgcn_readlane((int)M, 0), m1 = (unsigned)__builtin_amdgcn_readlane((int)M, 16), m2 = (unsigned)__builtin_amdgcn_readlane((int)M, 32), m3 = (unsigned)__builtin_amdgcn_readlane((int)M, 48);
                const unsigned ma = m0 > m1 ? m0 : m1, mb = m2 > m3 ? m2 : m3, mm = ma > mb ? ma : mb;
                top = (lane == it) ? mm : top; key = (key == mm) ? 0u : key; }
            const int fl = 255 - (int)(top & 255u), ti = fl >> 4, tj = fl & 15;
            const float tv = __shfl(sval, l0 + ti) + __shfl(sval, l1 + tj);
            const int ex = __shfl(sidx, l0 + ti) * 128 + __shfl(sidx, l1 + tj);
            float mx = tv; DPP_FMAX(mx, 0x128) DPP_FMAX(mx, 0x124) DPP_FMAX(mx, 0x122) DPP_FMAX(mx, 0x121)
            float p = __expf(tv - mx), ps = p; DPP_ADD(ps, 0x128, 0xF); DPP_ADD(ps, 0x124, 0xF); DPP_ADD(ps, 0x122, 0xF); DPP_ADD(ps, 0x121, 0xF);
            const float gate = p / ps;
            const int ex_m = __shfl(ex, i); const float g_m = __shfl(gate, i);
            if (r == (h & 3)) { if (h < 4) { e_lo = ex_m; g_lo = g_m; } else { e_hi = ex_m; g_hi = g_m; } }
        }
    }
}
}
namespace ew {
using peer::wave_sum_u;
__device__ __forceinline__ void mod_phase(const float* c, const float* w_ada, const float* b_ada, float* MOD, LAS unsigned char* lds, int bx, int G) {
    int tx = threadIdx.x; asm volatile("" : "+v"(tx));
    LAS float* red = (LAS float*)lds;
    for (int it = bx; it < 192; it += G) {
        const int col = tx & 31, kg = tx >> 5, j = it * 32 + col; float a0 = 0.f, a1 = 0.f, b0 = 0.f, b1 = 0.f;
#pragma unroll 4
        for (int k = kg * 64; k < kg * 64 + 64; k += 2) { const float w0 = w_ada[(size_t)k * 6144 + j], w1 = w_ada[(size_t)(k + 1) * 6144 + j]; const float c00 = c[k], c01 = c[k + 1], c10 = c[1024 + k], c11 = c[1024 + k + 1];
            a0 = fmaf(c00 / (1.f + __expf(-c00)), w0, a0); b0 = fmaf(c01 / (1.f + __expf(-c01)), w1, b0); a1 = fmaf(c10 / (1.f + __expf(-c10)), w0, a1); b1 = fmaf(c11 / (1.f + __expf(-c11)), w1, b1); }
        red[(kg * 2 + 0) * 32 + col] = a0 + b0; red[(kg * 2 + 1) * 32 + col] = a1 + b1;
        __syncthreads();
        if (tx < 64) { const int bb = tx >> 5; float s = b_ada[j];
#pragma unroll
            for (int q = 0; q < 16; ++q) s += red[(q * 2 + bb) * 32 + col];
            MOD[(size_t)bb * 6144 + j] = s; }
        __syncthreads();
    }
}
__device__ __forceinline__ void modnorm_row(const f32x4 (&v)[4], const float* nw, const float* MOD, int which, bf16_t* H, int t, int lane) {
    const int b = t >> 13; const float* sh = MOD + (size_t)b * 6144 + (which ? 3072 : 0) + 16 * lane; const float* sc = sh + 1024; const float* wr = nw + 16 * lane;
    float ss = 0.f;
#pragma unroll
    for (int i = 0; i < 4; ++i) ss += v[i][0] * v[i][0] + v[i][1] * v[i][1] + v[i][2] * v[i][2] + v[i][3] * v[i][3];
    ss = wave_sum_u(ss); const float rstd = 1.f / sqrtf(ss * (1.f / 1024.f) + 1e-6f);
    float y[16];
#pragma unroll
    for (int i = 0; i < 4; ++i) { const f32x4 w = *(const f32x4*)(wr + 4 * i), s1 = *(const f32x4*)(sc + 4 * i), s0 = *(const f32x4*)(sh + 4 * i);
#pragma unroll
        for (int k = 0; k < 4; ++k) y[4 * i + k] = v[i][k] * rstd * w[k] * (1.f + s1[k]) + s0[k]; }
    u32x4 o0, o1; o0.x = pk2bf(y[0], y[1]); o0.y = pk2bf(y[2], y[3]); o0.z = pk2bf(y[4], y[5]); o0.w = pk2bf(y[6], y[7]); o1.x = pk2bf(y[8], y[9]); o1.y = pk2bf(y[10], y[11]); o1.z = pk2bf(y[12], y[13]); o1.w = pk2bf(y[14], y[15]);
    *(u32x4*)(H + (size_t)t * 1024 + 16 * lane) = o0; *(u32x4*)(H + (size_t)t * 1024 + 16 * lane + 8) = o1;
}
__device__ __forceinline__ void modnorm_phase(const float* X, const float* nw, const float* MOD, int which, bf16_t* H, int gw, int NGW, int lane) {
    for (int t = gw; t < 16384; t += 4 * NGW) {
        f32x4 v[4][4];
#pragma unroll
        for (int u = 0; u < 4; ++u) { const int tu = t + u * NGW; if (tu < 16384) {
#pragma unroll
            for (int i = 0; i < 4; ++i) v[u][i] = *(const f32x4*)(X + (size_t)tu * 1024 + 16 * lane + 4 * i); } }
#pragma unroll
        for (int u = 0; u < 4; ++u) { const int tu = t + u * NGW; if (tu < 16384) modnorm_row(v[u], nw, MOD, which, H, tu, lane); }
    }
}
struct SmallArgs { const bf16_t* RAW; const float *qw, *kvw, *kiw, *a_log, *dt_bias; bf16_t *QLATN, *CKVN, *KIDXN; float *BETA, *G, *WIDX; };
__device__ __forceinline__ void small_phase(const SmallArgs& A, int gw, int NGW, int lane) {
    for (int t = gw; t < 16384; t += NGW) {
        const bf16_t* r = A.RAW + (size_t)t * 768;
        const uint2 qp = *(const uint2*)(r + 4 * lane), kp = *(const uint2*)(r + 256 + 4 * lane);
        const float q0 = __builtin_bit_cast(float, qp.x << 16), q1 = __builtin_bit_cast(float, qp.x & 0xffff0000u), q2 = __builtin_bit_cast(float, qp.y << 16), q3 = __builtin_bit_cast(float, qp.y & 0xffff0000u);
        const float k0 = __builtin_bit_cast(float, kp.x << 16), k1 = __builtin_bit_cast(float, kp.x & 0xffff0000u), k2 = __builtin_bit_cast(float, kp.y << 16), k3 = __builtin_bit_cast(float, kp.y & 0xffff0000u);
        const float ki = bf2f(r[512 + lane]);
        const float sq = wave_sum_u(q0 * q0 + q1 * q1 + q2 * q2 + q3 * q3), skv = wave_sum_u(k0 * k0 + k1 * k1 + k2 * k2 + k3 * k3), ski = wave_sum_u(ki * ki);
        const float rq = 1.f / sqrtf(sq * (1.f / 256.f) + 1e-6f), rkv = 1.f / sqrtf(skv * (1.f / 256.f) + 1e-6f), rki = 1.f / sqrtf(ski * (1.f / 64.f) + 1e-6f);
        const f32x4 wq = *(const f32x4*)(A.qw + 4 * lane), wkv = *(const f32x4*)(A.kvw + 4 * lane);
        *(uint2*)(A.QLATN + (size_t)t * 256 + 4 * lane) = make_uint2(pk2bf(q0 * rq * wq[0], q1 * rq * wq[1]), pk2bf(q2 * rq * wq[2], q3 * rq * wq[3]));
        *(uint2*)(A.CKVN + (size_t)t * 256 + 4 * lane) = make_uint2(pk2bf(k0 * rkv * wkv[0], k1 * rkv * wkv[1]), pk2bf(k2 * rkv * wkv[2], k3 * rkv * wkv[3]));
        A.KIDXN[(size_t)t * 64 + lane] = f2bfd(ki * rki * A.kiw[lane]);
        if (lane < 8) { const float be = bf2f(r[576 + lane]), de = bf2f(r[584 + lane]), wi = bf2f(r[592 + lane]);
            A.BETA[(size_t)t * 8 + lane] = 1.f / (1.f + __expf(-be));
            const float xs = de + A.dt_bias[lane]; A.G[(size_t)t * 8 + lane] = -__expf(A.a_log[lane]) * (xs > 20.f ? xs : log1pf(__expf(xs)));
            A.WIDX[(size_t)t * 8 + lane] = wi * 0.04419417382415922f; }
    }
}
__device__ __forceinline__ void ogate_phase(const bf16_t* O, const bf16_t* Z, const float* ow, bf16_t* OG, int gw, int NGW, int lane) {
    for (int t = gw; t < 16384; t += NGW) {
        const u32x4 o0 = *(const u32x4*)(O + (size_t)t * 1024 + 16 * lane), o1 = *(const u32x4*)(O + (size_t)t * 1024 + 16 * lane + 8);
        const u32x4 z0 = *(const u32x4*)(Z + (size_t)t * 1024 + 16 * lane), z1 = *(const u32x4*)(Z + (size_t)t * 1024 + 16 * lane + 8);
        float ov[16], zv[16]; float ss = 0.f;
#pragma unroll
        for (int i = 0; i < 4; ++i) { const unsigned a = o0[i], b = o1[i], c = z0[i], d = z1[i];
            ov[2 * i] = __builtin_bit_cast(float, a << 16); ov[2 * i + 1] = __builtin_bit_cast(float, a & 0xffff0000u); ov[8 + 2 * i] = __builtin_bit_cast(float, b << 16); ov[8 + 2 * i + 1] = __builtin_bit_cast(float, b & 0xffff0000u);
            zv[2 * i] = __builtin_bit_cast(float, c << 16); zv[2 * i + 1] = __builtin_bit_cast(float, c & 0xffff0000u); zv[8 + 2 * i] = __builtin_bit_cast(float, d << 16); zv[8 + 2 * i + 1] = __builtin_bit_cast(float, d & 0xffff0000u); }
#pragma unroll
        for (int i = 0; i < 16; ++i) ss += ov[i] * ov[i];
        DPP_ADD(ss, 0xB1, 0xF); DPP_ADD(ss, 0x4E, 0xF); DPP_ADD(ss, 0x141, 0xF);
        const float rs = 1.f / sqrtf(ss * (1.f / 128.f) + 1e-6f); const float* w = ow + 16 * (lane & 7);
        float y[16];
#pragma unroll
        for (int i = 0; i < 16; ++i) y[i] = ov[i] * rs * w[i] * (zv[i] / (1.f + __expf(-zv[i])));
        u32x4 r0, r1; r0.x = pk2bf(y[0], y[1]); r0.y = pk2bf(y[2], y[3]); r0.z = pk2bf(y[4], y[5]); r0.w = pk2bf(y[6], y[7]); r1.x = pk2bf(y[8], y[9]); r1.y = pk2bf(y[10], y[11]); r1.z = pk2bf(y[12], y[13]); r1.w = pk2bf(y[14], y[15]);
        *(u32x4*)(OG + (size_t)t * 1024 + 16 * lane) = r0; *(u32x4*)(OG + (size_t)t * 1024 + 16 * lane + 8) = r1;
    }
}
}
constexpr int NTHR = 512;
constexpr int LDS_BYTES = 155648;
constexpr size_t CTL_ZERO_BYTES = 32768;
struct MArgs { NP P; NP P2; OP Q; unsigned* ctl; };

typedef const __attribute__((address_space(4))) MArgs* KAP;
typedef const __attribute__((address_space(4))) unsigned long long* KW;
#define KA(ka) KAP ka = (KAP)__builtin_amdgcn_kernarg_segment_ptr(); asm volatile("" : "+s"(ka))
template <class TT, class SS> __device__ __forceinline__ void ka_copy(TT& dst, SS src) { static_assert(sizeof(TT) % 8 == 0, "8-byte words");
    void** d = (void**)&dst; KW s = (KW)src;
#pragma unroll
    for (int i = 0; i < (int)(sizeof(TT) / 8); ++i) d[i] = (void*)(__attribute__((address_space(1))) void*)s[i]; }
#define LOADP(P, ka) NP P; ka_copy(P, &ka->P)
#define LOADQ(Q, ka) OP Q; ka_copy(Q, &ka->Q)
__global__ void __launch_bounds__(NTHR, 2) mega(MArgs a_unused) {
    typedef CfgFull C; typedef WsMap<C> W;
    extern __shared__ __attribute__((aligned(16))) unsigned char lds_raw[];
    LAS unsigned char* lds = (LAS unsigned char*)lds_raw;
    volatile LAS unsigned* MISC = (volatile LAS unsigned*)(lds + LDS_BYTES - 256);
    if (threadIdx.x < 64) MISC[threadIdx.x] = 0u;
    __syncthreads();
    XcdBarrier bar; { KA(ka); bar = xcd_barrier_post((unsigned*)(__attribute__((address_space(1))) unsigned*)(unsigned long long)ka->ctl, MISC + 8); }
    const int G = gridDim.x, NTall = G * NTHR, bx = blockIdx.x;
#define TIDS() int tx_ = threadIdx.x; asm volatile("" : "+v"(tx_)); const int wave = __builtin_amdgcn_readfirstlane(tx_ >> 6), lane = tx_ & 63; \
        const int tid = (wave * G + bx) * 64 + lane;
#define NAIVE_(WHICH, st) do { KA(ka_); NP PP_; ka_copy(PP_, &ka_->WHICH); TIDS(); const long n_ = stage_items<C>(st); const int words_ = stage_scr_words<C>(st); \
        int nt_ = NTall; if (words_) { const long cap_ = (long)(W::SCR_BYTES / (4 * (size_t)words_)); if (cap_ < nt_) nt_ = (int)cap_; } \
        if (tid < nt_) for (long it_ = tid; it_ < n_; it_ += nt_) run_item<C>(PP_, st, it_, tid, nt_); } while (0)
#define NAIVE(st) NAIVE_(P, st)
#define BAR() xcd_barrier(bar)
    { KA(ka); LOADP(P, ka); ew::mod_phase(P.c, P.w_ada, P.b_ada, P.MOD, lds, bx, G); }
    { KA(ka); LOADP(P, ka); LOADQ(Q, ka); TIDS(); (void)tid; p0_weights(P, Q, lds, bx * 8 + wave, G * 8, bx * NTHR + tx_, NTall, wave, lane); }
    BAR();
    { KA(ka); LOADP(P, ka); TIDS(); (void)tid; ew::modnorm_phase(P.x, P.norm1_w, P.MOD, 0, P.H1, bx * 8 + wave, G * 8, lane); }
    { KA(ka); LOADQ(Q, ka); const int c0 = bx < 40 ? bx : -1; WSched S0{0, c0, Q.wuk, Q.wuq, Q.wbT, Q.wuv, Q.skb, Q.pwq}; EpiG<FWeights> E{FWeights{Q.WcombT, Q.WcatT, Q.WsT}};
      pg8::gemm_phase<EpiG<FWeights>, WSched, false, true>(lds, pg8::Gemm{1024, 1024, 128}, S0, E);
      const int c1 = (bx >= 40 && bx < 72) ? bx - 40 : -1; WSched S1{1, c1, Q.wuk, Q.wuq, Q.wbT, Q.wuv, Q.skb, Q.pwq};
      pg8::gemm_phase<EpiG<FWeights>, WSched, false, true>(lds, pg8::Gemm{256, 2048, 256}, S1, E); }
    BAR();
    { KA(ka); LOADP(P, ka); LOADQ(Q, ka); GridSched S; S.init(64, 15, G, bx, P.H1, (size_t)256 * 1024 * 2, Q.WinT, (size_t)256 * 1024 * 2); EpiG<FInprojA> E{FInprojA{P.QKVP, Q.RAWB}};
      pg8::gemm_phase<EpiG<FInprojA>, GridSched, true, true>(lds, pg8::Gemm{1024, 1024, 1024}, S, E); }
    BAR();
    { KA(ka); LOADP(P, ka); LOADQ(Q, ka); TIDS(); (void)tid; ew::SmallArgs SA{Q.RAWB, P.q_norm_w, P.kv_norm_w, P.idx_k_norm_w, P.dn_a_log, P.dn_dt_bias, P.QLATN, P.CKVN, P.KIDXN, P.BETA, P.G, P.WIDX}; ew::small_phase(SA, bx * 8 + wave, G * 8, lane); }
    { KA(ka); LOADP(P, ka); TIDS(); (void)tid; dnet::conv_phase(P.QKVP, P.QKVN, P.dn_conv_w, bx * 8 + wave, G * 8, lane); }
    BAR();
    { KA(ka); LOADP(P, ka); dnet::PrepArgs PA{P.QKVN, P.BETA, P.G, P.W, P.ATT, P.GL}; dnet::prep_phase(PA, lds, bx, G); }
    { KA(ka); LOADP(P, ka); LOADQ(Q, ka); GridSched S; S.init(64, 8, G, bx, P.QLATN, (size_t)256 * 256 * 2, Q.WcombT, (size_t)256 * 256 * 2); EpiG<FStoreBf16> E{FStoreBf16{Q.QA0, 2048, Q.QA1, sattn::QSPLIT / 256}};
      pg8::gemm_phase<EpiG<FStoreBf16>, GridSched, false, true>(lds, pg8::Gemm{256, 256, 256}, S, E); }
    BAR();
    { KA(ka); LOADP(P, ka); dnet::ScanArgs SA{P.QKVN, P.W, P.ATT, P.GL, P.O, P.dn_onorm_w}; dnet::scan_phase(SA, lds, bx, G); }
    { KA(ka); LOADP(P, ka); LOADQ(Q, ka); dsa::DArgs DA{idxk::IdxArgs{P.QLATN, P.KIDXN, P.WIDX, Q.WiqT, nullptr}, sattn::AArgs{P.CKVN, Q.QA0, Q.QA1}, Q.qword};
      dsa::dsa_queue(DA, lds, MISC + 16); }
    BAR();
    { KA(ka); LOADP(P, ka); LOADQ(Q, ka); GridSched S; S.init(64, 12, G, bx, P.H1, (size_t)256 * 1024 * 2, Q.WinT + (size_t)3840 * 1024, (size_t)256 * 1024 * 2); EpiG<FInprojB> E{FInprojB{P.Z, P.GA, P.GB, P.O}};
      pg8::gemm_phase<EpiG<FInprojB>, GridSched, true, true>(lds, pg8::Gemm{1024, 1024, 1024}, S, E); }
    BAR();
    { KA(ka); LOADP(P, ka); LOADQ(Q, ka); GridSched S; S.init(64, 4, G, bx, P.Z, (size_t)256 * 1024 * 2, Q.WcatT, (size_t)256 * 3072 * 2); EpiG<FMerge<0>> E{FMerge<0>{P.GA, P.M}};
      pg8::gemm_phase<EpiG<FMerge<0>>, GridSched, false, true>(lds, pg8::Gemm{1024, 3072, 1024}, S, E); }
    { KA(ka); LOADP(P, ka); LOADQ(Q, ka); GridSched S; S.init(64, 4, G, bx, Q.QA0, (size_t)256 * 2048 * 2, Q.WcatT + 1024, (size_t)256 * 3072 * 2); S.A2 = (const char*)Q.QA1; S.splitA = sattn::QSPLIT / 256; EpiG<FMerge<1>> E{FMerge<1>{P.GB, P.M}};
      pg8::gemm_phase<EpiG<FMerge<1>>, GridSched, false, true>(lds, pg8::Gemm{2048, 3072, 2048}, S, E); }
    BAR();
    { KA(ka); LOADP(P, ka); LOADQ(Q, ka); GridSched S; S.init(64, 4, G, bx, P.M, (size_t)256 * 1024 * 2, Q.WoT, (size_t)256 * 1024 * 2); EpiG<FWo> E{FWo{P.MOD, P.x, P.X1}};
      pg8::gemm_phase<EpiG<FWo>, GridSched, false, true>(lds, pg8::Gemm{1024, 1024, 1024}, S, E); }
    BAR();
    { KA(ka); LOADP(P, ka); LOADQ(Q, ka); TIDS(); (void)tid; ew::modnorm_phase(P.X1, P.norm2_w, P.MOD, 1, P.H2, bx * 8 + wave, G * 8, lane);
      peer::convert_tables(P.peer_u, P.peer_v, Q.Ub, Q.Vb, bx * NTHR + tx_, NTall); }
    BAR();
#pragma unroll 1
    for (int half = 0; half < 2; ++half) {
        { KA(ka); LOADP(P, ka); LOADQ(Q, ka); GridSched S; S.init(32, 8, G, bx, P.H2 + (size_t)half * 8192 * 1024, (size_t)256 * 1024 * 2, Q.WsT, (size_t)256 * 1024 * 2); EpiG<FStoreF32> E{FStoreF32{Q.S, 2048}};
          pg8::gemm_phase<EpiG<FStoreF32>, GridSched, true, true>(lds, pg8::Gemm{1024, 1024, 1024}, S, E); }
        BAR();
        { KA(ka); LOADP(P, ka); LOADQ(Q, ka); peer::PeerArgs EA{Q.Ub, Q.Vb, P.H2, P.X1, P.MOD, Q.S, P.final_norm_w, P.out}; peer::expert_phase(EA, half, bx, G, lds); }
        if (half == 0) BAR();
    }
#undef NAIVE
#undef NAIVE_
#undef BAR
}
extern "C" void kernel_launch(void* const* d_in, const int* in_sizes, int n_in, void* d_out, int out_size, void* d_ws, size_t ws_size, hipStream_t stream) {
    typedef CfgFull C; typedef WsMap<C> W;
    static int grid = 0;
    if (grid == 0) {
        if (n_in != 26 || ws_size < X_END) { fprintf(stderr, "kernel_launch: need 26 inputs and %zu bytes of workspace, got %d / %zu\n", (size_t)X_END, n_in, ws_size); grid = -1; return; }
        int dev = 0, cus = 0, per_cu = 0;
        if (hipGetDevice(&dev) != hipSuccess || hipDeviceGetAttribute(&cus, hipDeviceAttributeMultiprocessorCount, dev) != hipSuccess) { grid = -1; return; }
        if (hipFuncSetAttribute((const void*)mega, hipFuncAttributeMaxDynamicSharedMemorySize, LDS_BYTES) != hipSuccess) { fprintf(stderr, "kernel_launch: hipFuncSetAttribute failed\n"); grid = -1; return; }
        if (hipOccupancyMaxActiveBlocksPerMultiprocessor(&per_cu, (const void*)mega, NTHR, LDS_BYTES) != hipSuccess || per_cu < 1) { fprintf(stderr, "kernel_launch: occupancy query says %d\n", per_cu); }
        (void)hipGetLastError();
        grid = cus;
    }
    if (grid < 0) return;
    hipMemsetAsync(d_ws, 0, CTL_ZERO_BYTES, stream);
    MArgs a{}; np_setup<C>(a.P, d_in, d_out, d_ws);
    char* ws = (char*)d_ws;
    a.Q.WinT = (bf16_t*)(ws + X_WINT); a.Q.WcatT = (bf16_t*)(ws + X_WCAT); a.Q.WoT = (bf16_t*)(ws + X_WOT); a.Q.WsT = (bf16_t*)(ws + X_WST); a.Q.WcombT = (bf16_t*)(ws + X_WCOMB); a.Q.WiqT = (bf16_t*)(ws + X_WIQT);
    a.Q.wuk = (bf16_t*)(ws + X_WUK); a.Q.wuq = (bf16_t*)(ws + X_WUQ); a.Q.wbT = (bf16_t*)(ws + X_WBT); a.Q.wuv = (bf16_t*)(ws + X_WUV); a.Q.skb = (bf16_t*)(ws + X_SKB); a.Q.pwq = (bf16_t*)(ws + X_PWQ);
    a.Q.S = (float*)(ws + W::A0 + (size_t)64 * 1048576);
    a.Q.Ub = (unsigned char*)(ws + W::A0); a.Q.Vb = (unsigned char*)(ws + W::A0 + (size_t)16 * 1048576);
    a.Q.EXPI2 = (int*)(ws + X_EXPI); a.Q.GATE2 = (float*)(ws + X_GATE);
    a.P.ATT = (bf16_t*)(ws + W::A0); a.P.W = (bf16_t*)(ws + W::A0 + (size_t)16 * 1048576);
    a.Q.QA0 = (bf16_t*)(ws + W::A0 + (size_t)48 * 1048576); a.Q.QA1 = (bf16_t*)(ws + W::A3); a.Q.qword = (unsigned*)d_ws + 6144;
    a.P.Z = (bf16_t*)(ws + W::A1); a.P.GA = (bf16_t*)(ws + W::A1 + (size_t)32 * 1048576); a.P.GB = (bf16_t*)(ws + W::A1 + (size_t)64 * 1048576);
    a.Q.RAWB = (bf16_t*)((char*)d_out + (size_t)32 * 1048576);
    a.P2 = a.P; a.P2.EXPI = a.Q.EXPI2; a.P2.GATE = a.Q.GATE2; a.P2.SCRP = (float*)((char*)d_out + W::d_SCR); a.P2.S = a.Q.S; a.ctl = (unsigned*)d_ws;
    hipLaunchKernelGGL(mega, dim3(grid), dim3(NTHR), LDS_BYTES, stream, a);
}
```
